# Optimizing an MI355X kernel written in HIP

```python
import math
import jax
import jax.numpy as jnp
from jax import lax
import numpy as np

D_MODEL = 1024
BATCH = 16
SEQ = 256
DEPTH = 2
DEC_BATCH = 4
DEC_SEQ = 1024
PAST_LEN = 256

GRID_W = 64
D_MIX = 1024
Q_BLK = 128
ROPE_BASE = 10000.0
NORM_EPS = 1e-6
NEG_INF = -1e30
F32 = jnp.float32
W_A = 256
H_A = 4
N_A = 64
LORA_W = 64
LORA_A = 64
GN_EPS = 64e-5
W_B = 256
H_B = 4
KV_B = 2
G_B = 2
HD_B = 64
WINDOW = 128
W_C = 256
NB_C = 4
BS_C = 64
CONV_W = 4
C_RG = 8.0
W_D = 256
H_D = 4
DQ_D = 32
HD_D = 64

PROJ_SIZES = (W_A, W_A, W_A, LORA_W, LORA_A, W_A,
              H_B * HD_B, KV_B * HD_B, KV_B * HD_B, W_B,
              W_C, W_C,
              H_D * 2 * DQ_D, H_D * 2 * DQ_D, H_D * HD_D, W_D)
P_TOTAL = 3456

kernel_name = 'hybrid_diffusion_prefix_step'


def split_cols(p):
    idx = np.cumsum(PROJ_SIZES)[:-1].tolist()
    return jnp.split(p, idx, axis=-1)


def rms_norm(x, g, eps=NORM_EPS):
    xf = x.astype(F32)
    y = xf * lax.rsqrt(jnp.mean(jnp.square(xf), -1, keepdims=True) + eps)
    return (y * g.astype(F32)).astype(x.dtype)


def grid_positions(n_tok):
    rows = n_tok // GRID_W
    row = jnp.repeat(jnp.arange(rows), GRID_W).astype(F32)
    col = jnp.tile(jnp.arange(GRID_W), rows).astype(F32)
    return row, col


def rope_1d(x, pos):
    d = x.shape[-1]
    inv = ROPE_BASE ** (-jnp.arange(0, d, 2, dtype=F32) / d)
    ang = pos[:, None] * inv[None]
    shape = (1, x.shape[1]) + (1,) * (x.ndim - 3) + (d // 2,)
    cos = jnp.cos(ang).reshape(shape)
    sin = jnp.sin(ang).reshape(shape)
    xf = x.astype(F32)
    x1, x2 = xf[..., :d // 2], xf[..., d // 2:]
    return jnp.concatenate([x1 * cos - x2 * sin, x1 * sin + x2 * cos], -1).astype(x.dtype)


def rope_2d(x, row, col):
    h = x.shape[-1] // 2
    return jnp.concatenate([rope_1d(x[..., :h], row), rope_1d(x[..., h:], col)], -1)


def over_query_blocks(fn, q):
    b, t = q.shape[:2]
    nb = t // Q_BLK
    qb = jnp.moveaxis(q.reshape((b, nb, Q_BLK) + q.shape[2:]), 1, 0)
    out = lax.map(lambda a: fn(a[0], a[1]), (jnp.arange(nb), qb))
    return jnp.moveaxis(out, 0, 1).reshape((b, t) + out.shape[3:])


def wkv7_scan(r, w, k, v, kk, a, s0, reverse):
    def step(s, inp):
        r_t, w_t, k_t, v_t, kk_t, a_t = inp
        sa = jnp.einsum('bhij,bhj->bhi', s, -kk_t)
        s = (s * w_t[:, :, None, :] + sa[..., None] * (kk_t * a_t)[:, :, None, :]
             + v_t[..., None] * k_t[:, :, None, :])
        return s, jnp.einsum('bhij,bhj->bhi', s, r_t)
    xs = tuple(jnp.moveaxis(z.astype(F32), 1, 0) for z in (r, w, k, v, kk, a))
    s_fin, y = lax.scan(step, s0.astype(F32), xs, reverse=reverse)
    return s_fin, jnp.moveaxis(y, 0, 1)


def rwkv_branch(r, k, v, wd, ad, lp, s0):
    b, t = r.shape[:2]
    heads = lambda z: z.reshape(b, t, H_A, N_A)
    kk = heads(k * lp['rwkv_k_k']).astype(F32)
    kk = kk * lax.rsqrt(jnp.sum(kk * kk, -1, keepdims=True) + 1e-12)
    wd_t = jnp.tanh(wd)
    ys, finals = [], []
    for d, rev in enumerate((False, True)):
        w_log = -jax.nn.softplus(-(lp['rwkv_w0'][d] + wd_t @ lp['rwkv_w_up'][d]).astype(F32)) - 0.5
        decay = jnp.exp(-jnp.exp(w_log))
        a = jax.nn.sigmoid((lp['rwkv_a0'][d] + ad @ lp['rwkv_a_up'][d]).astype(F32))
        k_d = k.astype(F32) * (1.0 + (a - 1.0) * lp['rwkv_k_a'].astype(F32))
        s_fin, y = wkv7_scan(heads(r), heads(decay), heads(k_d), heads(v), kk, heads(a), s0[:, d], rev)
        ys.append(y)
        finals.append(s_fin)
    y = ys[0] + ys[1]
    mu = jnp.mean(y, -1, keepdims=True)
    var = jnp.mean(jnp.square(y - mu), -1, keepdims=True)
    y = ((y - mu) * lax.rsqrt(var + GN_EPS)).reshape(b, t, W_A) * lp['rwkv_gn_g'].astype(F32) + lp['rwkv_gn_b'].astype(F32)
    bonus = jnp.sum(heads(r).astype(F32) * heads(k).astype(F32) * lp['rwkv_r_k'].astype(F32), -1, keepdims=True) * heads(v).astype(F32)
    y = y + bonus.reshape(b, t, W_A)
    return y.astype(r.dtype), jnp.stack(finals, 1)


def sink_gqa_block(qj, key_sets, sink):
    scale = HD_B ** -0.5
    logits = []
    for k, v, m in key_sets:
        s = jnp.einsum('bqhgd,bkhd->bhgqk', qj, k).astype(F32) * scale
        if m is not None:
            s = jnp.where(m, s, NEG_INF)
        logits.append(s)
    b, q = qj.shape[:2]
    sink_l = jnp.broadcast_to(sink.astype(F32).reshape(1, KV_B, G_B, 1, 1), (b, KV_B, G_B, q, 1))
    p = jax.nn.softmax(jnp.concatenate(logits + [sink_l], -1), -1)
    out, off = None, 0
    for k, v, m in key_sets:
        n = k.shape[1]
        o = jnp.einsum('bhgqk,bkhd->bqhgd', p[..., off:off + n].astype(v.dtype), v)
        out = o if out is None else out + o
        off += n
    return out


def window_latent(q, k, v, ck, cv, sink):
    t = q.shape[1]
    pad = ((0, 0), (Q_BLK, Q_BLK), (0, 0), (0, 0))
    kp = jnp.pad(k, pad)
    vp = jnp.pad(v, pad)

    def blk(j, qj):
        kj = lax.dynamic_slice_in_dim(kp, j * Q_BLK, 3 * Q_BLK, axis=1)
        vj = lax.dynamic_slice_in_dim(vp, j * Q_BLK, 3 * Q_BLK, axis=1)
        qpos = j * Q_BLK + jnp.arange(Q_BLK)
        kpos = (j - 1) * Q_BLK + jnp.arange(3 * Q_BLK)
        valid = (jnp.abs(kpos[None] - qpos[:, None]) <= WINDOW) & (kpos[None] >= 0) & (kpos[None] < t)
        return sink_gqa_block(qj, [(kj, vj, valid), (ck, cv, None)], sink)
    return over_query_blocks(blk, q)


def conv_centred(x, w, bias):
    t = x.shape[1]
    xp = jnp.pad(x, ((0, 0), (CONV_W // 2, CONV_W - 1 - CONV_W // 2), (0, 0)))
    y = bias + xp[:, 0:t] * w[0]
    for i in range(1, CONV_W):
        y = y + xp[:, i:i + t] * w[i]
    return y


def lin_combine(e1, e2):
    a1, b1 = e1
    a2, b2 = e2
    return a1 * a2, a2 * b1 + b2


def rglru_branch(x, lp, h0):
    b, t = x.shape[:2]
    x = conv_centred(x, lp['lru_conv_w'], lp['lru_conv_b'])
    xb = x.reshape(b, t, NB_C, BS_C)
    ys, finals = [], []
    for d, rev in enumerate((False, True)):
        gate_a = jax.nn.sigmoid((jnp.einsum('btnd,nde->btne', xb, lp['lru_wa'][d]).reshape(b, t, W_C) + lp['lru_ba'][d]).astype(F32))
        gate_x = jax.nn.sigmoid((jnp.einsum('btnd,nde->btne', xb, lp['lru_wx'][d]).reshape(b, t, W_C) + lp['lru_bx'][d]).astype(F32))
        log_a = -C_RG * gate_a * jax.nn.softplus(-lp['lru_lambda'][d].astype(F32))
        a = jnp.exp(log_a)
        u = jnp.sqrt(-jnp.expm1(2.0 * log_a)) * (gate_x * x.astype(F32))
        a_cum, h = lax.associative_scan(lin_combine, (a, u), reverse=rev, axis=1)
        h = h + a_cum * h0[:, d][:, None].astype(F32)
        ys.append(h)
        finals.append(h[:, 0] if rev else h[:, -1])
    return (ys[0] + ys[1]).astype(x.dtype), jnp.stack(finals, 1)


def diff_block(qj, key_sets, lam):
    s = jnp.concatenate([jnp.einsum('bqhmd,bkhmd->bhmqk', qj, k) for k, _ in key_sets], -1).astype(F32) * (DQ_D ** -0.5)
    p = jax.nn.softmax(s, -1)
    p = p[:, :, 0] - lam * p[:, :, 1]
    out, off = None, 0
    for k, v in key_sets:
        n = k.shape[1]
        o = jnp.einsum('bhqk,bkhd->bqhd', p[..., off:off + n].astype(v.dtype), v)
        out = o if out is None else out + o
        off += n
    return out


def diff_attend(q, key_sets, lp, lam_init):
    b, t = q.shape[:2]
    lq1, lk1, lq2, lk2 = lp['diff_lambda'].astype(F32)
    lam = jnp.exp(jnp.sum(lq1 * lk1)) - jnp.exp(jnp.sum(lq2 * lk2)) + lam_init
    y = over_query_blocks(lambda j, qj: diff_block(qj, key_sets, lam), q)
    y = rms_norm(y, lp['diff_subln_g']) * (1.0 - lam_init)
    return y.reshape(b, t, W_D)


def mixer(h, lp, lam_init, cache):
    b, t = h.shape[:2]
    (ar, ak, av, awd, aad, ag, bq, bk, bv, bg, cx, cg, dq, dk, dv, dg) = split_cols(h @ lp['w_in'])
    latent = cache is not None
    s0_a = cache['rwkv'] if latent else jnp.zeros((b, 2, H_A, N_A, N_A), F32)
    ya, st_a = rwkv_branch(ar, ak, av, awd, aad, lp, s0_a)
    bq = bq.reshape(b, t, KV_B, G_B, HD_B)
    bk = bk.reshape(b, t, KV_B, HD_B)
    bv = bv.reshape(b, t, KV_B, HD_B)
    dq = dq.reshape(b, t, H_D, 2, DQ_D)
    dk = dk.reshape(b, t, H_D, 2, DQ_D)
    dv = dv.reshape(b, t, H_D, HD_D)
    if latent:
        row, col = grid_positions(t)
        yb = window_latent(rope_2d(bq, row, col), rope_2d(bk, row, col), bv,
                           cache['win_k'], cache['win_v'], lp['win_sink'])
        yd = diff_attend(rope_2d(dq, row, col),
                         [(rope_2d(dk, row, col), dv), (cache['diff_k'], cache['diff_v'])], lp, lam_init)
    else:
        yb = over_query_blocks(lambda j, qj: sink_gqa_block(qj, [(bk, bv, None)], lp['win_sink']), bq)
        yd = diff_attend(dq, [(dk, dv)], lp, lam_init)
    h0_c = cache['lru'] if latent else jnp.zeros((b, 2, W_C), F32)
    yc, st_c = rglru_branch(cx, lp, h0_c)
    y = jnp.concatenate([ya * jax.nn.silu(ag), yb.reshape(b, t, W_B) * jax.nn.silu(bg),
                         yc * jax.nn.silu(cg), yd * jax.nn.silu(dg)], -1) @ lp['w_out']
    new_cache = None if latent else (bk, bv, dk, dv, st_a, st_c)
    return y, new_cache


def layer(x, cvec, lp, lam_init, cache):
    mod = jax.nn.silu(cvec) @ lp['w_mod'] + lp['b_mod']
    shift, scale, gate = jnp.split(mod[:, None, :], 3, -1)
    h = rms_norm(x, lp['g_pre']) * (1.0 + scale) + shift
    y, new_cache = mixer(h, lp, lam_init, cache)
    return x + gate * rms_norm(y, lp['g_post']), new_cache


def setup_inputs(seed: int = 0) -> dict:
    key = jax.random.key(seed)
    ks = iter(jax.random.split(key, 48))
    nrm = lambda shape, s=1.0: jax.random.normal(next(ks), shape, F32) * s
    L = DEPTH
    u = jax.random.uniform(next(ks), (L, 2, W_C), F32, 0.9, 0.999)
    sl = u ** (1.0 / C_RG)
    lru_lambda = jnp.log(sl) - jnp.log1p(-sl)
    rwkv_w0 = jax.random.uniform(next(ks), (L, 2, W_A), F32, -6.0, 1.0)
    return {
        'x_prompt': nrm((BATCH, SEQ, D_MODEL)),
        'x_sample': nrm((DEC_BATCH, DEC_SEQ, D_MODEL)),
        'c': nrm((DEC_BATCH, D_MODEL)),
        'cache_win_k': nrm((DEC_BATCH, L, PAST_LEN, KV_B, HD_B)),
        'cache_win_v': nrm((DEC_BATCH, L, PAST_LEN, KV_B, HD_B)),
        'cache_diff_k': nrm((DEC_BATCH, L, PAST_LEN, H_D, 2, DQ_D)),
        'cache_diff_v': nrm((DEC_BATCH, L, PAST_LEN, H_D, HD_D)),
        'state_rwkv': nrm((DEC_BATCH, L, 2, H_A, N_A, N_A), 0.3),
        'state_lru': nrm((DEC_BATCH, L, 2, W_C), 0.5),
        'c_ctx': nrm((D_MODEL,)),
        'w_mod': nrm((L, D_MODEL, 3 * D_MODEL), 0.5 * D_MODEL ** -0.5),
        'b_mod': nrm((L, 3 * D_MODEL), 0.02),
        'g_pre': 1.0 + nrm((L, D_MODEL), 0.02),
        'g_post': 1.0 + nrm((L, D_MODEL), 0.02),
        'w_in': nrm((L, D_MODEL, P_TOTAL), D_MODEL ** -0.5),
        'w_out': nrm((L, D_MIX, D_MODEL), D_MIX ** -0.5),
        'rwkv_w0': rwkv_w0,
        'rwkv_w_up': nrm((L, 2, LORA_W, W_A), 0.1 * LORA_W ** -0.5),
        'rwkv_a0': nrm((L, 2, W_A), 0.1),
        'rwkv_a_up': nrm((L, 2, LORA_A, W_A), 0.1 * LORA_A ** -0.5),
        'rwkv_k_k': 0.85 + nrm((L, W_A), 0.02),
        'rwkv_k_a': 1.0 + nrm((L, W_A), 0.02),
        'rwkv_r_k': nrm((L, H_A, N_A), 0.1),
        'rwkv_gn_g': 1.0 + nrm((L, W_A), 0.02),
        'rwkv_gn_b': nrm((L, W_A), 0.02),
        'win_sink': nrm((L, H_B), 0.5),
        'lru_conv_w': nrm((L, CONV_W, W_C), CONV_W ** -0.5),
        'lru_conv_b': nrm((L, W_C), 0.02),
        'lru_wa': nrm((L, 2, NB_C, BS_C, BS_C), BS_C ** -0.5),
        'lru_ba': nrm((L, 2, W_C), 0.02),
        'lru_wx': nrm((L, 2, NB_C, BS_C, BS_C), BS_C ** -0.5),
        'lru_bx': nrm((L, 2, W_C), 0.02),
        'lru_lambda': lru_lambda,
        'diff_lambda': nrm((L, 4, DQ_D), 0.1),
        'diff_subln_g': 1.0 + nrm((L, HD_D), 0.02),
    }


def reference(x_prompt, x_sample, c, cache_win_k, cache_win_v, cache_diff_k, cache_diff_v, state_rwkv, state_lru,
              c_ctx, w_mod, b_mod, g_pre, g_post, w_in, w_out,
              rwkv_w0, rwkv_w_up, rwkv_a0, rwkv_a_up, rwkv_k_k, rwkv_k_a, rwkv_r_k, rwkv_gn_g, rwkv_gn_b,
              win_sink, lru_conv_w, lru_conv_b, lru_wa, lru_ba, lru_wx, lru_bx, lru_lambda,
              diff_lambda, diff_subln_g):
    y_p = x_prompt
    y_s = x_sample
    ctx_tensors = []
    for l in range(DEPTH):
        lp = dict(w_mod=w_mod[l], b_mod=b_mod[l], g_pre=g_pre[l], g_post=g_post[l], w_in=w_in[l], w_out=w_out[l],
                  rwkv_w0=rwkv_w0[l], rwkv_w_up=rwkv_w_up[l], rwkv_a0=rwkv_a0[l], rwkv_a_up=rwkv_a_up[l],
                  rwkv_k_k=rwkv_k_k[l], rwkv_k_a=rwkv_k_a[l], rwkv_r_k=rwkv_r_k[l],
                  rwkv_gn_g=rwkv_gn_g[l], rwkv_gn_b=rwkv_gn_b[l], win_sink=win_sink[l],
                  lru_conv_w=lru_conv_w[l], lru_conv_b=lru_conv_b[l], lru_wa=lru_wa[l], lru_ba=lru_ba[l],
                  lru_wx=lru_wx[l], lru_bx=lru_bx[l], lru_lambda=lru_lambda[l],
                  diff_lambda=diff_lambda[l], diff_subln_g=diff_subln_g[l])
        lam_init = 0.8 - 0.6 * math.exp(-0.3 * l)
        y_p, nc = layer(y_p, c_ctx[None], lp, lam_init, None)
        ctx_tensors.append(nc)
        layer_cache = dict(win_k=cache_win_k[:, l], win_v=cache_win_v[:, l], diff_k=cache_diff_k[:, l],
                           diff_v=cache_diff_v[:, l], rwkv=state_rwkv[:, l], lru=state_lru[:, l])
        y_s, _ = layer(y_s, c, lp, lam_init, layer_cache)
    new_win_k = jnp.stack([ct[0] for ct in ctx_tensors], 1)
    new_win_v = jnp.stack([ct[1] for ct in ctx_tensors], 1)
    new_diff_k = jnp.stack([ct[2] for ct in ctx_tensors], 1)
    new_diff_v = jnp.stack([ct[3] for ct in ctx_tensors], 1)
    new_state_rwkv = jnp.stack([ct[4] for ct in ctx_tensors], 1)
    new_state_lru = jnp.stack([ct[5] for ct in ctx_tensors], 1)
    return (y_p, y_s, new_win_k, new_win_v, new_diff_k, new_diff_v, new_state_rwkv, new_state_lru)
```

```cpp
#include <hip/hip_runtime.h>
#include <hip/hip_cooperative_groups.h>
#include <cstdio>
#include <cstdint>
namespace cg = cooperative_groups;

typedef unsigned short bf16_t;
typedef short bf16x8 __attribute__((ext_vector_type(8)));
typedef float f32x4 __attribute__((ext_vector_type(4)));
typedef unsigned u32x4 __attribute__((ext_vector_type(4)));
#define DI __device__ __forceinline__

#define O_YP 0
#define O_NWK 8388608
#define O_NWV 9437184
#define O_NDK 10485760
#define O_NDV 12582912
#define O_NSR 14680064
#define O_NSL 15728640

#define NTOK 8192
#define PW 3456

struct Params {
  const float *x_prompt, *x_sample, *c, *cwk, *cwv, *cdk, *cdv, *st_rwkv, *st_lru, *c_ctx, *w_mod, *b_mod, *g_pre, *g_post, *w_in, *w_out;
  const float *rw_w0, *rw_wup, *rw_a0, *rw_aup, *rw_kk, *rw_ka, *rw_rk, *rw_gng, *rw_gnb, *win_sink;
  const float *lru_cw, *lru_cb, *lru_wa, *lru_ba, *lru_wx, *lru_bx, *lru_lam, *diff_lam, *diff_g;
  float* out;
  float* MOD; bf16_t* WINT; bf16_t* WOUTT; bf16_t* CWK; bf16_t* CWVT; bf16_t* CDK; bf16_t* CDVT;
  bf16_t* H; bf16_t* P; float* NKK; float* AW; float* AB; float* AKD; float* YA; float* LA; float* LU;
  bf16_t* QBR; bf16_t* KBR; bf16_t* QDR; bf16_t* KDR; bf16_t* VBT; bf16_t* VDT; float* OB; float* OD; float* Y2;
};

DI bf16_t f2bf(float x) { unsigned u = __float_as_uint(x); u += 0x7fffu + ((u >> 16) & 1u); return (bf16_t)(u >> 16); }
DI float bf2f(bf16_t b) { return __uint_as_float(((unsigned)b) << 16); }
DI unsigned pack2(float a, float b) { return (unsigned)f2bf(a) | ((unsigned)f2bf(b) << 16); }
DI float bflo(unsigned u) { return __uint_as_float(u << 16); }
DI float bfhi(unsigned u) { return __uint_as_float(u & 0xffff0000u); }
DI float wave_sum(float v) { for (int o = 32; o > 0; o >>= 1) v += __shfl_xor(v, o); return v; }
DI float sigmoidf_(float x) { return 1.0f / (1.0f + expf(-x)); }
DI float siluf_(float x) { return x / (1.0f + expf(-x)); }
DI float softplusf_(float z) { return z > 20.f ? z : log1pf(expf(z)); }
DI f32x4 mfma16(bf16x8 a, bf16x8 b, f32x4 c) { return __builtin_amdgcn_mfma_f32_16x16x32_bf16(a, b, c, 0, 0, 0); }
DI float quad_sum(float v) {
  v += __builtin_bit_cast(float, __builtin_amdgcn_update_dpp(0, __builtin_bit_cast(int, v), 0xB1, 0xf, 0xf, true));
  v += __builtin_bit_cast(float, __builtin_amdgcn_update_dpp(0, __builtin_bit_cast(int, v), 0x4E, 0xf, 0xf, true));
  return v;
}

template <typename T> DI float ldval(const T* p);
template <> DI float ldval<float>(const float* p) { return *p; }
template <> DI float ldval<bf16_t>(const bf16_t* p) { return bf2f(*p); }
template <typename T>
DI void transpose_tile(const T* src, int src_ld, bf16_t* dst, int dst_ld, float* lds) {
  const int tid = threadIdx.x;
  for (int i = 0; i < 16; ++i) { int r = (tid >> 6) + 4 * i, c = tid & 63; lds[r * 65 + c] = ldval<T>(src + (size_t)r * src_ld + c); }
  __syncthreads();
  for (int i = 0; i < 16; ++i) { int c = (tid >> 6) + 4 * i, r = tid & 63; dst[(size_t)c * dst_ld + r] = f2bf(lds[r * 65 + c]); }
  __syncthreads();
}

__device__ void phase_prologue(const Params& p, unsigned char* smem) {
  float* lds = (float*)smem;
  const int tid = threadIdx.x;
  const int n0 = 1728, n1 = n0 + 512, n2 = n1 + 192, n3 = n2 + 64, n4 = n3 + 128, n5 = n4 + 192;
  for (int it = blockIdx.x; it < n5; it += gridDim.x) {
    if (it < n0) {
      int l = it / 864, r = it % 864, kt = r / 54, nt = r % 54;
      transpose_tile<float>(p.w_in + (size_t)l * 1024 * PW + (size_t)kt * 64 * PW + nt * 64, PW,
                            p.WINT + (size_t)l * PW * 1024 + (size_t)nt * 64 * 1024 + kt * 64, 1024, lds);
    } else if (it < n1) {
      int i2 = it - n0; int l = i2 / 256, r = i2 % 256, kt = r / 16, nt = r % 16;
      transpose_tile<float>(p.w_out + (size_t)l * 1024 * 1024 + (size_t)kt * 64 * 1024 + nt * 64, 1024,
                            p.WOUTT + (size_t)l * 1024 * 1024 + (size_t)nt * 64 * 1024 + kt * 64, 1024, lds);
    } else if (it < n2) {
      int i2 = it - n1; int l = i2 / 96, nb = (i2 % 96) * 32;
      float* sc = lds;
      float* red = lds + 5 * 1024;
      for (int i = tid; i < 5 * 1024; i += 256) { int v = i >> 10, k = i & 1023; float x = v == 0 ? p.c_ctx[k] : p.c[(v - 1) * 1024 + k]; sc[i] = siluf_(x); }
      __syncthreads();
      int n = tid & 31, kg = tid >> 5;
      float a0 = 0, a1 = 0, a2 = 0, a3 = 0, a4 = 0;
      const float* wp = p.w_mod + (size_t)l * 1024 * 3072 + nb + n;
      for (int k = kg * 128; k < kg * 128 + 128; ++k) {
        float w = wp[(size_t)k * 3072];
        a0 += sc[k] * w; a1 += sc[1024 + k] * w; a2 += sc[2048 + k] * w; a3 += sc[3072 + k] * w; a4 += sc[4096 + k] * w;
      }
      red[(kg * 5 + 0) * 32 + n] = a0; red[(kg * 5 + 1) * 32 + n] = a1; red[(kg * 5 + 2) * 32 + n] = a2; red[(kg * 5 + 3) * 32 + n] = a3; red[(kg * 5 + 4) * 32 + n] = a4;
      __syncthreads();
      if (tid < 160) { int v = tid >> 5, nn = tid & 31; float s = p.b_mod[l * 3072 + nb + nn]; for (int q = 0; q < 8; ++q) s += red[(q * 5 + v) * 32 + nn]; p.MOD[(size_t)(l * 5 + v) * 3072 + nb + nn] = s; }
      __syncthreads();
    } else if (it < n3) {
      int i2 = it - n2; int bl = i2 >> 3, r = i2 & 7, pt = r >> 1, ct = r & 1;
      transpose_tile<float>(p.cwv + (size_t)bl * 256 * 128 + (size_t)pt * 64 * 128 + ct * 64, 128,
                            p.CWVT + (size_t)bl * 128 * 256 + (size_t)ct * 64 * 256 + pt * 64, 256, lds);
    } else if (it < n4) {
      int i2 = it - n3; int bl = i2 >> 4, r = i2 & 15, pt = r >> 2, ct = r & 3;
      transpose_tile<float>(p.cdv + (size_t)bl * 256 * 256 + (size_t)pt * 64 * 256 + ct * 64, 256,
                            p.CDVT + (size_t)bl * 256 * 256 + (size_t)ct * 64 * 256 + pt * 64, 256, lds);
    } else {
      int i2 = it - n4;
      const float* src; bf16_t* dst;
      if (i2 < 64) { src = p.cwk + (size_t)i2 * 4096; dst = p.CWK + (size_t)i2 * 4096; }
      else { src = p.cdk + (size_t)(i2 - 64) * 4096; dst = p.CDK + (size_t)(i2 - 64) * 4096; }
      for (int i = tid * 4; i < 4096; i += 1024) { float4 v = *(const float4*)(src + i); uint2 o; o.x = pack2(v.x, v.y); o.y = pack2(v.z, v.w); *(uint2*)(dst + i) = o; }
    }
  }
}

__device__ void phase_norm(const Params& p, int stage) {
  const int lane = threadIdx.x & 63, wave = threadIdx.x >> 6;
  for (int tok = blockIdx.x * 4 + wave; tok < NTOK; tok += gridDim.x * 4) {
    const int mv = tok < 4096 ? 0 : 1 + ((tok - 4096) >> 10);
    const float* xin;
    if (stage <= 1) xin = tok < 4096 ? p.x_prompt + (size_t)tok * 1024 : p.x_sample + (size_t)(tok - 4096) * 1024;
    else xin = p.out + (size_t)tok * 1024;
    float4 x[4];
#pragma unroll
    for (int i = 0; i < 4; ++i) x[i] = *(const float4*)(xin + i * 256 + lane * 4);
    if (stage >= 1) {
      const int lp = stage - 1;
      float4 y[4]; float ss = 0.f;
#pragma unroll
      for (int i = 0; i < 4; ++i) { y[i] = *(const float4*)(p.Y2 + (size_t)tok * 1024 + i * 256 + lane * 4); ss += y[i].x * y[i].x + y[i].y * y[i].y + y[i].z * y[i].z + y[i].w * y[i].w; }
      ss = wave_sum(ss);
      const float rstd = rsqrtf(ss * (1.0f / 1024.0f) + 1e-6f);
      const float* gate = p.MOD + (size_t)(lp * 5 + mv) * 3072 + 2048;
      const float* gp = p.g_post + lp * 1024;
#pragma unroll
      for (int i = 0; i < 4; ++i) {
        const int col = i * 256 + lane * 4;
        float4 g = *(const float4*)(gate + col), q = *(const float4*)(gp + col);
        x[i].x += g.x * (y[i].x * rstd * q.x); x[i].y += g.y * (y[i].y * rstd * q.y); x[i].z += g.z * (y[i].z * rstd * q.z); x[i].w += g.w * (y[i].w * rstd * q.w);
        *(float4*)(p.out + (size_t)tok * 1024 + col) = x[i];
      }
    }
    if (stage <= 1) {
      const int l = stage;
      float ss = 0.f;
#pragma unroll
      for (int i = 0; i < 4; ++i) ss += x[i].x * x[i].x + x[i].y * x[i].y + x[i].z * x[i].z + x[i].w * x[i].w;
      ss = wave_sum(ss);
      const float rstd = rsqrtf(ss * (1.0f / 1024.0f) + 1e-6f);
      const float* md = p.MOD + (size_t)(l * 5 + mv) * 3072;
      const float* gp = p.g_pre + l * 1024;
#pragma unroll
      for (int i = 0; i < 4; ++i) {
        const int col = i * 256 + lane * 4;
        float4 sh = *(const float4*)(md + col), sc = *(const float4*)(md + 1024 + col), g = *(const float4*)(gp + col);
        float h0 = x[i].x * rstd * g.x * (1.f + sc.x) + sh.x, h1 = x[i].y * rstd * g.y * (1.f + sc.y) + sh.y;
        float h2 = x[i].z * rstd * g.z * (1.f + sc.z) + sh.z, h3 = x[i].w * rstd * g.w * (1.f + sc.w) + sh.w;
        uint2 o; o.x = pack2(h0, h1); o.y = pack2(h2, h3);
        *(uint2*)(p.H + (size_t)tok * 1024 + col) = o;
      }
    }
  }
}

template <int MODE>
__device__ void phase_gemm(const Params& p, int l, unsigned char* smem) {
  const bf16_t* A = p.H;
  const bf16_t* Bt = MODE == 0 ? p.WINT + (size_t)l * PW * 1024 : p.WOUTT + (size_t)l * 1024 * 1024;
  const int N = MODE == 0 ? PW : 1024, K = 1024;
  const int NTN = N / 128, NT = 64 * NTN;
  bf16_t* As = (bf16_t*)smem; bf16_t* Bs = As + 128 * 72;
  const int tid = threadIdx.x, lane = tid & 63, wave = tid >> 6, wm = wave >> 1, wn = wave & 1, r16 = lane & 15, quad = lane >> 4;
  for (int tile = blockIdx.x; tile < NT; tile += gridDim.x) {
    const int tm = tile / NTN, tn = tile % NTN, m0 = tm * 128, n0 = tn * 128;
    f32x4 acc[4][4];
#pragma unroll
    for (int i = 0; i < 4; ++i)
#pragma unroll
      for (int j = 0; j < 4; ++j) acc[i][j] = (f32x4){0.f, 0.f, 0.f, 0.f};
    u32x4 ra[4], rb[4];
#pragma unroll
    for (int i = 0; i < 4; ++i) { int id = tid + 256 * i, row = id >> 3, c8 = id & 7; ra[i] = *(const u32x4*)(A + (size_t)(m0 + row) * K + c8 * 8); rb[i] = *(const u32x4*)(Bt + (size_t)(n0 + row) * K + c8 * 8); }
#pragma unroll
    for (int i = 0; i < 4; ++i) { int id = tid + 256 * i, row = id >> 3, c8 = id & 7; *(u32x4*)(As + row * 72 + c8 * 8) = ra[i]; *(u32x4*)(Bs + row * 72 + c8 * 8) = rb[i]; }
    __syncthreads();
    for (int kt = 0; kt < 16; ++kt) {
      if (kt + 1 < 16) {
#pragma unroll
        for (int i = 0; i < 4; ++i) { int id = tid + 256 * i, row = id >> 3, c8 = id & 7; ra[i] = *(const u32x4*)(A + (size_t)(m0 + row) * K + (kt + 1) * 64 + c8 * 8); rb[i] = *(const u32x4*)(Bt + (size_t)(n0 + row) * K + (kt + 1) * 64 + c8 * 8); }
      }
#pragma unroll
      for (int ks = 0; ks < 2; ++ks) {
        bf16x8 af[4], bfr[4];
#pragma unroll
        for (int i = 0; i < 4; ++i) {
          af[i] = *(const bf16x8*)(As + (wm * 64 + i * 16 + r16) * 72 + ks * 32 + quad * 8);
          bfr[i] = *(const bf16x8*)(Bs + (wn * 64 + i * 16 + r16) * 72 + ks * 32 + quad * 8);
        }
#pragma unroll
        for (int mi = 0; mi < 4; ++mi)
#pragma unroll
          for (int ni = 0; ni < 4; ++ni) acc[mi][ni] = mfma16(bfr[ni], af[mi], acc[mi][ni]);
      }
      __syncthreads();
      if (kt + 1 < 16) {
#pragma unroll
        for (int i = 0; i < 4; ++i) { int id = tid + 256 * i, row = id >> 3, c8 = id & 7; *(u32x4*)(As + row * 72 + c8 * 8) = ra[i]; *(u32x4*)(Bs + row * 72 + c8 * 8) = rb[i]; }
        __syncthreads();
      }
    }
#pragma unroll
    for (int mi = 0; mi < 4; ++mi)
#pragma unroll
      for (int ni = 0; ni < 4; ++ni) {
        const int m = m0 + wm * 64 + mi * 16 + r16, n = n0 + wn * 64 + ni * 16 + quad * 4;
        const f32x4 v = acc[mi][ni];
        if (MODE == 0) {
          uint2 o; o.x = pack2(v[0], v[1]); o.y = pack2(v[2], v[3]);
          *(uint2*)(p.P + (size_t)m * PW + n) = o;
          if (m0 < 4096) {
            const int row = ((m >> 8) * 2 + l) * 256 + (m & 255);
            float* dst = nullptr;
            if (tn == 11) dst = p.out + O_NWK + (size_t)row * 128 + (n - 1408);
            else if (tn == 12) dst = p.out + O_NWV + (size_t)row * 128 + (n - 1536);
            else if (tn == 21 || tn == 22) dst = p.out + O_NDK + (size_t)row * 256 + (n - 2688);
            else if (tn == 23 || tn == 24) dst = p.out + O_NDV + (size_t)row * 256 + (n - 2944);
            if (dst) *(float4*)dst = (float4){v[0], v[1], v[2], v[3]};
          }
        } else {
          *(float4*)(p.Y2 + (size_t)m * 1024 + n) = (float4){v[0], v[1], v[2], v[3]};
        }
      }
  }
}

__device__ void pre_rwkv(const Params& p, int l, int item, unsigned char* smem) {
  float* s_wd = (float*)smem;
  float* s_ad = s_wd + 16 * 64;
  const int tid = threadIdx.x, c = tid;
  const int tok0 = item * 16;
  for (int i = 0; i < 8; ++i) {
    int idx = tid + 256 * i, tt = idx >> 7, m = idx & 127;
    float v = bf2f(p.P[(size_t)(tok0 + tt) * PW + 768 + m]);
    if (m < 64) s_wd[tt * 64 + m] = tanhf(v); else s_ad[tt * 64 + m - 64] = v;
  }
  __syncthreads();
  float aw0[16], aw1[16], aa0[16], aa1[16];
#pragma unroll
  for (int t = 0; t < 16; ++t) { aw0[t] = 0.f; aw1[t] = 0.f; aa0[t] = 0.f; aa1[t] = 0.f; }
  const float* wu0 = p.rw_wup + (size_t)(l * 2 + 0) * 64 * 256 + c;
  const float* wu1 = p.rw_wup + (size_t)(l * 2 + 1) * 64 * 256 + c;
  const float* au0 = p.rw_aup + (size_t)(l * 2 + 0) * 64 * 256 + c;
  const float* au1 = p.rw_aup + (size_t)(l * 2 + 1) * 64 * 256 + c;
  for (int m = 0; m < 64; m += 4) {
    float w0[4], w1[4], a0[4], a1[4];
#pragma unroll
    for (int q = 0; q < 4; ++q) { w0[q] = wu0[(m + q) * 256]; w1[q] = wu1[(m + q) * 256]; a0[q] = au0[(m + q) * 256]; a1[q] = au1[(m + q) * 256]; }
#pragma unroll
    for (int t = 0; t < 16; ++t) {
      const float4 xv = *(const float4*)(s_wd + t * 64 + m), yv = *(const float4*)(s_ad + t * 64 + m);
      aw0[t] += xv.x * w0[0] + xv.y * w0[1] + xv.z * w0[2] + xv.w * w0[3];
      aw1[t] += xv.x * w1[0] + xv.y * w1[1] + xv.z * w1[2] + xv.w * w1[3];
      aa0[t] += yv.x * a0[0] + yv.y * a0[1] + yv.z * a0[2] + yv.w * a0[3];
      aa1[t] += yv.x * a1[0] + yv.y * a1[1] + yv.z * a1[2] + yv.w * a1[3];
    }
  }
  const float kkc = p.rw_kk[l * 256 + c], kac = p.rw_ka[l * 256 + c];
  const float w00 = p.rw_w0[(l * 2 + 0) * 256 + c], w01 = p.rw_w0[(l * 2 + 1) * 256 + c];
  const float a00 = p.rw_a0[(l * 2 + 0) * 256 + c], a01 = p.rw_a0[(l * 2 + 1) * 256 + c];
#pragma unroll
  for (int t = 0; t < 16; ++t) {
    const int tok = tok0 + t;
    const float k = bf2f(p.P[(size_t)tok * PW + 256 + c]);
    float kk = k * kkc;
    const float ss = wave_sum(kk * kk);
    kk *= rsqrtf(ss + 1e-12f);
    p.NKK[(size_t)tok * 256 + c] = -kk;
#pragma unroll
    for (int d = 0; d < 2; ++d) {
      const float wl = (d ? w01 : w00) + (d ? aw1[t] : aw0[t]);
      const float w_log = -softplusf_(-wl) - 0.5f;
      const float decay = expf(-expf(w_log));
      const float a = sigmoidf_((d ? a01 : a00) + (d ? aa1[t] : aa0[t]));
      const float kd = k * (1.f + (a - 1.f) * kac);
      const size_t o = ((size_t)d * NTOK + tok) * 256 + c;
      p.AW[o] = decay; p.AB[o] = kk * a; p.AKD[o] = kd;
    }
  }
  __syncthreads();
}

__device__ void pre_lru(const Params& p, int l, int item, unsigned char* smem) {
  float* s_xc = (float*)smem;
  const int tid = threadIdx.x, c = tid, n = c >> 6;
  const int tok0 = item * 16;
  int T, sb, t0;
  if (tok0 < 4096) { T = 256; sb = tok0 & ~255; t0 = tok0 & 255; } else { T = 1024; sb = 4096 + ((tok0 - 4096) & ~1023); t0 = (tok0 - 4096) & 1023; }
  {
    float xs[19];
#pragma unroll
    for (int i = 0; i < 19; ++i) { int t = t0 - 2 + i; xs[i] = (t >= 0 && t < T) ? bf2f(p.P[(size_t)(sb + t) * PW + 1920 + c]) : 0.f; }
    const float cw0 = p.lru_cw[(l * 4 + 0) * 256 + c], cw1 = p.lru_cw[(l * 4 + 1) * 256 + c], cw2 = p.lru_cw[(l * 4 + 2) * 256 + c], cw3 = p.lru_cw[(l * 4 + 3) * 256 + c];
    const float cb = p.lru_cb[l * 256 + c];
#pragma unroll
    for (int t = 0; t < 16; ++t) s_xc[t * 256 + c] = cb + cw0 * xs[t] + cw1 * xs[t + 1] + cw2 * xs[t + 2] + cw3 * xs[t + 3];
  }
  __syncthreads();
  float ga0[16], ga1[16], gx0[16], gx1[16];
#pragma unroll
  for (int t = 0; t < 16; ++t) { ga0[t] = 0.f; ga1[t] = 0.f; gx0[t] = 0.f; gx1[t] = 0.f; }
  const int e = c & 63;
  const float* wa0 = p.lru_wa + ((size_t)((l * 2 + 0) * 4 + n) * 64) * 64 + e;
  const float* wa1 = p.lru_wa + ((size_t)((l * 2 + 1) * 4 + n) * 64) * 64 + e;
  const float* wx0 = p.lru_wx + ((size_t)((l * 2 + 0) * 4 + n) * 64) * 64 + e;
  const float* wx1 = p.lru_wx + ((size_t)((l * 2 + 1) * 4 + n) * 64) * 64 + e;
  for (int m = 0; m < 64; m += 4) {
    float a0[4], a1[4], x0[4], x1[4];
#pragma unroll
    for (int q = 0; q < 4; ++q) { a0[q] = wa0[(m + q) * 64]; a1[q] = wa1[(m + q) * 64]; x0[q] = wx0[(m + q) * 64]; x1[q] = wx1[(m + q) * 64]; }
#pragma unroll
    for (int t = 0; t < 16; ++t) {
      const float4 xv = *(const float4*)(s_xc + t * 256 + n * 64 + m);
      ga0[t] += xv.x * a0[0] + xv.y * a0[1] + xv.z * a0[2] + xv.w * a0[3];
      ga1[t] += xv.x * a1[0] + xv.y * a1[1] + xv.z * a1[2] + xv.w * a1[3];
      gx0[t] += xv.x * x0[0] + xv.y * x0[1] + xv.z * x0[2] + xv.w * x0[3];
      gx1[t] += xv.x * x1[0] + xv.y * x1[1] + xv.z * x1[2] + xv.w * x1[3];
    }
  }
  const float ba0 = p.lru_ba[(l * 2 + 0) * 256 + c], ba1 = p.lru_ba[(l * 2 + 1) * 256 + c];
  const float bx0 = p.lru_bx[(l * 2 + 0) * 256 + c], bx1 = p.lru_bx[(l * 2 + 1) * 256 + c];
  const float sp0 = softplusf_(-p.lru_lam[(l * 2 + 0) * 256 + c]), sp1 = softplusf_(-p.lru_lam[(l * 2 + 1) * 256 + c]);
#pragma unroll
  for (int t = 0; t < 16; ++t) {
    const int tok = tok0 + t;
    const float x = s_xc[t * 256 + c];
#pragma unroll
    for (int d = 0; d < 2; ++d) {
      const float ga = sigmoidf_((d ? ga1[t] : ga0[t]) + (d ? ba1 : ba0));
      const float gx = sigmoidf_((d ? gx1[t] : gx0[t]) + (d ? bx1 : bx0));
      const float log_a = -8.0f * ga * (d ? sp1 : sp0);
      const float a = expf(log_a);
      const float u = sqrtf(-expm1f(2.0f * log_a)) * (gx * x);
      const size_t o = ((size_t)d * NTOK + tok) * 256 + c;
      p.LA[o] = a; p.LU[o] = u;
    }
  }
  __syncthreads();
}

__device__ void pre_rope(const Params& p, int item) {
  const int tid = threadIdx.x;
  for (int tt = 0; tt < 16; ++tt) {
    const int ts = item * 16 + tt;
    const int t = ts & 1023;
    const float row = (float)(t >> 6), col = (float)(t & 63);
    const bf16_t* src = p.P + (size_t)(4096 + ts) * PW;
    for (int pp = tid; pp < 448; pp += 256) {
      int scol, d1, d2, half, i; bf16_t* dst; float inv;
      if (pp < 192) {
        int q = pp < 128 ? pp : pp - 128; int vec = q >> 5, pi = q & 31; half = pi >> 4; i = pi & 15;
        d1 = half * 32 + i; d2 = d1 + 16; inv = exp2f(-(float)i * (13.287712379549449f / 16.0f));
        if (pp < 128) { scol = 1152 + vec * 64; dst = p.QBR + (size_t)ts * 256 + vec * 64; }
        else { scol = 1408 + vec * 64; dst = p.KBR + (size_t)ts * 128 + vec * 64; }
      } else {
        int q = pp < 320 ? pp - 192 : pp - 320; int vec = q >> 4, pi = q & 15; half = pi >> 3; i = pi & 7;
        d1 = half * 16 + i; d2 = d1 + 8; inv = exp2f(-(float)i * (13.287712379549449f / 8.0f));
        if (pp < 320) { scol = 2432 + vec * 32; dst = p.QDR + (size_t)ts * 256 + vec * 32; }
        else { scol = 2688 + vec * 32; dst = p.KDR + (size_t)ts * 256 + vec * 32; }
      }
      const float ang = (half ? col : row) * inv;
      float sn, cs; sincosf(ang, &sn, &cs);
      const float x1 = bf2f(src[scol + d1]), x2 = bf2f(src[scol + d2]);
      dst[d1] = f2bf(x1 * cs - x2 * sn); dst[d2] = f2bf(x1 * sn + x2 * cs);
    }
  }
}

__device__ void phase_pre(const Params& p, int l, unsigned char* smem) {
  const int n0 = 512, n1 = n0 + 512, n2 = n1 + 256, n3 = n2 + 256, n4 = n3 + 512;
  for (int it = blockIdx.x; it < n4; it += gridDim.x) {
    if (it < n0) pre_rwkv(p, l, it, smem);
    else if (it < n1) pre_lru(p, l, it - n0, smem);
    else if (it < n2) pre_rope(p, it - n1);
    else if (it < n3) {
      int i2 = it - n2; int tt = i2 >> 1, ct = i2 & 1; int tok0 = tt * 64;
      int T, sb; if (tok0 < 4096) { T = 256; sb = tok0 & ~255; } else { T = 1024; sb = 4096 + ((tok0 - 4096) & ~1023); }
      transpose_tile<bf16_t>(p.P + (size_t)tok0 * PW + 1536 + ct * 64, PW, p.VBT + (size_t)sb * 128 + (size_t)(ct * 64) * T + (tok0 - sb), T, (float*)smem);
    } else {
      int i2 = it - n3; int tt = i2 >> 2, ct = i2 & 3; int tok0 = tt * 64;
      int T, sb; if (tok0 < 4096) { T = 256; sb = tok0 & ~255; } else { T = 1024; sb = 4096 + ((tok0 - 4096) & ~1023); }
      transpose_tile<bf16_t>(p.P + (size_t)tok0 * PW + 2944 + ct * 64, PW, p.VDT + (size_t)sb * 256 + (size_t)(ct * 64) * T + (tok0 - sb), T, (float*)smem);
    }
  }
}

__device__ void rwkv_chain(const Params& p, int l, int chain, unsigned char* smem) {
  const int tid = threadIdx.x, lane = tid & 63, wave = tid >> 6;
  int seq, d, h;
  if (chain < 32) { seq = 16 + (chain >> 3); d = (chain >> 2) & 1; h = chain & 3; }
  else { int c2 = chain - 32; seq = c2 >> 3; d = (c2 >> 2) & 1; h = c2 & 3; }
  const int T = seq < 16 ? 256 : 1024, tokb = seq < 16 ? seq * 256 : 4096 + (seq - 16) * 1024;
  const int g = lane & 3, rl = lane >> 2, i = wave * 16 + rl;
  float S[16];
  if (seq >= 16) {
    const float* s0 = p.st_rwkv + ((((size_t)(seq - 16) * 2 + l) * 2 + d) * 4 + h) * 4096 + i * 64;
#pragma unroll
    for (int m = 0; m < 4; ++m) { float4 t = *(const float4*)(s0 + 4 * (g + 4 * m)); S[4 * m] = t.x; S[4 * m + 1] = t.y; S[4 * m + 2] = t.z; S[4 * m + 3] = t.w; }
  } else {
#pragma unroll
    for (int j = 0; j < 16; ++j) S[j] = 0.f;
  }
  float* buf = (float*)smem;
  const int lvec = (tid >> 4) & 3, lc4 = tid & 15, ls = tid >> 6;
  const float* fsrc = (lvec == 0 ? p.NKK : lvec == 1 ? p.AW + (size_t)d * NTOK * 256 : lvec == 2 ? p.AB + (size_t)d * NTOK * 256 : p.AKD + (size_t)d * NTOK * 256) + h * 64 + lc4 * 4;
  const int bs = tid >> 4, bvec = (tid >> 3) & 1, bc8 = tid & 7;
  const bf16_t* bsrc = p.P + (bvec ? 512 : 0) + h * 64 + bc8 * 8;
  f32x4 rf[4]; u32x4 rb;
  const int nch = T / 16;
  auto gload = [&](int ck) {
#pragma unroll
    for (int i4 = 0; i4 < 4; ++i4) { int step = ck * 16 + ls + 4 * i4; int t = d ? T - 1 - step : step; rf[i4] = *(const f32x4*)(fsrc + (size_t)(tokb + t) * 256); }
    { int step = ck * 16 + bs; int t = d ? T - 1 - step : step; rb = *(const u32x4*)(bsrc + (size_t)(tokb + t) * PW); }
  };
  auto sstore = [&](int bi) {
    float* b = buf + bi * 16 * 384;
#pragma unroll
    for (int i4 = 0; i4 < 4; ++i4) *(f32x4*)(b + (ls + 4 * i4) * 384 + lvec * 64 + lc4 * 4) = rf[i4];
    float* q = b + bs * 384 + (4 + bvec) * 64 + bc8 * 8;
    *(f32x4*)q = (f32x4){bflo(rb.x), bfhi(rb.x), bflo(rb.y), bfhi(rb.y)};
    *(f32x4*)(q + 4) = (f32x4){bflo(rb.z), bfhi(rb.z), bflo(rb.w), bfhi(rb.w)};
  };
  gload(0); sstore(0); __syncthreads();
  for (int ck = 0; ck < nch; ++ck) {
    if (ck + 1 < nch) gload(ck + 1);
    const float* cb = buf + (ck & 1) * 16 * 384;
    for (int s = 0; s < 16; ++s) {
      const float* ob = cb + s * 384;
      float4 nk[4], ww[4], bb[4], kk[4], rr[4];
#pragma unroll
      for (int m = 0; m < 4; ++m) {
        const int off = 4 * (g + 4 * m);
        nk[m] = *(const float4*)(ob + off); ww[m] = *(const float4*)(ob + 64 + off); bb[m] = *(const float4*)(ob + 128 + off);
        kk[m] = *(const float4*)(ob + 192 + off); rr[m] = *(const float4*)(ob + 256 + off);
      }
      const float vi = ob[320 + i];
      float sa = 0.f;
#pragma unroll
      for (int m = 0; m < 4; ++m) sa += S[4 * m] * nk[m].x + S[4 * m + 1] * nk[m].y + S[4 * m + 2] * nk[m].z + S[4 * m + 3] * nk[m].w;
      sa = quad_sum(sa);
      float y = 0.f;
#pragma unroll
      for (int m = 0; m < 4; ++m) {
        S[4 * m] = S[4 * m] * ww[m].x + (sa * bb[m].x + vi * kk[m].x);
        S[4 * m + 1] = S[4 * m + 1] * ww[m].y + (sa * bb[m].y + vi * kk[m].y);
        S[4 * m + 2] = S[4 * m + 2] * ww[m].z + (sa * bb[m].z + vi * kk[m].z);
        S[4 * m + 3] = S[4 * m + 3] * ww[m].w + (sa * bb[m].w + vi * kk[m].w);
        y += S[4 * m] * rr[m].x + S[4 * m + 1] * rr[m].y + S[4 * m + 2] * rr[m].z + S[4 * m + 3] * rr[m].w;
      }
      y = quad_sum(y);
      if (g == 0) { const int step = ck * 16 + s; const int t = d ? T - 1 - step : step; p.YA[((size_t)d * NTOK + tokb + t) * 256 + h * 64 + i] = y; }
    }
    if (ck + 1 < nch) sstore((ck + 1) & 1);
    __syncthreads();
  }
  if (seq < 16) {
    float* so = p.out + O_NSR + ((((size_t)seq * 2 + l) * 2 + d) * 4 + h) * 4096 + i * 64;
#pragma unroll
    for (int m = 0; m < 4; ++m) *(float4*)(so + 4 * (g + 4 * m)) = (float4){S[4 * m], S[4 * m + 1], S[4 * m + 2], S[4 * m + 3]};
  }
}

__device__ void lru_scan(const Params& p, int l, int item) {
  const int c = threadIdx.x;
  int seq, d;
  if (item < 8) { seq = 16 + (item >> 1); d = item & 1; } else { seq = (item - 8) >> 1; d = item & 1; }
  const int T = seq < 16 ? 256 : 1024, tokb = seq < 16 ? seq * 256 : 4096 + (seq - 16) * 1024;
  float h = seq >= 16 ? p.st_lru[(((seq - 16) * 2 + l) * 2 + d) * 256 + c] : 0.f;
  const float* la = p.LA + (size_t)d * NTOK * 256 + c; float* lu = p.LU + (size_t)d * NTOK * 256 + c;
  for (int step = 0; step < T; step += 8) {
    float a[8], u[8];
#pragma unroll
    for (int k = 0; k < 8; ++k) { int t = d ? T - 1 - (step + k) : step + k; size_t idx = (size_t)(tokb + t) * 256; a[k] = la[idx]; u[k] = lu[idx]; }
#pragma unroll
    for (int k = 0; k < 8; ++k) { int t = d ? T - 1 - (step + k) : step + k; size_t idx = (size_t)(tokb + t) * 256; h = a[k] * h + u[k]; lu[idx] = h; }
  }
  if (seq < 16) p.out[O_NSL + ((seq * 2 + l) * 2 + d) * 256 + c] = h;
}

template <bool DIFF>
DI void attn_keytile(const bf16_t* Kp, int kstride, const bf16_t* Vtp, int vstride, const bf16x8 (&qf)[2], float scale_log2,
                     bool masked, int kpos0, int qpos, float (&m)[2], float (&lsum)[2], f32x4 (&o)[2][4], int lane) {
  const int r16 = lane & 15, quad = lane >> 4;
  constexpr int NS = DIFF ? 2 : 1;
  f32x4 sc[NS][4];
  const f32x4 z4 = {0.f, 0.f, 0.f, 0.f};
#pragma unroll
  for (int kt = 0; kt < 4; ++kt) {
    const int s = kt >> 1, u = kt & 1;
    const int key = 32 * s + 8 * (r16 >> 2) + 4 * u + (r16 & 3);
    const bf16_t* kr = Kp + (size_t)key * kstride + quad * 8;
    const bf16x8 k0 = *(const bf16x8*)kr, k1 = *(const bf16x8*)(kr + 32);
    if (!DIFF) { sc[0][kt] = mfma16(k0, qf[0], z4); sc[0][kt] = mfma16(k1, qf[1], sc[0][kt]); }
    else { sc[0][kt] = mfma16(k0, qf[0], z4); sc[NS - 1][kt] = mfma16(k1, qf[1], z4); }
  }
  bf16x8 pf[NS][2];
#pragma unroll
  for (int st = 0; st < NS; ++st) {
    float mx = -3.0e38f;
#pragma unroll
    for (int kt = 0; kt < 4; ++kt)
#pragma unroll
      for (int r = 0; r < 4; ++r) {
        float x = sc[st][kt][r] * scale_log2;
        if (masked) { const int kp = kpos0 + 32 * (kt >> 1) + 8 * quad + 4 * (kt & 1) + r; const int dd = kp - qpos; if (dd > 128 || dd < -128) x = -1.0e30f; }
        sc[st][kt][r] = x; mx = fmaxf(mx, x);
      }
    mx = fmaxf(mx, __shfl_xor(mx, 16)); mx = fmaxf(mx, __shfl_xor(mx, 32));
    const float mnew = fmaxf(m[st], mx);
    const float alpha = exp2f(m[st] - mnew);
    m[st] = mnew;
    float ps = 0.f;
#pragma unroll
    for (int kt = 0; kt < 4; ++kt)
#pragma unroll
      for (int r = 0; r < 4; ++r) { const float e = exp2f(sc[st][kt][r] - mnew); sc[st][kt][r] = e; ps += e; }
    lsum[st] = lsum[st] * alpha + ps;
#pragma unroll
    for (int dt = 0; dt < 4; ++dt) o[st][dt] *= alpha;
#pragma unroll
    for (int s = 0; s < 2; ++s) {
      bf16x8 t;
#pragma unroll
      for (int j = 0; j < 8; ++j) t[j] = (short)f2bf(sc[st][2 * s + (j >> 2)][j & 3]);
      pf[st][s] = t;
    }
  }
#pragma unroll
  for (int dt = 0; dt < 4; ++dt)
#pragma unroll
    for (int s = 0; s < 2; ++s) {
      const bf16x8 vf = *(const bf16x8*)(Vtp + (size_t)(dt * 16 + r16) * vstride + 32 * s + 8 * quad);
#pragma unroll
      for (int st = 0; st < NS; ++st) o[st][dt] = mfma16(vf, pf[st][s], o[st][dt]);
    }
}

template <bool DIFF>
__device__ void attn_item(const Params& p, int l, bool sample, int sq  , int h, int qt) {
  const int lane = threadIdx.x & 63, wave = threadIdx.x >> 6, r16 = lane & 15, quad = lane >> 4;
  const int T = sample ? 1024 : 256;
  const int tokb = sample ? 4096 + sq * 1024 : sq * 256;
  const int q0 = qt * 64 + wave * 16;
  const int qpos = q0 + r16;
  const int kvh = DIFF ? h : (h >> 1);
  bf16x8 qf[2];
  {
    const bf16_t* qp;
    if (sample) qp = (DIFF ? p.QDR : p.QBR) + (size_t)(sq * 1024 + qpos) * 256 + h * 64;
    else qp = p.P + (size_t)(tokb + qpos) * PW + (DIFF ? 2432 : 1152) + h * 64;
    qf[0] = *(const bf16x8*)(qp + quad * 8); qf[1] = *(const bf16x8*)(qp + 32 + quad * 8);
  }
  float m[2] = {-3.0e38f, -3.0e38f}, lsum[2] = {0.f, 0.f};
  f32x4 o[2][4];
#pragma unroll
  for (int a = 0; a < 2; ++a)
#pragma unroll
    for (int b = 0; b < 4; ++b) o[a][b] = (f32x4){0.f, 0.f, 0.f, 0.f};
  const float scale_log2 = (DIFF ? 0.17677669529663687f : 0.125f) * 1.4426950408889634f;
  if (sample) {
    const int bl = sq * 2 + l;
    const bf16_t* K; const bf16_t* Vt; int ks;
    if (DIFF) { K = p.CDK + (size_t)bl * 256 * 256 + h * 64; ks = 256; Vt = p.CDVT + (size_t)bl * 256 * 256 + (size_t)(h * 64) * 256; }
    else { K = p.CWK + (size_t)bl * 256 * 128 + kvh * 64; ks = 128; Vt = p.CWVT + (size_t)bl * 128 * 256 + (size_t)(kvh * 64) * 256; }
    for (int kb = 0; kb < 256; kb += 64)
      attn_keytile<DIFF>(K + (size_t)kb * ks, ks, Vt + kb, 256, qf, scale_log2, false, 0, 0, m, lsum, o, lane);
  }
  {
    const bf16_t* K; const bf16_t* Vt; int ks;
    if (sample) {
      if (DIFF) { K = p.KDR + (size_t)(sq * 1024) * 256 + h * 64; ks = 256; Vt = p.VDT + (size_t)tokb * 256 + (size_t)(h * 64) * T; }
      else { K = p.KBR + (size_t)(sq * 1024) * 128 + kvh * 64; ks = 128; Vt = p.VBT + (size_t)tokb * 128 + (size_t)(kvh * 64) * T; }
    } else {
      if (DIFF) { K = p.P + (size_t)tokb * PW + 2688 + h * 64; ks = PW; Vt = p.VDT + (size_t)tokb * 256 + (size_t)(h * 64) * T; }
      else { K = p.P + (size_t)tokb * PW + 1408 + kvh * 64; ks = PW; Vt = p.VBT + (size_t)tokb * 128 + (size_t)(kvh * 64) * T; }
    }
    int kb0 = 0, kb1 = T; bool masked = false;
    if (sample && !DIFF) { const int qb = qt * 64; kb0 = qb - 128 < 0 ? 0 : qb - 128; kb1 = qb + 192 > T ? T : qb + 192; masked = true; }
    for (int kb = kb0; kb < kb1; kb += 64)
      attn_keytile<DIFF>(K + (size_t)kb * ks, ks, Vt + kb, T, qf, scale_log2, masked, kb, qpos, m, lsum, o, lane);
  }
  float l0 = lsum[0]; l0 += __shfl_xor(l0, 16); l0 += __shfl_xor(l0, 32);
  const int tok = tokb + qpos;
  if (!DIFF) {
    l0 += exp2f(p.win_sink[l * 4 + h] * 1.4426950408889634f - m[0]);
    const float inv = 1.0f / l0;
#pragma unroll
    for (int dt = 0; dt < 4; ++dt) {
      f32x4 v = o[0][dt] * inv;
      *(float4*)(p.OB + (size_t)tok * 256 + h * 64 + dt * 16 + quad * 4) = (float4){v[0], v[1], v[2], v[3]};
    }
  } else {
    float l1 = lsum[1]; l1 += __shfl_xor(l1, 16); l1 += __shfl_xor(l1, 32);
    float d1 = 0.f, d2 = 0.f;
    const float* dl = p.diff_lam + l * 128;
    for (int j = 0; j < 32; ++j) { d1 += dl[j] * dl[32 + j]; d2 += dl[64 + j] * dl[96 + j]; }
    const float lam_init = 0.8f - 0.6f * expf(-0.3f * (float)l);
    const float lam = expf(d1) - expf(d2) + lam_init;
    const float i0 = 1.0f / l0, i1 = lam / l1;
    f32x4 v[4]; float ss = 0.f;
#pragma unroll
    for (int dt = 0; dt < 4; ++dt) { v[dt] = o[0][dt] * i0 - o[1][dt] * i1; ss += v[dt][0] * v[dt][0] + v[dt][1] * v[dt][1] + v[dt][2] * v[dt][2] + v[dt][3] * v[dt][3]; }
    ss += __shfl_xor(ss, 16); ss += __shfl_xor(ss, 32);
    const float rstd = rsqrtf(ss * (1.0f / 64.0f) + 1e-6f) * (1.0f - lam_init);
#pragma unroll
    for (int dt = 0; dt < 4; ++dt) {
      const float4 g = *(const float4*)(p.diff_g + l * 64 + dt * 16 + quad * 4);
      *(float4*)(p.OD + (size_t)tok * 256 + h * 64 + dt * 16 + quad * 4) = (float4){v[dt][0] * rstd * g.x, v[dt][1] * rstd * g.y, v[dt][2] * rstd * g.z, v[dt][3] * rstd * g.w};
    }
  }
}

__device__ void mix_other(const Params& p, int l, int it) {
  if (it < 256) { attn_item<true>(p, l, true, it >> 6, (it >> 4) & 3, it & 15); return; }
  it -= 256;
  if (it < 40) { lru_scan(p, l, it); return; }
  it -= 40;
  if (it < 256) { attn_item<false>(p, l, true, it >> 6, (it >> 4) & 3, it & 15); return; }
  it -= 256;
  if (it < 256) { attn_item<true>(p, l, false, it >> 4, (it >> 2) & 3, it & 3); return; }
  it -= 256;
  attn_item<false>(p, l, false, it >> 4, (it >> 2) & 3, it & 3);
}

__device__ void phase_mix(const Params& p, int l, unsigned char* smem) {
  const int NCH = 160, NOTH = 1064;
  const int G = gridDim.x, b = blockIdx.x;
  if (G >= NCH + 64) {
    if (b < NCH) rwkv_chain(p, l, b, smem);
    else for (int it = b - NCH; it < NOTH; it += G - NCH) mix_other(p, l, it);
  } else {
    for (int it = b; it < NCH + NOTH; it += G) { if (it < NCH) rwkv_chain(p, l, it, smem); else mix_other(p, l, it - NCH); }
  }
}

DI float sum16(float v) { v += __shfl_xor(v, 1); v += __shfl_xor(v, 2); v += __shfl_xor(v, 4); v += __shfl_xor(v, 8); return v; }
DI void ld4bf(const bf16_t* q, float (&o)[4]) { uint2 u = *(const uint2*)q; o[0] = bflo(u.x); o[1] = bfhi(u.x); o[2] = bflo(u.y); o[3] = bfhi(u.y); }
DI void st4bf(bf16_t* q, const float (&v)[4]) { uint2 u; u.x = pack2(v[0], v[1]); u.y = pack2(v[2], v[3]); *(uint2*)q = u; }

__device__ void phase_post(const Params& p, int l) {
  const int lane = threadIdx.x & 63, wave = threadIdx.x >> 6;
  const int c = lane * 4;
  for (int tok = blockIdx.x * 4 + wave; tok < NTOK; tok += gridDim.x * 4) {
    const bf16_t* pr = p.P + (size_t)tok * PW;
    float out[4], g[4];
    {
      const float4 y0 = *(const float4*)(p.YA + (size_t)tok * 256 + c), y1 = *(const float4*)(p.YA + ((size_t)NTOK + tok) * 256 + c);
      float y[4] = {y0.x + y1.x, y0.y + y1.y, y0.z + y1.z, y0.w + y1.w};
      const float mu = sum16(y[0] + y[1] + y[2] + y[3]) * (1.0f / 64.0f);
      float dv[4] = {y[0] - mu, y[1] - mu, y[2] - mu, y[3] - mu};
      const float var = sum16(dv[0] * dv[0] + dv[1] * dv[1] + dv[2] * dv[2] + dv[3] * dv[3]) * (1.0f / 64.0f);
      const float rstd = rsqrtf(var + 64e-5f);
      float r[4], k[4], v[4];
      ld4bf(pr + c, r); ld4bf(pr + 256 + c, k); ld4bf(pr + 512 + c, v); ld4bf(pr + 896 + c, g);
      const float4 rk = *(const float4*)(p.rw_rk + l * 256 + c), gg = *(const float4*)(p.rw_gng + l * 256 + c), gb = *(const float4*)(p.rw_gnb + l * 256 + c);
      const float bs = sum16(r[0] * k[0] * rk.x + r[1] * k[1] * rk.y + r[2] * k[2] * rk.z + r[3] * k[3] * rk.w);
      out[0] = (dv[0] * rstd * gg.x + gb.x + bs * v[0]) * siluf_(g[0]);
      out[1] = (dv[1] * rstd * gg.y + gb.y + bs * v[1]) * siluf_(g[1]);
      out[2] = (dv[2] * rstd * gg.z + gb.z + bs * v[2]) * siluf_(g[2]);
      out[3] = (dv[3] * rstd * gg.w + gb.w + bs * v[3]) * siluf_(g[3]);
      st4bf(p.H + (size_t)tok * 1024 + c, out);
    }
    {
      const float4 y = *(const float4*)(p.OB + (size_t)tok * 256 + c);
      ld4bf(pr + 1664 + c, g);
      out[0] = y.x * siluf_(g[0]); out[1] = y.y * siluf_(g[1]); out[2] = y.z * siluf_(g[2]); out[3] = y.w * siluf_(g[3]);
      st4bf(p.H + (size_t)tok * 1024 + 256 + c, out);
    }
    {
      const float4 y0 = *(const float4*)(p.LU + (size_t)tok * 256 + c), y1 = *(const float4*)(p.LU + ((size_t)NTOK + tok) * 256 + c);
      ld4bf(pr + 2176 + c, g);
      out[0] = (y0.x + y1.x) * siluf_(g[0]); out[1] = (y0.y + y1.y) * siluf_(g[1]); out[2] = (y0.z + y1.z) * siluf_(g[2]); out[3] = (y0.w + y1.w) * siluf_(g[3]);
      st4bf(p.H + (size_t)tok * 1024 + 512 + c, out);
    }
    {
      const float4 y = *(const float4*)(p.OD + (size_t)tok * 256 + c);
      ld4bf(pr + 3200 + c, g);
      out[0] = y.x * siluf_(g[0]); out[1] = y.y * siluf_(g[1]); out[2] = y.z * siluf_(g[2]); out[3] = y.w * siluf_(g[3]);
      st4bf(p.H + (size_t)tok * 1024 + 768 + c, out);
    }
  }
}

__global__ void __launch_bounds__(256, 1) fwd_megakernel(Params p) {
  __shared__ __attribute__((aligned(16))) unsigned char smem[49152];
  cg::grid_group grid = cg::this_grid();
  phase_prologue(p, smem);
  grid.sync();
  phase_norm(p, 0);
  grid.sync();
  for (int l = 0; l < 2; ++l) {
    phase_gemm<0>(p, l, smem);
    grid.sync();
    phase_pre(p, l, smem);
    grid.sync();
    phase_mix(p, l, smem);
    grid.sync();
    phase_post(p, l);
    grid.sync();
    phase_gemm<1>(p, l, smem);
    grid.sync();
    phase_norm(p, l + 1);
    if (l == 0) grid.sync();
  }
}

extern "C" void kernel_launch(void* const* d_in, const int* in_sizes, int n_in, void* d_out, int out_size, void* d_ws, size_t ws_size, hipStream_t stream) {
  static int grid_blocks = 0;
  if (!grid_blocks) {
    int dev = 0, cus = 0, per_cu = 0;
    hipGetDevice(&dev);
    hipDeviceGetAttribute(&cus, hipDeviceAttributeMultiprocessorCount, dev);
    hipOccupancyMaxActiveBlocksPerMultiprocessor(&per_cu, (const void*)fwd_megakernel, 256, 0);
    if (per_cu < 1) per_cu = 1;
    if (per_cu > 2) per_cu = 2;
    grid_blocks = cus * per_cu;
  }
  Params p{};
  const float** f = (const float**)&p;
  for (int i = 0; i < 35; ++i) f[i] = (const float*)d_in[i];
  p.out = (float*)d_out;
  size_t off = 0;
  auto take = [&](size_t bytes) { void* r = (char*)d_ws + off; off += (bytes + 255) & ~(size_t)255; return r; };
  p.MOD = (float*)take(2 * 5 * 3072 * 4);
  p.WINT = (bf16_t*)take((size_t)2 * PW * 1024 * 2);
  p.WOUTT = (bf16_t*)take((size_t)2 * 1024 * 1024 * 2);
  p.CWK = (bf16_t*)take((size_t)4 * 2 * 256 * 128 * 2);
  p.CWVT = (bf16_t*)take((size_t)4 * 2 * 256 * 128 * 2);
  p.CDK = (bf16_t*)take((size_t)4 * 2 * 256 * 256 * 2);
  p.CDVT = (bf16_t*)take((size_t)4 * 2 * 256 * 256 * 2);
  p.H = (bf16_t*)take((size_t)NTOK * 1024 * 2);
  p.P = (bf16_t*)take((size_t)NTOK * PW * 2);
  p.NKK = (float*)take((size_t)NTOK * 256 * 4);
  p.AW = (float*)take((size_t)2 * NTOK * 256 * 4);
  p.AB = (float*)take((size_t)2 * NTOK * 256 * 4);
  p.AKD = (float*)take((size_t)2 * NTOK * 256 * 4);
  p.Y2 = p.NKK;
  p.YA = (float*)take((size_t)2 * NTOK * 256 * 4);
  p.LA = (float*)take((size_t)2 * NTOK * 256 * 4);
  p.LU = (float*)take((size_t)2 * NTOK * 256 * 4);
  p.QBR = (bf16_t*)take((size_t)4096 * 256 * 2);
  p.KBR = (bf16_t*)take((size_t)4096 * 128 * 2);
  p.QDR = (bf16_t*)take((size_t)4096 * 256 * 2);
  p.KDR = (bf16_t*)take((size_t)4096 * 256 * 2);
  p.VBT = (bf16_t*)take((size_t)NTOK * 128 * 2);
  p.VDT = (bf16_t*)take((size_t)NTOK * 256 * 2);
  p.OB = (float*)take((size_t)NTOK * 256 * 4);
  p.OD = (float*)take((size_t)NTOK * 256 * 4);
  if (off > ws_size) { fprintf(stderr, "workspace too small: need %zu have %zu\n", off, ws_size); return; }
  void* args[] = {&p};
  hipError_t e = hipLaunchCooperativeKernel((const void*)fwd_megakernel, dim3(grid_blocks), dim3(256), args, 0, stream);
  if (e != hipSuccess) fprintf(stderr, "cooperative launch failed: %s (grid %d)\n", hipGetErrorString(e), grid_blocks);
}
```

```cpp
#include <hip/hip_runtime.h>
#include <cstdio>
#include <cstdint>

typedef unsigned short bf16_t;
typedef short bf16x8 __attribute__((ext_vector_type(8)));
typedef float f32x4 __attribute__((ext_vector_type(4)));
typedef unsigned u32x4 __attribute__((ext_vector_type(4)));
#define DI __device__ __forceinline__

#define O_YP 0
#define O_NWK 8388608
#define O_NWV 9437184
#define O_NDK 10485760
#define O_NDV 12582912
#define O_NSR 14680064
#define O_NSL 15728640

#define NTOK 8192
#define PW 3456

struct Params {
  const float *x_prompt, *x_sample, *c, *cwk, *cwv, *cdk, *cdv, *st_rwkv, *st_lru, *c_ctx, *w_mod, *b_mod, *g_pre, *g_post, *w_in, *w_out;
  const float *rw_w0, *rw_wup, *rw_a0, *rw_aup, *rw_kk, *rw_ka, *rw_rk, *rw_gng, *rw_gnb, *win_sink;
  const float *lru_cw, *lru_cb, *lru_wa, *lru_ba, *lru_wx, *lru_bx, *lru_lam, *diff_lam, *diff_g;
  float* out;
  float* MOD; bf16_t* WINT; bf16_t* WOUTT; bf16_t* CWK; bf16_t* CWVT; bf16_t* CDK; bf16_t* CDVT;
  bf16_t* H; bf16_t* P; float* NKK; float* AW; float* AB; float* AKD; float* YA; float* LA; float* LU;
  bf16_t* QBR; bf16_t* KBR; bf16_t* QDR; bf16_t* KDR; bf16_t* VBT; bf16_t* VDT; float* OB; float* OD; float* Y2; float* LC; unsigned* bar;
};

DI int tid_opaque() { int t = threadIdx.x; asm volatile("" : "+v"(t)); return t; }
DI bf16_t f2bf(float x) { unsigned u = __float_as_uint(x); u += 0x7fffu + ((u >> 16) & 1u); return (bf16_t)(u >> 16); }
DI float bf2f(bf16_t b) { return __uint_as_float(((unsigned)b) << 16); }
DI unsigned pack2(float a, float b) { return (unsigned)f2bf(a) | ((unsigned)f2bf(b) << 16); }
DI float bflo(unsigned u) { return __uint_as_float(u << 16); }
DI float bfhi(unsigned u) { return __uint_as_float(u & 0xffff0000u); }
DI float wave_sum(float v) { for (int o = 32; o > 0; o >>= 1) v += __shfl_xor(v, o); return v; }
DI float sigmoidf_(float x) { return 1.0f / (1.0f + expf(-x)); }
DI float siluf_(float x) { return x / (1.0f + expf(-x)); }
DI float softplusf_(float z) { return z > 20.f ? z : log1pf(expf(z)); }
DI f32x4 mfma16(bf16x8 a, bf16x8 b, f32x4 c) { return __builtin_amdgcn_mfma_f32_16x16x32_bf16(a, b, c, 0, 0, 0); }
DI float quad_sum(float v) {
  v += __builtin_bit_cast(float, __builtin_amdgcn_update_dpp(0, __builtin_bit_cast(int, v), 0xB1, 0xf, 0xf, true));
  v += __builtin_bit_cast(float, __builtin_amdgcn_update_dpp(0, __builtin_bit_cast(int, v), 0x4E, 0xf, 0xf, true));
  return v;
}


#define XB_TMO      128
#define XB_XCNT(j)  (256  + 64 * (j))
#define XB_XSUB(j)  (1280 + 64 * (j))
#define XB_XGEN(j)  (2304 + 64 * (j))
#define XB_TOP      3328
#define XB_TOPGEN   3392
#define XCD_BAR_WORDS 3456
#define XB_SPIN_CAP (1u << 18)
#define LAS __attribute__((address_space(3)))
DI unsigned xb_ld(unsigned* p)              { return __hip_atomic_load(p, __ATOMIC_RELAXED, __HIP_MEMORY_SCOPE_AGENT); }
DI unsigned xb_add(unsigned* p, unsigned v) { return __hip_atomic_fetch_add(p, v, __ATOMIC_RELAXED, __HIP_MEMORY_SCOPE_AGENT); }
DI unsigned xb_xcc_id() { return (unsigned)__builtin_amdgcn_s_getreg((3 << 11) | 20) & 0xFu; }
#define XB_SPIN(cond, bar) do { unsigned _sp = 0; while (cond) { __builtin_amdgcn_s_sleep(1); \
    if ((++_sp & 255u) == 0u) { if (xb_ld(&(bar)[XB_TMO])) break; if (_sp > XB_SPIN_CAP) { atomicAdd(&(bar)[XB_TMO], 1u); break; } } } } while (0)
struct XcdBarrier { unsigned* bar; unsigned x; volatile LAS unsigned* st; };
DI XcdBarrier xcd_barrier_post(unsigned* bar, volatile LAS unsigned* st) {
    XcdBarrier b; b.bar = bar; b.x = xb_xcc_id(); b.st = st;
    if (threadIdx.x == 0) (void)xb_add(&bar[XB_XCNT(b.x)], 1u);
    return b;
}
DI void xcd_barrier_complete(unsigned* bar, unsigned x, unsigned& nloc, unsigned& nx) {
    const unsigned G = gridDim.x * gridDim.y * gridDim.z;
    unsigned sum, cnt, mine, sp = 0u;
    for (;;) {
        sum = 0u; cnt = 0u; mine = 0u;
#pragma unroll
        for (unsigned j = 0; j < 16; ++j) { const unsigned c = xb_ld(&bar[XB_XCNT(j)]); sum += c; cnt += (c > 0u) ? 1u : 0u; mine = (j == x) ? c : mine; }
        if (sum == G) break;
        __builtin_amdgcn_s_sleep(1);
        if ((++sp & 255u) == 0u) { if (xb_ld(&bar[XB_TMO])) break; if (sp > XB_SPIN_CAP) { atomicAdd(&bar[XB_TMO], 1u); break; } }
    }
    nloc = mine > 0u ? mine : 1u; nx = cnt > 0u ? cnt : 1u;
}
DI void xcd_barrier(const XcdBarrier& b) {
    asm volatile("s_waitcnt vmcnt(0)" ::: "memory");
    __syncthreads();
    if (threadIdx.x == 0) {
        unsigned* bar = b.bar;
        __builtin_amdgcn_s_waitcnt(0);
        unsigned nloc = b.st[0], nx = b.st[1];
        if (nloc == 0u) { xcd_barrier_complete(bar, b.x, nloc, nx); b.st[0] = nloc; b.st[1] = nx; }
        const unsigned old = xb_add(&bar[XB_XSUB(b.x)], 1u);
        const unsigned gen = old / nloc;
        if (old + 1u == (gen + 1u) * nloc) {
            __builtin_amdgcn_fence(__ATOMIC_RELEASE, "agent");
            asm volatile("s_waitcnt vmcnt(0)" ::: "memory");
            const unsigned og = xb_add(&bar[XB_TOP], 1u);
            const unsigned tg = og / nx;
            if (og + 1u == (tg + 1u) * nx) xb_add(&bar[XB_TOPGEN], 1u);
            else XB_SPIN(xb_ld(&bar[XB_TOPGEN]) == tg, bar);
            __builtin_amdgcn_fence(__ATOMIC_ACQUIRE, "agent");
            xb_add(&bar[XB_XGEN(b.x)], 1u);
            asm volatile("s_waitcnt vmcnt(0)" ::: "memory");
        } else {
            XB_SPIN(xb_ld(&bar[XB_XGEN(b.x)]) == gen, bar);
            __builtin_amdgcn_fence(__ATOMIC_ACQUIRE, "agent");
            asm volatile("s_waitcnt vmcnt(0)" ::: "memory");
        }
    }
    __syncthreads();
}

template <typename T> DI float ldval(const T* p);
template <> DI float ldval<float>(const float* p) { return *p; }
template <> DI float ldval<bf16_t>(const bf16_t* p) { return bf2f(*p); }
template <typename T>
DI void transpose_tile(const T* src, int src_ld, bf16_t* dst, int dst_ld, float* lds) {
  const int tid = tid_opaque();
  for (int i = 0; i < 16; ++i) { int r = (tid >> 6) + 4 * i, c = tid & 63; lds[r * 65 + c] = ldval<T>(src + (size_t)r * src_ld + c); }
  __syncthreads();
  for (int i = 0; i < 16; ++i) { int c = (tid >> 6) + 4 * i, r = tid & 63; dst[(size_t)c * dst_ld + r] = f2bf(lds[r * 65 + c]); }
  __syncthreads();
}

__device__ void phase_prologue(const Params& p, unsigned char* smem) {
  float* lds = (float*)smem;
  const int n0 = 1728, n1 = n0 + 512, n2 = n1 + 192, n3 = n2 + 64, n4 = n3 + 128, n5 = n4 + 192;
#pragma unroll 1
  for (int it = blockIdx.x; it < n5; it += gridDim.x) {
    const int tid = tid_opaque();
    if (it < n0) {
      int l = it / 864, r = it % 864, kt = r / 54, nt = r % 54;
      transpose_tile<float>(p.w_in + (size_t)l * 1024 * PW + (size_t)kt * 64 * PW + nt * 64, PW,
                            p.WINT + (size_t)l * PW * 1024 + (size_t)nt * 64 * 1024 + kt * 64, 1024, lds);
    } else if (it < n1) {
      int i2 = it - n0; int l = i2 / 256, r = i2 % 256, kt = r / 16, nt = r % 16;
      transpose_tile<float>(p.w_out + (size_t)l * 1024 * 1024 + (size_t)kt * 64 * 1024 + nt * 64, 1024,
                            p.WOUTT + (size_t)l * 1024 * 1024 + (size_t)nt * 64 * 1024 + kt * 64, 1024, lds);
    } else if (it < n2) {
      int i2 = it - n1; int l = i2 / 96, nb = (i2 % 96) * 32;
      float* sc = lds;
      float* red = lds + 5 * 1024;
      for (int i = tid; i < 5 * 1024; i += 256) { int v = i >> 10, k = i & 1023; float x = v == 0 ? p.c_ctx[k] : p.c[(v - 1) * 1024 + k]; sc[i] = siluf_(x); }
      __syncthreads();
      int n = tid & 31, kg = tid >> 5;
      float a0 = 0, a1 = 0, a2 = 0, a3 = 0, a4 = 0;
      const float* wp = p.w_mod + (size_t)l * 1024 * 3072 + nb + n;
      for (int k = kg * 128; k < kg * 128 + 128; ++k) {
        float w = wp[(size_t)k * 3072];
        a0 += sc[k] * w; a1 += sc[1024 + k] * w; a2 += sc[2048 + k] * w; a3 += sc[3072 + k] * w; a4 += sc[4096 + k] * w;
      }
      red[(kg * 5 + 0) * 32 + n] = a0; red[(kg * 5 + 1) * 32 + n] = a1; red[(kg * 5 + 2) * 32 + n] = a2; red[(kg * 5 + 3) * 32 + n] = a3; red[(kg * 5 + 4) * 32 + n] = a4;
      __syncthreads();
      if (tid < 160) { int v = tid >> 5, nn = tid & 31; float s = p.b_mod[l * 3072 + nb + nn]; for (int q = 0; q < 8; ++q) s += red[(q * 5 + v) * 32 + nn]; p.MOD[(size_t)(l * 5 + v) * 3072 + nb + nn] = s; }
      __syncthreads();
    } else if (it < n3) {
      int i2 = it - n2; int bl = i2 >> 3, r = i2 & 7, pt = r >> 1, ct = r & 1;
      transpose_tile<float>(p.cwv + (size_t)bl * 256 * 128 + (size_t)pt * 64 * 128 + ct * 64, 128,
                            p.CWVT + (size_t)bl * 128 * 256 + (size_t)ct * 64 * 256 + pt * 64, 256, lds);
    } else if (it < n4) {
      int i2 = it - n3; int bl = i2 >> 4, r = i2 & 15, pt = r >> 2, ct = r & 3;
      transpose_tile<float>(p.cdv + (size_t)bl * 256 * 256 + (size_t)pt * 64 * 256 + ct * 64, 256,
                            p.CDVT + (size_t)bl * 256 * 256 + (size_t)ct * 64 * 256 + pt * 64, 256, lds);
    } else {
      int i2 = it - n4;
      const float* src; bf16_t* dst;
      if (i2 < 64) { src = p.cwk + (size_t)i2 * 4096; dst = p.CWK + (size_t)i2 * 4096; }
      else { src = p.cdk + (size_t)(i2 - 64) * 4096; dst = p.CDK + (size_t)(i2 - 64) * 4096; }
      for (int i = tid * 4; i < 4096; i += 1024) { float4 v = *(const float4*)(src + i); uint2 o; o.x = pack2(v.x, v.y); o.y = pack2(v.z, v.w); *(uint2*)(dst + i) = o; }
    }
  }
}

__device__ void phase_norm(const Params& p, int stage) {
  const int tid0 = tid_opaque();
  const int lane = tid0 & 63, wave = tid0 >> 6;
#pragma unroll 1
  for (int tok = blockIdx.x * 4 + wave; tok < NTOK; tok += gridDim.x * 4) {
    const int mv = tok < 4096 ? 0 : 1 + ((tok - 4096) >> 10);
    const float* xin;
    if (stage <= 1) xin = tok < 4096 ? p.x_prompt + (size_t)tok * 1024 : p.x_sample + (size_t)(tok - 4096) * 1024;
    else xin = p.out + (size_t)tok * 1024;
    float4 x[4];
#pragma unroll
    for (int i = 0; i < 4; ++i) x[i] = *(const float4*)(xin + i * 256 + lane * 4);
    if (stage >= 1) {
      const int lp = stage - 1;
      float4 y[4]; float ss = 0.f;
#pragma unroll
      for (int i = 0; i < 4; ++i) { y[i] = *(const float4*)(p.Y2 + (size_t)tok * 1024 + i * 256 + lane * 4); ss += y[i].x * y[i].x + y[i].y * y[i].y + y[i].z * y[i].z + y[i].w * y[i].w; }
      ss = wave_sum(ss);
      const float rstd = rsqrtf(ss * (1.0f / 1024.0f) + 1e-6f);
      const float* gate = p.MOD + (size_t)(lp * 5 + mv) * 3072 + 2048;
      const float* gp = p.g_post + lp * 1024;
#pragma unroll
      for (int i = 0; i < 4; ++i) {
        const int col = i * 256 + lane * 4;
        float4 g = *(const float4*)(gate + col), q = *(const float4*)(gp + col);
        x[i].x += g.x * (y[i].x * rstd * q.x); x[i].y += g.y * (y[i].y * rstd * q.y); x[i].z += g.z * (y[i].z * rstd * q.z); x[i].w += g.w * (y[i].w * rstd * q.w);
        *(float4*)(p.out + (size_t)tok * 1024 + col) = x[i];
      }
    }
    if (stage <= 1) {
      const int l = stage;
      float ss = 0.f;
#pragma unroll
      for (int i = 0; i < 4; ++i) ss += x[i].x * x[i].x + x[i].y * x[i].y + x[i].z * x[i].z + x[i].w * x[i].w;
      ss = wave_sum(ss);
      const float rstd = rsqrtf(ss * (1.0f / 1024.0f) + 1e-6f);
      const float* md = p.MOD + (size_t)(l * 5 + mv) * 3072;
      const float* gp = p.g_pre + l * 1024;
#pragma unroll
      for (int i = 0; i < 4; ++i) {
        const int col = i * 256 + lane * 4;
        float4 sh = *(const float4*)(md + col), sc = *(const float4*)(md + 1024 + col), g = *(const float4*)(gp + col);
        float h0 = x[i].x * rstd * g.x * (1.f + sc.x) + sh.x, h1 = x[i].y * rstd * g.y * (1.f + sc.y) + sh.y;
        float h2 = x[i].z * rstd * g.z * (1.f + sc.z) + sh.z, h3 = x[i].w * rstd * g.w * (1.f + sc.w) + sh.w;
        uint2 o; o.x = pack2(h0, h1); o.y = pack2(h2, h3);
        *(uint2*)(p.H + (size_t)tok * 1024 + col) = o;
      }
    }
  }
}

template <int MODE>
__device__ void phase_gemm(const Params& p, int l, unsigned char* smem) {
  const bf16_t* A = p.H;
  const bf16_t* Bt = MODE == 0 ? p.WINT + (size_t)l * PW * 1024 : p.WOUTT + (size_t)l * 1024 * 1024;
  const int N = MODE == 0 ? PW : 1024, K = 1024;
  const int NTN = N / 128, NT = 64 * NTN;
  bf16_t* As = (bf16_t*)smem; bf16_t* Bs = As + 128 * 72;
#pragma unroll 1
  for (int tile = blockIdx.x; tile < NT; tile += gridDim.x) {
    const int tid = tid_opaque(), lane = tid & 63, wave = tid >> 6, wm = wave >> 1, wn = wave & 1, r16 = lane & 15, quad = lane >> 4;
    const int tm = tile / NTN, tn = tile % NTN, m0 = tm * 128, n0 = tn * 128;
    f32x4 acc[4][4];
#pragma unroll
    for (int i = 0; i < 4; ++i)
#pragma unroll
      for (int j = 0; j < 4; ++j) acc[i][j] = (f32x4){0.f, 0.f, 0.f, 0.f};
    u32x4 ra[4], rb[4];
#pragma unroll
    for (int i = 0; i < 4; ++i) { int id = tid + 256 * i, row = id >> 3, c8 = id & 7; ra[i] = *(const u32x4*)(A + (size_t)(m0 + row) * K + c8 * 8); rb[i] = *(const u32x4*)(Bt + (size_t)(n0 + row) * K + c8 * 8); }
#pragma unroll
    for (int i = 0; i < 4; ++i) { int id = tid + 256 * i, row = id >> 3, c8 = id & 7; *(u32x4*)(As + row * 72 + c8 * 8) = ra[i]; *(u32x4*)(Bs + row * 72 + c8 * 8) = rb[i]; }
    __syncthreads();
    for (int kt = 0; kt < 16; ++kt) {
      if (kt + 1 < 16) {
#pragma unroll
        for (int i = 0; i < 4; ++i) { int id = tid + 256 * i, row = id >> 3, c8 = id & 7; ra[i] = *(const u32x4*)(A + (size_t)(m0 + row) * K + (kt + 1) * 64 + c8 * 8); rb[i] = *(const u32x4*)(Bt + (size_t)(n0 + row) * K + (kt + 1) * 64 + c8 * 8); }
      }
#pragma unroll
      for (int ks = 0; ks < 2; ++ks) {
        bf16x8 af[4], bfr[4];
#pragma unroll
        for (int i = 0; i < 4; ++i) {
          af[i] = *(const bf16x8*)(As + (wm * 64 + i * 16 + r16) * 72 + ks * 32 + quad * 8);
          bfr[i] = *(const bf16x8*)(Bs + (wn * 64 + i * 16 + r16) * 72 + ks * 32 + quad * 8);
        }
#pragma unroll
        for (int mi = 0; mi < 4; ++mi)
#pragma unroll
          for (int ni = 0; ni < 4; ++ni) acc[mi][ni] = mfma16(bfr[ni], af[mi], acc[mi][ni]);
      }
      __syncthreads();
      if (kt + 1 < 16) {
#pragma unroll
        for (int i = 0; i < 4; ++i) { int id = tid + 256 * i, row = id >> 3, c8 = id & 7; *(u32x4*)(As + row * 72 + c8 * 8) = ra[i]; *(u32x4*)(Bs + row * 72 + c8 * 8) = rb[i]; }
        __syncthreads();
      }
    }
#pragma unroll
    for (int mi = 0; mi < 4; ++mi)
#pragma unroll
      for (int ni = 0; ni < 4; ++ni) {
        const int m = m0 + wm * 64 + mi * 16 + r16, n = n0 + wn * 64 + ni * 16 + quad * 4;
        const f32x4 v = acc[mi][ni];
        if (MODE == 0) {
          uint2 o; o.x = pack2(v[0], v[1]); o.y = pack2(v[2], v[3]);
          *(uint2*)(p.P + (size_t)m * PW + n) = o;
          if (m0 < 4096) {
            const int row = ((m >> 8) * 2 + l) * 256 + (m & 255);
            float* dst = nullptr;
            if (tn == 11) dst = p.out + O_NWK + (size_t)row * 128 + (n - 1408);
            else if (tn == 12) dst = p.out + O_NWV + (size_t)row * 128 + (n - 1536);
            else if (tn == 21 || tn == 22) dst = p.out + O_NDK + (size_t)row * 256 + (n - 2688);
            else if (tn == 23 || tn == 24) dst = p.out + O_NDV + (size_t)row * 256 + (n - 2944);
            if (dst) *(float4*)dst = (float4){v[0], v[1], v[2], v[3]};
          }
        } else {
          *(float4*)(p.Y2 + (size_t)m * 1024 + n) = (float4){v[0], v[1], v[2], v[3]};
        }
      }
  }
}

__device__ void pre_rwkv(const Params& p, int l, int item, unsigned char* smem) {
  float* s_wd = (float*)smem;
  float* s_ad = s_wd + 16 * 64;
  const int tid = tid_opaque(), c = tid;
  const int tok0 = item * 16;
  for (int i = 0; i < 8; ++i) {
    int idx = tid + 256 * i, tt = idx >> 7, m = idx & 127;
    float v = bf2f(p.P[(size_t)(tok0 + tt) * PW + 768 + m]);
    if (m < 64) s_wd[tt * 64 + m] = tanhf(v); else s_ad[tt * 64 + m - 64] = v;
  }
  __syncthreads();
  float aw0[16], aw1[16], aa0[16], aa1[16];
#pragma unroll
  for (int t = 0; t < 16; ++t) { aw0[t] = 0.f; aw1[t] = 0.f; aa0[t] = 0.f; aa1[t] = 0.f; }
  const float* wu0 = p.rw_wup + (size_t)(l * 2 + 0) * 64 * 256 + c;
  const float* wu1 = p.rw_wup + (size_t)(l * 2 + 1) * 64 * 256 + c;
  const float* au0 = p.rw_aup + (size_t)(l * 2 + 0) * 64 * 256 + c;
  const float* au1 = p.rw_aup + (size_t)(l * 2 + 1) * 64 * 256 + c;
  for (int m = 0; m < 64; m += 4) {
    float w0[4], w1[4], a0[4], a1[4];
#pragma unroll
    for (int q = 0; q < 4; ++q) { w0[q] = wu0[(m + q) * 256]; w1[q] = wu1[(m + q) * 256]; a0[q] = au0[(m + q) * 256]; a1[q] = au1[(m + q) * 256]; }
#pragma unroll
    for (int t = 0; t < 16; ++t) {
      const float4 xv = *(const float4*)(s_wd + t * 64 + m), yv = *(const float4*)(s_ad + t * 64 + m);
      aw0[t] += xv.x * w0[0] + xv.y * w0[1] + xv.z * w0[2] + xv.w * w0[3];
      aw1[t] += xv.x * w1[0] + xv.y * w1[1] + xv.z * w1[2] + xv.w * w1[3];
      aa0[t] += yv.x * a0[0] + yv.y * a0[1] + yv.z * a0[2] + yv.w * a0[3];
      aa1[t] += yv.x * a1[0] + yv.y * a1[1] + yv.z * a1[2] + yv.w * a1[3];
    }
  }
  const float kkc = p.rw_kk[l * 256 + c], kac = p.rw_ka[l * 256 + c];
  const float w00 = p.rw_w0[(l * 2 + 0) * 256 + c], w01 = p.rw_w0[(l * 2 + 1) * 256 + c];
  const float a00 = p.rw_a0[(l * 2 + 0) * 256 + c], a01 = p.rw_a0[(l * 2 + 1) * 256 + c];
#pragma unroll
  for (int t = 0; t < 16; ++t) {
    const int tok = tok0 + t;
    const float k = bf2f(p.P[(size_t)tok * PW + 256 + c]);
    float kk = k * kkc;
    const float ss = wave_sum(kk * kk);
    kk *= rsqrtf(ss + 1e-12f);
    p.NKK[(size_t)tok * 256 + c] = -kk;
#pragma unroll
    for (int d = 0; d < 2; ++d) {
      const float wl = (d ? w01 : w00) + (d ? aw1[t] : aw0[t]);
      const float w_log = -softplusf_(-wl) - 0.5f;
      const float decay = expf(-expf(w_log));
      const float a = sigmoidf_((d ? a01 : a00) + (d ? aa1[t] : aa0[t]));
      const float kd = k * (1.f + (a - 1.f) * kac);
      const size_t o = ((size_t)d * NTOK + tok) * 256 + c;
      p.AW[o] = decay; p.AB[o] = kk * a; p.AKD[o] = kd;
    }
  }
  __syncthreads();
}

__device__ void pre_lru(const Params& p, int l, int item, unsigned char* smem) {
  float* s_xc = (float*)smem;
  const int tid = tid_opaque(), c = tid, n = c >> 6;
  const int tok0 = item * 16;
  int T, sb, t0;
  if (tok0 < 4096) { T = 256; sb = tok0 & ~255; t0 = tok0 & 255; } else { T = 1024; sb = 4096 + ((tok0 - 4096) & ~1023); t0 = (tok0 - 4096) & 1023; }
  {
    float xs[19];
#pragma unroll
    for (int i = 0; i < 19; ++i) { int t = t0 - 2 + i; xs[i] = (t >= 0 && t < T) ? bf2f(p.P[(size_t)(sb + t) * PW + 1920 + c]) : 0.f; }
    const float cw0 = p.lru_cw[(l * 4 + 0) * 256 + c], cw1 = p.lru_cw[(l * 4 + 1) * 256 + c], cw2 = p.lru_cw[(l * 4 + 2) * 256 + c], cw3 = p.lru_cw[(l * 4 + 3) * 256 + c];
    const float cb = p.lru_cb[l * 256 + c];
#pragma unroll
    for (int t = 0; t < 16; ++t) s_xc[t * 256 + c] = cb + cw0 * xs[t] + cw1 * xs[t + 1] + cw2 * xs[t + 2] + cw3 * xs[t + 3];
  }
  __syncthreads();
  float ga0[16], ga1[16], gx0[16], gx1[16];
#pragma unroll
  for (int t = 0; t < 16; ++t) { ga0[t] = 0.f; ga1[t] = 0.f; gx0[t] = 0.f; gx1[t] = 0.f; }
  const int e = c & 63;
  const float* wa0 = p.lru_wa + ((size_t)((l * 2 + 0) * 4 + n) * 64) * 64 + e;
  const float* wa1 = p.lru_wa + ((size_t)((l * 2 + 1) * 4 + n) * 64) * 64 + e;
  const float* wx0 = p.lru_wx + ((size_t)((l * 2 + 0) * 4 + n) * 64) * 64 + e;
  const float* wx1 = p.lru_wx + ((size_t)((l * 2 + 1) * 4 + n) * 64) * 64 + e;
  for (int m = 0; m < 64; m += 4) {
    float a0[4], a1[4], x0[4], x1[4];
#pragma unroll
    for (int q = 0; q < 4; ++q) { a0[q] = wa0[(m + q) * 64]; a1[q] = wa1[(m + q) * 64]; x0[q] = wx0[(m + q) * 64]; x1[q] = wx1[(m + q) * 64]; }
#pragma unroll
    for (int t = 0; t < 16; ++t) {
      const float4 xv = *(const float4*)(s_xc + t * 256 + n * 64 + m);
      ga0[t] += xv.x * a0[0] + xv.y * a0[1] + xv.z * a0[2] + xv.w * a0[3];
      ga1[t] += xv.x * a1[0] + xv.y * a1[1] + xv.z * a1[2] + xv.w * a1[3];
      gx0[t] += xv.x * x0[0] + xv.y * x0[1] + xv.z * x0[2] + xv.w * x0[3];
      gx1[t] += xv.x * x1[0] + xv.y * x1[1] + xv.z * x1[2] + xv.w * x1[3];
    }
  }
  const float ba0 = p.lru_ba[(l * 2 + 0) * 256 + c], ba1 = p.lru_ba[(l * 2 + 1) * 256 + c];
  const float bx0 = p.lru_bx[(l * 2 + 0) * 256 + c], bx1 = p.lru_bx[(l * 2 + 1) * 256 + c];
  const float sp0 = softplusf_(-p.lru_lam[(l * 2 + 0) * 256 + c]), sp1 = softplusf_(-p.lru_lam[(l * 2 + 1) * 256 + c]);
#pragma unroll
  for (int t = 0; t < 16; ++t) {
    const float x = s_xc[t * 256 + c];
#pragma unroll
    for (int d = 0; d < 2; ++d) {
      const float ga = sigmoidf_((d ? ga1[t] : ga0[t]) + (d ? ba1 : ba0));
      const float gx = sigmoidf_((d ? gx1[t] : gx0[t]) + (d ? bx1 : bx0));
      const float log_a = -8.0f * ga * (d ? sp1 : sp0);
      const float a = expf(log_a);
      const float u = sqrtf(-expm1f(2.0f * log_a)) * (gx * x);
      if (d) { ga1[t] = a; gx1[t] = u; } else { ga0[t] = a; gx0[t] = u; }
    }
  }
  {
    float h = 0.f, A = 1.f;
#pragma unroll
    for (int t = 0; t < 16; ++t) { h = ga0[t] * h + gx0[t]; A *= ga0[t]; const size_t o = (size_t)(tok0 + t) * 256 + c; p.LA[o] = A; p.LU[o] = h; }
    h = 0.f; A = 1.f;
#pragma unroll
    for (int t = 15; t >= 0; --t) { h = ga1[t] * h + gx1[t]; A *= ga1[t]; const size_t o = ((size_t)NTOK + tok0 + t) * 256 + c; p.LA[o] = A; p.LU[o] = h; }
  }
  __syncthreads();
}

__device__ void pre_rope(const Params& p, int item) {
  const int tid = tid_opaque();
  for (int tt = 0; tt < 16; ++tt) {
    const int ts = item * 16 + tt;
    const int t = ts & 1023;
    const float row = (float)(t >> 6), col = (float)(t & 63);
    const bf16_t* src = p.P + (size_t)(4096 + ts) * PW;
    for (int pp = tid; pp < 448; pp += 256) {
      int scol, d1, d2, half, i; bf16_t* dst; float inv;
      if (pp < 192) {
        int q = pp < 128 ? pp : pp - 128; int vec = q >> 5, pi = q & 31; half = pi >> 4; i = pi & 15;
        d1 = half * 32 + i; d2 = d1 + 16; inv = exp2f(-(float)i * (13.287712379549449f / 16.0f));
        if (pp < 128) { scol = 1152 + vec * 64; dst = p.QBR + (size_t)ts * 256 + vec * 64; }
        else { scol = 1408 + vec * 64; dst = p.KBR + (size_t)ts * 128 + vec * 64; }
      } else {
        int q = pp < 320 ? pp - 192 : pp - 320; int vec = q >> 4, pi = q & 15; half = pi >> 3; i = pi & 7;
        d1 = half * 16 + i; d2 = d1 + 8; inv = exp2f(-(float)i * (13.287712379549449f / 8.0f));
        if (pp < 320) { scol = 2432 + vec * 32; dst = p.QDR + (size_t)ts * 256 + vec * 32; }
        else { scol = 2688 + vec * 32; dst = p.KDR + (size_t)ts * 256 + vec * 32; }
      }
      const float ang = (half ? col : row) * inv;
      float sn, cs; sincosf(ang, &sn, &cs);
      const float x1 = bf2f(src[scol + d1]), x2 = bf2f(src[scol + d2]);
      dst[d1] = f2bf(x1 * cs - x2 * sn); dst[d2] = f2bf(x1 * sn + x2 * cs);
    }
  }
}

__device__ void phase_pre(const Params& p, int l, unsigned char* smem) {
  const int n0 = 512, n1 = n0 + 512, n2 = n1 + 256, n3 = n2 + 256, n4 = n3 + 512;
#pragma unroll 1
  for (int it = blockIdx.x; it < n4; it += gridDim.x) {
    if (it < n0) pre_rwkv(p, l, it, smem);
    else if (it < n1) pre_lru(p, l, it - n0, smem);
    else if (it < n2) pre_rope(p, it - n1);
    else if (it < n3) {
      int i2 = it - n2; int tt = i2 >> 1, ct = i2 & 1; int tok0 = tt * 64;
      int T, sb; if (tok0 < 4096) { T = 256; sb = tok0 & ~255; } else { T = 1024; sb = 4096 + ((tok0 - 4096) & ~1023); }
      transpose_tile<bf16_t>(p.P + (size_t)tok0 * PW + 1536 + ct * 64, PW, p.VBT + (size_t)sb * 128 + (size_t)(ct * 64) * T + (tok0 - sb), T, (float*)smem);
    } else {
      int i2 = it - n3; int tt = i2 >> 2, ct = i2 & 3; int tok0 = tt * 64;
      int T, sb; if (tok0 < 4096) { T = 256; sb = tok0 & ~255; } else { T = 1024; sb = 4096 + ((tok0 - 4096) & ~1023); }
      transpose_tile<bf16_t>(p.P + (size_t)tok0 * PW + 2944 + ct * 64, PW, p.VDT + (size_t)sb * 256 + (size_t)(ct * 64) * T + (tok0 - sb), T, (float*)smem);
    }
  }
}

template <int LR> DI float group_sum(float v) {
  v += __builtin_bit_cast(float, __builtin_amdgcn_update_dpp(0, __builtin_bit_cast(int, v), 0xB1, 0xf, 0xf, true));
  v += __builtin_bit_cast(float, __builtin_amdgcn_update_dpp(0, __builtin_bit_cast(int, v), 0x4E, 0xf, 0xf, true));
  if (LR >= 8) v += __builtin_bit_cast(float, __builtin_amdgcn_update_dpp(0, __builtin_bit_cast(int, v), 0x141, 0xf, 0xf, true));
  if (LR >= 16) v += __builtin_bit_cast(float, __builtin_amdgcn_update_dpp(0, __builtin_bit_cast(int, v), 0x140, 0xf, 0xf, true));
  return v;
}
template <int E>
__device__ void rwkv_chain(const Params& p, int l, int chain, int part, unsigned char* smem) {
  constexpr int LR = 64 / E, NM = E / 4;
  const int tid = tid_opaque(), lane = tid & 63, wave = tid >> 6;
  int seq, d, h;
  if (chain < 32) { seq = 16 + (chain >> 3); d = (chain >> 2) & 1; h = chain & 3; }
  else { int c2 = chain - 32; seq = c2 >> 3; d = (c2 >> 2) & 1; h = c2 & 3; }
  const int T = seq < 16 ? 256 : 1024, tokb = seq < 16 ? seq * 256 : 4096 + (seq - 16) * 1024;
  const int g = lane % LR, rl = lane / LR, i = part * 4 * E + wave * E + rl;
  float S[E];
  if (seq >= 16) {
    const float* s0 = p.st_rwkv + ((((size_t)(seq - 16) * 2 + l) * 2 + d) * 4 + h) * 4096 + i * 64;
#pragma unroll
    for (int m = 0; m < NM; ++m) { f32x4 t = *(const f32x4*)(s0 + 4 * (g + LR * m)); S[4 * m] = t[0]; S[4 * m + 1] = t[1]; S[4 * m + 2] = t[2]; S[4 * m + 3] = t[3]; }
  } else {
#pragma unroll
    for (int j = 0; j < E; ++j) S[j] = 0.f;
  }
  float* buf = (float*)smem;
  const int lvec = (tid >> 4) & 3, lc4 = tid & 15, ls = tid >> 6;
  const float* fsrc = (lvec == 0 ? p.NKK : lvec == 1 ? p.AW + (size_t)d * NTOK * 256 : lvec == 2 ? p.AB + (size_t)d * NTOK * 256 : p.AKD + (size_t)d * NTOK * 256) + h * 64 + lc4 * 4;
  const int bs = tid >> 4, bvec = (tid >> 3) & 1, bc8 = tid & 7;
  const bf16_t* bsrc = p.P + (bvec ? 512 : 0) + h * 64 + bc8 * 8;
  f32x4 rf[4]; u32x4 rb;
  const int nch = T / 16;
  auto gload = [&](int ck) {
#pragma unroll
    for (int i4 = 0; i4 < 4; ++i4) { int step = ck * 16 + ls + 4 * i4; int t = d ? T - 1 - step : step; rf[i4] = *(const f32x4*)(fsrc + (size_t)(tokb + t) * 256); }
    { int step = ck * 16 + bs; int t = d ? T - 1 - step : step; rb = *(const u32x4*)(bsrc + (size_t)(tokb + t) * PW); }
  };
  auto sstore = [&](int bi) {
    float* b = buf + bi * 16 * 384;
#pragma unroll
    for (int i4 = 0; i4 < 4; ++i4) *(f32x4*)(b + (ls + 4 * i4) * 384 + lvec * 64 + lc4 * 4) = rf[i4];
    float* q = b + bs * 384 + (4 + bvec) * 64 + bc8 * 8;
    *(f32x4*)q = (f32x4){bflo(rb.x), bfhi(rb.x), bflo(rb.y), bfhi(rb.y)};
    *(f32x4*)(q + 4) = (f32x4){bflo(rb.z), bfhi(rb.z), bflo(rb.w), bfhi(rb.w)};
  };
  gload(0); sstore(0); __syncthreads();
  float* yout = p.YA + ((size_t)d * NTOK + tokb) * 256 + h * 64 + i;
#pragma unroll 1
  for (int ck = 0; ck < nch; ++ck) {
    if (ck + 1 < nch) gload(ck + 1);
    const float* cb = buf + (ck & 1) * 16 * 384;
#pragma unroll
    for (int s = 0; s < 16; ++s) {
      const float* ob = cb + s * 384;
      f32x4 nk[NM], ww[NM], bb[NM], kk[NM], rr[NM];
#pragma unroll
      for (int m = 0; m < NM; ++m) {
        const int off = 4 * (g + LR * m);
        nk[m] = *(const f32x4*)(ob + off); ww[m] = *(const f32x4*)(ob + 64 + off); bb[m] = *(const f32x4*)(ob + 128 + off);
        kk[m] = *(const f32x4*)(ob + 192 + off); rr[m] = *(const f32x4*)(ob + 256 + off);
      }
      const float vi = ob[320 + i];
      float sa = 0.f;
#pragma unroll
      for (int m = 0; m < NM; ++m) sa += (S[4 * m] * nk[m][0] + S[4 * m + 1] * nk[m][1]) + (S[4 * m + 2] * nk[m][2] + S[4 * m + 3] * nk[m][3]);
      sa = group_sum<LR>(sa);
      float y = 0.f;
#pragma unroll
      for (int m = 0; m < NM; ++m) {
#pragma unroll
        for (int e = 0; e < 4; ++e) S[4 * m + e] = S[4 * m + e] * ww[m][e] + (sa * bb[m][e] + vi * kk[m][e]);
        y += (S[4 * m] * rr[m][0] + S[4 * m + 1] * rr[m][1]) + (S[4 * m + 2] * rr[m][2] + S[4 * m + 3] * rr[m][3]);
      }
      y = group_sum<LR>(y);
      if (g == 0) { const int step = ck * 16 + s; const int t = d ? T - 1 - step : step; yout[(size_t)t * 256] = y; }
    }
    if (ck + 1 < nch) sstore((ck + 1) & 1);
    __syncthreads();
  }
  if (seq < 16) {
    float* so = p.out + O_NSR + ((((size_t)seq * 2 + l) * 2 + d) * 4 + h) * 4096 + i * 64;
#pragma unroll
    for (int m = 0; m < NM; ++m) *(f32x4*)(so + 4 * (g + LR * m)) = (f32x4){S[4 * m], S[4 * m + 1], S[4 * m + 2], S[4 * m + 3]};
  }
}

__device__ void lru_scan(const Params& p, int l, int item) {
  const int c = tid_opaque();
  int seq, d;
  if (item < 8) { seq = 16 + (item >> 1); d = item & 1; } else { seq = (item - 8) >> 1; d = item & 1; }
  const int T = seq < 16 ? 256 : 1024, tokb = seq < 16 ? seq * 256 : 4096 + (seq - 16) * 1024;
  const int NC = T >> 4;
  float h = seq >= 16 ? p.st_lru[(((seq - 16) * 2 + l) * 2 + d) * 256 + c] : 0.f;
  const float* la = p.LA + (size_t)d * NTOK * 256 + c; const float* lu = p.LU + (size_t)d * NTOK * 256 + c;
  float* lc = p.LC + (size_t)d * 512 * 256 + (size_t)(tokb >> 4) * 256 + c;
  for (int k0 = 0; k0 < NC; k0 += 8) {
    float a[8], u[8];
#pragma unroll
    for (int q = 0; q < 8; ++q) { const int k = d ? NC - 1 - (k0 + q) : k0 + q; const size_t idx = (size_t)(tokb + k * 16 + (d ? 0 : 15)) * 256; a[q] = la[idx]; u[q] = lu[idx]; }
#pragma unroll
    for (int q = 0; q < 8; ++q) { const int k = d ? NC - 1 - (k0 + q) : k0 + q; lc[(size_t)k * 256] = h; h = a[q] * h + u[q]; }
  }
  if (seq < 16) p.out[O_NSL + ((seq * 2 + l) * 2 + d) * 256 + c] = h;
}

template <bool DIFF>
DI void attn_keytile(const bf16_t* Kp, int kstride, const bf16_t* Vtp, int vstride, const bf16x8 (&qf)[2], float scale_log2,
                     bool masked, int kpos0, int qpos, float (&m)[2], float (&lsum)[2], f32x4 (&o)[2][4], int lane) {
  const int r16 = lane & 15, quad = lane >> 4;
  constexpr int NS = DIFF ? 2 : 1;
  f32x4 sc[NS][4];
  const f32x4 z4 = {0.f, 0.f, 0.f, 0.f};
#pragma unroll
  for (int kt = 0; kt < 4; ++kt) {
    const int s = kt >> 1, u = kt & 1;
    const int key = 32 * s + 8 * (r16 >> 2) + 4 * u + (r16 & 3);
    const bf16_t* kr = Kp + (size_t)key * kstride + quad * 8;
    const bf16x8 k0 = *(const bf16x8*)kr, k1 = *(const bf16x8*)(kr + 32);
    if (!DIFF) { sc[0][kt] = mfma16(k0, qf[0], z4); sc[0][kt] = mfma16(k1, qf[1], sc[0][kt]); }
    else { sc[0][kt] = mfma16(k0, qf[0], z4); sc[NS - 1][kt] = mfma16(k1, qf[1], z4); }
  }
  bf16x8 pf[NS][2];
#pragma unroll
  for (int st = 0; st < NS; ++st) {
    float mx = -3.0e38f;
#pragma unroll
    for (int kt = 0; kt < 4; ++kt)
#pragma unroll
      for (int r = 0; r < 4; ++r) {
        float x = sc[st][kt][r] * scale_log2;
        if (masked) { const int kp = kpos0 + 32 * (kt >> 1) + 8 * quad + 4 * (kt & 1) + r; const int dd = kp - qpos; if (dd > 128 || dd < -128) x = -1.0e30f; }
        sc[st][kt][r] = x; mx = fmaxf(mx, x);
      }
    mx = fmaxf(mx, __shfl_xor(mx, 16)); mx = fmaxf(mx, __shfl_xor(mx, 32));
    const float mnew = fmaxf(m[st], mx);
    const float alpha = exp2f(m[st] - mnew);
    m[st] = mnew;
    float ps = 0.f;
#pragma unroll
    for (int kt = 0; kt < 4; ++kt)
#pragma unroll
      for (int r = 0; r < 4; ++r) { const float e = exp2f(sc[st][kt][r] - mnew); sc[st][kt][r] = e; ps += e; }
    lsum[st] = lsum[st] * alpha + ps;
#pragma unroll
    for (int dt = 0; dt < 4; ++dt) o[st][dt] *= alpha;
#pragma unroll
    for (int s = 0; s < 2; ++s) {
      bf16x8 t;
#pragma unroll
      for (int j = 0; j < 8; ++j) t[j] = (short)f2bf(sc[st][2 * s + (j >> 2)][j & 3]);
      pf[st][s] = t;
    }
  }
#pragma unroll
  for (int dt = 0; dt < 4; ++dt)
#pragma unroll
    for (int s = 0; s < 2; ++s) {
      const bf16x8 vf = *(const bf16x8*)(Vtp + (size_t)(dt * 16 + r16) * vstride + 32 * s + 8 * quad);
#pragma unroll
      for (int st = 0; st < NS; ++st) o[st][dt] = mfma16(vf, pf[st][s], o[st][dt]);
    }
}

template <bool DIFF>
__device__ void attn_item(const Params& p, int l, bool sample, int sq  , int h, int qt) {
  const int tid = tid_opaque();
  const int lane = tid & 63, wave = tid >> 6, r16 = lane & 15, quad = lane >> 4;
  const int T = sample ? 1024 : 256;
  const int tokb = sample ? 4096 + sq * 1024 : sq * 256;
  const int q0 = qt * 64 + wave * 16;
  const int qpos = q0 + r16;
  const int kvh = DIFF ? h : (h >> 1);
  bf16x8 qf[2];
  {
    const bf16_t* qp;
    if (sample) qp = (DIFF ? p.QDR : p.QBR) + (size_t)(sq * 1024 + qpos) * 256 + h * 64;
    else qp = p.P + (size_t)(tokb + qpos) * PW + (DIFF ? 2432 : 1152) + h * 64;
    qf[0] = *(const bf16x8*)(qp + quad * 8); qf[1] = *(const bf16x8*)(qp + 32 + quad * 8);
  }
  float m[2] = {-3.0e38f, -3.0e38f}, lsum[2] = {0.f, 0.f};
  f32x4 o[2][4];
#pragma unroll
  for (int a = 0; a < 2; ++a)
#pragma unroll
    for (int b = 0; b < 4; ++b) o[a][b] = (f32x4){0.f, 0.f, 0.f, 0.f};
  const float scale_log2 = (DIFF ? 0.17677669529663687f : 0.125f) * 1.4426950408889634f;
  if (sample) {
    const int bl = sq * 2 + l;
    const bf16_t* K; const bf16_t* Vt; int ks;
    if (DIFF) { K = p.CDK + (size_t)bl * 256 * 256 + h * 64; ks = 256; Vt = p.CDVT + (size_t)bl * 256 * 256 + (size_t)(h * 64) * 256; }
    else { K = p.CWK + (size_t)bl * 256 * 128 + kvh * 64; ks = 128; Vt = p.CWVT + (size_t)bl * 128 * 256 + (size_t)(kvh * 64) * 256; }
    for (int kb = 0; kb < 256; kb += 64)
      attn_keytile<DIFF>(K + (size_t)kb * ks, ks, Vt + kb, 256, qf, scale_log2, false, 0, 0, m, lsum, o, lane);
  }
  {
    const bf16_t* K; const bf16_t* Vt; int ks;
    if (sample) {
      if (DIFF) { K = p.KDR + (size_t)(sq * 1024) * 256 + h * 64; ks = 256; Vt = p.VDT + (size_t)tokb * 256 + (size_t)(h * 64) * T; }
      else { K = p.KBR + (size_t)(sq * 1024) * 128 + kvh * 64; ks = 128; Vt = p.VBT + (size_t)tokb * 128 + (size_t)(kvh * 64) * T; }
    } else {
      if (DIFF) { K = p.P + (size_t)tokb * PW + 2688 + h * 64; ks = PW; Vt = p.VDT + (size_t)tokb * 256 + (size_t)(h * 64) * T; }
      else { K = p.P + (size_t)tokb * PW + 1408 + kvh * 64; ks = PW; Vt = p.VBT + (size_t)tokb * 128 + (size_t)(kvh * 64) * T; }
    }
    int kb0 = 0, kb1 = T; bool masked = false;
    if (sample && !DIFF) { const int qb = qt * 64; kb0 = qb - 128 < 0 ? 0 : qb - 128; kb1 = qb + 192 > T ? T : qb + 192; masked = true; }
    for (int kb = kb0; kb < kb1; kb += 64)
      attn_keytile<DIFF>(K + (size_t)kb * ks, ks, Vt + kb, T, qf, scale_log2, masked, kb, qpos, m, lsum, o, lane);
  }
  float l0 = lsum[0]; l0 += __shfl_xor(l0, 16); l0 += __shfl_xor(l0, 32);
  const int tok = tokb + qpos;
  if (!DIFF) {
    l0 += exp2f(p.win_sink[l * 4 + h] * 1.4426950408889634f - m[0]);
    const float inv = 1.0f / l0;
#pragma unroll
    for (int dt = 0; dt < 4; ++dt) {
      f32x4 v = o[0][dt] * inv;
      *(float4*)(p.OB + (size_t)tok * 256 + h * 64 + dt * 16 + quad * 4) = (float4){v[0], v[1], v[2], v[3]};
    }
  } else {
    float l1 = lsum[1]; l1 += __shfl_xor(l1, 16); l1 += __shfl_xor(l1, 32);
    float d1 = 0.f, d2 = 0.f;
    const float* dl = p.diff_lam + l * 128;
    for (int j = 0; j < 32; ++j) { d1 += dl[j] * dl[32 + j]; d2 += dl[64 + j] * dl[96 + j]; }
    const float lam_init = 0.8f - 0.6f * expf(-0.3f * (float)l);
    const float lam = expf(d1) - expf(d2) + lam_init;
    const float i0 = 1.0f / l0, i1 = lam / l1;
    f32x4 v[4]; float ss = 0.f;
#pragma unroll
    for (int dt = 0; dt < 4; ++dt) { v[dt] = o[0][dt] * i0 - o[1][dt] * i1; ss += v[dt][0] * v[dt][0] + v[dt][1] * v[dt][1] + v[dt][2] * v[dt][2] + v[dt][3] * v[dt][3]; }
    ss += __shfl_xor(ss, 16); ss += __shfl_xor(ss, 32);
    const float rstd = rsqrtf(ss * (1.0f / 64.0f) + 1e-6f) * (1.0f - lam_init);
#pragma unroll
    for (int dt = 0; dt < 4; ++dt) {
      const float4 g = *(const float4*)(p.diff_g + l * 64 + dt * 16 + quad * 4);
      *(float4*)(p.OD + (size_t)tok * 256 + h * 64 + dt * 16 + quad * 4) = (float4){v[dt][0] * rstd * g.x, v[dt][1] * rstd * g.y, v[dt][2] * rstd * g.z, v[dt][3] * rstd * g.w};
    }
  }
}

__device__ void mix_other(const Params& p, int l, int it) {
  if (it < 256) { attn_item<true>(p, l, true, it >> 6, (it >> 4) & 3, it & 15); return; }
  it -= 256;
  if (it < 40) { lru_scan(p, l, it); return; }
  it -= 40;
  if (it < 256) { attn_item<false>(p, l, true, it >> 6, (it >> 4) & 3, it & 15); return; }
  it -= 256;
  if (it < 256) { attn_item<true>(p, l, false, it >> 4, (it >> 2) & 3, it & 3); return; }
  it -= 256;
  attn_item<false>(p, l, false, it >> 4, (it >> 2) & 3, it & 3);
}

#define ES 4
#define EP 8
__device__ void mix_item(const Params& p, int l, int it, unsigned char* smem) {
  constexpr int NPS = 16 / ES, NPP = 16 / EP, NS = 32 * NPS, NP = 128 * NPP;
  if (it < NS) { rwkv_chain<ES>(p, l, it / NPS, it % NPS, smem); return; }
  it -= NS;
  if (it < NP) { rwkv_chain<EP>(p, l, 32 + it / NPP, it % NPP, smem); return; }
  it -= NP;
  mix_other(p, l, it);
}
__device__ void phase_mix(const Params& p, int l, unsigned char* smem) {
  constexpr int NS = 32 * (16 / ES), NP = 128 * (16 / EP), NALL = NS + NP + 1064;
  const int G = gridDim.x, b = blockIdx.x;
  if (G >= 2 * NS) {
    if (b < NS) mix_item(p, l, b, smem);
    else {
#pragma unroll 1
      for (int it = NS + (b - NS); it < NALL; it += G - NS) mix_item(p, l, it, smem);
    }
  } else {
#pragma unroll 1
    for (int it = b; it < NALL; it += G) mix_item(p, l, it, smem);
  }
}

DI float sum16(float v) { v += __shfl_xor(v, 1); v += __shfl_xor(v, 2); v += __shfl_xor(v, 4); v += __shfl_xor(v, 8); return v; }
DI void ld4bf(const bf16_t* q, float (&o)[4]) { uint2 u = *(const uint2*)q; o[0] = bflo(u.x); o[1] = bfhi(u.x); o[2] = bflo(u.y); o[3] = bfhi(u.y); }
DI void st4bf(bf16_t* q, const float (&v)[4]) { uint2 u; u.x = pack2(v[0], v[1]); u.y = pack2(v[2], v[3]); *(uint2*)q = u; }

__device__ void phase_post(const Params& p, int l) {
  const int tid0 = tid_opaque();
  const int lane = tid0 & 63, wave = tid0 >> 6;
  const int c = lane * 4;
#pragma unroll 1
  for (int tok = blockIdx.x * 4 + wave; tok < NTOK; tok += gridDim.x * 4) {
    const bf16_t* pr = p.P + (size_t)tok * PW;
    float out[4], g[4];
    {
      const float4 y0 = *(const float4*)(p.YA + (size_t)tok * 256 + c), y1 = *(const float4*)(p.YA + ((size_t)NTOK + tok) * 256 + c);
      float y[4] = {y0.x + y1.x, y0.y + y1.y, y0.z + y1.z, y0.w + y1.w};
      const float mu = sum16(y[0] + y[1] + y[2] + y[3]) * (1.0f / 64.0f);
      float dv[4] = {y[0] - mu, y[1] - mu, y[2] - mu, y[3] - mu};
      const float var = sum16(dv[0] * dv[0] + dv[1] * dv[1] + dv[2] * dv[2] + dv[3] * dv[3]) * (1.0f / 64.0f);
      const float rstd = rsqrtf(var + 64e-5f);
      float r[4], k[4], v[4];
      ld4bf(pr + c, r); ld4bf(pr + 256 + c, k); ld4bf(pr + 512 + c, v); ld4bf(pr + 896 + c, g);
      const float4 rk = *(const float4*)(p.rw_rk + l * 256 + c), gg = *(const float4*)(p.rw_gng + l * 256 + c), gb = *(const float4*)(p.rw_gnb + l * 256 + c);
      const float bs = sum16(r[0] * k[0] * rk.x + r[1] * k[1] * rk.y + r[2] * k[2] * rk.z + r[3] * k[3] * rk.w);
      out[0] = (dv[0] * rstd * gg.x + gb.x + bs * v[0]) * siluf_(g[0]);
      out[1] = (dv[1] * rstd * gg.y + gb.y + bs * v[1]) * siluf_(g[1]);
      out[2] = (dv[2] * rstd * gg.z + gb.z + bs * v[2]) * siluf_(g[2]);
      out[3] = (dv[3] * rstd * gg.w + gb.w + bs * v[3]) * siluf_(g[3]);
      st4bf(p.H + (size_t)tok * 1024 + c, out);
    }
    {
      const float4 y = *(const float4*)(p.OB + (size_t)tok * 256 + c);
      ld4bf(pr + 1664 + c, g);
      out[0] = y.x * siluf_(g[0]); out[1] = y.y * siluf_(g[1]); out[2] = y.z * siluf_(g[2]); out[3] = y.w * siluf_(g[3]);
      st4bf(p.H + (size_t)tok * 1024 + 256 + c, out);
    }
    {
      const float4 y0 = *(const float4*)(p.LU + (size_t)tok * 256 + c), y1 = *(const float4*)(p.LU + ((size_t)NTOK + tok) * 256 + c);
      const float4 A0 = *(const float4*)(p.LA + (size_t)tok * 256 + c), A1 = *(const float4*)(p.LA + ((size_t)NTOK + tok) * 256 + c);
      const float4 c0 = *(const float4*)(p.LC + (size_t)(tok >> 4) * 256 + c), c1 = *(const float4*)(p.LC + ((size_t)512 + (tok >> 4)) * 256 + c);
      ld4bf(pr + 2176 + c, g);
      out[0] = (y0.x + A0.x * c0.x + y1.x + A1.x * c1.x) * siluf_(g[0]); out[1] = (y0.y + A0.y * c0.y + y1.y + A1.y * c1.y) * siluf_(g[1]);
      out[2] = (y0.z + A0.z * c0.z + y1.z + A1.z * c1.z) * siluf_(g[2]); out[3] = (y0.w + A0.w * c0.w + y1.w + A1.w * c1.w) * siluf_(g[3]);
      st4bf(p.H + (size_t)tok * 1024 + 512 + c, out);
    }
    {
      const float4 y = *(const float4*)(p.OD + (size_t)tok * 256 + c);
      ld4bf(pr + 3200 + c, g);
      out[0] = y.x * siluf_(g[0]); out[1] = y.y * siluf_(g[1]); out[2] = y.z * siluf_(g[2]); out[3] = y.w * siluf_(g[3]);
      st4bf(p.H + (size_t)tok * 1024 + 768 + c, out);
    }
  }
}

__global__ void __launch_bounds__(256, 2) fwd_megakernel(Params p) {
  __shared__ __attribute__((aligned(16))) unsigned char smem[49152];
  __shared__ uint4 xb_words;
  if (threadIdx.x == 0) xb_words = make_uint4(0u, 0u, 0u, 0u);
  __syncthreads();
  XcdBarrier xb = xcd_barrier_post(p.bar, (volatile LAS unsigned*)&xb_words);
  phase_prologue(p, smem);
  xcd_barrier(xb);
  phase_norm(p, 0);
  xcd_barrier(xb);
#pragma unroll 1
  for (int l = 0; l < 2; ++l) {
    phase_gemm<0>(p, l, smem);
    xcd_barrier(xb);
    phase_pre(p, l, smem);
    xcd_barrier(xb);
    phase_mix(p, l, smem);
    xcd_barrier(xb);
    phase_post(p, l);
    xcd_barrier(xb);
    phase_gemm<1>(p, l, smem);
    xcd_barrier(xb);
    phase_norm(p, l + 1);
    if (l == 0) xcd_barrier(xb);
  }
}

extern "C" void kernel_launch(void* const* d_in, const int* in_sizes, int n_in, void* d_out, int out_size, void* d_ws, size_t ws_size, hipStream_t stream) {
  static int grid_blocks = 0;
  if (!grid_blocks) {
    int dev = 0, cus = 0, per_cu = 0;
    hipGetDevice(&dev);
    hipDeviceGetAttribute(&cus, hipDeviceAttributeMultiprocessorCount, dev);
    hipOccupancyMaxActiveBlocksPerMultiprocessor(&per_cu, (const void*)fwd_megakernel, 256, 0);
    if (per_cu < 1) per_cu = 1;
    if (per_cu > 2) per_cu = 2;
    grid_blocks = cus * per_cu;
  }
  Params p{};
  const float** f = (const float**)&p;
  for (int i = 0; i < 35; ++i) f[i] = (const float*)d_in[i];
  p.out = (float*)d_out;
  size_t off = 0;
  auto take = [&](size_t bytes) { void* r = (char*)d_ws + off; off += (bytes + 255) & ~(size_t)255; return r; };
  p.MOD = (float*)take(2 * 5 * 3072 * 4);
  p.WINT = (bf16_t*)take((size_t)2 * PW * 1024 * 2);
  p.WOUTT = (bf16_t*)take((size_t)2 * 1024 * 1024 * 2);
  p.CWK = (bf16_t*)take((size_t)4 * 2 * 256 * 128 * 2);
  p.CWVT = (bf16_t*)take((size_t)4 * 2 * 256 * 128 * 2);
  p.CDK = (bf16_t*)take((size_t)4 * 2 * 256 * 256 * 2);
  p.CDVT = (bf16_t*)take((size_t)4 * 2 * 256 * 256 * 2);
  p.H = (bf16_t*)take((size_t)NTOK * 1024 * 2);
  p.P = (bf16_t*)take((size_t)NTOK * PW * 2);
  p.NKK = (float*)take((size_t)NTOK * 256 * 4);
  p.AW = (float*)take((size_t)2 * NTOK * 256 * 4);
  p.AB = (float*)take((size_t)2 * NTOK * 256 * 4);
  p.AKD = (float*)take((size_t)2 * NTOK * 256 * 4);
  p.Y2 = p.NKK;
  p.YA = (float*)take((size_t)2 * NTOK * 256 * 4);
  p.LA = (float*)take((size_t)2 * NTOK * 256 * 4);
  p.LU = (float*)take((size_t)2 * NTOK * 256 * 4);
  p.QBR = (bf16_t*)take((size_t)4096 * 256 * 2);
  p.KBR = (bf16_t*)take((size_t)4096 * 128 * 2);
  p.QDR = (bf16_t*)take((size_t)4096 * 256 * 2);
  p.KDR = (bf16_t*)take((size_t)4096 * 256 * 2);
  p.VBT = (bf16_t*)take((size_t)NTOK * 128 * 2);
  p.VDT = (bf16_t*)take((size_t)NTOK * 256 * 2);
  p.OB = (float*)take((size_t)NTOK * 256 * 4);
  p.OD = (float*)take((size_t)NTOK * 256 * 4);
  p.LC = (float*)take((size_t)2 * 512 * 256 * 4);
  p.bar = (unsigned*)take((size_t)XCD_BAR_WORDS * 4);
  if (off > ws_size) { fprintf(stderr, "workspace too small: need %zu have %zu\n", off, ws_size); return; }
  hipMemsetAsync(p.bar, 0, (size_t)XCD_BAR_WORDS * 4, stream);
  void* args[] = {&p};
  hipError_t e = hipLaunchCooperativeKernel((const void*)fwd_megakernel, dim3(grid_blocks), dim3(256), args, 0, stream);
  if (e != hipSuccess) fprintf(stderr, "cooperative launch failed: %s (grid %d)\n", hipGetErrorString(e), grid_blocks);
}
```

```cpp
#include <hip/hip_runtime.h>
#include <cstdio>
#include <cstdint>

typedef unsigned short bf16_t;
typedef short bf16x8 __attribute__((ext_vector_type(8)));
typedef float f32x4 __attribute__((ext_vector_type(4)));
typedef unsigned u32x4 __attribute__((ext_vector_type(4)));
#define DI __device__ __forceinline__

#define O_YP 0
#define O_NWK 8388608
#define O_NWV 9437184
#define O_NDK 10485760
#define O_NDV 12582912
#define O_NSR 14680064
#define O_NSL 15728640

#define NTOK 8192
#define PW 3456

struct Params {
  const float *x_prompt, *x_sample, *c, *cwk, *cwv, *cdk, *cdv, *st_rwkv, *st_lru, *c_ctx, *w_mod, *b_mod, *g_pre, *g_post, *w_in, *w_out;
  const float *rw_w0, *rw_wup, *rw_a0, *rw_aup, *rw_kk, *rw_ka, *rw_rk, *rw_gng, *rw_gnb, *win_sink;
  const float *lru_cw, *lru_cb, *lru_wa, *lru_ba, *lru_wx, *lru_bx, *lru_lam, *diff_lam, *diff_g;
  float* out;
  float* MOD; bf16_t* WINT; bf16_t* WOUTT; bf16_t* CWK; bf16_t* CWVT; bf16_t* CDK; bf16_t* CDVT;
  bf16_t* H; bf16_t* P; float* NKK; float* AW; float* AB; float* AKD; float* YA; float* LA; float* LU;
  bf16_t* QBR; bf16_t* KBR; bf16_t* QDR; bf16_t* KDR; bf16_t* VBT; bf16_t* VDT; float* OB; float* OD; float* Y2; float* LC; unsigned* bar;
  int rep[8];
  int rep2[8];
};

DI int tid_opaque() { int t = threadIdx.x; asm volatile("" : "+v"(t)); return t; }
DI bf16_t f2bf(float x) { unsigned u = __float_as_uint(x); u += 0x7fffu + ((u >> 16) & 1u); return (bf16_t)(u >> 16); }
DI float bf2f(bf16_t b) { return __uint_as_float(((unsigned)b) << 16); }
DI unsigned pack2(float a, float b) { return (unsigned)f2bf(a) | ((unsigned)f2bf(b) << 16); }
DI float bflo(unsigned u) { return __uint_as_float(u << 16); }
DI float bfhi(unsigned u) { return __uint_as_float(u & 0xffff0000u); }
DI float wave_sum(float v) { for (int o = 32; o > 0; o >>= 1) v += __shfl_xor(v, o); return v; }
DI float sigmoidf_(float x) { return 1.0f / (1.0f + expf(-x)); }
DI float fsigmoid(float x) { return __frcp_rn(1.0f + __expf(-x)); }
DI float wave_sum_dpp(float v) {
  v += __builtin_bit_cast(float, __builtin_amdgcn_update_dpp(0, __builtin_bit_cast(int, v), 0xB1, 0xf, 0xf, true));
  v += __builtin_bit_cast(float, __builtin_amdgcn_update_dpp(0, __builtin_bit_cast(int, v), 0x4E, 0xf, 0xf, true));
  v += __builtin_bit_cast(float, __builtin_amdgcn_update_dpp(0, __builtin_bit_cast(int, v), 0x141, 0xf, 0xf, true));
  v += __builtin_bit_cast(float, __builtin_amdgcn_update_dpp(0, __builtin_bit_cast(int, v), 0x140, 0xf, 0xf, true));
  const int iv = __builtin_bit_cast(int, v);
  return __builtin_bit_cast(float, __builtin_amdgcn_readlane(iv, 0)) + __builtin_bit_cast(float, __builtin_amdgcn_readlane(iv, 16)) + __builtin_bit_cast(float, __builtin_amdgcn_readlane(iv, 32)) + __builtin_bit_cast(float, __builtin_amdgcn_readlane(iv, 48));
}
DI float siluf_(float x) { return x * __frcp_rn(1.0f + __expf(-x)); }
DI float softplusf_(float z) { return z > 20.f ? z : log1pf(expf(z)); }
DI f32x4 mfma16(bf16x8 a, bf16x8 b, f32x4 c) { return __builtin_amdgcn_mfma_f32_16x16x32_bf16(a, b, c, 0, 0, 0); }
DI float quad_sum(float v) {
  v += __builtin_bit_cast(float, __builtin_amdgcn_update_dpp(0, __builtin_bit_cast(int, v), 0xB1, 0xf, 0xf, true));
  v += __builtin_bit_cast(float, __builtin_amdgcn_update_dpp(0, __builtin_bit_cast(int, v), 0x4E, 0xf, 0xf, true));
  return v;
}


#define XB_TMO      128
#define XB_XCNT(j)  (256  + 64 * (j))
#define XB_XSUB(j)  (1280 + 64 * (j))
#define XB_XGEN(j)  (2304 + 64 * (j))
#define XB_TOP      3328
#define XB_TOPGEN   3392
#define XCD_BAR_WORDS 3456
#define XB_SPIN_CAP (1u << 18)
#define LAS __attribute__((address_space(3)))
DI unsigned xb_ld(unsigned* p)              { return __hip_atomic_load(p, __ATOMIC_RELAXED, __HIP_MEMORY_SCOPE_AGENT); }
DI unsigned xb_add(unsigned* p, unsigned v) { return __hip_atomic_fetch_add(p, v, __ATOMIC_RELAXED, __HIP_MEMORY_SCOPE_AGENT); }
DI unsigned xb_xcc_id() { return (unsigned)__builtin_amdgcn_s_getreg((3 << 11) | 20) & 0xFu; }
#define XB_SPIN(cond, bar) do { unsigned _sp = 0; while (cond) { __builtin_amdgcn_s_sleep(1); \
    if ((++_sp & 255u) == 0u) { if (xb_ld(&(bar)[XB_TMO])) break; if (_sp > XB_SPIN_CAP) { atomicAdd(&(bar)[XB_TMO], 1u); break; } } } } while (0)
struct XcdBarrier { unsigned* bar; unsigned x; volatile LAS unsigned* st; };
DI XcdBarrier xcd_barrier_post(unsigned* bar, volatile LAS unsigned* st) {
    XcdBarrier b; b.bar = bar; b.x = xb_xcc_id(); b.st = st;
    if (threadIdx.x == 0) (void)xb_add(&bar[XB_XCNT(b.x)], 1u);
    return b;
}
DI void xcd_barrier_complete(unsigned* bar, unsigned x, unsigned& nloc, unsigned& nx) {
    const unsigned G = gridDim.x * gridDim.y * gridDim.z;
    unsigned sum, cnt, mine, sp = 0u;
    for (;;) {
        sum = 0u; cnt = 0u; mine = 0u;
#pragma unroll
        for (unsigned j = 0; j < 16; ++j) { const unsigned c = xb_ld(&bar[XB_XCNT(j)]); sum += c; cnt += (c > 0u) ? 1u : 0u; mine = (j == x) ? c : mine; }
        if (sum == G) break;
        __builtin_amdgcn_s_sleep(1);
        if ((++sp & 255u) == 0u) { if (xb_ld(&bar[XB_TMO])) break; if (sp > XB_SPIN_CAP) { atomicAdd(&bar[XB_TMO], 1u); break; } }
    }
    nloc = mine > 0u ? mine : 1u; nx = cnt > 0u ? cnt : 1u;
}
DI void xcd_barrier(const XcdBarrier& b) {
    asm volatile("s_waitcnt vmcnt(0)" ::: "memory");
    __syncthreads();
    if (threadIdx.x == 0) {
        unsigned* bar = b.bar;
        __builtin_amdgcn_s_waitcnt(0);
        unsigned nloc = b.st[0], nx = b.st[1];
        if (nloc == 0u) { xcd_barrier_complete(bar, b.x, nloc, nx); b.st[0] = nloc; b.st[1] = nx; }
        const unsigned old = xb_add(&bar[XB_XSUB(b.x)], 1u);
        const unsigned gen = old / nloc;
        if (old + 1u == (gen + 1u) * nloc) {
            __builtin_amdgcn_fence(__ATOMIC_RELEASE, "agent");
            asm volatile("s_waitcnt vmcnt(0)" ::: "memory");
            const unsigned og = xb_add(&bar[XB_TOP], 1u);
            const unsigned tg = og / nx;
            if (og + 1u == (tg + 1u) * nx) xb_add(&bar[XB_TOPGEN], 1u);
            else XB_SPIN(xb_ld(&bar[XB_TOPGEN]) == tg, bar);
            __builtin_amdgcn_fence(__ATOMIC_ACQUIRE, "agent");
            xb_add(&bar[XB_XGEN(b.x)], 1u);
            asm volatile("s_waitcnt vmcnt(0)" ::: "memory");
        } else {
            XB_SPIN(xb_ld(&bar[XB_XGEN(b.x)]) == gen, bar);
            __builtin_amdgcn_fence(__ATOMIC_ACQUIRE, "agent");
            asm volatile("s_waitcnt vmcnt(0)" ::: "memory");
        }
    }
    __syncthreads();
}

template <typename T> DI float ldval(const T* p);
template <> DI float ldval<float>(const float* p) { return *p; }
template <> DI float ldval<bf16_t>(const bf16_t* p) { return bf2f(*p); }
template <typename T>
DI void transpose_tile(const T* src, int src_ld, bf16_t* dst, int dst_ld, float* lds) {
  const int tid = tid_opaque();
  for (int i = 0; i < 16; ++i) { int r = (tid >> 6) + 4 * i, c = tid & 63; lds[r * 65 + c] = ldval<T>(src + (size_t)r * src_ld + c); }
  __syncthreads();
  for (int i = 0; i < 16; ++i) { int c = (tid >> 6) + 4 * i, r = tid & 63; dst[(size_t)c * dst_ld + r] = f2bf(lds[r * 65 + c]); }
  __syncthreads();
}

__device__ void phase_prologue(const Params& p, unsigned char* smem) {
  float* lds = (float*)smem;
  const int n0 = 1728, n1 = n0 + 512, n2 = n1 + 192, n3 = n2 + 64, n4 = n3 + 128, n5 = n4 + 192;
#pragma unroll 1
  for (int it = blockIdx.x; it < n5; it += gridDim.x) {
    const int tid = tid_opaque();
    if (it < n0) {
      int l = it / 864, r = it % 864, kt = r / 54, nt = r % 54;
      transpose_tile<float>(p.w_in + (size_t)l * 1024 * PW + (size_t)kt * 64 * PW + nt * 64, PW,
                            p.WINT + (size_t)l * PW * 1024 + (size_t)nt * 64 * 1024 + kt * 64, 1024, lds);
    } else if (it < n1) {
      int i2 = it - n0; int l = i2 / 256, r = i2 % 256, kt = r / 16, nt = r % 16;
      transpose_tile<float>(p.w_out + (size_t)l * 1024 * 1024 + (size_t)kt * 64 * 1024 + nt * 64, 1024,
                            p.WOUTT + (size_t)l * 1024 * 1024 + (size_t)nt * 64 * 1024 + kt * 64, 1024, lds);
    } else if (it < n2) {
      int i2 = it - n1; int l = i2 / 96, nb = (i2 % 96) * 32;
      float* sc = lds;
      float* red = lds + 5 * 1024;
      for (int i = tid; i < 5 * 1024; i += 256) { int v = i >> 10, k = i & 1023; float x = v == 0 ? p.c_ctx[k] : p.c[(v - 1) * 1024 + k]; sc[i] = siluf_(x); }
      __syncthreads();
      int n = tid & 31, kg = tid >> 5;
      float a0 = 0, a1 = 0, a2 = 0, a3 = 0, a4 = 0;
      const float* wp = p.w_mod + (size_t)l * 1024 * 3072 + nb + n;
      for (int k = kg * 128; k < kg * 128 + 128; ++k) {
        float w = wp[(size_t)k * 3072];
        a0 += sc[k] * w; a1 += sc[1024 + k] * w; a2 += sc[2048 + k] * w; a3 += sc[3072 + k] * w; a4 += sc[4096 + k] * w;
      }
      red[(kg * 5 + 0) * 32 + n] = a0; red[(kg * 5 + 1) * 32 + n] = a1; red[(kg * 5 + 2) * 32 + n] = a2; red[(kg * 5 + 3) * 32 + n] = a3; red[(kg * 5 + 4) * 32 + n] = a4;
      __syncthreads();
      if (tid < 160) { int v = tid >> 5, nn = tid & 31; float s = p.b_mod[l * 3072 + nb + nn]; for (int q = 0; q < 8; ++q) s += red[(q * 5 + v) * 32 + nn]; p.MOD[(size_t)(l * 5 + v) * 3072 + nb + nn] = s; }
      __syncthreads();
    } else if (it < n3) {
      int i2 = it - n2; int bl = i2 >> 3, r = i2 & 7, pt = r >> 1, ct = r & 1;
      transpose_tile<float>(p.cwv + (size_t)bl * 256 * 128 + (size_t)pt * 64 * 128 + ct * 64, 128,
                            p.CWVT + (size_t)bl * 128 * 256 + (size_t)ct * 64 * 256 + pt * 64, 256, lds);
    } else if (it < n4) {
      int i2 = it - n3; int bl = i2 >> 4, r = i2 & 15, pt = r >> 2, ct = r & 3;
      transpose_tile<float>(p.cdv + (size_t)bl * 256 * 256 + (size_t)pt * 64 * 256 + ct * 64, 256,
                            p.CDVT + (size_t)bl * 256 * 256 + (size_t)ct * 64 * 256 + pt * 64, 256, lds);
    } else {
      int i2 = it - n4;
      const float* src; bf16_t* dst;
      if (i2 < 64) { src = p.cwk + (size_t)i2 * 4096; dst = p.CWK + (size_t)i2 * 4096; }
      else { src = p.cdk + (size_t)(i2 - 64) * 4096; dst = p.CDK + (size_t)(i2 - 64) * 4096; }
      for (int i = tid * 4; i < 4096; i += 1024) { float4 v = *(const float4*)(src + i); uint2 o; o.x = pack2(v.x, v.y); o.y = pack2(v.z, v.w); *(uint2*)(dst + i) = o; }
    }
  }
}

__device__ void phase_norm(const Params& p, int stage) {
  const int tid0 = tid_opaque();
  const int lane = tid0 & 63, wave = tid0 >> 6;
#pragma unroll 1
  for (int tok = blockIdx.x * 4 + wave; tok < NTOK; tok += gridDim.x * 4) {
    const int mv = tok < 4096 ? 0 : 1 + ((tok - 4096) >> 10);
    const float* xin;
    if (stage <= 1) xin = tok < 4096 ? p.x_prompt + (size_t)tok * 1024 : p.x_sample + (size_t)(tok - 4096) * 1024;
    else xin = p.out + (size_t)tok * 1024;
    float4 x[4];
#pragma unroll
    for (int i = 0; i < 4; ++i) x[i] = *(const float4*)(xin + i * 256 + lane * 4);
    if (stage >= 1) {
      const int lp = stage - 1;
      float4 y[4]; float ss = 0.f;
#pragma unroll
      for (int i = 0; i < 4; ++i) { y[i] = *(const float4*)(p.Y2 + (size_t)tok * 1024 + i * 256 + lane * 4); ss += y[i].x * y[i].x + y[i].y * y[i].y + y[i].z * y[i].z + y[i].w * y[i].w; }
      ss = wave_sum(ss);
      const float rstd = rsqrtf(ss * (1.0f / 1024.0f) + 1e-6f);
      const float* gate = p.MOD + (size_t)(lp * 5 + mv) * 3072 + 2048;
      const float* gp = p.g_post + lp * 1024;
#pragma unroll
      for (int i = 0; i < 4; ++i) {
        const int col = i * 256 + lane * 4;
        float4 g = *(const float4*)(gate + col), q = *(const float4*)(gp + col);
        x[i].x += g.x * (y[i].x * rstd * q.x); x[i].y += g.y * (y[i].y * rstd * q.y); x[i].z += g.z * (y[i].z * rstd * q.z); x[i].w += g.w * (y[i].w * rstd * q.w);
        *(float4*)(p.out + (size_t)tok * 1024 + col) = x[i];
      }
    }
    if (stage <= 1) {
      const int l = stage;
      float ss = 0.f;
#pragma unroll
      for (int i = 0; i < 4; ++i) ss += x[i].x * x[i].x + x[i].y * x[i].y + x[i].z * x[i].z + x[i].w * x[i].w;
      ss = wave_sum(ss);
      const float rstd = rsqrtf(ss * (1.0f / 1024.0f) + 1e-6f);
      const float* md = p.MOD + (size_t)(l * 5 + mv) * 3072;
      const float* gp = p.g_pre + l * 1024;
#pragma unroll
      for (int i = 0; i < 4; ++i) {
        const int col = i * 256 + lane * 4;
        float4 sh = *(const float4*)(md + col), sc = *(const float4*)(md + 1024 + col), g = *(const float4*)(gp + col);
        float h0 = x[i].x * rstd * g.x * (1.f + sc.x) + sh.x, h1 = x[i].y * rstd * g.y * (1.f + sc.y) + sh.y;
        float h2 = x[i].z * rstd * g.z * (1.f + sc.z) + sh.z, h3 = x[i].w * rstd * g.w * (1.f + sc.w) + sh.w;
        uint2 o; o.x = pack2(h0, h1); o.y = pack2(h2, h3);
        *(uint2*)(p.H + (size_t)tok * 1024 + col) = o;
      }
    }
  }
}

template <int MODE>
__device__ void phase_gemm(const Params& p, int l, unsigned char* smem) {
  const bf16_t* A = p.H;
  const bf16_t* Bt = MODE == 0 ? p.WINT + (size_t)l * PW * 1024 : p.WOUTT + (size_t)l * 1024 * 1024;
  const int N = MODE == 0 ? PW : 1024, K = 1024;
  const int NTN = N / 128, NT = 64 * NTN;
  bf16_t* As = (bf16_t*)smem; bf16_t* Bs = As + 128 * 72;
#pragma unroll 1
  for (int tile = blockIdx.x; tile < NT; tile += gridDim.x) {
    const int tid = tid_opaque(), lane = tid & 63, wave = tid >> 6, wm = wave >> 1, wn = wave & 1, r16 = lane & 15, quad = lane >> 4;
    const int tm = tile / NTN, tn = tile % NTN, m0 = tm * 128, n0 = tn * 128;
    f32x4 acc[4][4];
#pragma unroll
    for (int i = 0; i < 4; ++i)
#pragma unroll
      for (int j = 0; j < 4; ++j) acc[i][j] = (f32x4){0.f, 0.f, 0.f, 0.f};
    u32x4 ra[4], rb[4];
#pragma unroll
    for (int i = 0; i < 4; ++i) { int id = tid + 256 * i, row = id >> 3, c8 = id & 7; ra[i] = *(const u32x4*)(A + (size_t)(m0 + row) * K + c8 * 8); rb[i] = *(const u32x4*)(Bt + (size_t)(n0 + row) * K + c8 * 8); }
#pragma unroll
    for (int i = 0; i < 4; ++i) { int id = tid + 256 * i, row = id >> 3, c8 = id & 7; *(u32x4*)(As + row * 72 + c8 * 8) = ra[i]; *(u32x4*)(Bs + row * 72 + c8 * 8) = rb[i]; }
    __syncthreads();
    for (int kt = 0; kt < 16; ++kt) {
      if (kt + 1 < 16) {
#pragma unroll
        for (int i = 0; i < 4; ++i) { int id = tid + 256 * i, row = id >> 3, c8 = id & 7; ra[i] = *(const u32x4*)(A + (size_t)(m0 + row) * K + (kt + 1) * 64 + c8 * 8); rb[i] = *(const u32x4*)(Bt + (size_t)(n0 + row) * K + (kt + 1) * 64 + c8 * 8); }
      }
#pragma unroll
      for (int ks = 0; ks < 2; ++ks) {
        bf16x8 af[4], bfr[4];
#pragma unroll
        for (int i = 0; i < 4; ++i) {
          af[i] = *(const bf16x8*)(As + (wm * 64 + i * 16 + r16) * 72 + ks * 32 + quad * 8);
          bfr[i] = *(const bf16x8*)(Bs + (wn * 64 + i * 16 + r16) * 72 + ks * 32 + quad * 8);
        }
#pragma unroll
        for (int mi = 0; mi < 4; ++mi)
#pragma unroll
          for (int ni = 0; ni < 4; ++ni) acc[mi][ni] = mfma16(bfr[ni], af[mi], acc[mi][ni]);
      }
      __syncthreads();
      if (kt + 1 < 16) {
#pragma unroll
        for (int i = 0; i < 4; ++i) { int id = tid + 256 * i, row = id >> 3, c8 = id & 7; *(u32x4*)(As + row * 72 + c8 * 8) = ra[i]; *(u32x4*)(Bs + row * 72 + c8 * 8) = rb[i]; }
        __syncthreads();
      }
    }
#pragma unroll
    for (int mi = 0; mi < 4; ++mi)
#pragma unroll
      for (int ni = 0; ni < 4; ++ni) {
        const int m = m0 + wm * 64 + mi * 16 + r16, n = n0 + wn * 64 + ni * 16 + quad * 4;
        const f32x4 v = acc[mi][ni];
        if (MODE == 0) {
          uint2 o; o.x = pack2(v[0], v[1]); o.y = pack2(v[2], v[3]);
          *(uint2*)(p.P + (size_t)m * PW + n) = o;
          if (m0 < 4096) {
            const int row = ((m >> 8) * 2 + l) * 256 + (m & 255);
            float* dst = nullptr;
            if (tn == 11) dst = p.out + O_NWK + (size_t)row * 128 + (n - 1408);
            else if (tn == 12) dst = p.out + O_NWV + (size_t)row * 128 + (n - 1536);
            else if (tn == 21 || tn == 22) dst = p.out + O_NDK + (size_t)row * 256 + (n - 2688);
            else if (tn == 23 || tn == 24) dst = p.out + O_NDV + (size_t)row * 256 + (n - 2944);
            if (dst) *(float4*)dst = (float4){v[0], v[1], v[2], v[3]};
          }
        } else {
          *(float4*)(p.Y2 + (size_t)m * 1024 + n) = (float4){v[0], v[1], v[2], v[3]};
        }
      }
  }
}

__device__ void pre_rwkv(const Params& p, int l, int item, unsigned char* smem) {
  float* s_wd = (float*)smem;
  float* s_ad = s_wd + 16 * 64;
  const int tid = tid_opaque(), c = tid;
  const int tok0 = item * 16;
  for (int i = 0; i < 8; ++i) {
    int idx = tid + 256 * i, tt = idx >> 7, m = idx & 127;
    float v = bf2f(p.P[(size_t)(tok0 + tt) * PW + 768 + m]);
    if (m < 64) s_wd[tt * 64 + m] = 1.0f - 2.0f * __frcp_rn(1.0f + __expf(2.0f * v)); else s_ad[tt * 64 + m - 64] = v;
  }
  __syncthreads();
  float aw0[16], aw1[16], aa0[16], aa1[16];
#pragma unroll
  for (int t = 0; t < 16; ++t) { aw0[t] = 0.f; aw1[t] = 0.f; aa0[t] = 0.f; aa1[t] = 0.f; }
  const float* wu0 = p.rw_wup + (size_t)(l * 2 + 0) * 64 * 256 + c;
  const float* wu1 = p.rw_wup + (size_t)(l * 2 + 1) * 64 * 256 + c;
  const float* au0 = p.rw_aup + (size_t)(l * 2 + 0) * 64 * 256 + c;
  const float* au1 = p.rw_aup + (size_t)(l * 2 + 1) * 64 * 256 + c;
  for (int m = 0; m < 64; m += 4) {
    float w0[4], w1[4], a0[4], a1[4];
#pragma unroll
    for (int q = 0; q < 4; ++q) { w0[q] = wu0[(m + q) * 256]; w1[q] = wu1[(m + q) * 256]; a0[q] = au0[(m + q) * 256]; a1[q] = au1[(m + q) * 256]; }
#pragma unroll
    for (int t = 0; t < 16; ++t) {
      const float4 xv = *(const float4*)(s_wd + t * 64 + m), yv = *(const float4*)(s_ad + t * 64 + m);
      aw0[t] += xv.x * w0[0] + xv.y * w0[1] + xv.z * w0[2] + xv.w * w0[3];
      aw1[t] += xv.x * w1[0] + xv.y * w1[1] + xv.z * w1[2] + xv.w * w1[3];
      aa0[t] += yv.x * a0[0] + yv.y * a0[1] + yv.z * a0[2] + yv.w * a0[3];
      aa1[t] += yv.x * a1[0] + yv.y * a1[1] + yv.z * a1[2] + yv.w * a1[3];
    }
  }
  const float kkc = p.rw_kk[l * 256 + c], kac = p.rw_ka[l * 256 + c];
  const float w00 = p.rw_w0[(l * 2 + 0) * 256 + c], w01 = p.rw_w0[(l * 2 + 1) * 256 + c];
  const float a00 = p.rw_a0[(l * 2 + 0) * 256 + c], a01 = p.rw_a0[(l * 2 + 1) * 256 + c];
#pragma unroll
  for (int t = 0; t < 16; ++t) {
    const int tok = tok0 + t;
    const float k = bf2f(p.P[(size_t)tok * PW + 256 + c]);
    float kk = k * kkc;
    const float ss = wave_sum_dpp(kk * kk);
    kk *= rsqrtf(ss + 1e-12f);
    p.NKK[(size_t)tok * 256 + c] = -kk;
#pragma unroll
    for (int d = 0; d < 2; ++d) {
      const float wl = (d ? w01 : w00) + (d ? aw1[t] : aw0[t]);
      const float w_log = -__logf(1.0f + __expf(-wl)) - 0.5f;
      const float decay = __expf(-__expf(w_log));
      const float a = fsigmoid((d ? a01 : a00) + (d ? aa1[t] : aa0[t]));
      const float kd = k * (1.f + (a - 1.f) * kac);
      const size_t o = ((size_t)d * NTOK + tok) * 256 + c;
      p.AW[o] = decay; p.AB[o] = kk * a; p.AKD[o] = kd;
    }
  }
  __syncthreads();
}

__device__ void pre_lru(const Params& p, int l, int item, unsigned char* smem) {
  float* s_xc = (float*)smem;
  const int tid = tid_opaque(), c = tid, n = c >> 6;
  const int tok0 = item * 16;
  int T, sb, t0;
  if (tok0 < 4096) { T = 256; sb = tok0 & ~255; t0 = tok0 & 255; } else { T = 1024; sb = 4096 + ((tok0 - 4096) & ~1023); t0 = (tok0 - 4096) & 1023; }
  {
    float xs[19];
#pragma unroll
    for (int i = 0; i < 19; ++i) { int t = t0 - 2 + i; xs[i] = (t >= 0 && t < T) ? bf2f(p.P[(size_t)(sb + t) * PW + 1920 + c]) : 0.f; }
    const float cw0 = p.lru_cw[(l * 4 + 0) * 256 + c], cw1 = p.lru_cw[(l * 4 + 1) * 256 + c], cw2 = p.lru_cw[(l * 4 + 2) * 256 + c], cw3 = p.lru_cw[(l * 4 + 3) * 256 + c];
    const float cb = p.lru_cb[l * 256 + c];
#pragma unroll
    for (int t = 0; t < 16; ++t) s_xc[t * 256 + c] = cb + cw0 * xs[t] + cw1 * xs[t + 1] + cw2 * xs[t + 2] + cw3 * xs[t + 3];
  }
  __syncthreads();
  float ga0[16], ga1[16], gx0[16], gx1[16];
#pragma unroll
  for (int t = 0; t < 16; ++t) { ga0[t] = 0.f; ga1[t] = 0.f; gx0[t] = 0.f; gx1[t] = 0.f; }
  const int e = c & 63;
  const float* wa0 = p.lru_wa + ((size_t)((l * 2 + 0) * 4 + n) * 64) * 64 + e;
  const float* wa1 = p.lru_wa + ((size_t)((l * 2 + 1) * 4 + n) * 64) * 64 + e;
  const float* wx0 = p.lru_wx + ((size_t)((l * 2 + 0) * 4 + n) * 64) * 64 + e;
  const float* wx1 = p.lru_wx + ((size_t)((l * 2 + 1) * 4 + n) * 64) * 64 + e;
  for (int m = 0; m < 64; m += 4) {
    float a0[4], a1[4], x0[4], x1[4];
#pragma unroll
    for (int q = 0; q < 4; ++q) { a0[q] = wa0[(m + q) * 64]; a1[q] = wa1[(m + q) * 64]; x0[q] = wx0[(m + q) * 64]; x1[q] = wx1[(m + q) * 64]; }
#pragma unroll
    for (int t = 0; t < 16; ++t) {
      const float4 xv = *(const float4*)(s_xc + t * 256 + n * 64 + m);
      ga0[t] += xv.x * a0[0] + xv.y * a0[1] + xv.z * a0[2] + xv.w * a0[3];
      ga1[t] += xv.x * a1[0] + xv.y * a1[1] + xv.z * a1[2] + xv.w * a1[3];
      gx0[t] += xv.x * x0[0] + xv.y * x0[1] + xv.z * x0[2] + xv.w * x0[3];
      gx1[t] += xv.x * x1[0] + xv.y * x1[1] + xv.z * x1[2] + xv.w * x1[3];
    }
  }
  const float ba0 = p.lru_ba[(l * 2 + 0) * 256 + c], ba1 = p.lru_ba[(l * 2 + 1) * 256 + c];
  const float bx0 = p.lru_bx[(l * 2 + 0) * 256 + c], bx1 = p.lru_bx[(l * 2 + 1) * 256 + c];
  const float sp0 = softplusf_(-p.lru_lam[(l * 2 + 0) * 256 + c]), sp1 = softplusf_(-p.lru_lam[(l * 2 + 1) * 256 + c]);
#pragma unroll
  for (int t = 0; t < 16; ++t) {
    const float x = s_xc[t * 256 + c];
#pragma unroll
    for (int d = 0; d < 2; ++d) {
      const float ga = fsigmoid((d ? ga1[t] : ga0[t]) + (d ? ba1 : ba0));
      const float gx = fsigmoid((d ? gx1[t] : gx0[t]) + (d ? bx1 : bx0));
      const float log_a = -8.0f * ga * (d ? sp1 : sp0);
      const float a = __expf(log_a);
      const float x2 = 2.0f * log_a;
      const float om = x2 > -0.05f ? -(x2 * (1.0f + x2 * (0.5f + x2 * (0.16666667f + x2 * 0.041666667f)))) : 1.0f - __expf(x2);
      const float u = __fsqrt_rn(om) * (gx * x);
      if (d) { ga1[t] = a; gx1[t] = u; } else { ga0[t] = a; gx0[t] = u; }
    }
  }
  {
    float h = 0.f, A = 1.f;
#pragma unroll
    for (int t = 0; t < 16; ++t) { h = ga0[t] * h + gx0[t]; A *= ga0[t]; const size_t o = (size_t)(tok0 + t) * 256 + c; p.LA[o] = A; p.LU[o] = h; }
    h = 0.f; A = 1.f;
#pragma unroll
    for (int t = 15; t >= 0; --t) { h = ga1[t] * h + gx1[t]; A *= ga1[t]; const size_t o = ((size_t)NTOK + tok0 + t) * 256 + c; p.LA[o] = A; p.LU[o] = h; }
  }
  __syncthreads();
}

__device__ void pre_rope(const Params& p, int item) {
  const int tid = tid_opaque();
  for (int tt = 0; tt < 16; ++tt) {
    const int ts = item * 16 + tt;
    const int t = ts & 1023;
    const float row = (float)(t >> 6), col = (float)(t & 63);
    const bf16_t* src = p.P + (size_t)(4096 + ts) * PW;
    for (int pp = tid; pp < 448; pp += 256) {
      int scol, d1, d2, half, i; bf16_t* dst; float inv;
      if (pp < 192) {
        int q = pp < 128 ? pp : pp - 128; int vec = q >> 5, pi = q & 31; half = pi >> 4; i = pi & 15;
        d1 = half * 32 + i; d2 = d1 + 16; inv = exp2f(-(float)i * (13.287712379549449f / 16.0f));
        if (pp < 128) { scol = 1152 + vec * 64; dst = p.QBR + (size_t)ts * 256 + vec * 64; }
        else { scol = 1408 + vec * 64; dst = p.KBR + (size_t)ts * 128 + vec * 64; }
      } else {
        int q = pp < 320 ? pp - 192 : pp - 320; int vec = q >> 4, pi = q & 15; half = pi >> 3; i = pi & 7;
        d1 = half * 16 + i; d2 = d1 + 8; inv = exp2f(-(float)i * (13.287712379549449f / 8.0f));
        if (pp < 320) { scol = 2432 + vec * 32; dst = p.QDR + (size_t)ts * 256 + vec * 32; }
        else { scol = 2688 + vec * 32; dst = p.KDR + (size_t)ts * 256 + vec * 32; }
      }
      const float ang = (half ? col : row) * inv;
      float sn, cs; sincosf(ang, &sn, &cs);
      const float x1 = bf2f(src[scol + d1]), x2 = bf2f(src[scol + d2]);
      dst[d1] = f2bf(x1 * cs - x2 * sn); dst[d2] = f2bf(x1 * sn + x2 * cs);
    }
  }
}

__device__ void phase_pre(const Params& p, int l, unsigned char* smem) {
  const int n0 = 512, n1 = n0 + 512, n2 = n1 + 256, n3 = n2 + 256, n4 = n3 + 512;
#pragma unroll 1
  for (int it = blockIdx.x; it < n4; it += gridDim.x) {
    if (it < n0) pre_rwkv(p, l, it, smem);
    else if (it < n1) pre_lru(p, l, it - n0, smem);
    else if (it < n2) pre_rope(p, it - n1);
    else if (it < n3) {
      int i2 = it - n2; int tt = i2 >> 1, ct = i2 & 1; int tok0 = tt * 64;
      int T, sb; if (tok0 < 4096) { T = 256; sb = tok0 & ~255; } else { T = 1024; sb = 4096 + ((tok0 - 4096) & ~1023); }
      transpose_tile<bf16_t>(p.P + (size_t)tok0 * PW + 1536 + ct * 64, PW, p.VBT + (size_t)sb * 128 + (size_t)(ct * 64) * T + (tok0 - sb), T, (float*)smem);
    } else {
      int i2 = it - n3; int tt = i2 >> 2, ct = i2 & 3; int tok0 = tt * 64;
      int T, sb; if (tok0 < 4096) { T = 256; sb = tok0 & ~255; } else { T = 1024; sb = 4096 + ((tok0 - 4096) & ~1023); }
      transpose_tile<bf16_t>(p.P + (size_t)tok0 * PW + 2944 + ct * 64, PW, p.VDT + (size_t)sb * 256 + (size_t)(ct * 64) * T + (tok0 - sb), T, (float*)smem);
    }
  }
}

template <int LR> DI float group_sum(float v) {
  v += __builtin_bit_cast(float, __builtin_amdgcn_update_dpp(0, __builtin_bit_cast(int, v), 0xB1, 0xf, 0xf, true));
  v += __builtin_bit_cast(float, __builtin_amdgcn_update_dpp(0, __builtin_bit_cast(int, v), 0x4E, 0xf, 0xf, true));
  if (LR >= 8) v += __builtin_bit_cast(float, __builtin_amdgcn_update_dpp(0, __builtin_bit_cast(int, v), 0x141, 0xf, 0xf, true));
  if (LR >= 16) v += __builtin_bit_cast(float, __builtin_amdgcn_update_dpp(0, __builtin_bit_cast(int, v), 0x140, 0xf, 0xf, true));
  return v;
}
template <int E>
__device__ void rwkv_chain(const Params& p, int l, int chain, int part, unsigned char* smem) {
  constexpr int LR = 64 / E, NM = E / 4;
  const int tid = tid_opaque(), lane = tid & 63, wave = tid >> 6;
  int seq, d, h;
  if (chain < 32) { seq = 16 + (chain >> 3); d = (chain >> 2) & 1; h = chain & 3; }
  else { int c2 = chain - 32; seq = c2 >> 3; d = (c2 >> 2) & 1; h = c2 & 3; }
  const int T = seq < 16 ? 256 : 1024, tokb = seq < 16 ? seq * 256 : 4096 + (seq - 16) * 1024;
  const int g = lane % LR, rl = lane / LR, i = part * 4 * E + wave * E + rl;
  float S[E];
  if (seq >= 16) {
    const float* s0 = p.st_rwkv + ((((size_t)(seq - 16) * 2 + l) * 2 + d) * 4 + h) * 4096 + i * 64;
#pragma unroll
    for (int m = 0; m < NM; ++m) { f32x4 t = *(const f32x4*)(s0 + 4 * (g + LR * m)); S[4 * m] = t[0]; S[4 * m + 1] = t[1]; S[4 * m + 2] = t[2]; S[4 * m + 3] = t[3]; }
  } else {
#pragma unroll
    for (int j = 0; j < E; ++j) S[j] = 0.f;
  }
  float* buf = (float*)smem;
  const int lvec = (tid >> 4) & 3, lc4 = tid & 15, ls = tid >> 6;
  const float* fsrc = (lvec == 0 ? p.NKK : lvec == 1 ? p.AW + (size_t)d * NTOK * 256 : lvec == 2 ? p.AB + (size_t)d * NTOK * 256 : p.AKD + (size_t)d * NTOK * 256) + h * 64 + lc4 * 4;
  const int bs = tid >> 4, bvec = (tid >> 3) & 1, bc8 = tid & 7;
  const bf16_t* bsrc = p.P + (bvec ? 512 : 0) + h * 64 + bc8 * 8;
  f32x4 rf[4]; u32x4 rb;
  const int nch = T / 16;
  auto gload = [&](int ck) {
#pragma unroll
    for (int i4 = 0; i4 < 4; ++i4) { int step = ck * 16 + ls + 4 * i4; int t = d ? T - 1 - step : step; rf[i4] = *(const f32x4*)(fsrc + (size_t)(tokb + t) * 256); }
    { int step = ck * 16 + bs; int t = d ? T - 1 - step : step; rb = *(const u32x4*)(bsrc + (size_t)(tokb + t) * PW); }
  };
  auto sstore = [&](int bi) {
    float* b = buf + bi * 16 * 384;
#pragma unroll
    for (int i4 = 0; i4 < 4; ++i4) *(f32x4*)(b + (ls + 4 * i4) * 384 + lvec * 64 + lc4 * 4) = rf[i4];
    float* q = b + bs * 384 + (4 + bvec) * 64 + bc8 * 8;
    *(f32x4*)q = (f32x4){bflo(rb.x), bfhi(rb.x), bflo(rb.y), bfhi(rb.y)};
    *(f32x4*)(q + 4) = (f32x4){bflo(rb.z), bfhi(rb.z), bflo(rb.w), bfhi(rb.w)};
  };
  gload(0); sstore(0); __syncthreads();
  float* yout = p.YA + ((size_t)d * NTOK + tokb) * 256 + h * 64 + i;
  constexpr int NY = 16 / LR;
#pragma unroll 1
  for (int ck = 0; ck < nch; ++ck) {
    if (ck + 1 < nch) gload(ck + 1);
    const float* cb = buf + (ck & 1) * 16 * 384;
    float yk[NY];
#pragma unroll
    for (int q = 0; q < NY; ++q) yk[q] = 0.f;
#pragma unroll 4
    for (int s = 0; s < 16; ++s) {
      const float* ob = cb + s * 384;
      f32x4 nk[NM], ww[NM], bb[NM], kk[NM], rr[NM];
#pragma unroll
      for (int m = 0; m < NM; ++m) {
        const int off = 4 * (g + LR * m);
        nk[m] = *(const f32x4*)(ob + off); ww[m] = *(const f32x4*)(ob + 64 + off); bb[m] = *(const f32x4*)(ob + 128 + off);
        kk[m] = *(const f32x4*)(ob + 192 + off); rr[m] = *(const f32x4*)(ob + 256 + off);
      }
      const float vi = ob[320 + i];
      float sa = 0.f;
#pragma unroll
      for (int m = 0; m < NM; ++m) sa += (S[4 * m] * nk[m][0] + S[4 * m + 1] * nk[m][1]) + (S[4 * m + 2] * nk[m][2] + S[4 * m + 3] * nk[m][3]);
      sa = group_sum<LR>(sa);
      float y = 0.f;
#pragma unroll
      for (int m = 0; m < NM; ++m) {
#pragma unroll
        for (int e = 0; e < 4; ++e) S[4 * m + e] = S[4 * m + e] * ww[m][e] + (sa * bb[m][e] + vi * kk[m][e]);
        y += (S[4 * m] * rr[m][0] + S[4 * m + 1] * rr[m][1]) + (S[4 * m + 2] * rr[m][2] + S[4 * m + 3] * rr[m][3]);
      }
      y = group_sum<LR>(y);
#pragma unroll
      for (int q = 0; q < NY; ++q) yk[q] = (s == q * LR + g) ? y : yk[q];
    }
#pragma unroll
    for (int q = 0; q < NY; ++q) { const int step = ck * 16 + q * LR + g; const int t = d ? T - 1 - step : step; yout[(size_t)t * 256] = yk[q]; }
    if (ck + 1 < nch) sstore((ck + 1) & 1);
    __syncthreads();
  }
  if (seq < 16) {
    float* so = p.out + O_NSR + ((((size_t)seq * 2 + l) * 2 + d) * 4 + h) * 4096 + i * 64;
#pragma unroll
    for (int m = 0; m < NM; ++m) *(f32x4*)(so + 4 * (g + LR * m)) = (f32x4){S[4 * m], S[4 * m + 1], S[4 * m + 2], S[4 * m + 3]};
  }
}

__device__ void lru_scan(const Params& p, int l, int item) {
  const int c = tid_opaque();
  int seq, d;
  if (item < 8) { seq = 16 + (item >> 1); d = item & 1; } else { seq = (item - 8) >> 1; d = item & 1; }
  const int T = seq < 16 ? 256 : 1024, tokb = seq < 16 ? seq * 256 : 4096 + (seq - 16) * 1024;
  const int NC = T >> 4;
  float h = seq >= 16 ? p.st_lru[(((seq - 16) * 2 + l) * 2 + d) * 256 + c] : 0.f;
  const float* la = p.LA + (size_t)d * NTOK * 256 + c; const float* lu = p.LU + (size_t)d * NTOK * 256 + c;
  float* lc = p.LC + (size_t)d * 512 * 256 + (size_t)(tokb >> 4) * 256 + c;
  for (int k0 = 0; k0 < NC; k0 += 8) {
    float a[8], u[8];
#pragma unroll
    for (int q = 0; q < 8; ++q) { const int k = d ? NC - 1 - (k0 + q) : k0 + q; const size_t idx = (size_t)(tokb + k * 16 + (d ? 0 : 15)) * 256; a[q] = la[idx]; u[q] = lu[idx]; }
#pragma unroll
    for (int q = 0; q < 8; ++q) { const int k = d ? NC - 1 - (k0 + q) : k0 + q; lc[(size_t)k * 256] = h; h = a[q] * h + u[q]; }
  }
  if (seq < 16) p.out[O_NSL + ((seq * 2 + l) * 2 + d) * 256 + c] = h;
}

template <bool DIFF>
DI void attn_keytile(const bf16_t* Kp, int kstride, const bf16_t* Vtp, int vstride, const bf16x8 (&qf)[2], float scale_log2,
                     bool masked, int kpos0, int qpos, float (&m)[2], float (&lsum)[2], f32x4 (&o)[2][4], int lane) {
  const int r16 = lane & 15, quad = lane >> 4;
  constexpr int NS = DIFF ? 2 : 1;
  f32x4 sc[NS][4];
  const f32x4 z4 = {0.f, 0.f, 0.f, 0.f};
  bf16x8 kf0[4], kf1[4], vfr[4][2];
#pragma unroll
  for (int kt = 0; kt < 4; ++kt) {
    const int s = kt >> 1, u = kt & 1;
    const int key = 32 * s + 8 * (r16 >> 2) + 4 * u + (r16 & 3);
    const bf16_t* kr = Kp + (size_t)key * kstride + quad * 8;
    kf0[kt] = *(const bf16x8*)kr; kf1[kt] = *(const bf16x8*)(kr + 32);
  }
#pragma unroll
  for (int dt = 0; dt < 4; ++dt)
#pragma unroll
    for (int s = 0; s < 2; ++s) vfr[dt][s] = *(const bf16x8*)(Vtp + (size_t)(dt * 16 + r16) * vstride + 32 * s + 8 * quad);
#pragma unroll
  for (int kt = 0; kt < 4; ++kt) {
    const bf16x8 k0 = kf0[kt], k1 = kf1[kt];
    if (!DIFF) { sc[0][kt] = mfma16(k0, qf[0], z4); sc[0][kt] = mfma16(k1, qf[1], sc[0][kt]); }
    else { sc[0][kt] = mfma16(k0, qf[0], z4); sc[NS - 1][kt] = mfma16(k1, qf[1], z4); }
  }
  bf16x8 pf[NS][2];
#pragma unroll
  for (int st = 0; st < NS; ++st) {
    float mx = -3.0e38f;
#pragma unroll
    for (int kt = 0; kt < 4; ++kt)
#pragma unroll
      for (int r = 0; r < 4; ++r) {
        float x = sc[st][kt][r] * scale_log2;
        if (masked) { const int kp = kpos0 + 32 * (kt >> 1) + 8 * quad + 4 * (kt & 1) + r; const int dd = kp - qpos; if (dd > 128 || dd < -128) x = -1.0e30f; }
        sc[st][kt][r] = x; mx = fmaxf(mx, x);
      }
    mx = fmaxf(mx, __shfl_xor(mx, 16)); mx = fmaxf(mx, __shfl_xor(mx, 32));
    const float mnew = fmaxf(m[st], mx);
    const float alpha = exp2f(m[st] - mnew);
    m[st] = mnew;
    float ps = 0.f;
#pragma unroll
    for (int kt = 0; kt < 4; ++kt)
#pragma unroll
      for (int r = 0; r < 4; ++r) { const float e = exp2f(sc[st][kt][r] - mnew); sc[st][kt][r] = e; ps += e; }
    lsum[st] = lsum[st] * alpha + ps;
#pragma unroll
    for (int dt = 0; dt < 4; ++dt) o[st][dt] *= alpha;
#pragma unroll
    for (int s = 0; s < 2; ++s) {
      bf16x8 t;
#pragma unroll
      for (int j = 0; j < 8; ++j) t[j] = (short)f2bf(sc[st][2 * s + (j >> 2)][j & 3]);
      pf[st][s] = t;
    }
  }
#pragma unroll
  for (int dt = 0; dt < 4; ++dt)
#pragma unroll
    for (int s = 0; s < 2; ++s) {
      const bf16x8 vf = vfr[dt][s];
#pragma unroll
      for (int st = 0; st < NS; ++st) o[st][dt] = mfma16(vf, pf[st][s], o[st][dt]);
    }
}

template <bool DIFF>
__device__ void attn_item(const Params& p, int l, bool sample, int sq  , int h, int qt) {
  const int tid = tid_opaque();
  const int lane = tid & 63, wave = tid >> 6, r16 = lane & 15, quad = lane >> 4;
  const int T = sample ? 1024 : 256;
  const int tokb = sample ? 4096 + sq * 1024 : sq * 256;
  const int q0 = qt * 64 + wave * 16;
  const int qpos = q0 + r16;
  const int kvh = DIFF ? h : (h >> 1);
  bf16x8 qf[2];
  {
    const bf16_t* qp;
    if (sample) qp = (DIFF ? p.QDR : p.QBR) + (size_t)(sq * 1024 + qpos) * 256 + h * 64;
    else qp = p.P + (size_t)(tokb + qpos) * PW + (DIFF ? 2432 : 1152) + h * 64;
    qf[0] = *(const bf16x8*)(qp + quad * 8); qf[1] = *(const bf16x8*)(qp + 32 + quad * 8);
  }
  float m[2] = {-3.0e38f, -3.0e38f}, lsum[2] = {0.f, 0.f};
  f32x4 o[2][4];
#pragma unroll
  for (int a = 0; a < 2; ++a)
#pragma unroll
    for (int b = 0; b < 4; ++b) o[a][b] = (f32x4){0.f, 0.f, 0.f, 0.f};
  const float scale_log2 = (DIFF ? 0.17677669529663687f : 0.125f) * 1.4426950408889634f;
  if (sample) {
    const int bl = sq * 2 + l;
    const bf16_t* K; const bf16_t* Vt; int ks;
    if (DIFF) { K = p.CDK + (size_t)bl * 256 * 256 + h * 64; ks = 256; Vt = p.CDVT + (size_t)bl * 256 * 256 + (size_t)(h * 64) * 256; }
    else { K = p.CWK + (size_t)bl * 256 * 128 + kvh * 64; ks = 128; Vt = p.CWVT + (size_t)bl * 128 * 256 + (size_t)(kvh * 64) * 256; }
    for (int kb = 0; kb < 256; kb += 64)
      attn_keytile<DIFF>(K + (size_t)kb * ks, ks, Vt + kb, 256, qf, scale_log2, false, 0, 0, m, lsum, o, lane);
  }
  {
    const bf16_t* K; const bf16_t* Vt; int ks;
    if (sample) {
      if (DIFF) { K = p.KDR + (size_t)(sq * 1024) * 256 + h * 64; ks = 256; Vt = p.VDT + (size_t)tokb * 256 + (size_t)(h * 64) * T; }
      else { K = p.KBR + (size_t)(sq * 1024) * 128 + kvh * 64; ks = 128; Vt = p.VBT + (size_t)tokb * 128 + (size_t)(kvh * 64) * T; }
    } else {
      if (DIFF) { K = p.P + (size_t)tokb * PW + 2688 + h * 64; ks = PW; Vt = p.VDT + (size_t)tokb * 256 + (size_t)(h * 64) * T; }
      else { K = p.P + (size_t)tokb * PW + 1408 + kvh * 64; ks = PW; Vt = p.VBT + (size_t)tokb * 128 + (size_t)(kvh * 64) * T; }
    }
    int kb0 = 0, kb1 = T; bool masked = false;
    if (sample && !DIFF) { const int qb = qt * 64; kb0 = qb - 128 < 0 ? 0 : qb - 128; kb1 = qb + 192 > T ? T : qb + 192; masked = true; }
    for (int kb = kb0; kb < kb1; kb += 64)
      attn_keytile<DIFF>(K + (size_t)kb * ks, ks, Vt + kb, T, qf, scale_log2, masked, kb, qpos, m, lsum, o, lane);
  }
  float l0 = lsum[0]; l0 += __shfl_xor(l0, 16); l0 += __shfl_xor(l0, 32);
  const int tok = tokb + qpos;
  if (!DIFF) {
    l0 += exp2f(p.win_sink[l * 4 + h] * 1.4426950408889634f - m[0]);
    const float inv = 1.0f / l0;
#pragma unroll
    for (int dt = 0; dt < 4; ++dt) {
      f32x4 v = o[0][dt] * inv;
      *(float4*)(p.OB + (size_t)tok * 256 + h * 64 + dt * 16 + quad * 4) = (float4){v[0], v[1], v[2], v[3]};
    }
  } else {
    float l1 = lsum[1]; l1 += __shfl_xor(l1, 16); l1 += __shfl_xor(l1, 32);
    float d1 = 0.f, d2 = 0.f;
    const float* dl = p.diff_lam + l * 128;
    for (int j = 0; j < 32; ++j) { d1 += dl[j] * dl[32 + j]; d2 += dl[64 + j] * dl[96 + j]; }
    const float lam_init = 0.8f - 0.6f * expf(-0.3f * (float)l);
    const float lam = expf(d1) - expf(d2) + lam_init;
    const float i0 = 1.0f / l0, i1 = lam / l1;
    f32x4 v[4]; float ss = 0.f;
#pragma unroll
    for (int dt = 0; dt < 4; ++dt) { v[dt] = o[0][dt] * i0 - o[1][dt] * i1; ss += v[dt][0] * v[dt][0] + v[dt][1] * v[dt][1] + v[dt][2] * v[dt][2] + v[dt][3] * v[dt][3]; }
    ss += __shfl_xor(ss, 16); ss += __shfl_xor(ss, 32);
    const float rstd = rsqrtf(ss * (1.0f / 64.0f) + 1e-6f) * (1.0f - lam_init);
#pragma unroll
    for (int dt = 0; dt < 4; ++dt) {
      const float4 g = *(const float4*)(p.diff_g + l * 64 + dt * 16 + quad * 4);
      *(float4*)(p.OD + (size_t)tok * 256 + h * 64 + dt * 16 + quad * 4) = (float4){v[dt][0] * rstd * g.x, v[dt][1] * rstd * g.y, v[dt][2] * rstd * g.z, v[dt][3] * rstd * g.w};
    }
  }
}

__device__ void mix_other(const Params& p, int l, int it) {
  if (it < 256) { attn_item<true>(p, l, true, it >> 6, (it >> 4) & 3, it & 15); return; }
  it -= 256;
  if (it < 40) { lru_scan(p, l, it); return; }
  it -= 40;
  if (it < 256) { attn_item<false>(p, l, true, it >> 6, (it >> 4) & 3, it & 15); return; }
  it -= 256;
  if (it < 256) { attn_item<true>(p, l, false, it >> 4, (it >> 2) & 3, it & 3); return; }
  it -= 256;
  attn_item<false>(p, l, false, it >> 4, (it >> 2) & 3, it & 3);
}

#define ES 4
#define EP 8
__device__ void mix_item(const Params& p, int l, int it, unsigned char* smem) {
  constexpr int NPS = 16 / ES, NPP = 16 / EP, NS = 32 * NPS, NP = 128 * NPP;
  if (it < NS) {
#pragma unroll 1
    for (int r = 0; r < p.rep2[0]; ++r) rwkv_chain<ES>(p, l, it / NPS, it % NPS, smem);
    return;
  }
  it -= NS;
  if (it < NP) {
#pragma unroll 1
    for (int r = 0; r < p.rep2[1]; ++r) rwkv_chain<EP>(p, l, 32 + it / NPP, it % NPP, smem);
    return;
  }
  it -= NP;
#pragma unroll 1
  for (int r = 0; r < p.rep2[2]; ++r) mix_other(p, l, it);
}
__device__ void phase_mix(const Params& p, int l, unsigned char* smem) {
  constexpr int NS = 32 * (16 / ES), NP = 128 * (16 / EP), NALL = NS + NP + 1064;
  const int G = gridDim.x, b = blockIdx.x;
  if (G >= 2 * NS) {
    if (b < NS) mix_item(p, l, b, smem);
    else {
#pragma unroll 1
      for (int it = NS + (b - NS); it < NALL; it += G - NS) mix_item(p, l, it, smem);
    }
  } else {
#pragma unroll 1
    for (int it = b; it < NALL; it += G) mix_item(p, l, it, smem);
  }
}

DI float sum16(float v) { v += __shfl_xor(v, 1); v += __shfl_xor(v, 2); v += __shfl_xor(v, 4); v += __shfl_xor(v, 8); return v; }
DI void ld4bf(const bf16_t* q, float (&o)[4]) { uint2 u = *(const uint2*)q; o[0] = bflo(u.x); o[1] = bfhi(u.x); o[2] = bflo(u.y); o[3] = bfhi(u.y); }
DI void st4bf(bf16_t* q, const float (&v)[4]) { uint2 u; u.x = pack2(v[0], v[1]); u.y = pack2(v[2], v[3]); *(uint2*)q = u; }

__device__ void phase_post(const Params& p, int l) {
  const int tid0 = tid_opaque();
  const int lane = tid0 & 63, wave = tid0 >> 6;
  const int c = lane * 4;
#pragma unroll 1
  for (int tok = blockIdx.x * 4 + wave; tok < NTOK; tok += gridDim.x * 4) {
    const bf16_t* pr = p.P + (size_t)tok * PW;
    float out[4], g[4];
    {
      const float4 y0 = *(const float4*)(p.YA + (size_t)tok * 256 + c), y1 = *(const float4*)(p.YA + ((size_t)NTOK + tok) * 256 + c);
      float y[4] = {y0.x + y1.x, y0.y + y1.y, y0.z + y1.z, y0.w + y1.w};
      const float mu = sum16(y[0] + y[1] + y[2] + y[3]) * (1.0f / 64.0f);
      float dv[4] = {y[0] - mu, y[1] - mu, y[2] - mu, y[3] - mu};
      const float var = sum16(dv[0] * dv[0] + dv[1] * dv[1] + dv[2] * dv[2] + dv[3] * dv[3]) * (1.0f / 64.0f);
      const float rstd = rsqrtf(var + 64e-5f);
      float r[4], k[4], v[4];
      ld4bf(pr + c, r); ld4bf(pr + 256 + c, k); ld4bf(pr + 512 + c, v); ld4bf(pr + 896 + c, g);
      const float4 rk = *(const float4*)(p.rw_rk + l * 256 + c), gg = *(const float4*)(p.rw_gng + l * 256 + c), gb = *(const float4*)(p.rw_gnb + l * 256 + c);
      const float bs = sum16(r[0] * k[0] * rk.x + r[1] * k[1] * rk.y + r[2] * k[2] * rk.z + r[3] * k[3] * rk.w);
      out[0] = (dv[0] * rstd * gg.x + gb.x + bs * v[0]) * siluf_(g[0]);
      out[1] = (dv[1] * rstd * gg.y + gb.y + bs * v[1]) * siluf_(g[1]);
      out[2] = (dv[2] * rstd * gg.z + gb.z + bs * v[2]) * siluf_(g[2]);
      out[3] = (dv[3] * rstd * gg.w + gb.w + bs * v[3]) * siluf_(g[3]);
      st4bf(p.H + (size_t)tok * 1024 + c, out);
    }
    {
      const float4 y = *(const float4*)(p.OB + (size_t)tok * 256 + c);
      ld4bf(pr + 1664 + c, g);
      out[0] = y.x * siluf_(g[0]); out[1] = y.y * siluf_(g[1]); out[2] = y.z * siluf_(g[2]); out[3] = y.w * siluf_(g[3]);
      st4bf(p.H + (size_t)tok * 1024 + 256 + c, out);
    }
    {
      const float4 y0 = *(const float4*)(p.LU + (size_t)tok * 256 + c), y1 = *(const float4*)(p.LU + ((size_t)NTOK + tok) * 256 + c);
      const float4 A0 = *(const float4*)(p.LA + (size_t)tok * 256 + c), A1 = *(const float4*)(p.LA + ((size_t)NTOK + tok) * 256 + c);
      const float4 c0 = *(const float4*)(p.LC + (size_t)(tok >> 4) * 256 + c), c1 = *(const float4*)(p.LC + ((size_t)512 + (tok >> 4)) * 256 + c);
      ld4bf(pr + 2176 + c, g);
      out[0] = (y0.x + A0.x * c0.x + y1.x + A1.x * c1.x) * siluf_(g[0]); out[1] = (y0.y + A0.y * c0.y + y1.y + A1.y * c1.y) * siluf_(g[1]);
      out[2] = (y0.z + A0.z * c0.z + y1.z + A1.z * c1.z) * siluf_(g[2]); out[3] = (y0.w + A0.w * c0.w + y1.w + A1.w * c1.w) * siluf_(g[3]);
      st4bf(p.H + (size_t)tok * 1024 + 512 + c, out);
    }
    {
      const float4 y = *(const float4*)(p.OD + (size_t)tok * 256 + c);
      ld4bf(pr + 3200 + c, g);
      out[0] = y.x * siluf_(g[0]); out[1] = y.y * siluf_(g[1]); out[2] = y.z * siluf_(g[2]); out[3] = y.w * siluf_(g[3]);
      st4bf(p.H + (size_t)tok * 1024 + 768 + c, out);
    }
  }
}

__global__ void __launch_bounds__(256, 2) fwd_megakernel(Params p) {
  __shared__ __attribute__((aligned(16))) unsigned char smem[49152];
  __shared__ uint4 xb_words;
  if (threadIdx.x == 0) xb_words = make_uint4(0u, 0u, 0u, 0u);
  __syncthreads();
  XcdBarrier xb = xcd_barrier_post(p.bar, (volatile LAS unsigned*)&xb_words);
#pragma unroll 1
  for (int r = 0; r < p.rep[0]; ++r) phase_prologue(p, smem);
  xcd_barrier(xb);
#pragma unroll 1
  for (int r = 0; r < p.rep[1]; ++r) phase_norm(p, 0);
  xcd_barrier(xb);
#pragma unroll 1
  for (int l = 0; l < 2; ++l) {
#pragma unroll 1
    for (int r = 0; r < p.rep[2]; ++r) phase_gemm<0>(p, l, smem);
    xcd_barrier(xb);
#pragma unroll 1
    for (int r = 0; r < p.rep[3]; ++r) phase_pre(p, l, smem);
    xcd_barrier(xb);
#pragma unroll 1
    for (int r = 0; r < p.rep[4]; ++r) phase_mix(p, l, smem);
    xcd_barrier(xb);
#pragma unroll 1
    for (int r = 0; r < p.rep[5]; ++r) phase_post(p, l);
    xcd_barrier(xb);
#pragma unroll 1
    for (int r = 0; r < p.rep[6]; ++r) phase_gemm<1>(p, l, smem);
    xcd_barrier(xb);
    phase_norm(p, l + 1);
    if (l == 0) xcd_barrier(xb);
#pragma unroll 1
    for (int r = 1; r < p.rep[7]; ++r) xcd_barrier(xb);
  }
}

extern "C" void kernel_launch(void* const* d_in, const int* in_sizes, int n_in, void* d_out, int out_size, void* d_ws, size_t ws_size, hipStream_t stream) {
  static int grid_blocks = 0;
  if (!grid_blocks) {
    int dev = 0, cus = 0, per_cu = 0;
    hipGetDevice(&dev);
    hipDeviceGetAttribute(&cus, hipDeviceAttributeMultiprocessorCount, dev);
    hipOccupancyMaxActiveBlocksPerMultiprocessor(&per_cu, (const void*)fwd_megakernel, 256, 0);
    if (per_cu < 1) per_cu = 1;
    if (per_cu > 2) per_cu = 2;
    grid_blocks = cus * per_cu;
  }
  Params p{};
  const float** f = (const float**)&p;
  for (int i = 0; i < 35; ++i) f[i] = (const float*)d_in[i];
  p.out = (float*)d_out;
  size_t off = 0;
  auto take = [&](size_t bytes) { void* r = (char*)d_ws + off; off += (bytes + 255) & ~(size_t)255; return r; };
  p.MOD = (float*)take(2 * 5 * 3072 * 4);
  p.WINT = (bf16_t*)take((size_t)2 * PW * 1024 * 2);
  p.WOUTT = (bf16_t*)take((size_t)2 * 1024 * 1024 * 2);
  p.CWK = (bf16_t*)take((size_t)4 * 2 * 256 * 128 * 2);
  p.CWVT = (bf16_t*)take((size_t)4 * 2 * 256 * 128 * 2);
  p.CDK = (bf16_t*)take((size_t)4 * 2 * 256 * 256 * 2);
  p.CDVT = (bf16_t*)take((size_t)4 * 2 * 256 * 256 * 2);
  p.H = (bf16_t*)take((size_t)NTOK * 1024 * 2);
  p.P = (bf16_t*)take((size_t)NTOK * PW * 2);
  p.NKK = (float*)take((size_t)NTOK * 256 * 4);
  p.AW = (float*)take((size_t)2 * NTOK * 256 * 4);
  p.AB = (float*)take((size_t)2 * NTOK * 256 * 4);
  p.AKD = (float*)take((size_t)2 * NTOK * 256 * 4);
  p.Y2 = p.NKK;
  p.YA = (float*)take((size_t)2 * NTOK * 256 * 4);
  p.LA = (float*)take((size_t)2 * NTOK * 256 * 4);
  p.LU = (float*)take((size_t)2 * NTOK * 256 * 4);
  p.QBR = (bf16_t*)take((size_t)4096 * 256 * 2);
  p.KBR = (bf16_t*)take((size_t)4096 * 128 * 2);
  p.QDR = (bf16_t*)take((size_t)4096 * 256 * 2);
  p.KDR = (bf16_t*)take((size_t)4096 * 256 * 2);
  p.VBT = (bf16_t*)take((size_t)NTOK * 128 * 2);
  p.VDT = (bf16_t*)take((size_t)NTOK * 256 * 2);
  p.OB = (float*)take((size_t)NTOK * 256 * 4);
  p.OD = (float*)take((size_t)NTOK * 256 * 4);
  p.LC = (float*)take((size_t)2 * 512 * 256 * 4);
  p.bar = (unsigned*)take((size_t)XCD_BAR_WORDS * 4);
  if (off > ws_size) { fprintf(stderr, "workspace too small: need %zu have %zu\n", off, ws_size); return; }
  static const int REPS[8] = {1, 1, 1, 1, 1, 1, 1, 1};
  for (int i = 0; i < 8; ++i) p.rep[i] = REPS[i];
  static const int REPS2[8] = {1, 1, 1, 1, 1, 1, 1, 1};
  for (int i = 0; i < 8; ++i) p.rep2[i] = REPS2[i];
  hipMemsetAsync(p.bar, 0, (size_t)XCD_BAR_WORDS * 4, stream);
  void* args[] = {&p};
  hipError_t e = hipLaunchCooperativeKernel((const void*)fwd_megakernel, dim3(grid_blocks), dim3(256), args, 0, stream);
  if (e != hipSuccess) fprintf(stderr, "cooperative launch failed: %s (grid %d)\n", hipGetErrorString(e), grid_blocks);
}
```

```cpp
#include <hip/hip_runtime.h>
#include <cstdio>
#include <cstdint>

typedef unsigned short bf16_t;
typedef short bf16x8 __attribute__((ext_vector_type(8)));
typedef float f32x4 __attribute__((ext_vector_type(4)));
typedef unsigned u32x4 __attribute__((ext_vector_type(4)));
typedef unsigned u32x2 __attribute__((ext_vector_type(2)));
#define DI __device__ __forceinline__

#define O_YP 0
#define O_NWK 8388608
#define O_NWV 9437184
#define O_NDK 10485760
#define O_NDV 12582912
#define O_NSR 14680064
#define O_NSL 15728640

#define NTOK 8192
#define PW 3456

struct Params {
  const float *x_prompt, *x_sample, *c, *cwk, *cwv, *cdk, *cdv, *st_rwkv, *st_lru, *c_ctx, *w_mod, *b_mod, *g_pre, *g_post, *w_in, *w_out;
  const float *rw_w0, *rw_wup, *rw_a0, *rw_aup, *rw_kk, *rw_ka, *rw_rk, *rw_gng, *rw_gnb, *win_sink;
  const float *lru_cw, *lru_cb, *lru_wa, *lru_ba, *lru_wx, *lru_bx, *lru_lam, *diff_lam, *diff_g;
  float* out;
  float* MOD; bf16_t* WINT; bf16_t* WOUTT; bf16_t* CWK; bf16_t* CWVT; bf16_t* CDK; bf16_t* CDVT;
  bf16_t* H; bf16_t* P; float* NKK; float* AW; float* AB; float* AKD; float* YA; float* LA; float* LU;
  bf16_t* QBR; bf16_t* KBR; bf16_t* QDR; bf16_t* KDR; bf16_t* VBT; bf16_t* VDT; float* OB; float* OD; float* Y2; float* LC; unsigned* bar; bf16_t* RWT; bf16_t* LWT;
  int rep[8];
  int rep2[8];
};

DI void lds_barrier() { asm volatile("s_waitcnt lgkmcnt(0)\n\ts_barrier" ::: "memory"); }
DI int tid_opaque() { int t = threadIdx.x; asm volatile("" : "+v"(t)); return t; }
DI bf16_t f2bf(float x) { unsigned u = __float_as_uint(x); u += 0x7fffu + ((u >> 16) & 1u); return (bf16_t)(u >> 16); }
DI float bf2f(bf16_t b) { return __uint_as_float(((unsigned)b) << 16); }
DI unsigned pack2(float a, float b) { return (unsigned)f2bf(a) | ((unsigned)f2bf(b) << 16); }
DI float bflo(unsigned u) { return __uint_as_float(u << 16); }
DI float bfhi(unsigned u) { return __uint_as_float(u & 0xffff0000u); }
DI void ld4bf(const bf16_t* q, float (&o)[4]) { u32x2 u = *(const u32x2*)q; o[0] = bflo(u.x); o[1] = bfhi(u.x); o[2] = bflo(u.y); o[3] = bfhi(u.y); }
DI void st4bf(bf16_t* q, const float (&v)[4]) { u32x2 u; u.x = pack2(v[0], v[1]); u.y = pack2(v[2], v[3]); *(u32x2*)q = u; }
DI float wave_sum(float v) { for (int o = 32; o > 0; o >>= 1) v += __shfl_xor(v, o); return v; }
DI float sigmoidf_(float x) { return 1.0f / (1.0f + expf(-x)); }
DI float fsigmoid(float x) { return __builtin_amdgcn_rcpf(1.0f + __expf(-x)); }
DI float wave_sum_dpp(float v) {
  v += __builtin_bit_cast(float, __builtin_amdgcn_update_dpp(0, __builtin_bit_cast(int, v), 0xB1, 0xf, 0xf, true));
  v += __builtin_bit_cast(float, __builtin_amdgcn_update_dpp(0, __builtin_bit_cast(int, v), 0x4E, 0xf, 0xf, true));
  v += __builtin_bit_cast(float, __builtin_amdgcn_update_dpp(0, __builtin_bit_cast(int, v), 0x141, 0xf, 0xf, true));
  v += __builtin_bit_cast(float, __builtin_amdgcn_update_dpp(0, __builtin_bit_cast(int, v), 0x140, 0xf, 0xf, true));
  const int iv = __builtin_bit_cast(int, v);
  return __builtin_bit_cast(float, __builtin_amdgcn_readlane(iv, 0)) + __builtin_bit_cast(float, __builtin_amdgcn_readlane(iv, 16)) + __builtin_bit_cast(float, __builtin_amdgcn_readlane(iv, 32)) + __builtin_bit_cast(float, __builtin_amdgcn_readlane(iv, 48));
}
DI float siluf_(float x) { return x * __builtin_amdgcn_rcpf(1.0f + __expf(-x)); }
DI float softplusf_(float z) { return z > 20.f ? z : log1pf(expf(z)); }
DI f32x4 mfma16(bf16x8 a, bf16x8 b, f32x4 c) { return __builtin_amdgcn_mfma_f32_16x16x32_bf16(a, b, c, 0, 0, 0); }
DI float quad_sum(float v) {
  v += __builtin_bit_cast(float, __builtin_amdgcn_update_dpp(0, __builtin_bit_cast(int, v), 0xB1, 0xf, 0xf, true));
  v += __builtin_bit_cast(float, __builtin_amdgcn_update_dpp(0, __builtin_bit_cast(int, v), 0x4E, 0xf, 0xf, true));
  return v;
}


#define XB_TMO      128
#define XB_XCNT(j)  (256  + 64 * (j))
#define XB_XSUB(j)  (1280 + 64 * (j))
#define XB_XGEN(j)  (2304 + 64 * (j))
#define XB_TOP      3328
#define XB_TOPGEN   3392
#define XCD_BAR_WORDS 3456
#define XB_SPIN_CAP (1u << 18)
#define LAS __attribute__((address_space(3)))
DI unsigned xb_ld(unsigned* p)              { return __hip_atomic_load(p, __ATOMIC_RELAXED, __HIP_MEMORY_SCOPE_AGENT); }
DI unsigned xb_add(unsigned* p, unsigned v) { return __hip_atomic_fetch_add(p, v, __ATOMIC_RELAXED, __HIP_MEMORY_SCOPE_AGENT); }
DI unsigned xb_xcc_id() { return (unsigned)__builtin_amdgcn_s_getreg((3 << 11) | 20) & 0xFu; }
#define XB_SPIN(cond, bar) do { unsigned _sp = 0; while (cond) { __builtin_amdgcn_s_sleep(1); \
    if ((++_sp & 255u) == 0u) { if (xb_ld(&(bar)[XB_TMO])) break; if (_sp > XB_SPIN_CAP) { atomicAdd(&(bar)[XB_TMO], 1u); break; } } } } while (0)
struct XcdBarrier { unsigned* bar; unsigned x; volatile LAS unsigned* st; };
DI XcdBarrier xcd_barrier_post(unsigned* bar, volatile LAS unsigned* st) {
    XcdBarrier b; b.bar = bar; b.x = xb_xcc_id(); b.st = st;
    if (threadIdx.x == 0) (void)xb_add(&bar[XB_XCNT(b.x)], 1u);
    return b;
}
DI void xcd_barrier_complete(unsigned* bar, unsigned x, unsigned& nloc, unsigned& nx) {
    const unsigned G = gridDim.x * gridDim.y * gridDim.z;
    unsigned sum, cnt, mine, sp = 0u;
    for (;;) {
        sum = 0u; cnt = 0u; mine = 0u;
#pragma unroll
        for (unsigned j = 0; j < 16; ++j) { const unsigned c = xb_ld(&bar[XB_XCNT(j)]); sum += c; cnt += (c > 0u) ? 1u : 0u; mine = (j == x) ? c : mine; }
        if (sum == G) break;
        __builtin_amdgcn_s_sleep(1);
        if ((++sp & 255u) == 0u) { if (xb_ld(&bar[XB_TMO])) break; if (sp > XB_SPIN_CAP) { atomicAdd(&bar[XB_TMO], 1u); break; } }
    }
    nloc = mine > 0u ? mine : 1u; nx = cnt > 0u ? cnt : 1u;
}
DI void xcd_barrier(const XcdBarrier& b) {
    asm volatile("s_waitcnt vmcnt(0)" ::: "memory");
    __syncthreads();
    if (threadIdx.x == 0) {
        unsigned* bar = b.bar;
        asm volatile("" : "+s"(bar));
        unsigned bx = xb_xcc_id();
        asm volatile("" : "+s"(bx));
        __builtin_amdgcn_s_waitcnt(0);
        unsigned nloc = b.st[0], nx = b.st[1];
        if (nloc == 0u) { xcd_barrier_complete(bar, bx, nloc, nx); b.st[0] = nloc; b.st[1] = nx; }
        const unsigned old = xb_add(&bar[XB_XSUB(bx)], 1u);
        const unsigned gen = old / nloc;
        if (old + 1u == (gen + 1u) * nloc) {
            __builtin_amdgcn_fence(__ATOMIC_RELEASE, "agent");
            asm volatile("s_waitcnt vmcnt(0)" ::: "memory");
            const unsigned og = xb_add(&bar[XB_TOP], 1u);
            const unsigned tg = og / nx;
            if (og + 1u == (tg + 1u) * nx) xb_add(&bar[XB_TOPGEN], 1u);
            else XB_SPIN(xb_ld(&bar[XB_TOPGEN]) == tg, bar);
            __builtin_amdgcn_fence(__ATOMIC_ACQUIRE, "agent");
            xb_add(&bar[XB_XGEN(bx)], 1u);
            asm volatile("s_waitcnt vmcnt(0)" ::: "memory");
        } else {
            XB_SPIN(xb_ld(&bar[XB_XGEN(bx)]) == gen, bar);
            __builtin_amdgcn_fence(__ATOMIC_ACQUIRE, "agent");
            asm volatile("s_waitcnt vmcnt(0)" ::: "memory");
        }
    }
    __syncthreads();
}

template <typename T> DI float ldval(const T* p);
template <> DI float ldval<float>(const float* p) { return *p; }
template <> DI float ldval<bf16_t>(const bf16_t* p) { return bf2f(*p); }
template <typename T>
DI void transpose_tile(const T* src, int src_ld, bf16_t* dst, int dst_ld, float* lds) {
  const int tid = tid_opaque();
  for (int i = 0; i < 16; ++i) { int r = (tid >> 6) + 4 * i, c = tid & 63; lds[r * 65 + c] = ldval<T>(src + (size_t)r * src_ld + c); }
  __syncthreads();
  for (int i = 0; i < 16; ++i) { int c = (tid >> 6) + 4 * i, r = tid & 63; dst[(size_t)c * dst_ld + r] = f2bf(lds[r * 65 + c]); }
  __syncthreads();
}

__device__ void phase_prologue(const Params& p, unsigned char* smem) {
  float* lds = (float*)smem;
  const int n0 = 1728, n1 = n0 + 512, n2 = n1 + 192, n3 = n2 + 64, n4 = n3 + 128, n5 = n4 + 192, n6 = n5 + 32, n7 = n6 + 32;
#pragma unroll 1
  for (int it = blockIdx.x; it < n7; it += gridDim.x) {
    const int tid = tid_opaque();
    if (it < n0) {
      int l = it / 864, r = it % 864, kt = r / 54, nt = r % 54;
      transpose_tile<float>(p.w_in + (size_t)l * 1024 * PW + (size_t)kt * 64 * PW + nt * 64, PW,
                            p.WINT + (size_t)l * PW * 1024 + (size_t)nt * 64 * 1024 + kt * 64, 1024, lds);
    } else if (it < n1) {
      int i2 = it - n0; int l = i2 / 256, r = i2 % 256, kt = r / 16, nt = r % 16;
      transpose_tile<float>(p.w_out + (size_t)l * 1024 * 1024 + (size_t)kt * 64 * 1024 + nt * 64, 1024,
                            p.WOUTT + (size_t)l * 1024 * 1024 + (size_t)nt * 64 * 1024 + kt * 64, 1024, lds);
    } else if (it < n2) {
      int i2 = it - n1; int l = i2 / 96, nb = (i2 % 96) * 32;
      float* sc = lds;
      float* red = lds + 5 * 1024;
      for (int i = tid; i < 5 * 1024; i += 256) { int v = i >> 10, k = i & 1023; float x = v == 0 ? p.c_ctx[k] : p.c[(v - 1) * 1024 + k]; sc[i] = siluf_(x); }
      __syncthreads();
      int n = tid & 31, kg = tid >> 5;
      float a0 = 0, a1 = 0, a2 = 0, a3 = 0, a4 = 0;
      const float* wp = p.w_mod + (size_t)l * 1024 * 3072 + nb + n;
      for (int k = kg * 128; k < kg * 128 + 128; ++k) {
        float w = wp[(size_t)k * 3072];
        a0 += sc[k] * w; a1 += sc[1024 + k] * w; a2 += sc[2048 + k] * w; a3 += sc[3072 + k] * w; a4 += sc[4096 + k] * w;
      }
      red[(kg * 5 + 0) * 32 + n] = a0; red[(kg * 5 + 1) * 32 + n] = a1; red[(kg * 5 + 2) * 32 + n] = a2; red[(kg * 5 + 3) * 32 + n] = a3; red[(kg * 5 + 4) * 32 + n] = a4;
      __syncthreads();
      if (tid < 160) { int v = tid >> 5, nn = tid & 31; float s = p.b_mod[l * 3072 + nb + nn]; for (int q = 0; q < 8; ++q) s += red[(q * 5 + v) * 32 + nn]; p.MOD[(size_t)(l * 5 + v) * 3072 + nb + nn] = s; }
      __syncthreads();
    } else if (it < n3) {
      int i2 = it - n2; int bl = i2 >> 3, r = i2 & 7, pt = r >> 1, ct = r & 1;
      transpose_tile<float>(p.cwv + (size_t)bl * 256 * 128 + (size_t)pt * 64 * 128 + ct * 64, 128,
                            p.CWVT + (size_t)bl * 128 * 256 + (size_t)ct * 64 * 256 + pt * 64, 256, lds);
    } else if (it < n4) {
      int i2 = it - n3; int bl = i2 >> 4, r = i2 & 15, pt = r >> 2, ct = r & 3;
      transpose_tile<float>(p.cdv + (size_t)bl * 256 * 256 + (size_t)pt * 64 * 256 + ct * 64, 256,
                            p.CDVT + (size_t)bl * 256 * 256 + (size_t)ct * 64 * 256 + pt * 64, 256, lds);
    } else if (it >= n6) {
      int i2 = it - n6; int l = i2 >> 4, mat = (i2 >> 2) & 3, n = i2 & 3;
      const float* src = (mat < 2 ? p.lru_wa : p.lru_wx) + (size_t)(((l * 2 + (mat & 1)) * 4 + n)) * 4096;
      transpose_tile<float>(src, 64, p.LWT + (size_t)(((l * 4 + mat) * 4 + n)) * 4096, 64, lds);
    } else if (it >= n5) {
      int i2 = it - n5; int l = i2 >> 4, mat = (i2 >> 2) & 3, ct = i2 & 3;
      const float* src = (mat < 2 ? p.rw_wup : p.rw_aup) + (size_t)(l * 2 + (mat & 1)) * 64 * 256 + ct * 64;
      transpose_tile<float>(src, 256, p.RWT + ((size_t)(l * 4 + mat) * 256 + ct * 64) * 64, 64, lds);
    } else {
      int i2 = it - n4;
      const float* src; bf16_t* dst;
      if (i2 < 64) { src = p.cwk + (size_t)i2 * 4096; dst = p.CWK + (size_t)i2 * 4096; }
      else { src = p.cdk + (size_t)(i2 - 64) * 4096; dst = p.CDK + (size_t)(i2 - 64) * 4096; }
      for (int i = tid * 4; i < 4096; i += 1024) { float4 v = *(const float4*)(src + i); uint2 o; o.x = pack2(v.x, v.y); o.y = pack2(v.z, v.w); *(uint2*)(dst + i) = o; }
    }
  }
}

__device__ void phase_norm(const Params& p, int stage) {
  const int tid0 = tid_opaque();
  const int lane = tid0 & 63, wave = tid0 >> 6;
#pragma unroll 1
  for (int tok = blockIdx.x * 4 + wave; tok < NTOK; tok += gridDim.x * 4) {
    const int mv = tok < 4096 ? 0 : 1 + ((tok - 4096) >> 10);
    const float* xin;
    if (stage <= 1) xin = tok < 4096 ? p.x_prompt + (size_t)tok * 1024 : p.x_sample + (size_t)(tok - 4096) * 1024;
    else xin = p.out + (size_t)tok * 1024;
    float4 x[4];
#pragma unroll
    for (int i = 0; i < 4; ++i) x[i] = *(const float4*)(xin + i * 256 + lane * 4);
    if (stage >= 1) {
      const int lp = stage - 1;
      float4 y[4]; float ss = 0.f;
#pragma unroll
      for (int i = 0; i < 4; ++i) { y[i] = *(const float4*)(p.Y2 + (size_t)tok * 1024 + i * 256 + lane * 4); ss += y[i].x * y[i].x + y[i].y * y[i].y + y[i].z * y[i].z + y[i].w * y[i].w; }
      ss = wave_sum(ss);
      const float rstd = rsqrtf(ss * (1.0f / 1024.0f) + 1e-6f);
      const float* gate = p.MOD + (size_t)(lp * 5 + mv) * 3072 + 2048;
      const float* gp = p.g_post + lp * 1024;
#pragma unroll
      for (int i = 0; i < 4; ++i) {
        const int col = i * 256 + lane * 4;
        float4 g = *(const float4*)(gate + col), q = *(const float4*)(gp + col);
        x[i].x += g.x * (y[i].x * rstd * q.x); x[i].y += g.y * (y[i].y * rstd * q.y); x[i].z += g.z * (y[i].z * rstd * q.z); x[i].w += g.w * (y[i].w * rstd * q.w);
        *(float4*)(p.out + (size_t)tok * 1024 + col) = x[i];
      }
    }
    if (stage <= 1) {
      const int l = stage;
      float ss = 0.f;
#pragma unroll
      for (int i = 0; i < 4; ++i) ss += x[i].x * x[i].x + x[i].y * x[i].y + x[i].z * x[i].z + x[i].w * x[i].w;
      ss = wave_sum(ss);
      const float rstd = rsqrtf(ss * (1.0f / 1024.0f) + 1e-6f);
      const float* md = p.MOD + (size_t)(l * 5 + mv) * 3072;
      const float* gp = p.g_pre + l * 1024;
#pragma unroll
      for (int i = 0; i < 4; ++i) {
        const int col = i * 256 + lane * 4;
        float4 sh = *(const float4*)(md + col), sc = *(const float4*)(md + 1024 + col), g = *(const float4*)(gp + col);
        float h0 = x[i].x * rstd * g.x * (1.f + sc.x) + sh.x, h1 = x[i].y * rstd * g.y * (1.f + sc.y) + sh.y;
        float h2 = x[i].z * rstd * g.z * (1.f + sc.z) + sh.z, h3 = x[i].w * rstd * g.w * (1.f + sc.w) + sh.w;
        uint2 o; o.x = pack2(h0, h1); o.y = pack2(h2, h3);
        *(uint2*)(p.H + (size_t)tok * 1024 + col) = o;
      }
    }
  }
}

template <int MODE>
__device__ void phase_gemm(const Params& p, int l, unsigned char* smem) {
  const bf16_t* A = p.H;
  const bf16_t* Bt = MODE == 0 ? p.WINT + (size_t)l * PW * 1024 : p.WOUTT + (size_t)l * 1024 * 1024;
  const int N = MODE == 0 ? PW : 1024, K = 1024;
  const int NTN = N / 128;
  bf16_t* As = (bf16_t*)smem; bf16_t* Bs = As + 128 * 64;
  const int xcd = blockIdx.x & 7, slot = blockIdx.x >> 3, nslot = (gridDim.x + 7 - xcd) >> 3;
  const int nx = (NTN - xcd + 7) >> 3;
#pragma unroll 1
  for (int j = slot; j < 64 * nx; j += nslot) {
    const int tid = tid_opaque(), lane = tid & 63, wave = tid >> 6, wm = wave >> 1, wn = wave & 1, r16 = lane & 15, quad = lane >> 4;
    const int tm = j / nx, tn = xcd + 8 * (j % nx), m0 = tm * 128, n0 = tn * 128;
    f32x4 acc[4][4];
#pragma unroll
    for (int i = 0; i < 4; ++i)
#pragma unroll
      for (int j = 0; j < 4; ++j) acc[i][j] = (f32x4){0.f, 0.f, 0.f, 0.f};
    u32x4 ra0[4], rb0[4], ra1[4], rb1[4];
    const int lrow = tid >> 3, lc8 = tid & 7;
    const bf16_t* ga = A + (size_t)(m0 + lrow) * K + lc8 * 8;
    const bf16_t* gb = Bt + (size_t)(n0 + lrow) * K + lc8 * 8;
    const int swz_w = (lc8 ^ ((lrow >> 1) & 7)) * 8, swz_r = (r16 >> 1) & 7;
    bf16_t* const sa_ = As + lrow * 64 + swz_w; bf16_t* const sb_ = Bs + lrow * 64 + swz_w;
#define G_LOAD(RA, RB, KT) { _Pragma("unroll") for (int i = 0; i < 4; ++i) { RA[i] = *(const u32x4*)(ga + (size_t)i * 32 * K + (KT) * 64); RB[i] = *(const u32x4*)(gb + (size_t)i * 32 * K + (KT) * 64); } }
#define G_STORE(RA, RB) { _Pragma("unroll") for (int i = 0; i < 4; ++i) { *(u32x4*)(sa_ + i * 32 * 64) = RA[i]; *(u32x4*)(sb_ + i * 32 * 64) = RB[i]; } }
#define G_COMPUTE() { _Pragma("unroll") for (int ks = 0; ks < 2; ++ks) { bf16x8 af[4], bfr[4]; \
      _Pragma("unroll") for (int i = 0; i < 4; ++i) { af[i] = *(const bf16x8*)(As + (wm * 64 + i * 16 + r16) * 64 + (((ks * 4 + quad) ^ swz_r) * 8)); bfr[i] = *(const bf16x8*)(Bs + (wn * 64 + i * 16 + r16) * 64 + (((ks * 4 + quad) ^ swz_r) * 8)); } \
      _Pragma("unroll") for (int mi = 0; mi < 4; ++mi) _Pragma("unroll") for (int ni = 0; ni < 4; ++ni) acc[mi][ni] = mfma16(bfr[ni], af[mi], acc[mi][ni]); } }
    G_LOAD(ra0, rb0, 0);
    G_STORE(ra0, rb0);
    G_LOAD(ra0, rb0, 1);
    __syncthreads();
#pragma unroll 1
    for (int kt = 0; kt < 16; kt += 2) {
      if (kt + 2 < 16) G_LOAD(ra1, rb1, kt + 2);
      __builtin_amdgcn_sched_barrier(0);
      G_COMPUTE();
      lds_barrier();
      G_STORE(ra0, rb0);
      lds_barrier();
      if (kt + 3 < 16) G_LOAD(ra0, rb0, kt + 3);
      __builtin_amdgcn_sched_barrier(0);
      G_COMPUTE();
      lds_barrier();
      if (kt + 2 < 16) { G_STORE(ra1, rb1); lds_barrier(); }
    }
#undef G_LOAD
#undef G_STORE
#undef G_COMPUTE
#pragma unroll
    for (int mi = 0; mi < 4; ++mi)
#pragma unroll
      for (int ni = 0; ni < 4; ++ni) {
        const int m = m0 + wm * 64 + mi * 16 + r16, n = n0 + wn * 64 + ni * 16 + quad * 4;
        const f32x4 v = acc[mi][ni];
        if (MODE == 0) {
          uint2 o; o.x = pack2(v[0], v[1]); o.y = pack2(v[2], v[3]);
          *(uint2*)(p.P + (size_t)m * PW + n) = o;
          if (m0 < 4096) {
            const int row = ((m >> 8) * 2 + l) * 256 + (m & 255);
            float* dst = nullptr;
            if (tn == 11) dst = p.out + O_NWK + (size_t)row * 128 + (n - 1408);
            else if (tn == 12) dst = p.out + O_NWV + (size_t)row * 128 + (n - 1536);
            else if (tn == 21 || tn == 22) dst = p.out + O_NDK + (size_t)row * 256 + (n - 2688);
            else if (tn == 23 || tn == 24) dst = p.out + O_NDV + (size_t)row * 256 + (n - 2944);
            if (dst) *(float4*)dst = (float4){v[0], v[1], v[2], v[3]};
          }
        } else {
          *(float4*)(p.Y2 + (size_t)m * 1024 + n) = (float4){v[0], v[1], v[2], v[3]};
        }
      }
  }
}

DI void unpack8(u32x4 u, float (&o)[8]) { o[0] = bflo(u.x); o[1] = bfhi(u.x); o[2] = bflo(u.y); o[3] = bfhi(u.y); o[4] = bflo(u.z); o[5] = bfhi(u.z); o[6] = bflo(u.w); o[7] = bfhi(u.w); }
DI bf16x8 pack8(const float (&o)[8]) { u32x4 u; u.x = pack2(o[0], o[1]); u.y = pack2(o[2], o[3]); u.z = pack2(o[4], o[5]); u.w = pack2(o[6], o[7]); return __builtin_bit_cast(bf16x8, u); }

__device__ void pre_rwkv(const Params& p, int l, int item) {
  const int tid = tid_opaque(), lane = tid & 63, h = tid >> 6, r16 = lane & 15, quad = lane >> 4;
  const int tok = item * 16 + r16;
  const bf16_t* pr = p.P + (size_t)tok * PW;
  bf16x8 wdf[2], adf[2];
#pragma unroll
  for (int ks = 0; ks < 2; ++ks) {
    float o[8]; unpack8(*(const u32x4*)(pr + 768 + ks * 32 + quad * 8), o);
#pragma unroll
    for (int j = 0; j < 8; ++j) o[j] = 1.0f - 2.0f * __builtin_amdgcn_rcpf(1.0f + __expf(2.0f * o[j]));
    wdf[ks] = pack8(o);
    adf[ks] = *(const bf16x8*)(pr + 832 + ks * 32 + quad * 8);
  }
  float kv[4][4];
#pragma unroll
  for (int ct = 0; ct < 4; ++ct) ld4bf(pr + 256 + h * 64 + ct * 16 + quad * 4, kv[ct]);
  const bf16_t* wt = p.RWT + (size_t)l * 4 * 256 * 64;
  float ss = 0.f;
#pragma unroll
  for (int ct = 0; ct < 4; ++ct) {
    const f32x4 kkc = *(const f32x4*)(p.rw_kk + l * 256 + h * 64 + ct * 16 + quad * 4);
#pragma unroll
    for (int r = 0; r < 4; ++r) { const float q = kv[ct][r] * kkc[r]; ss += q * q; }
  }
  ss += __shfl_xor(ss, 16); ss += __shfl_xor(ss, 32);
  const float rn = rsqrtf(ss + 1e-12f);
#pragma unroll
  for (int ct = 0; ct < 4; ++ct) {
    f32x4 acc[4];
#pragma unroll
    for (int mat = 0; mat < 4; ++mat) {
      f32x4 a = {0.f, 0.f, 0.f, 0.f};
#pragma unroll
      for (int ks = 0; ks < 2; ++ks) {
        const bf16x8 wf = *(const bf16x8*)(wt + ((size_t)mat * 256 + h * 64 + ct * 16 + r16) * 64 + ks * 32 + quad * 8);
        a = mfma16(wf, mat < 2 ? wdf[ks] : adf[ks], a);
      }
      acc[mat] = a;
    }
    const int c0 = h * 64 + ct * 16 + quad * 4;
    const f32x4 kkc = *(const f32x4*)(p.rw_kk + l * 256 + c0), kac = *(const f32x4*)(p.rw_ka + l * 256 + c0);
    const f32x4 w00 = *(const f32x4*)(p.rw_w0 + (l * 2 + 0) * 256 + c0), w01 = *(const f32x4*)(p.rw_w0 + (l * 2 + 1) * 256 + c0);
    const f32x4 a00 = *(const f32x4*)(p.rw_a0 + (l * 2 + 0) * 256 + c0), a01 = *(const f32x4*)(p.rw_a0 + (l * 2 + 1) * 256 + c0);
    f32x4 nkk, w0v, w1v, b0v, b1v, k0v, k1v;
#pragma unroll
    for (int r = 0; r < 4; ++r) {
      const float k = kv[ct][r];
      const float kkn = k * kkc[r] * rn;
      nkk[r] = -kkn;
#pragma unroll
      for (int d = 0; d < 2; ++d) {
        const float wl = (d ? w01[r] : w00[r]) + acc[d][r];
        const float w_log = -__logf(1.0f + __expf(-wl)) - 0.5f;
        const float decay = __expf(-__expf(w_log));
        const float a = fsigmoid((d ? a01[r] : a00[r]) + acc[2 + d][r]);
        const float kd = k * (1.f + (a - 1.f) * kac[r]);
        if (d) { w1v[r] = decay; b1v[r] = kkn * a; k1v[r] = kd; } else { w0v[r] = decay; b0v[r] = kkn * a; k0v[r] = kd; }
      }
    }
    const size_t o0 = (size_t)tok * 256 + c0, o1 = ((size_t)NTOK + tok) * 256 + c0;
    *(f32x4*)(p.NKK + o0) = nkk;
    *(f32x4*)(p.AW + o0) = w0v; *(f32x4*)(p.AW + o1) = w1v;
    *(f32x4*)(p.AB + o0) = b0v; *(f32x4*)(p.AB + o1) = b1v;
    *(f32x4*)(p.AKD + o0) = k0v; *(f32x4*)(p.AKD + o1) = k1v;
  }
}

#define LSCAN_STEP(A, H, CTRL) { \
    const float Ap = __builtin_bit_cast(float, __builtin_amdgcn_update_dpp(0x3f800000, __builtin_bit_cast(int, A), CTRL, 0xf, 0xf, false)); \
    const float Hp = __builtin_bit_cast(float, __builtin_amdgcn_update_dpp(0, __builtin_bit_cast(int, H), CTRL, 0xf, 0xf, true)); \
    H = A * Hp + H; A = A * Ap; }

__device__ void pre_lru(const Params& p, int l, int item) {
  const int tid = tid_opaque(), lane = tid & 63, n = tid >> 6, r16 = lane & 15, quad = lane >> 4;
  const int tok0 = item * 16;
  int T, sb, t0;
  if (tok0 < 4096) { T = 256; sb = tok0 & ~255; t0 = tok0 & 255; } else { T = 1024; sb = 4096 + ((tok0 - 4096) & ~1023); t0 = (tok0 - 4096) & 1023; }
  const int t = t0 + r16, tok = tok0 + r16;
  bf16x8 xf[2];
#pragma unroll
  for (int ks = 0; ks < 2; ++ks) {
    const int cb = n * 64 + ks * 32 + quad * 8;
    float o[8];
    { const f32x4 b0 = *(const f32x4*)(p.lru_cb + l * 256 + cb), b1 = *(const f32x4*)(p.lru_cb + l * 256 + cb + 4);
      o[0] = b0[0]; o[1] = b0[1]; o[2] = b0[2]; o[3] = b0[3]; o[4] = b1[0]; o[5] = b1[1]; o[6] = b1[2]; o[7] = b1[3]; }
#pragma unroll
    for (int i = 0; i < 4; ++i) {
      const int tt = t - 2 + i;
      u32x4 xr = {0u, 0u, 0u, 0u};
      if (tt >= 0 && tt < T) xr = *(const u32x4*)(p.P + (size_t)(sb + tt) * PW + 1920 + cb);
      float x[8]; unpack8(xr, x);
      const f32x4 w0 = *(const f32x4*)(p.lru_cw + (l * 4 + i) * 256 + cb), w1 = *(const f32x4*)(p.lru_cw + (l * 4 + i) * 256 + cb + 4);
      o[0] += w0[0] * x[0]; o[1] += w0[1] * x[1]; o[2] += w0[2] * x[2]; o[3] += w0[3] * x[3];
      o[4] += w1[0] * x[4]; o[5] += w1[1] * x[5]; o[6] += w1[2] * x[6]; o[7] += w1[3] * x[7];
    }
    xf[ks] = pack8(o);
  }
  float xc[4][4];
#pragma unroll
  for (int et = 0; et < 4; ++et) {
    const int c0 = n * 64 + et * 16 + quad * 4;
    const f32x4 b = *(const f32x4*)(p.lru_cb + l * 256 + c0);
    float o[4] = {b[0], b[1], b[2], b[3]};
#pragma unroll
    for (int i = 0; i < 4; ++i) {
      const int tt = t - 2 + i;
      u32x2 xr = {0u, 0u};
      if (tt >= 0 && tt < T) xr = *(const u32x2*)(p.P + (size_t)(sb + tt) * PW + 1920 + c0);
      const f32x4 w = *(const f32x4*)(p.lru_cw + (l * 4 + i) * 256 + c0);
      o[0] += w[0] * bflo(xr.x); o[1] += w[1] * bfhi(xr.x); o[2] += w[2] * bflo(xr.y); o[3] += w[3] * bfhi(xr.y);
    }
    xc[et][0] = o[0]; xc[et][1] = o[1]; xc[et][2] = o[2]; xc[et][3] = o[3];
  }
#pragma unroll
  for (int et = 0; et < 4; ++et) {
    f32x4 acc[4];
#pragma unroll
    for (int mat = 0; mat < 4; ++mat) {
      f32x4 a = {0.f, 0.f, 0.f, 0.f};
#pragma unroll
      for (int ks = 0; ks < 2; ++ks) {
        const bf16x8 wf = *(const bf16x8*)(p.LWT + ((size_t)((l * 4 + mat) * 4 + n) * 64 + et * 16 + r16) * 64 + ks * 32 + quad * 8);
        a = mfma16(wf, xf[ks], a);
      }
      acc[mat] = a;
    }
    const int c0 = n * 64 + et * 16 + quad * 4;
    const f32x4 ba0 = *(const f32x4*)(p.lru_ba + (l * 2 + 0) * 256 + c0), ba1 = *(const f32x4*)(p.lru_ba + (l * 2 + 1) * 256 + c0);
    const f32x4 bx0 = *(const f32x4*)(p.lru_bx + (l * 2 + 0) * 256 + c0), bx1 = *(const f32x4*)(p.lru_bx + (l * 2 + 1) * 256 + c0);
    const f32x4 lm0 = *(const f32x4*)(p.lru_lam + (l * 2 + 0) * 256 + c0), lm1 = *(const f32x4*)(p.lru_lam + (l * 2 + 1) * 256 + c0);
    f32x4 A0, H0, A1, H1;
#pragma unroll
    for (int r = 0; r < 4; ++r) {
      const float x = xc[et][r];
#pragma unroll
      for (int d = 0; d < 2; ++d) {
        const float ga = fsigmoid(acc[d][r] + (d ? ba1[r] : ba0[r]));
        const float gx = fsigmoid(acc[2 + d][r] + (d ? bx1[r] : bx0[r]));
        const float sp = softplusf_(-(d ? lm1[r] : lm0[r]));
        const float log_a = -8.0f * ga * sp;
        float a = __expf(log_a);
        const float x2 = 2.0f * log_a;
        const float om = x2 > -0.05f ? -(x2 * (1.0f + x2 * (0.5f + x2 * (0.16666667f + x2 * 0.041666667f)))) : 1.0f - __expf(x2);
        float u = __fsqrt_rn(om) * (gx * x);
        if (d == 0) { LSCAN_STEP(a, u, 0x111) LSCAN_STEP(a, u, 0x112) LSCAN_STEP(a, u, 0x114) LSCAN_STEP(a, u, 0x118) A0[r] = a; H0[r] = u; }
        else        { LSCAN_STEP(a, u, 0x101) LSCAN_STEP(a, u, 0x102) LSCAN_STEP(a, u, 0x104) LSCAN_STEP(a, u, 0x108) A1[r] = a; H1[r] = u; }
      }
    }
    const size_t o0 = (size_t)tok * 256 + c0, o1 = ((size_t)NTOK + tok) * 256 + c0;
    *(f32x4*)(p.LA + o0) = A0; *(f32x4*)(p.LU + o0) = H0;
    *(f32x4*)(p.LA + o1) = A1; *(f32x4*)(p.LU + o1) = H1;
  }
}

__device__ void pre_rope(const Params& p, int item) {
  const int tid = tid_opaque();
  const int ts0 = item * 16;
#pragma unroll 1
  for (int pp = tid; pp < 448; pp += 256) {
    int scol, d1, d2, half, i, dstride; bf16_t* dst; float inv;
    if (pp < 192) {
      int q = pp < 128 ? pp : pp - 128; int vec = q >> 5, pi = q & 31; half = pi >> 4; i = pi & 15;
      d1 = half * 32 + i; d2 = d1 + 16; inv = exp2f(-(float)i * (13.287712379549449f / 16.0f));
      if (pp < 128) { scol = 1152 + vec * 64; dst = p.QBR + vec * 64; dstride = 256; }
      else { scol = 1408 + vec * 64; dst = p.KBR + vec * 64; dstride = 128; }
    } else {
      int q = pp < 320 ? pp - 192 : pp - 320; int vec = q >> 4, pi = q & 15; half = pi >> 3; i = pi & 7;
      d1 = half * 16 + i; d2 = d1 + 8; inv = exp2f(-(float)i * (13.287712379549449f / 8.0f));
      if (pp < 320) { scol = 2432 + vec * 32; dst = p.QDR + vec * 32; dstride = 256; }
      else { scol = 2688 + vec * 32; dst = p.KDR + vec * 32; dstride = 256; }
    }
    float x1[16], x2[16];
#pragma unroll
    for (int tt = 0; tt < 16; ++tt) { const bf16_t* src = p.P + (size_t)(4096 + ts0 + tt) * PW + scol; x1[tt] = bf2f(src[d1]); x2[tt] = bf2f(src[d2]); }
#pragma unroll
    for (int tt = 0; tt < 16; ++tt) {
      const int t = (ts0 + tt) & 1023;
      const float ang = (float)(half ? (t & 63) : (t >> 6)) * inv;
      const float sn = __sinf(ang), cs = __cosf(ang);
      const float a = x1[tt], b = x2[tt];
      bf16_t* o = dst + (size_t)(ts0 + tt) * dstride;
      o[d1] = f2bf(a * cs - b * sn); o[d2] = f2bf(a * sn + b * cs);
    }
  }
}

__device__ void phase_pre(const Params& p, int l, unsigned char* smem) {
  const int n0 = 512, n1 = n0 + 512, n2 = n1 + 256, n3 = n2 + 256, n4 = n3 + 512;
#pragma unroll 1
  for (int it = blockIdx.x; it < n4; it += gridDim.x) {
    if (it < n0) pre_rwkv(p, l, it);
    else if (it < n1) pre_lru(p, l, it - n0);
    else if (it < n2) pre_rope(p, it - n1);
    else if (it < n3) {
      int i2 = it - n2; int tt = i2 >> 1, ct = i2 & 1; int tok0 = tt * 64;
      int T, sb; if (tok0 < 4096) { T = 256; sb = tok0 & ~255; } else { T = 1024; sb = 4096 + ((tok0 - 4096) & ~1023); }
      transpose_tile<bf16_t>(p.P + (size_t)tok0 * PW + 1536 + ct * 64, PW, p.VBT + (size_t)sb * 128 + (size_t)(ct * 64) * T + (tok0 - sb), T, (float*)smem);
    } else {
      int i2 = it - n3; int tt = i2 >> 2, ct = i2 & 3; int tok0 = tt * 64;
      int T, sb; if (tok0 < 4096) { T = 256; sb = tok0 & ~255; } else { T = 1024; sb = 4096 + ((tok0 - 4096) & ~1023); }
      transpose_tile<bf16_t>(p.P + (size_t)tok0 * PW + 2944 + ct * 64, PW, p.VDT + (size_t)sb * 256 + (size_t)(ct * 64) * T + (tok0 - sb), T, (float*)smem);
    }
  }
}

template <int LR> DI float group_sum(float v) {
  v += __builtin_bit_cast(float, __builtin_amdgcn_update_dpp(0, __builtin_bit_cast(int, v), 0xB1, 0xf, 0xf, true));
  v += __builtin_bit_cast(float, __builtin_amdgcn_update_dpp(0, __builtin_bit_cast(int, v), 0x4E, 0xf, 0xf, true));
  if (LR >= 8) v += __builtin_bit_cast(float, __builtin_amdgcn_update_dpp(0, __builtin_bit_cast(int, v), 0x141, 0xf, 0xf, true));
  if (LR >= 16) v += __builtin_bit_cast(float, __builtin_amdgcn_update_dpp(0, __builtin_bit_cast(int, v), 0x140, 0xf, 0xf, true));
  return v;
}
template <int E>
__device__ void rwkv_chain(const Params& p, int l, int chain, int part, unsigned char* smem) {
  constexpr int LR = 64 / E, NM = E / 4;
  const int tid = tid_opaque(), lane = tid & 63, wave = tid >> 6;
  int seq, d, h;
  if (chain < 32) { seq = 16 + (chain >> 3); d = (chain >> 2) & 1; h = chain & 3; }
  else { int c2 = chain - 32; seq = c2 >> 3; d = (c2 >> 2) & 1; h = c2 & 3; }
  const int T = seq < 16 ? 256 : 1024, tokb = seq < 16 ? seq * 256 : 4096 + (seq - 16) * 1024;
  const int g = lane % LR, rl = lane / LR, i = part * 4 * E + wave * E + rl;
  float S[E];
  if (seq >= 16) {
    const float* s0 = p.st_rwkv + ((((size_t)(seq - 16) * 2 + l) * 2 + d) * 4 + h) * 4096 + i * 64;
#pragma unroll
    for (int m = 0; m < NM; ++m) { f32x4 t = *(const f32x4*)(s0 + 4 * (g + LR * m)); S[4 * m] = t[0]; S[4 * m + 1] = t[1]; S[4 * m + 2] = t[2]; S[4 * m + 3] = t[3]; }
  } else {
#pragma unroll
    for (int j = 0; j < E; ++j) S[j] = 0.f;
  }
  float* buf = (float*)smem;
  const int lvec = (tid >> 4) & 3, lc4 = tid & 15, ls = tid >> 6;
  const float* fsrc = (lvec == 0 ? p.NKK : lvec == 1 ? p.AW + (size_t)d * NTOK * 256 : lvec == 2 ? p.AB + (size_t)d * NTOK * 256 : p.AKD + (size_t)d * NTOK * 256) + h * 64 + lc4 * 4;
  const int bs = tid >> 4, bvec = (tid >> 3) & 1, bc8 = tid & 7;
  const bf16_t* bsrc = p.P + (bvec ? 512 : 0) + h * 64 + bc8 * 8;
  f32x4 rf[4]; u32x4 rb;
  const int nch = T / 16;
  auto gload = [&](int ck) {
#pragma unroll
    for (int i4 = 0; i4 < 4; ++i4) { int step = ck * 16 + ls + 4 * i4; int t = d ? T - 1 - step : step; rf[i4] = *(const f32x4*)(fsrc + (size_t)(tokb + t) * 256); }
    { int step = ck * 16 + bs; int t = d ? T - 1 - step : step; rb = *(const u32x4*)(bsrc + (size_t)(tokb + t) * PW); }
  };
  auto sstore = [&](int bi) {
    float* b = buf + bi * 16 * 384;
#pragma unroll
    for (int i4 = 0; i4 < 4; ++i4) *(f32x4*)(b + (ls + 4 * i4) * 384 + lvec * 64 + lc4 * 4) = rf[i4];
    float* q = b + bs * 384 + (4 + bvec) * 64 + bc8 * 8;
    *(f32x4*)q = (f32x4){bflo(rb.x), bfhi(rb.x), bflo(rb.y), bfhi(rb.y)};
    *(f32x4*)(q + 4) = (f32x4){bflo(rb.z), bfhi(rb.z), bflo(rb.w), bfhi(rb.w)};
  };
  gload(0); sstore(0); __syncthreads();
  float* yout = p.YA + ((size_t)d * NTOK + tokb) * 256 + h * 64 + i;
  constexpr int NY = 16 / LR;
#pragma unroll 1
  for (int ck = 0; ck < nch; ++ck) {
    if (ck + 1 < nch) gload(ck + 1);
    const float* cb = buf + (ck & 1) * 16 * 384;
    float yk[NY];
#pragma unroll
    for (int q = 0; q < NY; ++q) yk[q] = 0.f;
#pragma unroll 4
    for (int s = 0; s < 16; ++s) {
      const float* ob = cb + s * 384;
      f32x4 nk[NM], ww[NM], bb[NM], kk[NM], rr[NM];
#pragma unroll
      for (int m = 0; m < NM; ++m) {
        const int off = 4 * (g + LR * m);
        nk[m] = *(const f32x4*)(ob + off); ww[m] = *(const f32x4*)(ob + 64 + off); bb[m] = *(const f32x4*)(ob + 128 + off);
        kk[m] = *(const f32x4*)(ob + 192 + off); rr[m] = *(const f32x4*)(ob + 256 + off);
      }
      const float vi = ob[320 + i];
      float sa = 0.f;
#pragma unroll
      for (int m = 0; m < NM; ++m) sa += (S[4 * m] * nk[m][0] + S[4 * m + 1] * nk[m][1]) + (S[4 * m + 2] * nk[m][2] + S[4 * m + 3] * nk[m][3]);
      sa = group_sum<LR>(sa);
      float y = 0.f;
#pragma unroll
      for (int m = 0; m < NM; ++m) {
#pragma unroll
        for (int e = 0; e < 4; ++e) S[4 * m + e] = S[4 * m + e] * ww[m][e] + (sa * bb[m][e] + vi * kk[m][e]);
        y += (S[4 * m] * rr[m][0] + S[4 * m + 1] * rr[m][1]) + (S[4 * m + 2] * rr[m][2] + S[4 * m + 3] * rr[m][3]);
      }
      y = group_sum<LR>(y);
#pragma unroll
      for (int q = 0; q < NY; ++q) yk[q] = (s == q * LR + g) ? y : yk[q];
    }
#pragma unroll
    for (int q = 0; q < NY; ++q) { const int step = ck * 16 + q * LR + g; const int t = d ? T - 1 - step : step; yout[(size_t)t * 256] = yk[q]; }
    if (ck + 1 < nch) sstore((ck + 1) & 1);
    __syncthreads();
  }
  if (seq < 16) {
    float* so = p.out + O_NSR + ((((size_t)seq * 2 + l) * 2 + d) * 4 + h) * 4096 + i * 64;
#pragma unroll
    for (int m = 0; m < NM; ++m) *(f32x4*)(so + 4 * (g + LR * m)) = (f32x4){S[4 * m], S[4 * m + 1], S[4 * m + 2], S[4 * m + 3]};
  }
}

__device__ void lru_scan(const Params& p, int l, int item) {
  const int c = tid_opaque();
  int seq, d;
  if (item < 8) { seq = 16 + (item >> 1); d = item & 1; } else { seq = (item - 8) >> 1; d = item & 1; }
  const int T = seq < 16 ? 256 : 1024, tokb = seq < 16 ? seq * 256 : 4096 + (seq - 16) * 1024;
  const int NC = T >> 4;
  float h = seq >= 16 ? p.st_lru[(((seq - 16) * 2 + l) * 2 + d) * 256 + c] : 0.f;
  const float* la = p.LA + (size_t)d * NTOK * 256 + c; const float* lu = p.LU + (size_t)d * NTOK * 256 + c;
  float* lc = p.LC + (size_t)d * 512 * 256 + (size_t)(tokb >> 4) * 256 + c;
  for (int k0 = 0; k0 < NC; k0 += 8) {
    float a[8], u[8];
#pragma unroll
    for (int q = 0; q < 8; ++q) { const int k = d ? NC - 1 - (k0 + q) : k0 + q; const size_t idx = (size_t)(tokb + k * 16 + (d ? 0 : 15)) * 256; a[q] = la[idx]; u[q] = lu[idx]; }
#pragma unroll
    for (int q = 0; q < 8; ++q) { const int k = d ? NC - 1 - (k0 + q) : k0 + q; lc[(size_t)k * 256] = h; h = a[q] * h + u[q]; }
  }
  if (seq < 16) p.out[O_NSL + ((seq * 2 + l) * 2 + d) * 256 + c] = h;
}

template <bool DIFF>
DI void attn_keytile(const bf16_t* Kp, int kstride, const bf16_t* Vtp, int vstride, const bf16x8 (&qf)[2], float scale_log2,
                     bool masked, int kpos0, int qpos, float (&m)[2], float (&lsum)[2], f32x4 (&o)[2][4], int lane) {
  const int r16 = lane & 15, quad = lane >> 4;
  constexpr int NS = DIFF ? 2 : 1;
  f32x4 sc[NS][4];
  const f32x4 z4 = {0.f, 0.f, 0.f, 0.f};
  bf16x8 kf0[4], kf1[4], vfr[4][2];
#pragma unroll
  for (int kt = 0; kt < 4; ++kt) {
    const int s = kt >> 1, u = kt & 1;
    const int key = 32 * s + 8 * (r16 >> 2) + 4 * u + (r16 & 3);
    const bf16_t* kr = Kp + (size_t)key * kstride + quad * 8;
    kf0[kt] = *(const bf16x8*)kr; kf1[kt] = *(const bf16x8*)(kr + 32);
  }
  if (!DIFF) {
#pragma unroll
    for (int dt = 0; dt < 4; ++dt)
#pragma unroll
      for (int s = 0; s < 2; ++s) vfr[dt][s] = *(const bf16x8*)(Vtp + (size_t)(dt * 16 + r16) * vstride + 32 * s + 8 * quad);
  }
#pragma unroll
  for (int kt = 0; kt < 4; ++kt) {
    const bf16x8 k0 = kf0[kt], k1 = kf1[kt];
    if (!DIFF) { sc[0][kt] = mfma16(k0, qf[0], z4); sc[0][kt] = mfma16(k1, qf[1], sc[0][kt]); }
    else { sc[0][kt] = mfma16(k0, qf[0], z4); sc[NS - 1][kt] = mfma16(k1, qf[1], z4); }
  }
  bf16x8 pf[NS][2];
#pragma unroll
  for (int st = 0; st < NS; ++st) {
    float mx = -3.0e38f;
#pragma unroll
    for (int kt = 0; kt < 4; ++kt)
#pragma unroll
      for (int r = 0; r < 4; ++r) {
        float x = sc[st][kt][r] * scale_log2;
        if (masked) { const int kp = kpos0 + 32 * (kt >> 1) + 8 * quad + 4 * (kt & 1) + r; const int dd = kp - qpos; if (dd > 128 || dd < -128) x = -1.0e30f; }
        sc[st][kt][r] = x; mx = fmaxf(mx, x);
      }
    mx = fmaxf(mx, __shfl_xor(mx, 16)); mx = fmaxf(mx, __shfl_xor(mx, 32));
    const float mnew = fmaxf(m[st], mx);
    const float alpha = exp2f(m[st] - mnew);
    m[st] = mnew;
    float ps = 0.f;
#pragma unroll
    for (int kt = 0; kt < 4; ++kt)
#pragma unroll
      for (int r = 0; r < 4; ++r) { const float e = exp2f(sc[st][kt][r] - mnew); sc[st][kt][r] = e; ps += e; }
    lsum[st] = lsum[st] * alpha + ps;
#pragma unroll
    for (int dt = 0; dt < 4; ++dt) o[st][dt] *= alpha;
#pragma unroll
    for (int s = 0; s < 2; ++s) {
      bf16x8 t;
#pragma unroll
      for (int j = 0; j < 8; ++j) t[j] = (short)f2bf(sc[st][2 * s + (j >> 2)][j & 3]);
      pf[st][s] = t;
    }
  }
#pragma unroll
  for (int dt = 0; dt < 4; ++dt)
#pragma unroll
    for (int s = 0; s < 2; ++s) {
      const bf16x8 vf = DIFF ? *(const bf16x8*)(Vtp + (size_t)(dt * 16 + r16) * vstride + 32 * s + 8 * quad) : vfr[dt][s];
#pragma unroll
      for (int st = 0; st < NS; ++st) o[st][dt] = mfma16(vf, pf[st][s], o[st][dt]);
    }
}

template <bool DIFF>
__device__ void attn_item(const Params& p, int l, bool sample, int sq  , int h, int qt) {
  const int tid = tid_opaque();
  const int lane = tid & 63, wave = tid >> 6, r16 = lane & 15, quad = lane >> 4;
  const int T = sample ? 1024 : 256;
  const int tokb = sample ? 4096 + sq * 1024 : sq * 256;
  const int q0 = qt * 64 + wave * 16;
  const int qpos = q0 + r16;
  const int kvh = DIFF ? h : (h >> 1);
  bf16x8 qf[2];
  {
    const bf16_t* qp;
    if (sample) qp = (DIFF ? p.QDR : p.QBR) + (size_t)(sq * 1024 + qpos) * 256 + h * 64;
    else qp = p.P + (size_t)(tokb + qpos) * PW + (DIFF ? 2432 : 1152) + h * 64;
    qf[0] = *(const bf16x8*)(qp + quad * 8); qf[1] = *(const bf16x8*)(qp + 32 + quad * 8);
  }
  float m[2] = {-3.0e38f, -3.0e38f}, lsum[2] = {0.f, 0.f};
  f32x4 o[2][4];
#pragma unroll
  for (int a = 0; a < 2; ++a)
#pragma unroll
    for (int b = 0; b < 4; ++b) o[a][b] = (f32x4){0.f, 0.f, 0.f, 0.f};
  const float scale_log2 = (DIFF ? 0.17677669529663687f : 0.125f) * 1.4426950408889634f;
  if (sample) {
    const int bl = sq * 2 + l;
    const bf16_t* K; const bf16_t* Vt; int ks;
    if (DIFF) { K = p.CDK + (size_t)bl * 256 * 256 + h * 64; ks = 256; Vt = p.CDVT + (size_t)bl * 256 * 256 + (size_t)(h * 64) * 256; }
    else { K = p.CWK + (size_t)bl * 256 * 128 + kvh * 64; ks = 128; Vt = p.CWVT + (size_t)bl * 128 * 256 + (size_t)(kvh * 64) * 256; }
    for (int kb = 0; kb < 256; kb += 64)
      attn_keytile<DIFF>(K + (size_t)kb * ks, ks, Vt + kb, 256, qf, scale_log2, false, 0, 0, m, lsum, o, lane);
  }
  {
    const bf16_t* K; const bf16_t* Vt; int ks;
    if (sample) {
      if (DIFF) { K = p.KDR + (size_t)(sq * 1024) * 256 + h * 64; ks = 256; Vt = p.VDT + (size_t)tokb * 256 + (size_t)(h * 64) * T; }
      else { K = p.KBR + (size_t)(sq * 1024) * 128 + kvh * 64; ks = 128; Vt = p.VBT + (size_t)tokb * 128 + (size_t)(kvh * 64) * T; }
    } else {
      if (DIFF) { K = p.P + (size_t)tokb * PW + 2688 + h * 64; ks = PW; Vt = p.VDT + (size_t)tokb * 256 + (size_t)(h * 64) * T; }
      else { K = p.P + (size_t)tokb * PW + 1408 + kvh * 64; ks = PW; Vt = p.VBT + (size_t)tokb * 128 + (size_t)(kvh * 64) * T; }
    }
    int kb0 = 0, kb1 = T; bool masked = false;
    if (sample && !DIFF) { const int qb = qt * 64; kb0 = qb - 128 < 0 ? 0 : qb - 128; kb1 = qb + 192 > T ? T : qb + 192; masked = true; }
    for (int kb = kb0; kb < kb1; kb += 64)
      attn_keytile<DIFF>(K + (size_t)kb * ks, ks, Vt + kb, T, qf, scale_log2, masked, kb, qpos, m, lsum, o, lane);
  }
  float l0 = lsum[0]; l0 += __shfl_xor(l0, 16); l0 += __shfl_xor(l0, 32);
  const int tok = tokb + qpos;
  if (!DIFF) {
    l0 += exp2f(p.win_sink[l * 4 + h] * 1.4426950408889634f - m[0]);
    const float inv = 1.0f / l0;
#pragma unroll
    for (int dt = 0; dt < 4; ++dt) {
      f32x4 v = o[0][dt] * inv;
      *(float4*)(p.OB + (size_t)tok * 256 + h * 64 + dt * 16 + quad * 4) = (float4){v[0], v[1], v[2], v[3]};
    }
  } else {
    float l1 = lsum[1]; l1 += __shfl_xor(l1, 16); l1 += __shfl_xor(l1, 32);
    float d1 = 0.f, d2 = 0.f;
    const float* dl = p.diff_lam + l * 128;
    for (int j = 0; j < 32; ++j) { d1 += dl[j] * dl[32 + j]; d2 += dl[64 + j] * dl[96 + j]; }
    const float lam_init = 0.8f - 0.6f * expf(-0.3f * (float)l);
    const float lam = expf(d1) - expf(d2) + lam_init;
    const float i0 = 1.0f / l0, i1 = lam / l1;
    f32x4 v[4]; float ss = 0.f;
#pragma unroll
    for (int dt = 0; dt < 4; ++dt) { v[dt] = o[0][dt] * i0 - o[1][dt] * i1; ss += v[dt][0] * v[dt][0] + v[dt][1] * v[dt][1] + v[dt][2] * v[dt][2] + v[dt][3] * v[dt][3]; }
    ss += __shfl_xor(ss, 16); ss += __shfl_xor(ss, 32);
    const float rstd = rsqrtf(ss * (1.0f / 64.0f) + 1e-6f) * (1.0f - lam_init);
#pragma unroll
    for (int dt = 0; dt < 4; ++dt) {
      const float4 g = *(const float4*)(p.diff_g + l * 64 + dt * 16 + quad * 4);
      *(float4*)(p.OD + (size_t)tok * 256 + h * 64 + dt * 16 + quad * 4) = (float4){v[dt][0] * rstd * g.x, v[dt][1] * rstd * g.y, v[dt][2] * rstd * g.z, v[dt][3] * rstd * g.w};
    }
  }
}

__device__ void mix_other(const Params& p, int l, int it) {
  if (it < 256) { attn_item<true>(p, l, true, it >> 6, (it >> 4) & 3, it & 15); return; }
  it -= 256;
  if (it < 40) { lru_scan(p, l, it); return; }
  it -= 40;
  if (it < 256) { attn_item<false>(p, l, true, it >> 6, (it >> 4) & 3, it & 15); return; }
  it -= 256;
  if (it < 256) { attn_item<true>(p, l, false, it >> 4, (it >> 2) & 3, it & 3); return; }
  it -= 256;
  attn_item<false>(p, l, false, it >> 4, (it >> 2) & 3, it & 3);
}

#define ES 4
#define EP 8
__device__ void mix_item(const Params& p, int l, int it, unsigned char* smem) {
  constexpr int NPS = 16 / ES, NPP = 16 / EP, NS = 32 * NPS, NP = 128 * NPP;
  if (it < NS) {
#pragma unroll 1
    for (int r = 0; r < p.rep2[0]; ++r) rwkv_chain<ES>(p, l, it / NPS, it % NPS, smem);
    return;
  }
  it -= NS;
  if (it < NP) {
#pragma unroll 1
    for (int r = 0; r < p.rep2[1]; ++r) rwkv_chain<EP>(p, l, 32 + it / NPP, it % NPP, smem);
    return;
  }
  it -= NP;
#pragma unroll 1
  for (int r = 0; r < p.rep2[2]; ++r) mix_other(p, l, it);
}
__device__ void phase_mix(const Params& p, int l, unsigned char* smem) {
  constexpr int NS = 32 * (16 / ES), NP = 128 * (16 / EP), NALL = NS + NP + 1064;
  const int G = gridDim.x, b = blockIdx.x;
  if (G >= 2 * NS) {
    if (b < NS) mix_item(p, l, b, smem);
    else {
#pragma unroll 1
      for (int it = NS + (b - NS); it < NALL; it += G - NS) mix_item(p, l, it, smem);
    }
  } else {
#pragma unroll 1
    for (int it = b; it < NALL; it += G) mix_item(p, l, it, smem);
  }
}

DI float sum16(float v) { v += __shfl_xor(v, 1); v += __shfl_xor(v, 2); v += __shfl_xor(v, 4); v += __shfl_xor(v, 8); return v; }

__device__ void phase_post(const Params& p, int l) {
  const int tid0 = tid_opaque();
  const int lane = tid0 & 63, wave = tid0 >> 6;
  const int c = lane * 4;
#pragma unroll 1
  for (int tok = blockIdx.x * 4 + wave; tok < NTOK; tok += gridDim.x * 4) {
    const bf16_t* pr = p.P + (size_t)tok * PW;
    float out[4], g[4];
    {
      const float4 y0 = *(const float4*)(p.YA + (size_t)tok * 256 + c), y1 = *(const float4*)(p.YA + ((size_t)NTOK + tok) * 256 + c);
      float y[4] = {y0.x + y1.x, y0.y + y1.y, y0.z + y1.z, y0.w + y1.w};
      const float mu = sum16(y[0] + y[1] + y[2] + y[3]) * (1.0f / 64.0f);
      float dv[4] = {y[0] - mu, y[1] - mu, y[2] - mu, y[3] - mu};
      const float var = sum16(dv[0] * dv[0] + dv[1] * dv[1] + dv[2] * dv[2] + dv[3] * dv[3]) * (1.0f / 64.0f);
      const float rstd = rsqrtf(var + 64e-5f);
      float r[4], k[4], v[4];
      ld4bf(pr + c, r); ld4bf(pr + 256 + c, k); ld4bf(pr + 512 + c, v); ld4bf(pr + 896 + c, g);
      const float4 rk = *(const float4*)(p.rw_rk + l * 256 + c), gg = *(const float4*)(p.rw_gng + l * 256 + c), gb = *(const float4*)(p.rw_gnb + l * 256 + c);
      const float bs = sum16(r[0] * k[0] * rk.x + r[1] * k[1] * rk.y + r[2] * k[2] * rk.z + r[3] * k[3] * rk.w);
      out[0] = (dv[0] * rstd * gg.x + gb.x + bs * v[0]) * siluf_(g[0]);
      out[1] = (dv[1] * rstd * gg.y + gb.y + bs * v[1]) * siluf_(g[1]);
      out[2] = (dv[2] * rstd * gg.z + gb.z + bs * v[2]) * siluf_(g[2]);
      out[3] = (dv[3] * rstd * gg.w + gb.w + bs * v[3]) * siluf_(g[3]);
      st4bf(p.H + (size_t)tok * 1024 + c, out);
    }
    {
      const float4 y = *(const float4*)(p.OB + (size_t)tok * 256 + c);
      ld4bf(pr + 1664 + c, g);
      out[0] = y.x * siluf_(g[0]); out[1] = y.y * siluf_(g[1]); out[2] = y.z * siluf_(g[2]); out[3] = y.w * siluf_(g[3]);
      st4bf(p.H + (size_t)tok * 1024 + 256 + c, out);
    }
    {
      const float4 y0 = *(const float4*)(p.LU + (size_t)tok * 256 + c), y1 = *(const float4*)(p.LU + ((size_t)NTOK + tok) * 256 + c);
      const float4 A0 = *(const float4*)(p.LA + (size_t)tok * 256 + c), A1 = *(const float4*)(p.LA + ((size_t)NTOK + tok) * 256 + c);
      const float4 c0 = *(const float4*)(p.LC + (size_t)(tok >> 4) * 256 + c), c1 = *(const float4*)(p.LC + ((size_t)512 + (tok >> 4)) * 256 + c);
      ld4bf(pr + 2176 + c, g);
      out[0] = (y0.x + A0.x * c0.x + y1.x + A1.x * c1.x) * siluf_(g[0]); out[1] = (y0.y + A0.y * c0.y + y1.y + A1.y * c1.y) * siluf_(g[1]);
      out[2] = (y0.z + A0.z * c0.z + y1.z + A1.z * c1.z) * siluf_(g[2]); out[3] = (y0.w + A0.w * c0.w + y1.w + A1.w * c1.w) * siluf_(g[3]);
      st4bf(p.H + (size_t)tok * 1024 + 512 + c, out);
    }
    {
      const float4 y = *(const float4*)(p.OD + (size_t)tok * 256 + c);
      ld4bf(pr + 3200 + c, g);
      out[0] = y.x * siluf_(g[0]); out[1] = y.y * siluf_(g[1]); out[2] = y.z * siluf_(g[2]); out[3] = y.w * siluf_(g[3]);
      st4bf(p.H + (size_t)tok * 1024 + 768 + c, out);
    }
  }
}

__global__ void __launch_bounds__(256, 2) fwd_megakernel(Params p) {
  __shared__ __attribute__((aligned(16))) unsigned char smem[49152];
  __shared__ uint4 xb_words;
  if (threadIdx.x == 0) xb_words = make_uint4(0u, 0u, 0u, 0u);
  __syncthreads();
  XcdBarrier xb = xcd_barrier_post(p.bar, (volatile LAS unsigned*)&xb_words);
#pragma unroll 1
  for (int r = 0; r < p.rep[0]; ++r) phase_prologue(p, smem);
  xcd_barrier(xb);
#pragma unroll 1
  for (int r = 0; r < p.rep[1]; ++r) phase_norm(p, 0);
  xcd_barrier(xb);
#pragma unroll 1
  for (int l = 0; l < 2; ++l) {
#pragma unroll 1
    for (int r = 0; r < p.rep[2]; ++r) phase_gemm<0>(p, l, smem);
    xcd_barrier(xb);
#pragma unroll 1
    for (int r = 0; r < p.rep[3]; ++r) phase_pre(p, l, smem);
    xcd_barrier(xb);
#pragma unroll 1
    for (int r = 0; r < p.rep[4]; ++r) phase_mix(p, l, smem);
    xcd_barrier(xb);
#pragma unroll 1
    for (int r = 0; r < p.rep[5]; ++r) phase_post(p, l);
    xcd_barrier(xb);
#pragma unroll 1
    for (int r = 0; r < p.rep[6]; ++r) phase_gemm<1>(p, l, smem);
    xcd_barrier(xb);
    phase_norm(p, l + 1);
    if (l == 0) xcd_barrier(xb);
#pragma unroll 1
    for (int r = 1; r < p.rep[7]; ++r) xcd_barrier(xb);
  }
}

extern "C" void kernel_launch(void* const* d_in, const int* in_sizes, int n_in, void* d_out, int out_size, void* d_ws, size_t ws_size, hipStream_t stream) {
  static int grid_blocks = 0;
  if (!grid_blocks) {
    int dev = 0, cus = 0, per_cu = 0;
    hipGetDevice(&dev);
    hipDeviceGetAttribute(&cus, hipDeviceAttributeMultiprocessorCount, dev);
    hipOccupancyMaxActiveBlocksPerMultiprocessor(&per_cu, (const void*)fwd_megakernel, 256, 0);
    if (per_cu < 1) per_cu = 1;
    if (per_cu > 2) per_cu = 2;
    grid_blocks = cus * per_cu;
  }
  Params p{};
  const float** f = (const float**)&p;
  for (int i = 0; i < 35; ++i) f[i] = (const float*)d_in[i];
  p.out = (float*)d_out;
  size_t off = 0;
  auto take = [&](size_t bytes) { void* r = (char*)d_ws + off; off += (bytes + 255) & ~(size_t)255; return r; };
  p.MOD = (float*)take(2 * 5 * 3072 * 4);
  p.WINT = (bf16_t*)take((size_t)2 * PW * 1024 * 2);
  p.WOUTT = (bf16_t*)take((size_t)2 * 1024 * 1024 * 2);
  p.CWK = (bf16_t*)take((size_t)4 * 2 * 256 * 128 * 2);
  p.CWVT = (bf16_t*)take((size_t)4 * 2 * 256 * 128 * 2);
  p.CDK = (bf16_t*)take((size_t)4 * 2 * 256 * 256 * 2);
  p.CDVT = (bf16_t*)take((size_t)4 * 2 * 256 * 256 * 2);
  p.H = (bf16_t*)take((size_t)NTOK * 1024 * 2);
  p.P = (bf16_t*)take((size_t)NTOK * PW * 2);
  p.NKK = (float*)take((size_t)NTOK * 256 * 4);
  p.AW = (float*)take((size_t)2 * NTOK * 256 * 4);
  p.AB = (float*)take((size_t)2 * NTOK * 256 * 4);
  p.AKD = (float*)take((size_t)2 * NTOK * 256 * 4);
  p.Y2 = p.NKK;
  p.YA = (float*)take((size_t)2 * NTOK * 256 * 4);
  p.LA = (float*)take((size_t)2 * NTOK * 256 * 4);
  p.LU = (float*)take((size_t)2 * NTOK * 256 * 4);
  p.QBR = (bf16_t*)take((size_t)4096 * 256 * 2);
  p.KBR = (bf16_t*)take((size_t)4096 * 128 * 2);
  p.QDR = (bf16_t*)take((size_t)4096 * 256 * 2);
  p.KDR = (bf16_t*)take((size_t)4096 * 256 * 2);
  p.VBT = (bf16_t*)take((size_t)NTOK * 128 * 2);
  p.VDT = (bf16_t*)take((size_t)NTOK * 256 * 2);
  p.OB = (float*)take((size_t)NTOK * 256 * 4);
  p.OD = (float*)take((size_t)NTOK * 256 * 4);
  p.LC = (float*)take((size_t)2 * 512 * 256 * 4);
  p.bar = (unsigned*)take((size_t)XCD_BAR_WORDS * 4);
  p.RWT = (bf16_t*)take((size_t)2 * 4 * 256 * 64 * 2);
  p.LWT = (bf16_t*)take((size_t)2 * 4 * 4 * 64 * 64 * 2);
  if (off > ws_size) { fprintf(stderr, "workspace too small: need %zu have %zu\n", off, ws_size); return; }
  static const int REPS[8] = {1, 1, 1, 1, 1, 1, 1, 1};
  for (int i = 0; i < 8; ++i) p.rep[i] = REPS[i];
  static const int REPS2[8] = {1, 1, 1, 1, 1, 1, 1, 1};
  for (int i = 0; i < 8; ++i) p.rep2[i] = REPS2[i];
  hipMemsetAsync(p.bar, 0, (size_t)XCD_BAR_WORDS * 4, stream);
  void* args[] = {&p};
  hipError_t e = hipLaunchCooperativeKernel((const void*)fwd_megakernel, dim3(grid_blocks), dim3(256), args, 0, stream);
  if (e != hipSuccess) fprintf(stderr, "cooperative launch failed: %s (grid %d)\n", hipGetErrorString(e), grid_blocks);
}
```

```cpp
#include <hip/hip_runtime.h>
#include <cstdio>
#include <cstdint>

typedef unsigned short bf16_t;
typedef short bf16x8 __attribute__((ext_vector_type(8)));
typedef float f32x4 __attribute__((ext_vector_type(4)));
typedef unsigned u32x4 __attribute__((ext_vector_type(4)));
typedef unsigned u32x2 __attribute__((ext_vector_type(2)));
#define DI __device__ __forceinline__

#define O_YP 0
#define O_NWK 8388608
#define O_NWV 9437184
#define O_NDK 10485760
#define O_NDV 12582912
#define O_NSR 14680064
#define O_NSL 15728640

#define NTOK 8192
#define PW 3456

struct Params {
  const float *x_prompt, *x_sample, *c, *cwk, *cwv, *cdk, *cdv, *st_rwkv, *st_lru, *c_ctx, *w_mod, *b_mod, *g_pre, *g_post, *w_in, *w_out;
  const float *rw_w0, *rw_wup, *rw_a0, *rw_aup, *rw_kk, *rw_ka, *rw_rk, *rw_gng, *rw_gnb, *win_sink;
  const float *lru_cw, *lru_cb, *lru_wa, *lru_ba, *lru_wx, *lru_bx, *lru_lam, *diff_lam, *diff_g;
  float* out;
  float* MOD; bf16_t* WINT; bf16_t* WOUTT; bf16_t* CWK; bf16_t* CWVT; bf16_t* CDK; bf16_t* CDVT;
  bf16_t* H; bf16_t* P; float* NKK; float* AW; float* AB; float* AKD; float* YA; float* LA; float* LU;
  bf16_t* QBR; bf16_t* KBR; bf16_t* QDR; bf16_t* KDR; bf16_t* VBT; bf16_t* VDT; float* OB; float* OD; float* Y2; float* LC; unsigned* bar; bf16_t* RWT; bf16_t* LWT;
  int rep[8];
  int rep2[8];
};

DI void lds_barrier() { asm volatile("s_waitcnt lgkmcnt(0)\n\ts_barrier" ::: "memory"); }
DI int tid_opaque() { int t = threadIdx.x; asm volatile("" : "+v"(t)); return t; }
DI bf16_t f2bf(float x) { unsigned u = __float_as_uint(x); u += 0x7fffu + ((u >> 16) & 1u); return (bf16_t)(u >> 16); }
DI float bf2f(bf16_t b) { return __uint_as_float(((unsigned)b) << 16); }
DI unsigned pack2(float a, float b) { return (unsigned)f2bf(a) | ((unsigned)f2bf(b) << 16); }
DI float bflo(unsigned u) { return __uint_as_float(u << 16); }
DI float bfhi(unsigned u) { return __uint_as_float(u & 0xffff0000u); }
DI void ld4bf(const bf16_t* q, float (&o)[4]) { u32x2 u = *(const u32x2*)q; o[0] = bflo(u.x); o[1] = bfhi(u.x); o[2] = bflo(u.y); o[3] = bfhi(u.y); }
DI void st4bf(bf16_t* q, const float (&v)[4]) { u32x2 u; u.x = pack2(v[0], v[1]); u.y = pack2(v[2], v[3]); *(u32x2*)q = u; }
DI float wave_sum(float v) { for (int o = 32; o > 0; o >>= 1) v += __shfl_xor(v, o); return v; }
DI float sigmoidf_(float x) { return 1.0f / (1.0f + expf(-x)); }
DI float fsigmoid(float x) { return __builtin_amdgcn_rcpf(1.0f + __expf(-x)); }
DI float wave_sum_dpp(float v) {
  v += __builtin_bit_cast(float, __builtin_amdgcn_update_dpp(0, __builtin_bit_cast(int, v), 0xB1, 0xf, 0xf, true));
  v += __builtin_bit_cast(float, __builtin_amdgcn_update_dpp(0, __builtin_bit_cast(int, v), 0x4E, 0xf, 0xf, true));
  v += __builtin_bit_cast(float, __builtin_amdgcn_update_dpp(0, __builtin_bit_cast(int, v), 0x141, 0xf, 0xf, true));
  v += __builtin_bit_cast(float, __builtin_amdgcn_update_dpp(0, __builtin_bit_cast(int, v), 0x140, 0xf, 0xf, true));
  const int iv = __builtin_bit_cast(int, v);
  return __builtin_bit_cast(float, __builtin_amdgcn_readlane(iv, 0)) + __builtin_bit_cast(float, __builtin_amdgcn_readlane(iv, 16)) + __builtin_bit_cast(float, __builtin_amdgcn_readlane(iv, 32)) + __builtin_bit_cast(float, __builtin_amdgcn_readlane(iv, 48));
}
DI float siluf_(float x) { return x * __builtin_amdgcn_rcpf(1.0f + __expf(-x)); }
DI float softplusf_(float z) { return z > 20.f ? z : log1pf(expf(z)); }
DI f32x4 mfma16(bf16x8 a, bf16x8 b, f32x4 c) { return __builtin_amdgcn_mfma_f32_16x16x32_bf16(a, b, c, 0, 0, 0); }
DI float quad_sum(float v) {
  v += __builtin_bit_cast(float, __builtin_amdgcn_update_dpp(0, __builtin_bit_cast(int, v), 0xB1, 0xf, 0xf, true));
  v += __builtin_bit_cast(float, __builtin_amdgcn_update_dpp(0, __builtin_bit_cast(int, v), 0x4E, 0xf, 0xf, true));
  return v;
}


#define XB_TMO      128
#define XB_XCNT(j)  (256  + 64 * (j))
#define XB_XSUB(j)  (1280 + 64 * (j))
#define XB_XGEN(j)  (2304 + 64 * (j))
#define XB_TOP      3328
#define XB_TOPGEN   3392
#define XCD_BAR_WORDS 3456
#define XB_SPIN_CAP (1u << 18)
#define LAS __attribute__((address_space(3)))
DI unsigned xb_ld(unsigned* p)              { return __hip_atomic_load(p, __ATOMIC_RELAXED, __HIP_MEMORY_SCOPE_AGENT); }
DI unsigned xb_add(unsigned* p, unsigned v) { return __hip_atomic_fetch_add(p, v, __ATOMIC_RELAXED, __HIP_MEMORY_SCOPE_AGENT); }
DI unsigned xb_xcc_id() { return (unsigned)__builtin_amdgcn_s_getreg((3 << 11) | 20) & 0xFu; }
#define XB_SPIN(cond, bar) do { unsigned _sp = 0; while (cond) { __builtin_amdgcn_s_sleep(1); \
    if ((++_sp & 255u) == 0u) { if (xb_ld(&(bar)[XB_TMO])) break; if (_sp > XB_SPIN_CAP) { atomicAdd(&(bar)[XB_TMO], 1u); break; } } } } while (0)
struct XcdBarrier { unsigned* bar; unsigned x; volatile LAS unsigned* st; };
DI XcdBarrier xcd_barrier_post(unsigned* bar, volatile LAS unsigned* st) {
    XcdBarrier b; b.bar = bar; b.x = xb_xcc_id(); b.st = st;
    if (threadIdx.x == 0) (void)xb_add(&bar[XB_XCNT(b.x)], 1u);
    return b;
}
DI void xcd_barrier_complete(unsigned* bar, unsigned x, unsigned& nloc, unsigned& nx) {
    const unsigned G = gridDim.x * gridDim.y * gridDim.z;
    unsigned sum, cnt, mine, sp = 0u;
    for (;;) {
        sum = 0u; cnt = 0u; mine = 0u;
#pragma unroll
        for (unsigned j = 0; j < 16; ++j) { const unsigned c = xb_ld(&bar[XB_XCNT(j)]); sum += c; cnt += (c > 0u) ? 1u : 0u; mine = (j == x) ? c : mine; }
        if (sum == G) break;
        __builtin_amdgcn_s_sleep(1);
        if ((++sp & 255u) == 0u) { if (xb_ld(&bar[XB_TMO])) break; if (sp > XB_SPIN_CAP) { atomicAdd(&bar[XB_TMO], 1u); break; } }
    }
    nloc = mine > 0u ? mine : 1u; nx = cnt > 0u ? cnt : 1u;
}
DI void xcd_barrier(const XcdBarrier& b) {
    asm volatile("s_waitcnt vmcnt(0)" ::: "memory");
    __syncthreads();
    if (threadIdx.x == 0) {
        unsigned* bar = b.bar;
        asm volatile("" : "+s"(bar));
        unsigned bx = xb_xcc_id();
        asm volatile("" : "+s"(bx));
        __builtin_amdgcn_s_waitcnt(0);
        unsigned nloc = b.st[0], nx = b.st[1];
        if (nloc == 0u) { xcd_barrier_complete(bar, bx, nloc, nx); b.st[0] = nloc; b.st[1] = nx; }
        const unsigned old = xb_add(&bar[XB_XSUB(bx)], 1u);
        const unsigned gen = old / nloc;
        if (old + 1u == (gen + 1u) * nloc) {
            __builtin_amdgcn_fence(__ATOMIC_RELEASE, "agent");
            asm volatile("s_waitcnt vmcnt(0)" ::: "memory");
            const unsigned og = xb_add(&bar[XB_TOP], 1u);
            const unsigned tg = og / nx;
            if (og + 1u == (tg + 1u) * nx) xb_add(&bar[XB_TOPGEN], 1u);
            else XB_SPIN(xb_ld(&bar[XB_TOPGEN]) == tg, bar);
            __builtin_amdgcn_fence(__ATOMIC_ACQUIRE, "agent");
            xb_add(&bar[XB_XGEN(bx)], 1u);
            asm volatile("s_waitcnt vmcnt(0)" ::: "memory");
        } else {
            XB_SPIN(xb_ld(&bar[XB_XGEN(bx)]) == gen, bar);
            __builtin_amdgcn_fence(__ATOMIC_ACQUIRE, "agent");
            asm volatile("s_waitcnt vmcnt(0)" ::: "memory");
        }
    }
    __syncthreads();
}

template <typename T> DI float ldval(const T* p);
template <> DI float ldval<float>(const float* p) { return *p; }
template <> DI float ldval<bf16_t>(const bf16_t* p) { return bf2f(*p); }
template <typename T>
DI void transpose_tile(const T* src, int src_ld, bf16_t* dst, int dst_ld, float* lds) {
  const int tid = tid_opaque();
#pragma unroll 8
  for (int i = 0; i < 16; ++i) { int r = (tid >> 6) + 4 * i, c = tid & 63; lds[r * 65 + c] = ldval<T>(src + (size_t)r * src_ld + c); }
  __syncthreads();
#pragma unroll 4
  for (int i = 0; i < 16; ++i) { int c = (tid >> 6) + 4 * i, r = tid & 63; dst[(size_t)c * dst_ld + r] = f2bf(lds[r * 65 + c]); }
  __syncthreads();
}

__device__ void phase_prologue(const Params& p, unsigned char* smem) {
  float* lds = (float*)smem;
  const int n0 = 1728, n1 = n0 + 512, n2 = n1 + 192, n3 = n2 + 64, n4 = n3 + 128, n5 = n4 + 192, n6 = n5 + 32, n7 = n6 + 32;
#pragma unroll 1
  for (int it = blockIdx.x; it < n7; it += gridDim.x) {
    const int tid = tid_opaque();
    if (it < n0) {
      int l = it / 864, r = it % 864, kt = r / 54, nt = r % 54;
      transpose_tile<float>(p.w_in + (size_t)l * 1024 * PW + (size_t)kt * 64 * PW + nt * 64, PW,
                            p.WINT + (size_t)l * PW * 1024 + (size_t)nt * 64 * 1024 + kt * 64, 1024, lds);
    } else if (it < n1) {
      int i2 = it - n0; int l = i2 / 256, r = i2 % 256, kt = r / 16, nt = r % 16;
      transpose_tile<float>(p.w_out + (size_t)l * 1024 * 1024 + (size_t)kt * 64 * 1024 + nt * 64, 1024,
                            p.WOUTT + (size_t)l * 1024 * 1024 + (size_t)nt * 64 * 1024 + kt * 64, 1024, lds);
    } else if (it < n2) {
      int i2 = it - n1; int l = i2 / 96, nb = (i2 % 96) * 32;
      float* sc = lds;
      float* red = lds + 5 * 1024;
      for (int i = tid; i < 5 * 1024; i += 256) { int v = i >> 10, k = i & 1023; float x = v == 0 ? p.c_ctx[k] : p.c[(v - 1) * 1024 + k]; sc[i] = siluf_(x); }
      __syncthreads();
      int n = tid & 31, kg = tid >> 5;
      float a0 = 0, a1 = 0, a2 = 0, a3 = 0, a4 = 0;
      const float* wp = p.w_mod + (size_t)l * 1024 * 3072 + nb + n;
      for (int k = kg * 128; k < kg * 128 + 128; ++k) {
        float w = wp[(size_t)k * 3072];
        a0 += sc[k] * w; a1 += sc[1024 + k] * w; a2 += sc[2048 + k] * w; a3 += sc[3072 + k] * w; a4 += sc[4096 + k] * w;
      }
      red[(kg * 5 + 0) * 32 + n] = a0; red[(kg * 5 + 1) * 32 + n] = a1; red[(kg * 5 + 2) * 32 + n] = a2; red[(kg * 5 + 3) * 32 + n] = a3; red[(kg * 5 + 4) * 32 + n] = a4;
      __syncthreads();
      if (tid < 160) { int v = tid >> 5, nn = tid & 31; float s = p.b_mod[l * 3072 + nb + nn]; for (int q = 0; q < 8; ++q) s += red[(q * 5 + v) * 32 + nn]; p.MOD[(size_t)(l * 5 + v) * 3072 + nb + nn] = s; }
      __syncthreads();
    } else if (it < n3) {
      int i2 = it - n2; int bl = i2 >> 3, r = i2 & 7, pt = r >> 1, ct = r & 1;
      transpose_tile<float>(p.cwv + (size_t)bl * 256 * 128 + (size_t)pt * 64 * 128 + ct * 64, 128,
                            p.CWVT + (size_t)bl * 128 * 256 + (size_t)ct * 64 * 256 + pt * 64, 256, lds);
    } else if (it < n4) {
      int i2 = it - n3; int bl = i2 >> 4, r = i2 & 15, pt = r >> 2, ct = r & 3;
      transpose_tile<float>(p.cdv + (size_t)bl * 256 * 256 + (size_t)pt * 64 * 256 + ct * 64, 256,
                            p.CDVT + (size_t)bl * 256 * 256 + (size_t)ct * 64 * 256 + pt * 64, 256, lds);
    } else if (it >= n6) {
      int i2 = it - n6; int l = i2 >> 4, mat = (i2 >> 2) & 3, n = i2 & 3;
      const float* src = (mat < 2 ? p.lru_wa : p.lru_wx) + (size_t)(((l * 2 + (mat & 1)) * 4 + n)) * 4096;
      transpose_tile<float>(src, 64, p.LWT + (size_t)(((l * 4 + mat) * 4 + n)) * 4096, 64, lds);
    } else if (it >= n5) {
      int i2 = it - n5; int l = i2 >> 4, mat = (i2 >> 2) & 3, ct = i2 & 3;
      const float* src = (mat < 2 ? p.rw_wup : p.rw_aup) + (size_t)(l * 2 + (mat & 1)) * 64 * 256 + ct * 64;
      transpose_tile<float>(src, 256, p.RWT + ((size_t)(l * 4 + mat) * 256 + ct * 64) * 64, 64, lds);
    } else {
      int i2 = it - n4;
      const float* src; bf16_t* dst;
      if (i2 < 64) { src = p.cwk + (size_t)i2 * 4096; dst = p.CWK + (size_t)i2 * 4096; }
      else { src = p.cdk + (size_t)(i2 - 64) * 4096; dst = p.CDK + (size_t)(i2 - 64) * 4096; }
      for (int i = tid * 4; i < 4096; i += 1024) { float4 v = *(const float4*)(src + i); uint2 o; o.x = pack2(v.x, v.y); o.y = pack2(v.z, v.w); *(uint2*)(dst + i) = o; }
    }
  }
}

__device__ void phase_norm(const Params& p, int stage) {
  const int tid0 = tid_opaque();
  const int lane = tid0 & 63, wave = tid0 >> 6;
#pragma unroll 1
  for (int tok = blockIdx.x * 4 + wave; tok < NTOK; tok += gridDim.x * 4) {
    const int mv = tok < 4096 ? 0 : 1 + ((tok - 4096) >> 10);
    const float* xin;
    if (stage <= 1) xin = tok < 4096 ? p.x_prompt + (size_t)tok * 1024 : p.x_sample + (size_t)(tok - 4096) * 1024;
    else xin = p.out + (size_t)tok * 1024;
    float4 x[4];
#pragma unroll
    for (int i = 0; i < 4; ++i) x[i] = *(const float4*)(xin + i * 256 + lane * 4);
    if (stage >= 1) {
      const int lp = stage - 1;
      float4 y[4]; float ss = 0.f;
#pragma unroll
      for (int i = 0; i < 4; ++i) { y[i] = *(const float4*)(p.Y2 + (size_t)tok * 1024 + i * 256 + lane * 4); ss += y[i].x * y[i].x + y[i].y * y[i].y + y[i].z * y[i].z + y[i].w * y[i].w; }
      ss = wave_sum(ss);
      const float rstd = rsqrtf(ss * (1.0f / 1024.0f) + 1e-6f);
      const float* gate = p.MOD + (size_t)(lp * 5 + mv) * 3072 + 2048;
      const float* gp = p.g_post + lp * 1024;
#pragma unroll
      for (int i = 0; i < 4; ++i) {
        const int col = i * 256 + lane * 4;
        float4 g = *(const float4*)(gate + col), q = *(const float4*)(gp + col);
        x[i].x += g.x * (y[i].x * rstd * q.x); x[i].y += g.y * (y[i].y * rstd * q.y); x[i].z += g.z * (y[i].z * rstd * q.z); x[i].w += g.w * (y[i].w * rstd * q.w);
        *(float4*)(p.out + (size_t)tok * 1024 + col) = x[i];
      }
    }
    if (stage <= 1) {
      const int l = stage;
      float ss = 0.f;
#pragma unroll
      for (int i = 0; i < 4; ++i) ss += x[i].x * x[i].x + x[i].y * x[i].y + x[i].z * x[i].z + x[i].w * x[i].w;
      ss = wave_sum(ss);
      const float rstd = rsqrtf(ss * (1.0f / 1024.0f) + 1e-6f);
      const float* md = p.MOD + (size_t)(l * 5 + mv) * 3072;
      const float* gp = p.g_pre + l * 1024;
#pragma unroll
      for (int i = 0; i < 4; ++i) {
        const int col = i * 256 + lane * 4;
        float4 sh = *(const float4*)(md + col), sc = *(const float4*)(md + 1024 + col), g = *(const float4*)(gp + col);
        float h0 = x[i].x * rstd * g.x * (1.f + sc.x) + sh.x, h1 = x[i].y * rstd * g.y * (1.f + sc.y) + sh.y;
        float h2 = x[i].z * rstd * g.z * (1.f + sc.z) + sh.z, h3 = x[i].w * rstd * g.w * (1.f + sc.w) + sh.w;
        uint2 o; o.x = pack2(h0, h1); o.y = pack2(h2, h3);
        *(uint2*)(p.H + (size_t)tok * 1024 + col) = o;
      }
    }
  }
}

template <int MODE>
__device__ void phase_gemm(const Params& p, int l, unsigned char* smem) {
  const bf16_t* A = p.H;
  const bf16_t* Bt = MODE == 0 ? p.WINT + (size_t)l * PW * 1024 : p.WOUTT + (size_t)l * 1024 * 1024;
  const int N = MODE == 0 ? PW : 1024, K = 1024;
  const int NTN = N / 128;
  bf16_t* As = (bf16_t*)smem; bf16_t* Bs = As + 128 * 64;
  const int xcd = blockIdx.x & 7, slot = blockIdx.x >> 3, nslot = (gridDim.x + 7 - xcd) >> 3;
  const int nx = (NTN - xcd + 7) >> 3;
#pragma unroll 1
  for (int j = slot; j < 64 * nx; j += nslot) {
    const int tid = tid_opaque(), lane = tid & 63, wave = tid >> 6, wm = wave >> 1, wn = wave & 1, r16 = lane & 15, quad = lane >> 4;
    const int tm = j / nx, tn = xcd + 8 * (j % nx), m0 = tm * 128, n0 = tn * 128;
    f32x4 acc[4][4];
#pragma unroll
    for (int i = 0; i < 4; ++i)
#pragma unroll
      for (int j = 0; j < 4; ++j) acc[i][j] = (f32x4){0.f, 0.f, 0.f, 0.f};
    u32x4 ra0[4], rb0[4];
    const int lrow = tid >> 3, lc8 = tid & 7;
    const bf16_t* ga = A + (size_t)(m0 + lrow) * K + lc8 * 8;
    const bf16_t* gb = Bt + (size_t)(n0 + lrow) * K + lc8 * 8;
    const int swz_w = (lc8 ^ ((lrow >> 1) & 7)) * 8, swz_r = (r16 >> 1) & 7;
    bf16_t* const sa_ = As + lrow * 64 + swz_w; bf16_t* const sb_ = Bs + lrow * 64 + swz_w;
#define G_LOAD(RA, RB, KT) { _Pragma("unroll") for (int i = 0; i < 4; ++i) { RA[i] = *(const u32x4*)(ga + (size_t)i * 32 * K + (KT) * 64); RB[i] = *(const u32x4*)(gb + (size_t)i * 32 * K + (KT) * 64); } }
#define G_STORE(RA, RB) { _Pragma("unroll") for (int i = 0; i < 4; ++i) { *(u32x4*)(sa_ + i * 32 * 64) = RA[i]; *(u32x4*)(sb_ + i * 32 * 64) = RB[i]; } }
#define G_COMPUTE() { _Pragma("unroll") for (int ks = 0; ks < 2; ++ks) { bf16x8 af[4], bfr[4]; \
      _Pragma("unroll") for (int i = 0; i < 4; ++i) { af[i] = *(const bf16x8*)(As + (wm * 64 + i * 16 + r16) * 64 + (((ks * 4 + quad) ^ swz_r) * 8)); bfr[i] = *(const bf16x8*)(Bs + (wn * 64 + i * 16 + r16) * 64 + (((ks * 4 + quad) ^ swz_r) * 8)); } \
      _Pragma("unroll") for (int mi = 0; mi < 4; ++mi) _Pragma("unroll") for (int ni = 0; ni < 4; ++ni) acc[mi][ni] = mfma16(bfr[ni], af[mi], acc[mi][ni]); } }
    G_LOAD(ra0, rb0, 0);
    G_STORE(ra0, rb0);
    __syncthreads();
#pragma unroll 1
    for (int kt = 0; kt < 16; ++kt) {
      if (kt + 1 < 16) G_LOAD(ra0, rb0, kt + 1);
      __builtin_amdgcn_sched_barrier(0);
      G_COMPUTE();
      lds_barrier();
      if (kt + 1 < 16) { G_STORE(ra0, rb0); lds_barrier(); }
    }
#undef G_LOAD
#undef G_STORE
#undef G_COMPUTE
#pragma unroll
    for (int mi = 0; mi < 4; ++mi)
#pragma unroll
      for (int ni = 0; ni < 4; ++ni) {
        const int m = m0 + wm * 64 + mi * 16 + r16, n = n0 + wn * 64 + ni * 16 + quad * 4;
        const f32x4 v = acc[mi][ni];
        if (MODE == 0) {
          uint2 o; o.x = pack2(v[0], v[1]); o.y = pack2(v[2], v[3]);
          *(uint2*)(p.P + (size_t)m * PW + n) = o;
          if (m0 < 4096) {
            const int row = ((m >> 8) * 2 + l) * 256 + (m & 255);
            float* dst = nullptr;
            if (tn == 11) dst = p.out + O_NWK + (size_t)row * 128 + (n - 1408);
            else if (tn == 12) dst = p.out + O_NWV + (size_t)row * 128 + (n - 1536);
            else if (tn == 21 || tn == 22) dst = p.out + O_NDK + (size_t)row * 256 + (n - 2688);
            else if (tn == 23 || tn == 24) dst = p.out + O_NDV + (size_t)row * 256 + (n - 2944);
            if (dst) *(float4*)dst = (float4){v[0], v[1], v[2], v[3]};
          }
        } else {
          *(float4*)(p.Y2 + (size_t)m * 1024 + n) = (float4){v[0], v[1], v[2], v[3]};
        }
      }
  }
}

DI void unpack8(u32x4 u, float (&o)[8]) { o[0] = bflo(u.x); o[1] = bfhi(u.x); o[2] = bflo(u.y); o[3] = bfhi(u.y); o[4] = bflo(u.z); o[5] = bfhi(u.z); o[6] = bflo(u.w); o[7] = bfhi(u.w); }
DI bf16x8 pack8(const float (&o)[8]) { u32x4 u; u.x = pack2(o[0], o[1]); u.y = pack2(o[2], o[3]); u.z = pack2(o[4], o[5]); u.w = pack2(o[6], o[7]); return __builtin_bit_cast(bf16x8, u); }

__device__ void pre_rwkv(const Params& p, int l, int item) {
  const int tid = tid_opaque(), lane = tid & 63, h = tid >> 6, r16 = lane & 15, quad = lane >> 4;
  const int tok = item * 16 + r16;
  const bf16_t* pr = p.P + (size_t)tok * PW;
  bf16x8 wdf[2], adf[2];
#pragma unroll
  for (int ks = 0; ks < 2; ++ks) {
    float o[8]; unpack8(*(const u32x4*)(pr + 768 + ks * 32 + quad * 8), o);
#pragma unroll
    for (int j = 0; j < 8; ++j) o[j] = 1.0f - 2.0f * __builtin_amdgcn_rcpf(1.0f + __expf(2.0f * o[j]));
    wdf[ks] = pack8(o);
    adf[ks] = *(const bf16x8*)(pr + 832 + ks * 32 + quad * 8);
  }
  float kv[4][4];
#pragma unroll
  for (int ct = 0; ct < 4; ++ct) ld4bf(pr + 256 + h * 64 + ct * 16 + quad * 4, kv[ct]);
  const bf16_t* wt = p.RWT + (size_t)l * 4 * 256 * 64;
  float ss = 0.f;
#pragma unroll
  for (int ct = 0; ct < 4; ++ct) {
    const f32x4 kkc = *(const f32x4*)(p.rw_kk + l * 256 + h * 64 + ct * 16 + quad * 4);
#pragma unroll
    for (int r = 0; r < 4; ++r) { const float q = kv[ct][r] * kkc[r]; ss += q * q; }
  }
  ss += __shfl_xor(ss, 16); ss += __shfl_xor(ss, 32);
  const float rn = rsqrtf(ss + 1e-12f);
#pragma unroll
  for (int ct = 0; ct < 4; ++ct) {
    f32x4 acc[4];
    const int c0 = h * 64 + ct * 16 + quad * 4;
    bf16x8 wfr[4][2];
#pragma unroll
    for (int mat = 0; mat < 4; ++mat)
#pragma unroll
      for (int ks = 0; ks < 2; ++ks) wfr[mat][ks] = *(const bf16x8*)(wt + ((size_t)mat * 256 + h * 64 + ct * 16 + r16) * 64 + ks * 32 + quad * 8);
    const f32x4 kkc = *(const f32x4*)(p.rw_kk + l * 256 + c0), kac = *(const f32x4*)(p.rw_ka + l * 256 + c0);
    const f32x4 w00 = *(const f32x4*)(p.rw_w0 + (l * 2 + 0) * 256 + c0), w01 = *(const f32x4*)(p.rw_w0 + (l * 2 + 1) * 256 + c0);
    const f32x4 a00 = *(const f32x4*)(p.rw_a0 + (l * 2 + 0) * 256 + c0), a01 = *(const f32x4*)(p.rw_a0 + (l * 2 + 1) * 256 + c0);
    __builtin_amdgcn_sched_barrier(0);
#pragma unroll
    for (int mat = 0; mat < 4; ++mat) {
      f32x4 a = {0.f, 0.f, 0.f, 0.f};
#pragma unroll
      for (int ks = 0; ks < 2; ++ks) a = mfma16(wfr[mat][ks], mat < 2 ? wdf[ks] : adf[ks], a);
      acc[mat] = a;
    }
    f32x4 nkk, w0v, w1v, b0v, b1v, k0v, k1v;
#pragma unroll
    for (int r = 0; r < 4; ++r) {
      const float k = kv[ct][r];
      const float kkn = k * kkc[r] * rn;
      nkk[r] = -kkn;
#pragma unroll
      for (int d = 0; d < 2; ++d) {
        const float wl = (d ? w01[r] : w00[r]) + acc[d][r];
        const float w_log = -__logf(1.0f + __expf(-wl)) - 0.5f;
        const float decay = __expf(-__expf(w_log));
        const float a = fsigmoid((d ? a01[r] : a00[r]) + acc[2 + d][r]);
        const float kd = k * (1.f + (a - 1.f) * kac[r]);
        if (d) { w1v[r] = decay; b1v[r] = kkn * a; k1v[r] = kd; } else { w0v[r] = decay; b0v[r] = kkn * a; k0v[r] = kd; }
      }
    }
    const size_t o0 = (size_t)tok * 256 + c0, o1 = ((size_t)NTOK + tok) * 256 + c0;
    *(f32x4*)(p.NKK + o0) = nkk;
    *(f32x4*)(p.AW + o0) = w0v; *(f32x4*)(p.AW + o1) = w1v;
    *(f32x4*)(p.AB + o0) = b0v; *(f32x4*)(p.AB + o1) = b1v;
    *(f32x4*)(p.AKD + o0) = k0v; *(f32x4*)(p.AKD + o1) = k1v;
  }
}

#define LSCAN_STEP(A, H, CTRL) { \
    const float Ap = __builtin_bit_cast(float, __builtin_amdgcn_update_dpp(0x3f800000, __builtin_bit_cast(int, A), CTRL, 0xf, 0xf, false)); \
    const float Hp = __builtin_bit_cast(float, __builtin_amdgcn_update_dpp(0, __builtin_bit_cast(int, H), CTRL, 0xf, 0xf, true)); \
    H = A * Hp + H; A = A * Ap; }

__device__ void pre_lru(const Params& p, int l, int item) {
  const int tid = tid_opaque(), lane = tid & 63, n = tid >> 6, r16 = lane & 15, quad = lane >> 4;
  const int tok0 = item * 16;
  int T, sb, t0;
  if (tok0 < 4096) { T = 256; sb = tok0 & ~255; t0 = tok0 & 255; } else { T = 1024; sb = 4096 + ((tok0 - 4096) & ~1023); t0 = (tok0 - 4096) & 1023; }
  const int t = t0 + r16, tok = tok0 + r16;
  bf16x8 xf[2];
  float xo[2][8];
#pragma unroll
  for (int ks = 0; ks < 2; ++ks) {
    const int cb = n * 64 + ks * 32 + quad * 8;
    float o[8];
    { const f32x4 b0 = *(const f32x4*)(p.lru_cb + l * 256 + cb), b1 = *(const f32x4*)(p.lru_cb + l * 256 + cb + 4);
      o[0] = b0[0]; o[1] = b0[1]; o[2] = b0[2]; o[3] = b0[3]; o[4] = b1[0]; o[5] = b1[1]; o[6] = b1[2]; o[7] = b1[3]; }
#pragma unroll
    for (int i = 0; i < 4; ++i) {
      const int tt = t - 2 + i;
      u32x4 xr = {0u, 0u, 0u, 0u};
      if (tt >= 0 && tt < T) xr = *(const u32x4*)(p.P + (size_t)(sb + tt) * PW + 1920 + cb);
      float x[8]; unpack8(xr, x);
      const f32x4 w0 = *(const f32x4*)(p.lru_cw + (l * 4 + i) * 256 + cb), w1 = *(const f32x4*)(p.lru_cw + (l * 4 + i) * 256 + cb + 4);
      o[0] += w0[0] * x[0]; o[1] += w0[1] * x[1]; o[2] += w0[2] * x[2]; o[3] += w0[3] * x[3];
      o[4] += w1[0] * x[4]; o[5] += w1[1] * x[5]; o[6] += w1[2] * x[6]; o[7] += w1[3] * x[7];
    }
    xf[ks] = pack8(o);
#pragma unroll
    for (int j = 0; j < 8; ++j) xo[ks][j] = o[j];
  }
#pragma unroll
  for (int et = 0; et < 4; ++et) {
    f32x4 acc[4];
    const int c0 = n * 64 + (et >> 1) * 32 + quad * 8 + (et & 1) * 4;
    const int erow = (et >> 1) * 32 + (r16 >> 2) * 8 + (et & 1) * 4 + (r16 & 3);
    bf16x8 wfr[4][2];
#pragma unroll
    for (int mat = 0; mat < 4; ++mat)
#pragma unroll
      for (int ks = 0; ks < 2; ++ks) wfr[mat][ks] = *(const bf16x8*)(p.LWT + ((size_t)((l * 4 + mat) * 4 + n) * 64 + erow) * 64 + ks * 32 + quad * 8);
    const f32x4 ba0 = *(const f32x4*)(p.lru_ba + (l * 2 + 0) * 256 + c0), ba1 = *(const f32x4*)(p.lru_ba + (l * 2 + 1) * 256 + c0);
    const f32x4 bx0 = *(const f32x4*)(p.lru_bx + (l * 2 + 0) * 256 + c0), bx1 = *(const f32x4*)(p.lru_bx + (l * 2 + 1) * 256 + c0);
    const f32x4 lm0 = *(const f32x4*)(p.lru_lam + (l * 2 + 0) * 256 + c0), lm1 = *(const f32x4*)(p.lru_lam + (l * 2 + 1) * 256 + c0);
    __builtin_amdgcn_sched_barrier(0);
#pragma unroll
    for (int mat = 0; mat < 4; ++mat) {
      f32x4 a = {0.f, 0.f, 0.f, 0.f};
#pragma unroll
      for (int ks = 0; ks < 2; ++ks) a = mfma16(wfr[mat][ks], xf[ks], a);
      acc[mat] = a;
    }
    f32x4 A0, H0, A1, H1;
#pragma unroll
    for (int r = 0; r < 4; ++r) {
      const float x = xo[et >> 1][(et & 1) * 4 + r];
#pragma unroll
      for (int d = 0; d < 2; ++d) {
        const float ga = fsigmoid(acc[d][r] + (d ? ba1[r] : ba0[r]));
        const float gx = fsigmoid(acc[2 + d][r] + (d ? bx1[r] : bx0[r]));
        const float e_ = __expf(-(d ? lm1[r] : lm0[r]));
        const float sp = e_ < 0.05f ? e_ * (1.0f - e_ * (0.5f - e_ * (0.33333334f - 0.25f * e_))) : __logf(1.0f + e_);
        const float log_a = -8.0f * ga * sp;
        float a = __expf(log_a);
        const float x2 = 2.0f * log_a;
        const float om = x2 > -0.05f ? -(x2 * (1.0f + x2 * (0.5f + x2 * (0.16666667f + x2 * 0.041666667f)))) : 1.0f - __expf(x2);
        float u = __fsqrt_rn(om) * (gx * x);
        if (d == 0) { LSCAN_STEP(a, u, 0x111) LSCAN_STEP(a, u, 0x112) LSCAN_STEP(a, u, 0x114) LSCAN_STEP(a, u, 0x118) A0[r] = a; H0[r] = u; }
        else        { LSCAN_STEP(a, u, 0x101) LSCAN_STEP(a, u, 0x102) LSCAN_STEP(a, u, 0x104) LSCAN_STEP(a, u, 0x108) A1[r] = a; H1[r] = u; }
      }
    }
    const size_t o0 = (size_t)tok * 256 + c0, o1 = ((size_t)NTOK + tok) * 256 + c0;
    *(f32x4*)(p.LA + o0) = A0; *(f32x4*)(p.LU + o0) = H0;
    *(f32x4*)(p.LA + o1) = A1; *(f32x4*)(p.LU + o1) = H1;
  }
}

__device__ void pre_rope(const Params& p, int item) {
  const int tid = tid_opaque();
  const int ts0 = item * 16;
#pragma unroll 1
  for (int pp = tid; pp < 448; pp += 256) {
    int scol, d1, d2, half, i, dstride; bf16_t* dst; float inv;
    if (pp < 192) {
      int q = pp < 128 ? pp : pp - 128; int vec = q >> 5, pi = q & 31; half = pi >> 4; i = pi & 15;
      d1 = half * 32 + i; d2 = d1 + 16; inv = exp2f(-(float)i * (13.287712379549449f / 16.0f));
      if (pp < 128) { scol = 1152 + vec * 64; dst = p.QBR + vec * 64; dstride = 256; }
      else { scol = 1408 + vec * 64; dst = p.KBR + vec * 64; dstride = 128; }
    } else {
      int q = pp < 320 ? pp - 192 : pp - 320; int vec = q >> 4, pi = q & 15; half = pi >> 3; i = pi & 7;
      d1 = half * 16 + i; d2 = d1 + 8; inv = exp2f(-(float)i * (13.287712379549449f / 8.0f));
      if (pp < 320) { scol = 2432 + vec * 32; dst = p.QDR + vec * 32; dstride = 256; }
      else { scol = 2688 + vec * 32; dst = p.KDR + vec * 32; dstride = 256; }
    }
    float x1[16], x2[16];
#pragma unroll
    for (int tt = 0; tt < 16; ++tt) { const bf16_t* src = p.P + (size_t)(4096 + ts0 + tt) * PW + scol; x1[tt] = bf2f(src[d1]); x2[tt] = bf2f(src[d2]); }
#pragma unroll
    for (int tt = 0; tt < 16; ++tt) {
      const int t = (ts0 + tt) & 1023;
      const float ang = (float)(half ? (t & 63) : (t >> 6)) * inv;
      const float sn = __sinf(ang), cs = __cosf(ang);
      const float a = x1[tt], b = x2[tt];
      bf16_t* o = dst + (size_t)(ts0 + tt) * dstride;
      o[d1] = f2bf(a * cs - b * sn); o[d2] = f2bf(a * sn + b * cs);
    }
  }
}

__device__ void phase_pre(const Params& p, int l, unsigned char* smem) {
  const int n0 = 512, n1 = n0 + 512, n2 = n1 + 256, n3 = n2 + 256, n4 = n3 + 512;
#pragma unroll 1
  for (int it = blockIdx.x; it < n4; it += gridDim.x) {
    if (it < n0) pre_rwkv(p, l, it);
    else if (it < n1) pre_lru(p, l, it - n0);
    else if (it < n2) pre_rope(p, it - n1);
    else if (it < n3) {
      int i2 = it - n2; int tt = i2 >> 1, ct = i2 & 1; int tok0 = tt * 64;
      int T, sb; if (tok0 < 4096) { T = 256; sb = tok0 & ~255; } else { T = 1024; sb = 4096 + ((tok0 - 4096) & ~1023); }
      transpose_tile<bf16_t>(p.P + (size_t)tok0 * PW + 1536 + ct * 64, PW, p.VBT + (size_t)sb * 128 + (size_t)(ct * 64) * T + (tok0 - sb), T, (float*)smem);
    } else {
      int i2 = it - n3; int tt = i2 >> 2, ct = i2 & 3; int tok0 = tt * 64;
      int T, sb; if (tok0 < 4096) { T = 256; sb = tok0 & ~255; } else { T = 1024; sb = 4096 + ((tok0 - 4096) & ~1023); }
      transpose_tile<bf16_t>(p.P + (size_t)tok0 * PW + 2944 + ct * 64, PW, p.VDT + (size_t)sb * 256 + (size_t)(ct * 64) * T + (tok0 - sb), T, (float*)smem);
    }
  }
}

template <int LR> DI float group_sum(float v) {
  v += __builtin_bit_cast(float, __builtin_amdgcn_update_dpp(0, __builtin_bit_cast(int, v), 0xB1, 0xf, 0xf, true));
  v += __builtin_bit_cast(float, __builtin_amdgcn_update_dpp(0, __builtin_bit_cast(int, v), 0x4E, 0xf, 0xf, true));
  if (LR >= 8) v += __builtin_bit_cast(float, __builtin_amdgcn_update_dpp(0, __builtin_bit_cast(int, v), 0x141, 0xf, 0xf, true));
  if (LR >= 16) v += __builtin_bit_cast(float, __builtin_amdgcn_update_dpp(0, __builtin_bit_cast(int, v), 0x140, 0xf, 0xf, true));
  return v;
}
typedef float f32x2 __attribute__((ext_vector_type(2)));
template <int E> struct RwOps { f32x4 nk[E / 4], ww[E / 4], bb[E / 4], kk[E / 4], rr[E / 4]; float vi; };
template <int E> DI void rw_load(const float* ob, int g, int i, RwOps<E>& o) {
  constexpr int LR = 64 / E, NM = E / 4;
#pragma unroll
  for (int m = 0; m < NM; ++m) {
    const int off = 4 * (g + LR * m);
    o.nk[m] = *(const f32x4*)(ob + off); o.ww[m] = *(const f32x4*)(ob + 64 + off); o.bb[m] = *(const f32x4*)(ob + 128 + off);
    o.kk[m] = *(const f32x4*)(ob + 192 + off); o.rr[m] = *(const f32x4*)(ob + 256 + off);
  }
  o.vi = ob[320 + i];
}
template <int E> DI float rw_step(f32x2 (&S)[E / 2], const RwOps<E>& o) {
  constexpr int LR = 64 / E, NM = E / 4;
  f32x2 p2 = S[0] * o.nk[0].xy;
  p2 = S[1] * o.nk[0].zw + p2;
#pragma unroll
  for (int m = 1; m < NM; ++m) { p2 = S[2 * m] * o.nk[m].xy + p2; p2 = S[2 * m + 1] * o.nk[m].zw + p2; }
  const float sa = group_sum<LR>(p2.x + p2.y);
  const f32x2 sa2 = {sa, sa}, v2 = {o.vi, o.vi};
  f32x2 y2 = {0.f, 0.f};
#pragma unroll
  for (int m = 0; m < NM; ++m) {
    S[2 * m] = S[2 * m] * o.ww[m].xy + (sa2 * o.bb[m].xy + v2 * o.kk[m].xy);
    S[2 * m + 1] = S[2 * m + 1] * o.ww[m].zw + (sa2 * o.bb[m].zw + v2 * o.kk[m].zw);
    y2 = S[2 * m] * o.rr[m].xy + y2; y2 = S[2 * m + 1] * o.rr[m].zw + y2;
  }
  return group_sum<LR>(y2.x + y2.y);
}
template <int E>
__device__ void rwkv_chain(const Params& p, int l, int chain, int part, unsigned char* smem) {
  constexpr int LR = 64 / E, NM = E / 4;
  const int tid = tid_opaque(), lane = tid & 63, wave = tid >> 6;
  int seq, d, h;
  if (chain < 32) { seq = 16 + (chain >> 3); d = (chain >> 2) & 1; h = chain & 3; }
  else { int c2 = chain - 32; seq = c2 >> 3; d = (c2 >> 2) & 1; h = c2 & 3; }
  const int T = seq < 16 ? 256 : 1024, tokb = seq < 16 ? seq * 256 : 4096 + (seq - 16) * 1024;
  const int g = lane % LR, rl = lane / LR, i = part * 4 * E + wave * E + rl;
  f32x2 S[E / 2];
  if (seq >= 16) {
    const float* s0 = p.st_rwkv + ((((size_t)(seq - 16) * 2 + l) * 2 + d) * 4 + h) * 4096 + i * 64;
#pragma unroll
    for (int m = 0; m < NM; ++m) { f32x4 t = *(const f32x4*)(s0 + 4 * (g + LR * m)); S[2 * m] = t.xy; S[2 * m + 1] = t.zw; }
  } else {
#pragma unroll
    for (int j = 0; j < E / 2; ++j) S[j] = (f32x2){0.f, 0.f};
  }
  float* buf = (float*)smem;
  const int lvec = (tid >> 4) & 3, lc4 = tid & 15, ls = tid >> 6;
  const float* fsrc = (lvec == 0 ? p.NKK : lvec == 1 ? p.AW + (size_t)d * NTOK * 256 : lvec == 2 ? p.AB + (size_t)d * NTOK * 256 : p.AKD + (size_t)d * NTOK * 256) + h * 64 + lc4 * 4;
  const int bs = tid >> 4, bvec = (tid >> 3) & 1, bc8 = tid & 7;
  const bf16_t* bsrc = p.P + (bvec ? 512 : 0) + h * 64 + bc8 * 8;
  f32x4 rfA[4], rfB[4]; u32x4 rbA, rbB;
  const int nch = T / 16;
#define RW_GLOAD(RF, RB, CK) { _Pragma("unroll") for (int i4 = 0; i4 < 4; ++i4) { int step = (CK) * 16 + ls + 4 * i4; int t = d ? T - 1 - step : step; RF[i4] = *(const f32x4*)(fsrc + (size_t)(tokb + t) * 256); } \
    { int step = (CK) * 16 + bs; int t = d ? T - 1 - step : step; RB = *(const u32x4*)(bsrc + (size_t)(tokb + t) * PW); } }
#define RW_SSTORE(RF, RB, BI) { float* b_ = buf + (BI) * 16 * 384; \
    _Pragma("unroll") for (int i4 = 0; i4 < 4; ++i4) *(f32x4*)(b_ + (ls + 4 * i4) * 384 + lvec * 64 + lc4 * 4) = RF[i4]; \
    float* q_ = b_ + bs * 384 + (4 + bvec) * 64 + bc8 * 8; \
    *(f32x4*)q_ = (f32x4){bflo(RB.x), bfhi(RB.x), bflo(RB.y), bfhi(RB.y)}; \
    *(f32x4*)(q_ + 4) = (f32x4){bflo(RB.z), bfhi(RB.z), bflo(RB.w), bfhi(RB.w)}; }
  float* yout = p.YA + ((size_t)d * NTOK + tokb) * 256 + h * 64 + i;
  constexpr int NY = 16 / LR;
  auto compute = [&](int ck) {
    const float* cb = buf + (ck & 1) * 16 * 384;
    float yk[NY];
#pragma unroll
    for (int q = 0; q < NY; ++q) yk[q] = 0.f;
    RwOps<E> oa, ob2;
    rw_load<E>(cb, g, i, oa);
#pragma unroll 1
    for (int s = 0; s < 16; s += 2) {
      rw_load<E>(cb + (s + 1) * 384, g, i, ob2);
      const float y0 = rw_step<E>(S, oa);
#pragma unroll
      for (int q = 0; q < NY; ++q) yk[q] = (s == q * LR + g) ? y0 : yk[q];
      if (s + 2 < 16) rw_load<E>(cb + (s + 2) * 384, g, i, oa);
      const float y1 = rw_step<E>(S, ob2);
#pragma unroll
      for (int q = 0; q < NY; ++q) yk[q] = (s + 1 == q * LR + g) ? y1 : yk[q];
    }
#pragma unroll
    for (int q = 0; q < NY; ++q) { const int step = ck * 16 + q * LR + g; const int t = d ? T - 1 - step : step; yout[(size_t)t * 256] = yk[q]; }
  };
  __builtin_amdgcn_s_setprio(2);
  RW_GLOAD(rfA, rbA, 0); RW_SSTORE(rfA, rbA, 0); RW_GLOAD(rfA, rbA, 1); RW_GLOAD(rfB, rbB, 2);
  __syncthreads();
#pragma unroll 1
  for (int ck = 0; ck < nch; ck += 2) {
    compute(ck);
    RW_SSTORE(rfA, rbA, 1);
    if (ck + 3 < nch) RW_GLOAD(rfA, rbA, ck + 3);
    lds_barrier();
    compute(ck + 1);
    if (ck + 2 < nch) RW_SSTORE(rfB, rbB, 0);
    if (ck + 4 < nch) RW_GLOAD(rfB, rbB, ck + 4);
    lds_barrier();
  }
  __builtin_amdgcn_s_setprio(0);
#undef RW_GLOAD
#undef RW_SSTORE
  if (seq < 16) {
    float* so = p.out + O_NSR + ((((size_t)seq * 2 + l) * 2 + d) * 4 + h) * 4096 + i * 64;
#pragma unroll
    for (int m = 0; m < NM; ++m) *(f32x4*)(so + 4 * (g + LR * m)) = (f32x4){S[2 * m].x, S[2 * m].y, S[2 * m + 1].x, S[2 * m + 1].y};
  }
}

__device__ void lru_scan(const Params& p, int l, int item) {
  const int c = tid_opaque();
  int seq, d;
  if (item < 8) { seq = 16 + (item >> 1); d = item & 1; } else { seq = (item - 8) >> 1; d = item & 1; }
  const int T = seq < 16 ? 256 : 1024, tokb = seq < 16 ? seq * 256 : 4096 + (seq - 16) * 1024;
  const int NC = T >> 4;
  float h = seq >= 16 ? p.st_lru[(((seq - 16) * 2 + l) * 2 + d) * 256 + c] : 0.f;
  const float* la = p.LA + (size_t)d * NTOK * 256 + c; const float* lu = p.LU + (size_t)d * NTOK * 256 + c;
  float* lc = p.LC + (size_t)d * 512 * 256 + (size_t)(tokb >> 4) * 256 + c;
  for (int k0 = 0; k0 < NC; k0 += 8) {
    float a[8], u[8];
#pragma unroll
    for (int q = 0; q < 8; ++q) { const int k = d ? NC - 1 - (k0 + q) : k0 + q; const size_t idx = (size_t)(tokb + k * 16 + (d ? 0 : 15)) * 256; a[q] = la[idx]; u[q] = lu[idx]; }
#pragma unroll
    for (int q = 0; q < 8; ++q) { const int k = d ? NC - 1 - (k0 + q) : k0 + q; lc[(size_t)k * 256] = h; h = a[q] * h + u[q]; }
  }
  if (seq < 16) p.out[O_NSL + ((seq * 2 + l) * 2 + d) * 256 + c] = h;
}

template <bool DIFF>
DI void attn_keytile(const bf16_t* Kp, int kstride, const bf16_t* Vtp, int vstride, const bf16x8 (&qf)[2], float scale_log2,
                     bool masked, int kpos0, int qpos, float (&m)[2], float (&lsum)[2], f32x4 (&o)[2][4], int lane) {
  const int r16 = lane & 15, quad = lane >> 4;
  constexpr int NS = DIFF ? 2 : 1;
  const f32x4 z4 = {0.f, 0.f, 0.f, 0.f};
  bf16x8 kf0[4], kf1[4], vfr[4][2];
  const bf16_t* krow = Kp + (size_t)(8 * (r16 >> 2) + (r16 & 3)) * kstride + quad * 8;
#pragma unroll
  for (int kt = 0; kt < 4; ++kt) {
    const bf16_t* kr = krow + (size_t)(32 * (kt >> 1) + 4 * (kt & 1)) * kstride;
    kf0[kt] = *(const bf16x8*)kr; if (!DIFF) kf1[kt] = *(const bf16x8*)(kr + 32);
  }
  if (!DIFF) {
#pragma unroll
    for (int dt = 0; dt < 4; ++dt)
#pragma unroll
      for (int s = 0; s < 2; ++s) vfr[dt][s] = *(const bf16x8*)(Vtp + (size_t)(dt * 16 + r16) * vstride + 32 * s + 8 * quad);
  }
  bf16x8 pf[NS][2];
#pragma unroll
  for (int st = 0; st < NS; ++st) {
    f32x4 sc[4];
#pragma unroll
    for (int kt = 0; kt < 4; ++kt) {
      if (!DIFF) { sc[kt] = mfma16(kf0[kt], qf[0], z4); sc[kt] = mfma16(kf1[kt], qf[1], sc[kt]); }
      else sc[kt] = mfma16(kf0[kt], qf[st], z4);
    }
    if (DIFF && st == 0) {
#pragma unroll
      for (int kt = 0; kt < 4; ++kt) kf0[kt] = *(const bf16x8*)(krow + (size_t)(32 * (kt >> 1) + 4 * (kt & 1)) * kstride + 32);
    }
    float mx = -3.0e38f;
#pragma unroll
    for (int kt = 0; kt < 4; ++kt)
#pragma unroll
      for (int r = 0; r < 4; ++r) {
        float x = sc[kt][r] * scale_log2;
        if (masked) { const int kp = kpos0 + 32 * (kt >> 1) + 8 * quad + 4 * (kt & 1) + r; const int dd = kp - qpos; if (dd > 128 || dd < -128) x = -1.0e30f; }
        sc[kt][r] = x; mx = fmaxf(mx, x);
      }
    mx = fmaxf(mx, __shfl_xor(mx, 16)); mx = fmaxf(mx, __shfl_xor(mx, 32));
    const float mnew = fmaxf(m[st], mx);
    const float alpha = exp2f(m[st] - mnew);
    m[st] = mnew;
    float ps = 0.f;
#pragma unroll
    for (int kt = 0; kt < 4; ++kt)
#pragma unroll
      for (int r = 0; r < 4; ++r) { const float e = exp2f(sc[kt][r] - mnew); sc[kt][r] = e; ps += e; }
    lsum[st] = lsum[st] * alpha + ps;
#pragma unroll
    for (int dt = 0; dt < 4; ++dt) o[st][dt] *= alpha;
#pragma unroll
    for (int s = 0; s < 2; ++s) {
      bf16x8 t;
#pragma unroll
      for (int j = 0; j < 8; ++j) t[j] = (short)f2bf(sc[2 * s + (j >> 2)][j & 3]);
      pf[st][s] = t;
    }
  }
#pragma unroll
  for (int dt = 0; dt < 4; ++dt)
#pragma unroll
    for (int s = 0; s < 2; ++s) {
      const bf16x8 vf = DIFF ? *(const bf16x8*)(Vtp + (size_t)(dt * 16 + r16) * vstride + 32 * s + 8 * quad) : vfr[dt][s];
#pragma unroll
      for (int st = 0; st < NS; ++st) o[st][dt] = mfma16(vf, pf[st][s], o[st][dt]);
    }
}

template <bool DIFF>
__device__ void attn_item(const Params& p, int l, bool sample, int sq  , int h, int qt) {
  const int tid = tid_opaque();
  const int lane = tid & 63, wave = tid >> 6, r16 = lane & 15, quad = lane >> 4;
  const int T = sample ? 1024 : 256;
  const int tokb = sample ? 4096 + sq * 1024 : sq * 256;
  const int q0 = qt * 64 + wave * 16;
  const int qpos = q0 + r16;
  const int kvh = DIFF ? h : (h >> 1);
  bf16x8 qf[2];
  {
    const bf16_t* qp;
    if (sample) qp = (DIFF ? p.QDR : p.QBR) + (size_t)(sq * 1024 + qpos) * 256 + h * 64;
    else qp = p.P + (size_t)(tokb + qpos) * PW + (DIFF ? 2432 : 1152) + h * 64;
    qf[0] = *(const bf16x8*)(qp + quad * 8); qf[1] = *(const bf16x8*)(qp + 32 + quad * 8);
  }
  float m[2] = {-3.0e38f, -3.0e38f}, lsum[2] = {0.f, 0.f};
  f32x4 o[2][4];
#pragma unroll
  for (int a = 0; a < 2; ++a)
#pragma unroll
    for (int b = 0; b < 4; ++b) o[a][b] = (f32x4){0.f, 0.f, 0.f, 0.f};
  const float scale_log2 = (DIFF ? 0.17677669529663687f : 0.125f) * 1.4426950408889634f;
  if (sample) {
    const int bl = sq * 2 + l;
    const bf16_t* K; const bf16_t* Vt; int ks;
    if (DIFF) { K = p.CDK + (size_t)bl * 256 * 256 + h * 64; ks = 256; Vt = p.CDVT + (size_t)bl * 256 * 256 + (size_t)(h * 64) * 256; }
    else { K = p.CWK + (size_t)bl * 256 * 128 + kvh * 64; ks = 128; Vt = p.CWVT + (size_t)bl * 128 * 256 + (size_t)(kvh * 64) * 256; }
    for (int kb = 0; kb < 256; kb += 64)
      attn_keytile<DIFF>(K + (size_t)kb * ks, ks, Vt + kb, 256, qf, scale_log2, false, 0, 0, m, lsum, o, lane);
  }
  {
    const bf16_t* K; const bf16_t* Vt; int ks;
    if (sample) {
      if (DIFF) { K = p.KDR + (size_t)(sq * 1024) * 256 + h * 64; ks = 256; Vt = p.VDT + (size_t)tokb * 256 + (size_t)(h * 64) * T; }
      else { K = p.KBR + (size_t)(sq * 1024) * 128 + kvh * 64; ks = 128; Vt = p.VBT + (size_t)tokb * 128 + (size_t)(kvh * 64) * T; }
    } else {
      if (DIFF) { K = p.P + (size_t)tokb * PW + 2688 + h * 64; ks = PW; Vt = p.VDT + (size_t)tokb * 256 + (size_t)(h * 64) * T; }
      else { K = p.P + (size_t)tokb * PW + 1408 + kvh * 64; ks = PW; Vt = p.VBT + (size_t)tokb * 128 + (size_t)(kvh * 64) * T; }
    }
    int kb0 = 0, kb1 = T; bool masked = false;
    if (sample && !DIFF) { const int qb = qt * 64; kb0 = qb - 128 < 0 ? 0 : qb - 128; kb1 = qb + 192 > T ? T : qb + 192; masked = true; }
    for (int kb = kb0; kb < kb1; kb += 64)
      attn_keytile<DIFF>(K + (size_t)kb * ks, ks, Vt + kb, T, qf, scale_log2, masked, kb, qpos, m, lsum, o, lane);
  }
  float l0 = lsum[0]; l0 += __shfl_xor(l0, 16); l0 += __shfl_xor(l0, 32);
  const int tok = tokb + qpos;
  if (!DIFF) {
    l0 += exp2f(p.win_sink[l * 4 + h] * 1.4426950408889634f - m[0]);
    const float inv = 1.0f / l0;
#pragma unroll
    for (int dt = 0; dt < 4; ++dt) {
      f32x4 v = o[0][dt] * inv;
      *(float4*)(p.OB + (size_t)tok * 256 + h * 64 + dt * 16 + quad * 4) = (float4){v[0], v[1], v[2], v[3]};
    }
  } else {
    float l1 = lsum[1]; l1 += __shfl_xor(l1, 16); l1 += __shfl_xor(l1, 32);
    float d1 = 0.f, d2 = 0.f;
    const float* dl = p.diff_lam + l * 128;
    for (int j = 0; j < 32; ++j) { d1 += dl[j] * dl[32 + j]; d2 += dl[64 + j] * dl[96 + j]; }
    const float lam_init = 0.8f - 0.6f * expf(-0.3f * (float)l);
    const float lam = expf(d1) - expf(d2) + lam_init;
    const float i0 = 1.0f / l0, i1 = lam / l1;
    f32x4 v[4]; float ss = 0.f;
#pragma unroll
    for (int dt = 0; dt < 4; ++dt) { v[dt] = o[0][dt] * i0 - o[1][dt] * i1; ss += v[dt][0] * v[dt][0] + v[dt][1] * v[dt][1] + v[dt][2] * v[dt][2] + v[dt][3] * v[dt][3]; }
    ss += __shfl_xor(ss, 16); ss += __shfl_xor(ss, 32);
    const float rstd = rsqrtf(ss * (1.0f / 64.0f) + 1e-6f) * (1.0f - lam_init);
#pragma unroll
    for (int dt = 0; dt < 4; ++dt) {
      const float4 g = *(const float4*)(p.diff_g + l * 64 + dt * 16 + quad * 4);
      *(float4*)(p.OD + (size_t)tok * 256 + h * 64 + dt * 16 + quad * 4) = (float4){v[dt][0] * rstd * g.x, v[dt][1] * rstd * g.y, v[dt][2] * rstd * g.z, v[dt][3] * rstd * g.w};
    }
  }
}

__device__ void mix_other(const Params& p, int l, int it) {
  if (it < 256) { attn_item<true>(p, l, true, it >> 6, (it >> 4) & 3, it & 15); return; }
  it -= 256;
  if (it < 40) { lru_scan(p, l, it); return; }
  it -= 40;
  if (it < 256) { attn_item<false>(p, l, true, it >> 6, (it >> 4) & 3, it & 15); return; }
  it -= 256;
  if (it < 256) { attn_item<true>(p, l, false, it >> 4, (it >> 2) & 3, it & 3); return; }
  it -= 256;
  attn_item<false>(p, l, false, it >> 4, (it >> 2) & 3, it & 3);
}

#define ES 4
#define EP 8
__device__ void mix_item(const Params& p, int l, int it, unsigned char* smem) {
  constexpr int NPS = 16 / ES, NPP = 16 / EP, NS = 32 * NPS, NP = 128 * NPP;
  if (it < NS) {
#pragma unroll 1
    for (int r = 0; r < p.rep2[0]; ++r) rwkv_chain<ES>(p, l, it / NPS, it % NPS, smem);
    return;
  }
  it -= NS;
  if (it < NP) {
#pragma unroll 1
    for (int r = 0; r < p.rep2[1]; ++r) rwkv_chain<EP>(p, l, 32 + it / NPP, it % NPP, smem);
    return;
  }
  it -= NP;
#pragma unroll 1
  for (int r = 0; r < p.rep2[2]; ++r) mix_other(p, l, it);
}
__device__ void phase_mix(const Params& p, int l, unsigned char* smem) {
  constexpr int NS = 32 * (16 / ES), NP = 128 * (16 / EP), NALL = NS + NP + 1064;
  const int G = gridDim.x, b = blockIdx.x;
  if (G >= 2 * NS) {
    if (b < NS) mix_item(p, l, b, smem);
    else {
#pragma unroll 1
      for (int it = NS + (b - NS); it < NALL; it += G - NS) mix_item(p, l, it, smem);
    }
  } else {
#pragma unroll 1
    for (int it = b; it < NALL; it += G) mix_item(p, l, it, smem);
  }
}

DI float sum16(float v) { v += __shfl_xor(v, 1); v += __shfl_xor(v, 2); v += __shfl_xor(v, 4); v += __shfl_xor(v, 8); return v; }

__device__ void phase_post(const Params& p, int l) {
  const int tid0 = tid_opaque();
  const int lane = tid0 & 63, wave = tid0 >> 6;
  const int c = lane * 4;
#pragma unroll 1
  for (int tok = blockIdx.x * 4 + wave; tok < NTOK; tok += gridDim.x * 4) {
    const bf16_t* pr = p.P + (size_t)tok * PW;
    float out[4], g[4];
    {
      const float4 y0 = *(const float4*)(p.YA + (size_t)tok * 256 + c), y1 = *(const float4*)(p.YA + ((size_t)NTOK + tok) * 256 + c);
      float y[4] = {y0.x + y1.x, y0.y + y1.y, y0.z + y1.z, y0.w + y1.w};
      const float mu = sum16(y[0] + y[1] + y[2] + y[3]) * (1.0f / 64.0f);
      float dv[4] = {y[0] - mu, y[1] - mu, y[2] - mu, y[3] - mu};
      const float var = sum16(dv[0] * dv[0] + dv[1] * dv[1] + dv[2] * dv[2] + dv[3] * dv[3]) * (1.0f / 64.0f);
      const float rstd = rsqrtf(var + 64e-5f);
      float r[4], k[4], v[4];
      ld4bf(pr + c, r); ld4bf(pr + 256 + c, k); ld4bf(pr + 512 + c, v); ld4bf(pr + 896 + c, g);
      const float4 rk = *(const float4*)(p.rw_rk + l * 256 + c), gg = *(const float4*)(p.rw_gng + l * 256 + c), gb = *(const float4*)(p.rw_gnb + l * 256 + c);
      const float bs = sum16(r[0] * k[0] * rk.x + r[1] * k[1] * rk.y + r[2] * k[2] * rk.z + r[3] * k[3] * rk.w);
      out[0] = (dv[0] * rstd * gg.x + gb.x + bs * v[0]) * siluf_(g[0]);
      out[1] = (dv[1] * rstd * gg.y + gb.y + bs * v[1]) * siluf_(g[1]);
      out[2] = (dv[2] * rstd * gg.z + gb.z + bs * v[2]) * siluf_(g[2]);
      out[3] = (dv[3] * rstd * gg.w + gb.w + bs * v[3]) * siluf_(g[3]);
      st4bf(p.H + (size_t)tok * 1024 + c, out);
    }
    {
      const float4 y = *(const float4*)(p.OB + (size_t)tok * 256 + c);
      ld4bf(pr + 1664 + c, g);
      out[0] = y.x * siluf_(g[0]); out[1] = y.y * siluf_(g[1]); out[2] = y.z * siluf_(g[2]); out[3] = y.w * siluf_(g[3]);
      st4bf(p.H + (size_t)tok * 1024 + 256 + c, out);
    }
    {
      const float4 y0 = *(const float4*)(p.LU + (size_t)tok * 256 + c), y1 = *(const float4*)(p.LU + ((size_t)NTOK + tok) * 256 + c);
      const float4 A0 = *(const float4*)(p.LA + (size_t)tok * 256 + c), A1 = *(const float4*)(p.LA + ((size_t)NTOK + tok) * 256 + c);
      const float4 c0 = *(const float4*)(p.LC + (size_t)(tok >> 4) * 256 + c), c1 = *(const float4*)(p.LC + ((size_t)512 + (tok >> 4)) * 256 + c);
      ld4bf(pr + 2176 + c, g);
      out[0] = (y0.x + A0.x * c0.x + y1.x + A1.x * c1.x) * siluf_(g[0]); out[1] = (y0.y + A0.y * c0.y + y1.y + A1.y * c1.y) * siluf_(g[1]);
      out[2] = (y0.z + A0.z * c0.z + y1.z + A1.z * c1.z) * siluf_(g[2]); out[3] = (y0.w + A0.w * c0.w + y1.w + A1.w * c1.w) * siluf_(g[3]);
      st4bf(p.H + (size_t)tok * 1024 + 512 + c, out);
    }
    {
      const float4 y = *(const float4*)(p.OD + (size_t)tok * 256 + c);
      ld4bf(pr + 3200 + c, g);
      out[0] = y.x * siluf_(g[0]); out[1] = y.y * siluf_(g[1]); out[2] = y.z * siluf_(g[2]); out[3] = y.w * siluf_(g[3]);
      st4bf(p.H + (size_t)tok * 1024 + 768 + c, out);
    }
  }
}

__global__ void __launch_bounds__(256, 2) fwd_megakernel(Params p) {
  __shared__ __attribute__((aligned(16))) unsigned char smem[49152];
  __shared__ uint4 xb_words;
  if (threadIdx.x == 0) xb_words = make_uint4(0u, 0u, 0u, 0u);
  __syncthreads();
  XcdBarrier xb = xcd_barrier_post(p.bar, (volatile LAS unsigned*)&xb_words);
#pragma unroll 1
  for (int r = 0; r < p.rep[0]; ++r) phase_prologue(p, smem);
  xcd_barrier(xb);
#pragma unroll 1
  for (int r = 0; r < p.rep[1]; ++r) phase_norm(p, 0);
  xcd_barrier(xb);
#pragma unroll 1
  for (int l = 0; l < 2; ++l) {
#pragma unroll 1
    for (int r = 0; r < p.rep[2]; ++r) phase_gemm<0>(p, l, smem);
    xcd_barrier(xb);
#pragma unroll 1
    for (int r = 0; r < p.rep[3]; ++r) phase_pre(p, l, smem);
    xcd_barrier(xb);
#pragma unroll 1
    for (int r = 0; r < p.rep[4]; ++r) phase_mix(p, l, smem);
    xcd_barrier(xb);
#pragma unroll 1
    for (int r = 0; r < p.rep[5]; ++r) phase_post(p, l);
    xcd_barrier(xb);
#pragma unroll 1
    for (int r = 0; r < p.rep[6]; ++r) phase_gemm<1>(p, l, smem);
    xcd_barrier(xb);
    phase_norm(p, l + 1);
    if (l == 0) xcd_barrier(xb);
#pragma unroll 1
    for (int r = 1; r < p.rep[7]; ++r) xcd_barrier(xb);
  }
}

extern "C" void kernel_launch(void* const* d_in, const int* in_sizes, int n_in, void* d_out, int out_size, void* d_ws, size_t ws_size, hipStream_t stream) {
  static int grid_blocks = 0;
  if (!grid_blocks) {
    int dev = 0, cus = 0, per_cu = 0;
    hipGetDevice(&dev);
    hipDeviceGetAttribute(&cus, hipDeviceAttributeMultiprocessorCount, dev);
    hipOccupancyMaxActiveBlocksPerMultiprocessor(&per_cu, (const void*)fwd_megakernel, 256, 0);
    if (per_cu < 1) per_cu = 1;
    if (per_cu > 2) per_cu = 2;
    grid_blocks = cus * per_cu;
  }
  Params p{};
  const float** f = (const float**)&p;
  for (int i = 0; i < 35; ++i) f[i] = (const float*)d_in[i];
  p.out = (float*)d_out;
  size_t off = 0;
  auto take = [&](size_t bytes) { void* r = (char*)d_ws + off; off += (bytes + 255) & ~(size_t)255; return r; };
  p.MOD = (float*)take(2 * 5 * 3072 * 4);
  p.WINT = (bf16_t*)take((size_t)2 * PW * 1024 * 2);
  p.WOUTT = (bf16_t*)take((size_t)2 * 1024 * 1024 * 2);
  p.CWK = (bf16_t*)take((size_t)4 * 2 * 256 * 128 * 2);
  p.CWVT = (bf16_t*)take((size_t)4 * 2 * 256 * 128 * 2);
  p.CDK = (bf16_t*)take((size_t)4 * 2 * 256 * 256 * 2);
  p.CDVT = (bf16_t*)take((size_t)4 * 2 * 256 * 256 * 2);
  p.H = (bf16_t*)take((size_t)NTOK * 1024 * 2);
  p.P = (bf16_t*)take((size_t)NTOK * PW * 2);
  p.NKK = (float*)take((size_t)NTOK * 256 * 4);
  p.AW = (float*)take((size_t)2 * NTOK * 256 * 4);
  p.AB = (float*)take((size_t)2 * NTOK * 256 * 4);
  p.AKD = (float*)take((size_t)2 * NTOK * 256 * 4);
  p.Y2 = p.NKK;
  p.YA = (float*)take((size_t)2 * NTOK * 256 * 4);
  p.LA = (float*)take((size_t)2 * NTOK * 256 * 4);
  p.LU = (float*)take((size_t)2 * NTOK * 256 * 4);
  p.QBR = (bf16_t*)take((size_t)4096 * 256 * 2);
  p.KBR = (bf16_t*)take((size_t)4096 * 128 * 2);
  p.QDR = (bf16_t*)take((size_t)4096 * 256 * 2);
  p.KDR = (bf16_t*)take((size_t)4096 * 256 * 2);
  p.VBT = (bf16_t*)take((size_t)NTOK * 128 * 2);
  p.VDT = (bf16_t*)take((size_t)NTOK * 256 * 2);
  p.OB = (float*)take((size_t)NTOK * 256 * 4);
  p.OD = (float*)take((size_t)NTOK * 256 * 4);
  p.LC = (float*)take((size_t)2 * 512 * 256 * 4);
  p.bar = (unsigned*)take((size_t)XCD_BAR_WORDS * 4);
  p.RWT = (bf16_t*)take((size_t)2 * 4 * 256 * 64 * 2);
  p.LWT = (bf16_t*)take((size_t)2 * 4 * 4 * 64 * 64 * 2);
  if (off > ws_size) { fprintf(stderr, "workspace too small: need %zu have %zu\n", off, ws_size); return; }
  static const int REPS[8] = {1, 1, 1, 1, 1, 1, 1, 1};
  for (int i = 0; i < 8; ++i) p.rep[i] = REPS[i];
  static const int REPS2[8] = {1, 1, 1, 1, 1, 1, 1, 1};
  for (int i = 0; i < 8; ++i) p.rep2[i] = REPS2[i];
  hipMemsetAsync(p.bar, 0, (size_t)XCD_BAR_WORDS * 4, stream);
  void* args[] = {&p};
  hipError_t e = hipLaunchCooperativeKernel((const void*)fwd_megakernel, dim3(grid_blocks), dim3(256), args, 0, stream);
  if (e != hipSuccess) fprintf(stderr, "cooperative launch failed: %s (grid %d)\n", hipGetErrorString(e), grid_blocks);
}
```

```cpp
#include <hip/hip_runtime.h>
#include <cstdio>
#include <cstdint>

typedef unsigned short bf16_t;
typedef short bf16x8 __attribute__((ext_vector_type(8)));
typedef float f32x4 __attribute__((ext_vector_type(4)));
typedef unsigned u32x4 __attribute__((ext_vector_type(4)));
typedef unsigned u32x2 __attribute__((ext_vector_type(2)));
#define DI __device__ __forceinline__

#define O_YP 0
#define O_NWK 8388608
#define O_NWV 9437184
#define O_NDK 10485760
#define O_NDV 12582912
#define O_NSR 14680064
#define O_NSL 15728640

#define NTOK 8192
#define PW 3456

struct Params {
  const float *x_prompt, *x_sample, *c, *cwk, *cwv, *cdk, *cdv, *st_rwkv, *st_lru, *c_ctx, *w_mod, *b_mod, *g_pre, *g_post, *w_in, *w_out;
  const float *rw_w0, *rw_wup, *rw_a0, *rw_aup, *rw_kk, *rw_ka, *rw_rk, *rw_gng, *rw_gnb, *win_sink;
  const float *lru_cw, *lru_cb, *lru_wa, *lru_ba, *lru_wx, *lru_bx, *lru_lam, *diff_lam, *diff_g;
  float* out;
  float* MOD; bf16_t* WINT; bf16_t* WOUTT; bf16_t* CWK; bf16_t* CWVT; bf16_t* CDK; bf16_t* CDVT;
  bf16_t* H; bf16_t* P; float* NKK; float* AW; float* AB; float* AKD; float* YA; float* LA; float* LU;
  bf16_t* QBR; bf16_t* KBR; bf16_t* QDR; bf16_t* KDR; bf16_t* VBT; bf16_t* VDT; float* OB; float* OD; float* Y2; float* LC; unsigned* bar; bf16_t* RWT; bf16_t* LWT;
  int rep[8];
  int rep2[8];
};

DI void lds_barrier() { asm volatile("s_waitcnt lgkmcnt(0)\n\ts_barrier" ::: "memory"); }
DI int tid_opaque() { int t = threadIdx.x; asm volatile("" : "+v"(t)); return t; }
DI bf16_t f2bf(float x) { unsigned u = __float_as_uint(x); u += 0x7fffu + ((u >> 16) & 1u); return (bf16_t)(u >> 16); }
DI float bf2f(bf16_t b) { return __uint_as_float(((unsigned)b) << 16); }
typedef float f32x2_ __attribute__((ext_vector_type(2)));
typedef __bf16 bf16x2_t __attribute__((ext_vector_type(2)));
DI unsigned pack2(float a, float b) { f32x2_ v = {a, b}; bf16x2_t r = __builtin_convertvector(v, bf16x2_t); return __builtin_bit_cast(unsigned, r); }
DI float bflo(unsigned u) { return __uint_as_float(u << 16); }
DI float bfhi(unsigned u) { return __uint_as_float(u & 0xffff0000u); }
DI void ld4bf(const bf16_t* q, float (&o)[4]) { u32x2 u = *(const u32x2*)q; o[0] = bflo(u.x); o[1] = bfhi(u.x); o[2] = bflo(u.y); o[3] = bfhi(u.y); }
DI void st4bf(bf16_t* q, const float (&v)[4]) { u32x2 u; u.x = pack2(v[0], v[1]); u.y = pack2(v[2], v[3]); *(u32x2*)q = u; }
DI float wave_sum(float v) { for (int o = 32; o > 0; o >>= 1) v += __shfl_xor(v, o); return v; }
DI float sigmoidf_(float x) { return 1.0f / (1.0f + expf(-x)); }
DI float fsigmoid(float x) { return __builtin_amdgcn_rcpf(1.0f + __expf(-x)); }
DI float wave_sum_dpp(float v) {
  v += __builtin_bit_cast(float, __builtin_amdgcn_update_dpp(0, __builtin_bit_cast(int, v), 0xB1, 0xf, 0xf, true));
  v += __builtin_bit_cast(float, __builtin_amdgcn_update_dpp(0, __builtin_bit_cast(int, v), 0x4E, 0xf, 0xf, true));
  v += __builtin_bit_cast(float, __builtin_amdgcn_update_dpp(0, __builtin_bit_cast(int, v), 0x141, 0xf, 0xf, true));
  v += __builtin_bit_cast(float, __builtin_amdgcn_update_dpp(0, __builtin_bit_cast(int, v), 0x140, 0xf, 0xf, true));
  const int iv = __builtin_bit_cast(int, v);
  return __builtin_bit_cast(float, __builtin_amdgcn_readlane(iv, 0)) + __builtin_bit_cast(float, __builtin_amdgcn_readlane(iv, 16)) + __builtin_bit_cast(float, __builtin_amdgcn_readlane(iv, 32)) + __builtin_bit_cast(float, __builtin_amdgcn_readlane(iv, 48));
}
DI float siluf_(float x) { return x * __builtin_amdgcn_rcpf(1.0f + __expf(-x)); }
DI float softplusf_(float z) { return z > 20.f ? z : log1pf(expf(z)); }
DI f32x4 mfma16(bf16x8 a, bf16x8 b, f32x4 c) { return __builtin_amdgcn_mfma_f32_16x16x32_bf16(a, b, c, 0, 0, 0); }
DI float quad_sum(float v) {
  v += __builtin_bit_cast(float, __builtin_amdgcn_update_dpp(0, __builtin_bit_cast(int, v), 0xB1, 0xf, 0xf, true));
  v += __builtin_bit_cast(float, __builtin_amdgcn_update_dpp(0, __builtin_bit_cast(int, v), 0x4E, 0xf, 0xf, true));
  return v;
}


#define XB_TMO      128
#define XB_XCNT(j)  (256  + 64 * (j))
#define XB_XSUB(j)  (1280 + 64 * (j))
#define XB_XGEN(j)  (2304 + 64 * (j))
#define XB_TOP      3328
#define XB_TOPGEN   3392
#define XCD_BAR_WORDS 3456
#define XB_SPIN_CAP (1u << 18)
#define LAS __attribute__((address_space(3)))
DI unsigned xb_ld(unsigned* p)              { return __hip_atomic_load(p, __ATOMIC_RELAXED, __HIP_MEMORY_SCOPE_AGENT); }
DI unsigned xb_add(unsigned* p, unsigned v) { return __hip_atomic_fetch_add(p, v, __ATOMIC_RELAXED, __HIP_MEMORY_SCOPE_AGENT); }
DI unsigned xb_xcc_id() { return (unsigned)__builtin_amdgcn_s_getreg((3 << 11) | 20) & 0xFu; }
#define XB_SPIN(cond, bar) do { unsigned _sp = 0; while (cond) { __builtin_amdgcn_s_sleep(1); \
    if ((++_sp & 255u) == 0u) { if (xb_ld(&(bar)[XB_TMO])) break; if (_sp > XB_SPIN_CAP) { atomicAdd(&(bar)[XB_TMO], 1u); break; } } } } while (0)
struct XcdBarrier { unsigned* bar; unsigned x; volatile LAS unsigned* st; };
DI XcdBarrier xcd_barrier_post(unsigned* bar, volatile LAS unsigned* st) {
    XcdBarrier b; b.bar = bar; b.x = xb_xcc_id(); b.st = st;
    if (threadIdx.x == 0) (void)xb_add(&bar[XB_XCNT(b.x)], 1u);
    return b;
}
DI void xcd_barrier_complete(unsigned* bar, unsigned x, unsigned& nloc, unsigned& nx) {
    const unsigned G = gridDim.x * gridDim.y * gridDim.z;
    unsigned sum, cnt, mine, sp = 0u;
    for (;;) {
        sum = 0u; cnt = 0u; mine = 0u;
#pragma unroll
        for (unsigned j = 0; j < 16; ++j) { const unsigned c = xb_ld(&bar[XB_XCNT(j)]); sum += c; cnt += (c > 0u) ? 1u : 0u; mine = (j == x) ? c : mine; }
        if (sum == G) break;
        __builtin_amdgcn_s_sleep(1);
        if ((++sp & 255u) == 0u) { if (xb_ld(&bar[XB_TMO])) break; if (sp > XB_SPIN_CAP) { atomicAdd(&bar[XB_TMO], 1u); break; } }
    }
    nloc = mine > 0u ? mine : 1u; nx = cnt > 0u ? cnt : 1u;
}
DI void xcd_barrier(const XcdBarrier& b) {
    asm volatile("s_waitcnt vmcnt(0)" ::: "memory");
    __syncthreads();
    if (threadIdx.x == 0) {
        unsigned* bar = b.bar;
        asm volatile("" : "+s"(bar));
        unsigned bx = xb_xcc_id();
        asm volatile("" : "+s"(bx));
        __builtin_amdgcn_s_waitcnt(0);
        unsigned nloc = b.st[0], nx = b.st[1];
        if (nloc == 0u) { xcd_barrier_complete(bar, bx, nloc, nx); b.st[0] = nloc; b.st[1] = nx; }
        const unsigned old = xb_add(&bar[XB_XSUB(bx)], 1u);
        const unsigned gen = old / nloc;
        if (old + 1u == (gen + 1u) * nloc) {
            __builtin_amdgcn_fence(__ATOMIC_RELEASE, "agent");
            asm volatile("s_waitcnt vmcnt(0)" ::: "memory");
            const unsigned og = xb_add(&bar[XB_TOP], 1u);
            const unsigned tg = og / nx;
            if (og + 1u == (tg + 1u) * nx) xb_add(&bar[XB_TOPGEN], 1u);
            else XB_SPIN(xb_ld(&bar[XB_TOPGEN]) == tg, bar);
            __builtin_amdgcn_fence(__ATOMIC_ACQUIRE, "agent");
            xb_add(&bar[XB_XGEN(bx)], 1u);
            asm volatile("s_waitcnt vmcnt(0)" ::: "memory");
        } else {
            XB_SPIN(xb_ld(&bar[XB_XGEN(bx)]) == gen, bar);
            __builtin_amdgcn_fence(__ATOMIC_ACQUIRE, "agent");
            asm volatile("s_waitcnt vmcnt(0)" ::: "memory");
        }
    }
    __syncthreads();
}

template <typename T> DI float ldval(const T* p);
template <> DI float ldval<float>(const float* p) { return *p; }
template <> DI float ldval<bf16_t>(const bf16_t* p) { return bf2f(*p); }
template <typename T>
DI void transpose_tile(const T* src, int src_ld, bf16_t* dst, int dst_ld, float* lds) {
  const int tid = tid_opaque();
#pragma unroll 8
  for (int i = 0; i < 16; ++i) { int r = (tid >> 6) + 4 * i, c = tid & 63; lds[r * 65 + c] = ldval<T>(src + (size_t)r * src_ld + c); }
  __syncthreads();
#pragma unroll 4
  for (int i = 0; i < 16; ++i) { int c = (tid >> 6) + 4 * i, r = tid & 63; dst[(size_t)c * dst_ld + r] = f2bf(lds[r * 65 + c]); }
  __syncthreads();
}

__device__ void phase_prologue(const Params& p, unsigned char* smem) {
  float* lds = (float*)smem;
  const int n0 = 1728, n1 = n0 + 512, n2 = n1 + 192, n3 = n2 + 64, n4 = n3 + 128, n5 = n4 + 192, n6 = n5 + 32, n7 = n6 + 32;
#pragma unroll 1
  for (int it = blockIdx.x; it < n7; it += gridDim.x) {
    const int tid = tid_opaque();
    if (it < n0) {
      int l = it / 864, r = it % 864, kt = r / 54, nt = r % 54;
      transpose_tile<float>(p.w_in + (size_t)l * 1024 * PW + (size_t)kt * 64 * PW + nt * 64, PW,
                            p.WINT + (size_t)l * PW * 1024 + (size_t)nt * 64 * 1024 + kt * 64, 1024, lds);
    } else if (it < n1) {
      int i2 = it - n0; int l = i2 / 256, r = i2 % 256, kt = r / 16, nt = r % 16;
      transpose_tile<float>(p.w_out + (size_t)l * 1024 * 1024 + (size_t)kt * 64 * 1024 + nt * 64, 1024,
                            p.WOUTT + (size_t)l * 1024 * 1024 + (size_t)nt * 64 * 1024 + kt * 64, 1024, lds);
    } else if (it < n2) {
      int i2 = it - n1; int l = i2 / 96, nb = (i2 % 96) * 32;
      float* sc = lds;
      float* red = lds + 5 * 1024;
      for (int i = tid; i < 5 * 1024; i += 256) { int v = i >> 10, k = i & 1023; float x = v == 0 ? p.c_ctx[k] : p.c[(v - 1) * 1024 + k]; sc[i] = siluf_(x); }
      __syncthreads();
      int n = tid & 31, kg = tid >> 5;
      float a0 = 0, a1 = 0, a2 = 0, a3 = 0, a4 = 0;
      const float* wp = p.w_mod + (size_t)l * 1024 * 3072 + nb + n;
      for (int k = kg * 128; k < kg * 128 + 128; ++k) {
        float w = wp[(size_t)k * 3072];
        a0 += sc[k] * w; a1 += sc[1024 + k] * w; a2 += sc[2048 + k] * w; a3 += sc[3072 + k] * w; a4 += sc[4096 + k] * w;
      }
      red[(kg * 5 + 0) * 32 + n] = a0; red[(kg * 5 + 1) * 32 + n] = a1; red[(kg * 5 + 2) * 32 + n] = a2; red[(kg * 5 + 3) * 32 + n] = a3; red[(kg * 5 + 4) * 32 + n] = a4;
      __syncthreads();
      if (tid < 160) { int v = tid >> 5, nn = tid & 31; float s = p.b_mod[l * 3072 + nb + nn]; for (int q = 0; q < 8; ++q) s += red[(q * 5 + v) * 32 + nn]; p.MOD[(size_t)(l * 5 + v) * 3072 + nb + nn] = s; }
      __syncthreads();
    } else if (it < n3) {
      int i2 = it - n2; int bl = i2 >> 3, r = i2 & 7, pt = r >> 1, ct = r & 1;
      transpose_tile<float>(p.cwv + (size_t)bl * 256 * 128 + (size_t)pt * 64 * 128 + ct * 64, 128,
                            p.CWVT + (size_t)bl * 128 * 256 + (size_t)ct * 64 * 256 + pt * 64, 256, lds);
    } else if (it < n4) {
      int i2 = it - n3; int bl = i2 >> 4, r = i2 & 15, pt = r >> 2, ct = r & 3;
      transpose_tile<float>(p.cdv + (size_t)bl * 256 * 256 + (size_t)pt * 64 * 256 + ct * 64, 256,
                            p.CDVT + (size_t)bl * 256 * 256 + (size_t)ct * 64 * 256 + pt * 64, 256, lds);
    } else if (it >= n6) {
      int i2 = it - n6; int l = i2 >> 4, mat = (i2 >> 2) & 3, n = i2 & 3;
      const float* src = (mat < 2 ? p.lru_wa : p.lru_wx) + (size_t)(((l * 2 + (mat & 1)) * 4 + n)) * 4096;
      transpose_tile<float>(src, 64, p.LWT + (size_t)(((l * 4 + mat) * 4 + n)) * 4096, 64, lds);
    } else if (it >= n5) {
      int i2 = it - n5; int l = i2 >> 4, mat = (i2 >> 2) & 3, ct = i2 & 3;
      const float* src = (mat < 2 ? p.rw_wup : p.rw_aup) + (size_t)(l * 2 + (mat & 1)) * 64 * 256 + ct * 64;
      transpose_tile<float>(src, 256, p.RWT + ((size_t)(l * 4 + mat) * 256 + ct * 64) * 64, 64, lds);
    } else {
      int i2 = it - n4;
      const float* src; bf16_t* dst;
      if (i2 < 64) { src = p.cwk + (size_t)i2 * 4096; dst = p.CWK + (size_t)i2 * 4096; }
      else { src = p.cdk + (size_t)(i2 - 64) * 4096; dst = p.CDK + (size_t)(i2 - 64) * 4096; }
      for (int i = tid * 4; i < 4096; i += 1024) { float4 v = *(const float4*)(src + i); uint2 o; o.x = pack2(v.x, v.y); o.y = pack2(v.z, v.w); *(uint2*)(dst + i) = o; }
    }
  }
}

__device__ void phase_norm(const Params& p, int stage) {
  const int tid0 = tid_opaque();
  const int lane = tid0 & 63, wave = tid0 >> 6;
#pragma unroll 1
  for (int tok = blockIdx.x * 4 + wave; tok < NTOK; tok += gridDim.x * 4) {
    const int mv = tok < 4096 ? 0 : 1 + ((tok - 4096) >> 10);
    const float* xin;
    if (stage <= 1) xin = tok < 4096 ? p.x_prompt + (size_t)tok * 1024 : p.x_sample + (size_t)(tok - 4096) * 1024;
    else xin = p.out + (size_t)tok * 1024;
    float4 x[4];
#pragma unroll
    for (int i = 0; i < 4; ++i) x[i] = *(const float4*)(xin + i * 256 + lane * 4);
    if (stage >= 1) {
      const int lp = stage - 1;
      float4 y[4]; float ss = 0.f;
#pragma unroll
      for (int i = 0; i < 4; ++i) { float yv[4]; ld4bf((const bf16_t*)p.Y2 + (size_t)tok * 1024 + i * 256 + lane * 4, yv); y[i] = make_float4(yv[0], yv[1], yv[2], yv[3]); ss += y[i].x * y[i].x + y[i].y * y[i].y + y[i].z * y[i].z + y[i].w * y[i].w; }
      ss = wave_sum(ss);
      const float rstd = rsqrtf(ss * (1.0f / 1024.0f) + 1e-6f);
      const float* gate = p.MOD + (size_t)(lp * 5 + mv) * 3072 + 2048;
      const float* gp = p.g_post + lp * 1024;
#pragma unroll
      for (int i = 0; i < 4; ++i) {
        const int col = i * 256 + lane * 4;
        float4 g = *(const float4*)(gate + col), q = *(const float4*)(gp + col);
        x[i].x += g.x * (y[i].x * rstd * q.x); x[i].y += g.y * (y[i].y * rstd * q.y); x[i].z += g.z * (y[i].z * rstd * q.z); x[i].w += g.w * (y[i].w * rstd * q.w);
        *(float4*)(p.out + (size_t)tok * 1024 + col) = x[i];
      }
    }
    if (stage <= 1) {
      const int l = stage;
      float ss = 0.f;
#pragma unroll
      for (int i = 0; i < 4; ++i) ss += x[i].x * x[i].x + x[i].y * x[i].y + x[i].z * x[i].z + x[i].w * x[i].w;
      ss = wave_sum(ss);
      const float rstd = rsqrtf(ss * (1.0f / 1024.0f) + 1e-6f);
      const float* md = p.MOD + (size_t)(l * 5 + mv) * 3072;
      const float* gp = p.g_pre + l * 1024;
#pragma unroll
      for (int i = 0; i < 4; ++i) {
        const int col = i * 256 + lane * 4;
        float4 sh = *(const float4*)(md + col), sc = *(const float4*)(md + 1024 + col), g = *(const float4*)(gp + col);
        float h0 = x[i].x * rstd * g.x * (1.f + sc.x) + sh.x, h1 = x[i].y * rstd * g.y * (1.f + sc.y) + sh.y;
        float h2 = x[i].z * rstd * g.z * (1.f + sc.z) + sh.z, h3 = x[i].w * rstd * g.w * (1.f + sc.w) + sh.w;
        uint2 o; o.x = pack2(h0, h1); o.y = pack2(h2, h3);
        *(uint2*)(p.H + (size_t)tok * 1024 + col) = o;
      }
    }
  }
}

template <int MODE>
__device__ void phase_gemm(const Params& p, int l, unsigned char* smem) {
  const bf16_t* A = p.H;
  const bf16_t* Bt = MODE == 0 ? p.WINT + (size_t)l * PW * 1024 : p.WOUTT + (size_t)l * 1024 * 1024;
  const int N = MODE == 0 ? PW : 1024, K = 1024;
  const int NTN = N / 128;
  bf16_t* As = (bf16_t*)smem; bf16_t* Bs = As + 128 * 64;
  const int xcd = blockIdx.x & 7, slot = blockIdx.x >> 3, nslot = (gridDim.x + 7 - xcd) >> 3;
  const int nx = (NTN - xcd + 7) >> 3;
#pragma unroll 1
  for (int j = slot; j < 64 * nx; j += nslot) {
    const int tid = tid_opaque(), lane = tid & 63, wave = tid >> 6, wm = wave >> 1, wn = wave & 1, r16 = lane & 15, quad = lane >> 4;
    const int tm = j / nx, tn = xcd + 8 * (j % nx), m0 = tm * 128, n0 = tn * 128;
    f32x4 acc[4][4];
#pragma unroll
    for (int i = 0; i < 4; ++i)
#pragma unroll
      for (int j = 0; j < 4; ++j) acc[i][j] = (f32x4){0.f, 0.f, 0.f, 0.f};
    u32x4 ra0[4], rb0[4];
    const int lrow = tid >> 3, lc8 = tid & 7;
    const bf16_t* ga = A + (size_t)(m0 + lrow) * K + lc8 * 8;
    const bf16_t* gb = Bt + (size_t)(n0 + lrow) * K + lc8 * 8;
    const int swz_w = (lc8 ^ ((lrow >> 1) & 7)) * 8, swz_r = (r16 >> 1) & 7;
    bf16_t* const sa_ = As + lrow * 64 + swz_w; bf16_t* const sb_ = Bs + lrow * 64 + swz_w;
#define G_LOAD(RA, RB, KT) { _Pragma("unroll") for (int i = 0; i < 4; ++i) { RA[i] = *(const u32x4*)(ga + (size_t)i * 32 * K + (KT) * 64); RB[i] = *(const u32x4*)(gb + (size_t)i * 32 * K + (KT) * 64); } }
#define G_STORE(RA, RB) { _Pragma("unroll") for (int i = 0; i < 4; ++i) { *(u32x4*)(sa_ + i * 32 * 64) = RA[i]; *(u32x4*)(sb_ + i * 32 * 64) = RB[i]; } }
#define G_COMPUTE() { _Pragma("unroll") for (int ks = 0; ks < 2; ++ks) { bf16x8 af[4], bfr[4]; \
      _Pragma("unroll") for (int i = 0; i < 4; ++i) { af[i] = *(const bf16x8*)(As + (wm * 64 + i * 16 + r16) * 64 + (((ks * 4 + quad) ^ swz_r) * 8)); bfr[i] = *(const bf16x8*)(Bs + (wn * 64 + i * 16 + r16) * 64 + (((ks * 4 + quad) ^ swz_r) * 8)); } \
      _Pragma("unroll") for (int mi = 0; mi < 4; ++mi) _Pragma("unroll") for (int ni = 0; ni < 4; ++ni) acc[mi][ni] = mfma16(bfr[ni], af[mi], acc[mi][ni]); } }
    G_LOAD(ra0, rb0, 0);
    G_STORE(ra0, rb0);
    __syncthreads();
#pragma unroll 1
    for (int kt = 0; kt < 16; ++kt) {
      if (kt + 1 < 16) G_LOAD(ra0, rb0, kt + 1);
      __builtin_amdgcn_sched_barrier(0);
      G_COMPUTE();
      lds_barrier();
      if (kt + 1 < 16) { G_STORE(ra0, rb0); lds_barrier(); }
    }
#undef G_LOAD
#undef G_STORE
#undef G_COMPUTE
#pragma unroll
    for (int mi = 0; mi < 4; ++mi)
#pragma unroll
      for (int ni = 0; ni < 4; ++ni) {
        const int m = m0 + wm * 64 + mi * 16 + r16, n = n0 + wn * 64 + ni * 16 + quad * 4;
        const f32x4 v = acc[mi][ni];
        if (MODE == 0) {
          uint2 o; o.x = pack2(v[0], v[1]); o.y = pack2(v[2], v[3]);
          *(uint2*)(p.P + (size_t)m * PW + n) = o;
          if (m0 < 4096) {
            const int row = ((m >> 8) * 2 + l) * 256 + (m & 255);
            float* dst = nullptr;
            if (tn == 11) dst = p.out + O_NWK + (size_t)row * 128 + (n - 1408);
            else if (tn == 12) dst = p.out + O_NWV + (size_t)row * 128 + (n - 1536);
            else if (tn == 21 || tn == 22) dst = p.out + O_NDK + (size_t)row * 256 + (n - 2688);
            else if (tn == 23 || tn == 24) dst = p.out + O_NDV + (size_t)row * 256 + (n - 2944);
            if (dst) *(float4*)dst = (float4){v[0], v[1], v[2], v[3]};
          }
        } else {
          { u32x2 o; o.x = pack2(v[0], v[1]); o.y = pack2(v[2], v[3]); *(u32x2*)((bf16_t*)p.Y2 + (size_t)m * 1024 + n) = o; }
        }
      }
  }
}

DI void unpack8(u32x4 u, float (&o)[8]) { o[0] = bflo(u.x); o[1] = bfhi(u.x); o[2] = bflo(u.y); o[3] = bfhi(u.y); o[4] = bflo(u.z); o[5] = bfhi(u.z); o[6] = bflo(u.w); o[7] = bfhi(u.w); }
DI bf16x8 pack8(const float (&o)[8]) { u32x4 u; u.x = pack2(o[0], o[1]); u.y = pack2(o[2], o[3]); u.z = pack2(o[4], o[5]); u.w = pack2(o[6], o[7]); return __builtin_bit_cast(bf16x8, u); }

__device__ void pre_rwkv(const Params& p, int l, int item) {
  const int tid = tid_opaque(), lane = tid & 63, h = tid >> 6, r16 = lane & 15, quad = lane >> 4;
  const int tok = item * 16 + r16;
  const bf16_t* pr = p.P + (size_t)tok * PW;
  bf16x8 wdf[2], adf[2];
#pragma unroll
  for (int ks = 0; ks < 2; ++ks) {
    float o[8]; unpack8(*(const u32x4*)(pr + 768 + ks * 32 + quad * 8), o);
#pragma unroll
    for (int j = 0; j < 8; ++j) o[j] = 1.0f - 2.0f * __builtin_amdgcn_rcpf(1.0f + __expf(2.0f * o[j]));
    wdf[ks] = pack8(o);
    adf[ks] = *(const bf16x8*)(pr + 832 + ks * 32 + quad * 8);
  }
  float kv[4][4];
#pragma unroll
  for (int ct = 0; ct < 4; ++ct) ld4bf(pr + 256 + h * 64 + ct * 16 + quad * 4, kv[ct]);
  const bf16_t* wt = p.RWT + (size_t)l * 4 * 256 * 64;
  float ss = 0.f;
#pragma unroll
  for (int ct = 0; ct < 4; ++ct) {
    const f32x4 kkc = *(const f32x4*)(p.rw_kk + l * 256 + h * 64 + ct * 16 + quad * 4);
#pragma unroll
    for (int r = 0; r < 4; ++r) { const float q = kv[ct][r] * kkc[r]; ss += q * q; }
  }
  ss += __shfl_xor(ss, 16); ss += __shfl_xor(ss, 32);
  const float rn = rsqrtf(ss + 1e-12f);
#pragma unroll
  for (int ct = 0; ct < 4; ++ct) {
    f32x4 acc[4];
    const int c0 = h * 64 + ct * 16 + quad * 4;
    bf16x8 wfr[4][2];
#pragma unroll
    for (int mat = 0; mat < 4; ++mat)
#pragma unroll
      for (int ks = 0; ks < 2; ++ks) wfr[mat][ks] = *(const bf16x8*)(wt + ((size_t)mat * 256 + h * 64 + ct * 16 + r16) * 64 + ks * 32 + quad * 8);
    const f32x4 kkc = *(const f32x4*)(p.rw_kk + l * 256 + c0), kac = *(const f32x4*)(p.rw_ka + l * 256 + c0);
    const f32x4 w00 = *(const f32x4*)(p.rw_w0 + (l * 2 + 0) * 256 + c0), w01 = *(const f32x4*)(p.rw_w0 + (l * 2 + 1) * 256 + c0);
    const f32x4 a00 = *(const f32x4*)(p.rw_a0 + (l * 2 + 0) * 256 + c0), a01 = *(const f32x4*)(p.rw_a0 + (l * 2 + 1) * 256 + c0);
    __builtin_amdgcn_sched_barrier(0);
#pragma unroll
    for (int mat = 0; mat < 4; ++mat) {
      f32x4 a = {0.f, 0.f, 0.f, 0.f};
#pragma unroll
      for (int ks = 0; ks < 2; ++ks) a = mfma16(wfr[mat][ks], mat < 2 ? wdf[ks] : adf[ks], a);
      acc[mat] = a;
    }
    f32x4 nkk, w0v, w1v, b0v, b1v, k0v, k1v;
#pragma unroll
    for (int r = 0; r < 4; ++r) {
      const float k = kv[ct][r];
      const float kkn = k * kkc[r] * rn;
      nkk[r] = -kkn;
#pragma unroll
      for (int d = 0; d < 2; ++d) {
        const float wl = (d ? w01[r] : w00[r]) + acc[d][r];
        const float w_log = -__logf(1.0f + __expf(-wl)) - 0.5f;
        const float decay = __expf(-__expf(w_log));
        const float a = fsigmoid((d ? a01[r] : a00[r]) + acc[2 + d][r]);
        const float kd = k * (1.f + (a - 1.f) * kac[r]);
        if (d) { w1v[r] = decay; b1v[r] = kkn * a; k1v[r] = kd; } else { w0v[r] = decay; b0v[r] = kkn * a; k0v[r] = kd; }
      }
    }
    const size_t o0 = (size_t)tok * 256 + c0, o1 = ((size_t)NTOK + tok) * 256 + c0;
    *(f32x4*)(p.NKK + o0) = nkk;
    *(f32x4*)(p.AW + o0) = w0v; *(f32x4*)(p.AW + o1) = w1v;
    *(f32x4*)(p.AB + o0) = b0v; *(f32x4*)(p.AB + o1) = b1v;
    *(f32x4*)(p.AKD + o0) = k0v; *(f32x4*)(p.AKD + o1) = k1v;
  }
}

#define LSCAN_STEP(A, H, CTRL) { \
    const float Ap = __builtin_bit_cast(float, __builtin_amdgcn_update_dpp(0x3f800000, __builtin_bit_cast(int, A), CTRL, 0xf, 0xf, false)); \
    const float Hp = __builtin_bit_cast(float, __builtin_amdgcn_update_dpp(0, __builtin_bit_cast(int, H), CTRL, 0xf, 0xf, true)); \
    H = A * Hp + H; A = A * Ap; }

__device__ void pre_lru(const Params& p, int l, int item) {
  const int tid = tid_opaque(), lane = tid & 63, n = tid >> 6, r16 = lane & 15, quad = lane >> 4;
  const int tok0 = item * 16;
  int T, sb, t0;
  if (tok0 < 4096) { T = 256; sb = tok0 & ~255; t0 = tok0 & 255; } else { T = 1024; sb = 4096 + ((tok0 - 4096) & ~1023); t0 = (tok0 - 4096) & 1023; }
  const int t = t0 + r16, tok = tok0 + r16;
  bf16x8 xf[2];
  float xo[2][8];
#pragma unroll
  for (int ks = 0; ks < 2; ++ks) {
    const int cb = n * 64 + ks * 32 + quad * 8;
    float o[8];
    { const f32x4 b0 = *(const f32x4*)(p.lru_cb + l * 256 + cb), b1 = *(const f32x4*)(p.lru_cb + l * 256 + cb + 4);
      o[0] = b0[0]; o[1] = b0[1]; o[2] = b0[2]; o[3] = b0[3]; o[4] = b1[0]; o[5] = b1[1]; o[6] = b1[2]; o[7] = b1[3]; }
#pragma unroll
    for (int i = 0; i < 4; ++i) {
      const int tt = t - 2 + i;
      u32x4 xr = {0u, 0u, 0u, 0u};
      if (tt >= 0 && tt < T) xr = *(const u32x4*)(p.P + (size_t)(sb + tt) * PW + 1920 + cb);
      float x[8]; unpack8(xr, x);
      const f32x4 w0 = *(const f32x4*)(p.lru_cw + (l * 4 + i) * 256 + cb), w1 = *(const f32x4*)(p.lru_cw + (l * 4 + i) * 256 + cb + 4);
      o[0] += w0[0] * x[0]; o[1] += w0[1] * x[1]; o[2] += w0[2] * x[2]; o[3] += w0[3] * x[3];
      o[4] += w1[0] * x[4]; o[5] += w1[1] * x[5]; o[6] += w1[2] * x[6]; o[7] += w1[3] * x[7];
    }
    xf[ks] = pack8(o);
#pragma unroll
    for (int j = 0; j < 8; ++j) xo[ks][j] = o[j];
  }
#pragma unroll
  for (int et = 0; et < 4; ++et) {
    f32x4 acc[4];
    const int c0 = n * 64 + (et >> 1) * 32 + quad * 8 + (et & 1) * 4;
    const int erow = (et >> 1) * 32 + (r16 >> 2) * 8 + (et & 1) * 4 + (r16 & 3);
    bf16x8 wfr[4][2];
#pragma unroll
    for (int mat = 0; mat < 4; ++mat)
#pragma unroll
      for (int ks = 0; ks < 2; ++ks) wfr[mat][ks] = *(const bf16x8*)(p.LWT + ((size_t)((l * 4 + mat) * 4 + n) * 64 + erow) * 64 + ks * 32 + quad * 8);
    const f32x4 ba0 = *(const f32x4*)(p.lru_ba + (l * 2 + 0) * 256 + c0), ba1 = *(const f32x4*)(p.lru_ba + (l * 2 + 1) * 256 + c0);
    const f32x4 bx0 = *(const f32x4*)(p.lru_bx + (l * 2 + 0) * 256 + c0), bx1 = *(const f32x4*)(p.lru_bx + (l * 2 + 1) * 256 + c0);
    const f32x4 lm0 = *(const f32x4*)(p.lru_lam + (l * 2 + 0) * 256 + c0), lm1 = *(const f32x4*)(p.lru_lam + (l * 2 + 1) * 256 + c0);
    __builtin_amdgcn_sched_barrier(0);
#pragma unroll
    for (int mat = 0; mat < 4; ++mat) {
      f32x4 a = {0.f, 0.f, 0.f, 0.f};
#pragma unroll
      for (int ks = 0; ks < 2; ++ks) a = mfma16(wfr[mat][ks], xf[ks], a);
      acc[mat] = a;
    }
    f32x4 A0, H0, A1, H1;
#pragma unroll
    for (int r = 0; r < 4; ++r) {
      const float x = xo[et >> 1][(et & 1) * 4 + r];
#pragma unroll
      for (int d = 0; d < 2; ++d) {
        const float ga = fsigmoid(acc[d][r] + (d ? ba1[r] : ba0[r]));
        const float gx = fsigmoid(acc[2 + d][r] + (d ? bx1[r] : bx0[r]));
        const float e_ = __expf(-(d ? lm1[r] : lm0[r]));
        const float sp = e_ < 0.05f ? e_ * (1.0f - e_ * (0.5f - e_ * (0.33333334f - 0.25f * e_))) : __logf(1.0f + e_);
        const float log_a = -8.0f * ga * sp;
        float a = __expf(log_a);
        const float x2 = 2.0f * log_a;
        const float om = x2 > -0.05f ? -(x2 * (1.0f + x2 * (0.5f + x2 * (0.16666667f + x2 * 0.041666667f)))) : 1.0f - __expf(x2);
        float u = __fsqrt_rn(om) * (gx * x);
        if (d == 0) { LSCAN_STEP(a, u, 0x111) LSCAN_STEP(a, u, 0x112) LSCAN_STEP(a, u, 0x114) LSCAN_STEP(a, u, 0x118) A0[r] = a; H0[r] = u; }
        else        { LSCAN_STEP(a, u, 0x101) LSCAN_STEP(a, u, 0x102) LSCAN_STEP(a, u, 0x104) LSCAN_STEP(a, u, 0x108) A1[r] = a; H1[r] = u; }
      }
    }
    const size_t o0 = (size_t)tok * 256 + c0, o1 = ((size_t)NTOK + tok) * 256 + c0;
    *(f32x4*)(p.LA + o0) = A0; *(f32x4*)(p.LU + o0) = H0;
    *(f32x4*)(p.LA + o1) = A1; *(f32x4*)(p.LU + o1) = H1;
  }
}

__device__ void pre_rope(const Params& p, int item) {
  const int tid = tid_opaque();
  const int ts0 = item * 16;
#pragma unroll 1
  for (int pp = tid; pp < 448; pp += 256) {
    int scol, d1, d2, half, i, dstride; bf16_t* dst; float inv;
    if (pp < 192) {
      int q = pp < 128 ? pp : pp - 128; int vec = q >> 5, pi = q & 31; half = pi >> 4; i = pi & 15;
      d1 = half * 32 + i; d2 = d1 + 16; inv = exp2f(-(float)i * (13.287712379549449f / 16.0f));
      if (pp < 128) { scol = 1152 + vec * 64; dst = p.QBR + vec * 64; dstride = 256; }
      else { scol = 1408 + vec * 64; dst = p.KBR + vec * 64; dstride = 128; }
    } else {
      int q = pp < 320 ? pp - 192 : pp - 320; int vec = q >> 4, pi = q & 15; half = pi >> 3; i = pi & 7;
      d1 = half * 16 + i; d2 = d1 + 8; inv = exp2f(-(float)i * (13.287712379549449f / 8.0f));
      if (pp < 320) { scol = 2432 + vec * 32; dst = p.QDR + vec * 32; dstride = 256; }
      else { scol = 2688 + vec * 32; dst = p.KDR + vec * 32; dstride = 256; }
    }
    float x1[16], x2[16];
#pragma unroll
    for (int tt = 0; tt < 16; ++tt) { const bf16_t* src = p.P + (size_t)(4096 + ts0 + tt) * PW + scol; x1[tt] = bf2f(src[d1]); x2[tt] = bf2f(src[d2]); }
#pragma unroll
    for (int tt = 0; tt < 16; ++tt) {
      const int t = (ts0 + tt) & 1023;
      const float ang = (float)(half ? (t & 63) : (t >> 6)) * inv;
      const float sn = __sinf(ang), cs = __cosf(ang);
      const float a = x1[tt], b = x2[tt];
      bf16_t* o = dst + (size_t)(ts0 + tt) * dstride;
      o[d1] = f2bf(a * cs - b * sn); o[d2] = f2bf(a * sn + b * cs);
    }
  }
}

__device__ void phase_pre(const Params& p, int l, unsigned char* smem) {
  const int n0 = 512, n1 = n0 + 512, n2 = n1 + 256, n3 = n2 + 256, n4 = n3 + 512;
#pragma unroll 1
  for (int it = blockIdx.x; it < n4; it += gridDim.x) {
    if (it < n0) pre_rwkv(p, l, it);
    else if (it < n1) pre_lru(p, l, it - n0);
    else if (it < n2) pre_rope(p, it - n1);
    else if (it < n3) {
      int i2 = it - n2; int tt = i2 >> 1, ct = i2 & 1; int tok0 = tt * 64;
      int T, sb; if (tok0 < 4096) { T = 256; sb = tok0 & ~255; } else { T = 1024; sb = 4096 + ((tok0 - 4096) & ~1023); }
      transpose_tile<bf16_t>(p.P + (size_t)tok0 * PW + 1536 + ct * 64, PW, p.VBT + (size_t)sb * 128 + (size_t)(ct * 64) * T + (tok0 - sb), T, (float*)smem);
    } else {
      int i2 = it - n3; int tt = i2 >> 2, ct = i2 & 3; int tok0 = tt * 64;
      int T, sb; if (tok0 < 4096) { T = 256; sb = tok0 & ~255; } else { T = 1024; sb = 4096 + ((tok0 - 4096) & ~1023); }
      transpose_tile<bf16_t>(p.P + (size_t)tok0 * PW + 2944 + ct * 64, PW, p.VDT + (size_t)sb * 256 + (size_t)(ct * 64) * T + (tok0 - sb), T, (float*)smem);
    }
  }
}

template <int LR> DI float group_sum(float v) {
  v += __builtin_bit_cast(float, __builtin_amdgcn_update_dpp(0, __builtin_bit_cast(int, v), 0xB1, 0xf, 0xf, true));
  v += __builtin_bit_cast(float, __builtin_amdgcn_update_dpp(0, __builtin_bit_cast(int, v), 0x4E, 0xf, 0xf, true));
  if (LR >= 8) v += __builtin_bit_cast(float, __builtin_amdgcn_update_dpp(0, __builtin_bit_cast(int, v), 0x141, 0xf, 0xf, true));
  if (LR >= 16) v += __builtin_bit_cast(float, __builtin_amdgcn_update_dpp(0, __builtin_bit_cast(int, v), 0x140, 0xf, 0xf, true));
  return v;
}
typedef float f32x2 __attribute__((ext_vector_type(2)));
template <int E> struct RwOps { f32x4 nk[E / 4], ww[E / 4], bb[E / 4], kk[E / 4], rr[E / 4]; float vi; };
template <int E> DI void rw_load(const float* ob, int g, int i, RwOps<E>& o) {
  constexpr int LR = 64 / E, NM = E / 4;
#pragma unroll
  for (int m = 0; m < NM; ++m) {
    const int off = 4 * (g + LR * m);
    o.nk[m] = *(const f32x4*)(ob + off); o.ww[m] = *(const f32x4*)(ob + 64 + off); o.bb[m] = *(const f32x4*)(ob + 128 + off);
    o.kk[m] = *(const f32x4*)(ob + 192 + off); o.rr[m] = *(const f32x4*)(ob + 256 + off);
  }
  o.vi = ob[320 + i];
}
template <int E> DI float rw_step(f32x2 (&S)[E / 2], const RwOps<E>& o) {
  constexpr int LR = 64 / E, NM = E / 4;
  f32x2 p2 = S[0] * o.nk[0].xy;
  p2 = S[1] * o.nk[0].zw + p2;
#pragma unroll
  for (int m = 1; m < NM; ++m) { p2 = S[2 * m] * o.nk[m].xy + p2; p2 = S[2 * m + 1] * o.nk[m].zw + p2; }
  const float sa = group_sum<LR>(p2.x + p2.y);
  const f32x2 sa2 = {sa, sa}, v2 = {o.vi, o.vi};
  f32x2 y2 = {0.f, 0.f};
#pragma unroll
  for (int m = 0; m < NM; ++m) {
    S[2 * m] = S[2 * m] * o.ww[m].xy + (sa2 * o.bb[m].xy + v2 * o.kk[m].xy);
    S[2 * m + 1] = S[2 * m + 1] * o.ww[m].zw + (sa2 * o.bb[m].zw + v2 * o.kk[m].zw);
    y2 = S[2 * m] * o.rr[m].xy + y2; y2 = S[2 * m + 1] * o.rr[m].zw + y2;
  }
  return group_sum<LR>(y2.x + y2.y);
}
template <int E>
__device__ void rwkv_chain(const Params& p, int l, int chain, int part, unsigned char* smem) {
  constexpr int LR = 64 / E, NM = E / 4;
  const int tid = tid_opaque(), lane = tid & 63, wave = tid >> 6;
  int seq, d, h;
  if (chain < 32) { seq = 16 + (chain >> 3); d = (chain >> 2) & 1; h = chain & 3; }
  else { int c2 = chain - 32; seq = c2 >> 3; d = (c2 >> 2) & 1; h = c2 & 3; }
  const int T = seq < 16 ? 256 : 1024, tokb = seq < 16 ? seq * 256 : 4096 + (seq - 16) * 1024;
  const int g = lane % LR, rl = lane / LR, i = part * 4 * E + wave * E + rl;
  f32x2 S[E / 2];
  if (seq >= 16) {
    const float* s0 = p.st_rwkv + ((((size_t)(seq - 16) * 2 + l) * 2 + d) * 4 + h) * 4096 + i * 64;
#pragma unroll
    for (int m = 0; m < NM; ++m) { f32x4 t = *(const f32x4*)(s0 + 4 * (g + LR * m)); S[2 * m] = t.xy; S[2 * m + 1] = t.zw; }
  } else {
#pragma unroll
    for (int j = 0; j < E / 2; ++j) S[j] = (f32x2){0.f, 0.f};
  }
  float* buf = (float*)smem;
  const int lvec = (tid >> 4) & 3, lc4 = tid & 15, ls = tid >> 6;
  const float* fsrc = (lvec == 0 ? p.NKK : lvec == 1 ? p.AW + (size_t)d * NTOK * 256 : lvec == 2 ? p.AB + (size_t)d * NTOK * 256 : p.AKD + (size_t)d * NTOK * 256) + h * 64 + lc4 * 4;
  const int bs = tid >> 4, bvec = (tid >> 3) & 1, bc8 = tid & 7;
  const bf16_t* bsrc = p.P + (bvec ? 512 : 0) + h * 64 + bc8 * 8;
  f32x4 rfA[4], rfB[4]; u32x4 rbA, rbB;
  const int nch = T / 16;
#define RW_GLOAD(RF, RB, CK) { _Pragma("unroll") for (int i4 = 0; i4 < 4; ++i4) { int step = (CK) * 16 + ls + 4 * i4; int t = d ? T - 1 - step : step; RF[i4] = *(const f32x4*)(fsrc + (size_t)(tokb + t) * 256); } \
    { int step = (CK) * 16 + bs; int t = d ? T - 1 - step : step; RB = *(const u32x4*)(bsrc + (size_t)(tokb + t) * PW); } }
#define RW_SSTORE(RF, RB, BI) { float* b_ = buf + (BI) * 16 * 384; \
    _Pragma("unroll") for (int i4 = 0; i4 < 4; ++i4) *(f32x4*)(b_ + (ls + 4 * i4) * 384 + lvec * 64 + lc4 * 4) = RF[i4]; \
    float* q_ = b_ + bs * 384 + (4 + bvec) * 64 + bc8 * 8; \
    *(f32x4*)q_ = (f32x4){bflo(RB.x), bfhi(RB.x), bflo(RB.y), bfhi(RB.y)}; \
    *(f32x4*)(q_ + 4) = (f32x4){bflo(RB.z), bfhi(RB.z), bflo(RB.w), bfhi(RB.w)}; }
  float* yout = p.YA + ((size_t)d * NTOK + tokb) * 256 + h * 64 + i;
  constexpr int NY = 16 / LR;
  auto compute = [&](int ck) {
    const float* cb = buf + (ck & 1) * 16 * 384;
    float yk[NY];
#pragma unroll
    for (int q = 0; q < NY; ++q) yk[q] = 0.f;
    RwOps<E> oa, ob2;
    rw_load<E>(cb, g, i, oa);
#pragma unroll 1
    for (int s = 0; s < 16; s += 2) {
      rw_load<E>(cb + (s + 1) * 384, g, i, ob2);
      const float y0 = rw_step<E>(S, oa);
#pragma unroll
      for (int q = 0; q < NY; ++q) yk[q] = (s == q * LR + g) ? y0 : yk[q];
      if (s + 2 < 16) rw_load<E>(cb + (s + 2) * 384, g, i, oa);
      const float y1 = rw_step<E>(S, ob2);
#pragma unroll
      for (int q = 0; q < NY; ++q) yk[q] = (s + 1 == q * LR + g) ? y1 : yk[q];
    }
#pragma unroll
    for (int q = 0; q < NY; ++q) { const int step = ck * 16 + q * LR + g; const int t = d ? T - 1 - step : step; yout[(size_t)t * 256] = yk[q]; }
  };
  __builtin_amdgcn_s_setprio(2);
  RW_GLOAD(rfA, rbA, 0); RW_SSTORE(rfA, rbA, 0); RW_GLOAD(rfA, rbA, 1); RW_GLOAD(rfB, rbB, 2);
  __syncthreads();
#pragma unroll 1
  for (int ck = 0; ck < nch; ck += 2) {
    compute(ck);
    RW_SSTORE(rfA, rbA, 1);
    if (ck + 3 < nch) RW_GLOAD(rfA, rbA, ck + 3);
    lds_barrier();
    compute(ck + 1);
    if (ck + 2 < nch) RW_SSTORE(rfB, rbB, 0);
    if (ck + 4 < nch) RW_GLOAD(rfB, rbB, ck + 4);
    lds_barrier();
  }
  __builtin_amdgcn_s_setprio(0);
#undef RW_GLOAD
#undef RW_SSTORE
  if (seq < 16) {
    float* so = p.out + O_NSR + ((((size_t)seq * 2 + l) * 2 + d) * 4 + h) * 4096 + i * 64;
#pragma unroll
    for (int m = 0; m < NM; ++m) *(f32x4*)(so + 4 * (g + LR * m)) = (f32x4){S[2 * m].x, S[2 * m].y, S[2 * m + 1].x, S[2 * m + 1].y};
  }
}

__device__ void lru_scan(const Params& p, int l, int item) {
  const int c = tid_opaque();
  int seq, d;
  if (item < 8) { seq = 16 + (item >> 1); d = item & 1; } else { seq = (item - 8) >> 1; d = item & 1; }
  const int T = seq < 16 ? 256 : 1024, tokb = seq < 16 ? seq * 256 : 4096 + (seq - 16) * 1024;
  const int NC = T >> 4;
  float h = seq >= 16 ? p.st_lru[(((seq - 16) * 2 + l) * 2 + d) * 256 + c] : 0.f;
  const float* la = p.LA + (size_t)d * NTOK * 256 + c; const float* lu = p.LU + (size_t)d * NTOK * 256 + c;
  float* lc = p.LC + (size_t)d * 512 * 256 + (size_t)(tokb >> 4) * 256 + c;
  for (int k0 = 0; k0 < NC; k0 += 8) {
    float a[8], u[8];
#pragma unroll
    for (int q = 0; q < 8; ++q) { const int k = d ? NC - 1 - (k0 + q) : k0 + q; const size_t idx = (size_t)(tokb + k * 16 + (d ? 0 : 15)) * 256; a[q] = la[idx]; u[q] = lu[idx]; }
#pragma unroll
    for (int q = 0; q < 8; ++q) { const int k = d ? NC - 1 - (k0 + q) : k0 + q; lc[(size_t)k * 256] = h; h = a[q] * h + u[q]; }
  }
  if (seq < 16) p.out[O_NSL + ((seq * 2 + l) * 2 + d) * 256 + c] = h;
}

template <bool DIFF>
__device__ void attn_item(const Params& p, int l, bool sample, int sq  , int h, int qt) {
  constexpr int NS = DIFF ? 2 : 1;
  const int tid = tid_opaque();
  const int lane = tid & 63, wave = tid >> 6, r16 = lane & 15, quad = lane >> 4;
  const int T = sample ? 1024 : 256;
  const int tokb = sample ? 4096 + sq * 1024 : sq * 256;
  const int q0 = qt * 64 + wave * 16;
  const int qpos = q0 + r16;
  const int kvh = DIFF ? h : (h >> 1);
  bf16x8 qf[2];
  {
    const bf16_t* qp;
    if (sample) qp = (DIFF ? p.QDR : p.QBR) + (size_t)(sq * 1024 + qpos) * 256 + h * 64;
    else qp = p.P + (size_t)(tokb + qpos) * PW + (DIFF ? 2432 : 1152) + h * 64;
    qf[0] = *(const bf16x8*)(qp + quad * 8); qf[1] = *(const bf16x8*)(qp + 32 + quad * 8);
  }
  float m[2] = {-3.0e38f, -3.0e38f}, lsum[2] = {0.f, 0.f};
  f32x4 o[2][4];
#pragma unroll
  for (int a = 0; a < 2; ++a)
#pragma unroll
    for (int b = 0; b < 4; ++b) o[a][b] = (f32x4){0.f, 0.f, 0.f, 0.f};
  const float scale_log2 = (DIFF ? 0.17677669529663687f : 0.125f) * 1.4426950408889634f;
  const int nctx = sample ? 4 : 0;
  const bf16_t* Kc = nullptr; const bf16_t* Vc = nullptr; int ksc = 0;
  if (sample) {
    const int bl = sq * 2 + l;
    if (DIFF) { Kc = p.CDK + (size_t)bl * 256 * 256 + h * 64; ksc = 256; Vc = p.CDVT + (size_t)bl * 256 * 256 + (size_t)(h * 64) * 256; }
    else { Kc = p.CWK + (size_t)bl * 256 * 128 + kvh * 64; ksc = 128; Vc = p.CWVT + (size_t)bl * 128 * 256 + (size_t)(kvh * 64) * 256; }
  }
  const bf16_t* Kl; const bf16_t* Vl; int ksl;
  if (sample) {
    if (DIFF) { Kl = p.KDR + (size_t)(sq * 1024) * 256 + h * 64; ksl = 256; Vl = p.VDT + (size_t)tokb * 256 + (size_t)(h * 64) * T; }
    else { Kl = p.KBR + (size_t)(sq * 1024) * 128 + kvh * 64; ksl = 128; Vl = p.VBT + (size_t)tokb * 128 + (size_t)(kvh * 64) * T; }
  } else {
    if (DIFF) { Kl = p.P + (size_t)tokb * PW + 2688 + h * 64; ksl = PW; Vl = p.VDT + (size_t)tokb * 256 + (size_t)(h * 64) * T; }
    else { Kl = p.P + (size_t)tokb * PW + 1408 + kvh * 64; ksl = PW; Vl = p.VBT + (size_t)tokb * 128 + (size_t)(kvh * 64) * T; }
  }
  int kb0 = 0, kb1 = T; bool lmask = false;
  if (sample && !DIFF) { const int qb = qt * 64; kb0 = qb - 128 < 0 ? 0 : qb - 128; kb1 = qb + 192 > T ? T : qb + 192; lmask = true; }
  const int nt = nctx + ((kb1 - kb0) >> 6);
  const int rowoff = 8 * (r16 >> 2) + (r16 & 3);
  auto ktile = [&](int t, int& kst) -> const bf16_t* {
    if (t < nctx) { kst = ksc; return Kc + (size_t)(t * 64 + rowoff) * ksc + quad * 8; }
    kst = ksl; return Kl + (size_t)(kb0 + (t - nctx) * 64 + rowoff) * ksl + quad * 8;
  };
  const f32x4 z4 = {0.f, 0.f, 0.f, 0.f};
  bf16x8 kf0[4], kf1[4];
  {
    int kst; const bf16_t* kr = ktile(0, kst);
#pragma unroll
    for (int kt = 0; kt < 4; ++kt) { const bf16_t* q = kr + (size_t)(32 * (kt >> 1) + 4 * (kt & 1)) * kst; kf0[kt] = *(const bf16x8*)q; if (!DIFF) kf1[kt] = *(const bf16x8*)(q + 32); }
  }
#pragma unroll 1
  for (int t = 0; t < nt; ++t) {
    const bool isctx = t < nctx;
    int kst; const bf16_t* kr = ktile(t, kst);
    const bf16_t* Vtp = isctx ? Vc + t * 64 : Vl + kb0 + (t - nctx) * 64;
    const int vstride = isctx ? 256 : T;
    const bool masked = !isctx && lmask;
    const int kpos0 = kb0 + (t - nctx) * 64;
    bf16x8 vfr[4][2];
#pragma unroll
    for (int dt = 0; dt < 4; ++dt)
#pragma unroll
      for (int s2 = 0; s2 < 2; ++s2) vfr[dt][s2] = *(const bf16x8*)(Vtp + (size_t)(dt * 16 + r16) * vstride + 32 * s2 + 8 * quad);
    bf16x8 pf[NS][2];
#pragma unroll
    for (int st = 0; st < NS; ++st) {
      f32x4 sc[4];
#pragma unroll
      for (int kt = 0; kt < 4; ++kt) {
        if (!DIFF) { sc[kt] = mfma16(kf0[kt], qf[0], z4); sc[kt] = mfma16(kf1[kt], qf[1], sc[kt]); }
        else sc[kt] = mfma16(kf0[kt], qf[st], z4);
      }
      if (DIFF && st == 0) {
#pragma unroll
        for (int kt = 0; kt < 4; ++kt) kf0[kt] = *(const bf16x8*)(kr + (size_t)(32 * (kt >> 1) + 4 * (kt & 1)) * kst + 32);
      } else if (t + 1 < nt) {
        int kst2; const bf16_t* kr2 = ktile(t + 1, kst2);
#pragma unroll
        for (int kt = 0; kt < 4; ++kt) { const bf16_t* q = kr2 + (size_t)(32 * (kt >> 1) + 4 * (kt & 1)) * kst2; kf0[kt] = *(const bf16x8*)q; if (!DIFF) kf1[kt] = *(const bf16x8*)(q + 32); }
      }
      float mx = -3.0e38f;
#pragma unroll
      for (int kt = 0; kt < 4; ++kt)
#pragma unroll
        for (int r = 0; r < 4; ++r) {
          float x = sc[kt][r] * scale_log2;
          if (masked) { const int kp = kpos0 + 32 * (kt >> 1) + 8 * quad + 4 * (kt & 1) + r; const int dd = kp - qpos; if (dd > 128 || dd < -128) x = -1.0e30f; }
          sc[kt][r] = x; mx = fmaxf(mx, x);
        }
      mx = fmaxf(mx, __shfl_xor(mx, 16)); mx = fmaxf(mx, __shfl_xor(mx, 32));
      const float mnew = fmaxf(m[st], mx);
      const float alpha = __builtin_amdgcn_exp2f(m[st] - mnew);
      m[st] = mnew;
      float ps = 0.f;
#pragma unroll
      for (int kt = 0; kt < 4; ++kt)
#pragma unroll
        for (int r = 0; r < 4; ++r) { const float e = __builtin_amdgcn_exp2f(sc[kt][r] - mnew); sc[kt][r] = e; ps += e; }
      lsum[st] = lsum[st] * alpha + ps;
#pragma unroll
      for (int dt = 0; dt < 4; ++dt) o[st][dt] *= alpha;
#pragma unroll
      for (int s2 = 0; s2 < 2; ++s2) {
        u32x4 tt;
        tt.x = pack2(sc[2 * s2][0], sc[2 * s2][1]); tt.y = pack2(sc[2 * s2][2], sc[2 * s2][3]);
        tt.z = pack2(sc[2 * s2 + 1][0], sc[2 * s2 + 1][1]); tt.w = pack2(sc[2 * s2 + 1][2], sc[2 * s2 + 1][3]);
        pf[st][s2] = __builtin_bit_cast(bf16x8, tt);
      }
    }
#pragma unroll
    for (int dt = 0; dt < 4; ++dt)
#pragma unroll
      for (int s2 = 0; s2 < 2; ++s2)
#pragma unroll
        for (int st = 0; st < NS; ++st) o[st][dt] = mfma16(vfr[dt][s2], pf[st][s2], o[st][dt]);
  }
  float l0 = lsum[0]; l0 += __shfl_xor(l0, 16); l0 += __shfl_xor(l0, 32);
  const int tok = tokb + qpos;
  if (!DIFF) {
    l0 += __builtin_amdgcn_exp2f(p.win_sink[l * 4 + h] * 1.4426950408889634f - m[0]);
    const float inv = 1.0f / l0;
#pragma unroll
    for (int dt = 0; dt < 4; ++dt) {
      f32x4 v = o[0][dt] * inv;
      *(f32x4*)(p.OB + (size_t)tok * 256 + h * 64 + dt * 16 + quad * 4) = v;
    }
  } else {
    float l1 = lsum[1]; l1 += __shfl_xor(l1, 16); l1 += __shfl_xor(l1, 32);
    float d1 = 0.f, d2 = 0.f;
    const float* dl = p.diff_lam + l * 128;
    for (int j = 0; j < 32; ++j) { d1 += dl[j] * dl[32 + j]; d2 += dl[64 + j] * dl[96 + j]; }
    const float lam_init = 0.8f - 0.6f * expf(-0.3f * (float)l);
    const float lam = expf(d1) - expf(d2) + lam_init;
    const float i0 = 1.0f / l0, i1 = lam / l1;
    f32x4 v[4]; float ss = 0.f;
#pragma unroll
    for (int dt = 0; dt < 4; ++dt) { v[dt] = o[0][dt] * i0 - o[1][dt] * i1; ss += v[dt][0] * v[dt][0] + v[dt][1] * v[dt][1] + v[dt][2] * v[dt][2] + v[dt][3] * v[dt][3]; }
    ss += __shfl_xor(ss, 16); ss += __shfl_xor(ss, 32);
    const float rstd = rsqrtf(ss * (1.0f / 64.0f) + 1e-6f) * (1.0f - lam_init);
#pragma unroll
    for (int dt = 0; dt < 4; ++dt) {
      const f32x4 g = *(const f32x4*)(p.diff_g + l * 64 + dt * 16 + quad * 4);
      *(f32x4*)(p.OD + (size_t)tok * 256 + h * 64 + dt * 16 + quad * 4) = v[dt] * rstd * g;
    }
  }
}

__device__ void mix_other(const Params& p, int l, int it) {
  if (it < 256) { attn_item<true>(p, l, true, it >> 6, (it >> 4) & 3, it & 15); return; }
  it -= 256;
  if (it < 40) { lru_scan(p, l, it); return; }
  it -= 40;
  if (it < 256) { attn_item<false>(p, l, true, it >> 6, (it >> 4) & 3, it & 15); return; }
  it -= 256;
  if (it < 256) { attn_item<true>(p, l, false, it >> 4, (it >> 2) & 3, it & 3); return; }
  it -= 256;
  attn_item<false>(p, l, false, it >> 4, (it >> 2) & 3, it & 3);
}

#define ES 4
#define EP 8
__device__ void mix_item(const Params& p, int l, int it, unsigned char* smem) {
  constexpr int NPS = 16 / ES, NPP = 16 / EP, NS = 32 * NPS, NP = 128 * NPP;
  if (it < NS) {
#pragma unroll 1
    for (int r = 0; r < p.rep2[0]; ++r) rwkv_chain<ES>(p, l, it / NPS, it % NPS, smem);
    return;
  }
  it -= NS;
  if (it < NP) {
#pragma unroll 1
    for (int r = 0; r < p.rep2[1]; ++r) rwkv_chain<EP>(p, l, 32 + it / NPP, it % NPP, smem);
    return;
  }
  it -= NP;
#pragma unroll 1
  for (int r = 0; r < p.rep2[2]; ++r) mix_other(p, l, it);
}
__device__ void phase_mix(const Params& p, int l, unsigned char* smem) {
  constexpr int NS = 32 * (16 / ES), NP = 128 * (16 / EP), NALL = NS + NP + 1064;
  const int G = gridDim.x, b = blockIdx.x;
  if (G >= 2 * NS) {
    if (b < NS) mix_item(p, l, b, smem);
    else {
#pragma unroll 1
      for (int it = NS + (b - NS); it < NALL; it += G - NS) mix_item(p, l, it, smem);
    }
  } else {
#pragma unroll 1
    for (int it = b; it < NALL; it += G) mix_item(p, l, it, smem);
  }
}

DI float sum16(float v) { v += __shfl_xor(v, 1); v += __shfl_xor(v, 2); v += __shfl_xor(v, 4); v += __shfl_xor(v, 8); return v; }

__device__ void phase_post(const Params& p, int l) {
  const int tid0 = tid_opaque();
  const int lane = tid0 & 63, wave = tid0 >> 6;
  const int c = lane * 4;
#pragma unroll 1
  for (int tok = blockIdx.x * 4 + wave; tok < NTOK; tok += gridDim.x * 4) {
    const bf16_t* pr = p.P + (size_t)tok * PW;
    float out[4], g[4];
    {
      const float4 y0 = *(const float4*)(p.YA + (size_t)tok * 256 + c), y1 = *(const float4*)(p.YA + ((size_t)NTOK + tok) * 256 + c);
      float y[4] = {y0.x + y1.x, y0.y + y1.y, y0.z + y1.z, y0.w + y1.w};
      const float mu = sum16(y[0] + y[1] + y[2] + y[3]) * (1.0f / 64.0f);
      float dv[4] = {y[0] - mu, y[1] - mu, y[2] - mu, y[3] - mu};
      const float var = sum16(dv[0] * dv[0] + dv[1] * dv[1] + dv[2] * dv[2] + dv[3] * dv[3]) * (1.0f / 64.0f);
      const float rstd = rsqrtf(var + 64e-5f);
      float r[4], k[4], v[4];
      ld4bf(pr + c, r); ld4bf(pr + 256 + c, k); ld4bf(pr + 512 + c, v); ld4bf(pr + 896 + c, g);
      const float4 rk = *(const float4*)(p.rw_rk + l * 256 + c), gg = *(const float4*)(p.rw_gng + l * 256 + c), gb = *(const float4*)(p.rw_gnb + l * 256 + c);
      const float bs = sum16(r[0] * k[0] * rk.x + r[1] * k[1] * rk.y + r[2] * k[2] * rk.z + r[3] * k[3] * rk.w);
      out[0] = (dv[0] * rstd * gg.x + gb.x + bs * v[0]) * siluf_(g[0]);
      out[1] = (dv[1] * rstd * gg.y + gb.y + bs * v[1]) * siluf_(g[1]);
      out[2] = (dv[2] * rstd * gg.z + gb.z + bs * v[2]) * siluf_(g[2]);
      out[3] = (dv[3] * rstd * gg.w + gb.w + bs * v[3]) * siluf_(g[3]);
      st4bf(p.H + (size_t)tok * 1024 + c, out);
    }
    {
      const float4 y = *(const float4*)(p.OB + (size_t)tok * 256 + c);
      ld4bf(pr + 1664 + c, g);
      out[0] = y.x * siluf_(g[0]); out[1] = y.y * siluf_(g[1]); out[2] = y.z * siluf_(g[2]); out[3] = y.w * siluf_(g[3]);
      st4bf(p.H + (size_t)tok * 1024 + 256 + c, out);
    }
    {
      const float4 y0 = *(const float4*)(p.LU + (size_t)tok * 256 + c), y1 = *(const float4*)(p.LU + ((size_t)NTOK + tok) * 256 + c);
      const float4 A0 = *(const float4*)(p.LA + (size_t)tok * 256 + c), A1 = *(const float4*)(p.LA + ((size_t)NTOK + tok) * 256 + c);
      const float4 c0 = *(const float4*)(p.LC + (size_t)(tok >> 4) * 256 + c), c1 = *(const float4*)(p.LC + ((size_t)512 + (tok >> 4)) * 256 + c);
      ld4bf(pr + 2176 + c, g);
      out[0] = (y0.x + A0.x * c0.x + y1.x + A1.x * c1.x) * siluf_(g[0]); out[1] = (y0.y + A0.y * c0.y + y1.y + A1.y * c1.y) * siluf_(g[1]);
      out[2] = (y0.z + A0.z * c0.z + y1.z + A1.z * c1.z) * siluf_(g[2]); out[3] = (y0.w + A0.w * c0.w + y1.w + A1.w * c1.w) * siluf_(g[3]);
      st4bf(p.H + (size_t)tok * 1024 + 512 + c, out);
    }
    {
      const float4 y = *(const float4*)(p.OD + (size_t)tok * 256 + c);
      ld4bf(pr + 3200 + c, g);
      out[0] = y.x * siluf_(g[0]); out[1] = y.y * siluf_(g[1]); out[2] = y.z * siluf_(g[2]); out[3] = y.w * siluf_(g[3]);
      st4bf(p.H + (size_t)tok * 1024 + 768 + c, out);
    }
  }
}

__global__ void __launch_bounds__(256, 2) fwd_megakernel(Params p) {
  __shared__ __attribute__((aligned(16))) unsigned char smem[49152];
  __shared__ uint4 xb_words;
  if (threadIdx.x == 0) xb_words = make_uint4(0u, 0u, 0u, 0u);
  __syncthreads();
  XcdBarrier xb = xcd_barrier_post(p.bar, (volatile LAS unsigned*)&xb_words);
#pragma unroll 1
  for (int r = 0; r < p.rep[0]; ++r) phase_prologue(p, smem);
  xcd_barrier(xb);
#pragma unroll 1
  for (int r = 0; r < p.rep[1]; ++r) phase_norm(p, 0);
  xcd_barrier(xb);
#pragma unroll 1
  for (int l = 0; l < 2; ++l) {
#pragma unroll 1
    for (int r = 0; r < p.rep[2]; ++r) phase_gemm<0>(p, l, smem);
    xcd_barrier(xb);
#pragma unroll 1
    for (int r = 0; r < p.rep[3]; ++r) phase_pre(p, l, smem);
    xcd_barrier(xb);
#pragma unroll 1
    for (int r = 0; r < p.rep[4]; ++r) phase_mix(p, l, smem);
    xcd_barrier(xb);
#pragma unroll 1
    for (int r = 0; r < p.rep[5]; ++r) phase_post(p, l);
    xcd_barrier(xb);
#pragma unroll 1
    for (int r = 0; r < p.rep[6]; ++r) phase_gemm<1>(p, l, smem);
    xcd_barrier(xb);
    phase_norm(p, l + 1);
    if (l == 0) xcd_barrier(xb);
#pragma unroll 1
    for (int r = 1; r < p.rep[7]; ++r) xcd_barrier(xb);
  }
}

extern "C" void kernel_launch(void* const* d_in, const int* in_sizes, int n_in, void* d_out, int out_size, void* d_ws, size_t ws_size, hipStream_t stream) {
  static int grid_blocks = 0;
  if (!grid_blocks) {
    int dev = 0, cus = 0, per_cu = 0;
    hipGetDevice(&dev);
    hipDeviceGetAttribute(&cus, hipDeviceAttributeMultiprocessorCount, dev);
    hipOccupancyMaxActiveBlocksPerMultiprocessor(&per_cu, (const void*)fwd_megakernel, 256, 0);
    if (per_cu < 1) per_cu = 1;
    if (per_cu > 2) per_cu = 2;
    grid_blocks = cus * per_cu;
  }
  Params p{};
  const float** f = (const float**)&p;
  for (int i = 0; i < 35; ++i) f[i] = (const float*)d_in[i];
  p.out = (float*)d_out;
  size_t off = 0;
  auto take = [&](size_t bytes) { void* r = (char*)d_ws + off; off += (bytes + 255) & ~(size_t)255; return r; };
  p.MOD = (float*)take(2 * 5 * 3072 * 4);
  p.WINT = (bf16_t*)take((size_t)2 * PW * 1024 * 2);
  p.WOUTT = (bf16_t*)take((size_t)2 * 1024 * 1024 * 2);
  p.CWK = (bf16_t*)take((size_t)4 * 2 * 256 * 128 * 2);
  p.CWVT = (bf16_t*)take((size_t)4 * 2 * 256 * 128 * 2);
  p.CDK = (bf16_t*)take((size_t)4 * 2 * 256 * 256 * 2);
  p.CDVT = (bf16_t*)take((size_t)4 * 2 * 256 * 256 * 2);
  p.H = (bf16_t*)take((size_t)NTOK * 1024 * 2);
  p.P = (bf16_t*)take((size_t)NTOK * PW * 2);
  p.NKK = (float*)take((size_t)NTOK * 256 * 4);
  p.AW = (float*)take((size_t)2 * NTOK * 256 * 4);
  p.AB = (float*)take((size_t)2 * NTOK * 256 * 4);
  p.AKD = (float*)take((size_t)2 * NTOK * 256 * 4);
  p.Y2 = p.NKK;
  p.YA = (float*)take((size_t)2 * NTOK * 256 * 4);
  p.LA = (float*)take((size_t)2 * NTOK * 256 * 4);
  p.LU = (float*)take((size_t)2 * NTOK * 256 * 4);
  p.QBR = (bf16_t*)take((size_t)4096 * 256 * 2);
  p.KBR = (bf16_t*)take((size_t)4096 * 128 * 2);
  p.QDR = (bf16_t*)take((size_t)4096 * 256 * 2);
  p.KDR = (bf16_t*)take((size_t)4096 * 256 * 2);
  p.VBT = (bf16_t*)take((size_t)NTOK * 128 * 2);
  p.VDT = (bf16_t*)take((size_t)NTOK * 256 * 2);
  p.OB = (float*)take((size_t)NTOK * 256 * 4);
  p.OD = (float*)take((size_t)NTOK * 256 * 4);
  p.LC = (float*)take((size_t)2 * 512 * 256 * 4);
  p.bar = (unsigned*)take((size_t)XCD_BAR_WORDS * 4);
  p.RWT = (bf16_t*)take((size_t)2 * 4 * 256 * 64 * 2);
  p.LWT = (bf16_t*)take((size_t)2 * 4 * 4 * 64 * 64 * 2);
  if (off > ws_size) { fprintf(stderr, "workspace too small: need %zu have %zu\n", off, ws_size); return; }
  static const int REPS[8] = {1, 1, 1, 1, 1, 1, 1, 1};
  for (int i = 0; i < 8; ++i) p.rep[i] = REPS[i];
  static const int REPS2[8] = {1, 1, 1, 1, 1, 1, 1, 1};
  for (int i = 0; i < 8; ++i) p.rep2[i] = REPS2[i];
  hipMemsetAsync(p.bar, 0, (size_t)XCD_BAR_WORDS * 4, stream);
  void* args[] = {&p};
  hipError_t e = hipLaunchCooperativeKernel((const void*)fwd_megakernel, dim3(grid_blocks), dim3(256), args, 0, stream);
  if (e != hipSuccess) fprintf(stderr, "cooperative launch failed: %s (grid %d)\n", hipGetErrorString(e), grid_blocks);
}
```

```cpp
#include <hip/hip_runtime.h>
#include <cstdio>
#include <cstdint>

typedef unsigned short bf16_t;
typedef short bf16x8 __attribute__((ext_vector_type(8)));
typedef float f32x4 __attribute__((ext_vector_type(4)));
typedef unsigned u32x4 __attribute__((ext_vector_type(4)));
typedef unsigned u32x2 __attribute__((ext_vector_type(2)));
#define DI __device__ __forceinline__

#define O_YP 0
#define O_NWK 8388608
#define O_NWV 9437184
#define O_NDK 10485760
#define O_NDV 12582912
#define O_NSR 14680064
#define O_NSL 15728640

#define NTOK 8192
#define PW 3456
#define LDK 1088

struct Params {
  const float *x_prompt, *x_sample, *c, *cwk, *cwv, *cdk, *cdv, *st_rwkv, *st_lru, *c_ctx, *w_mod, *b_mod, *g_pre, *g_post, *w_in, *w_out;
  const float *rw_w0, *rw_wup, *rw_a0, *rw_aup, *rw_kk, *rw_ka, *rw_rk, *rw_gng, *rw_gnb, *win_sink;
  const float *lru_cw, *lru_cb, *lru_wa, *lru_ba, *lru_wx, *lru_bx, *lru_lam, *diff_lam, *diff_g;
  float* out;
  float* MOD; bf16_t* WINT; bf16_t* WOUTT; bf16_t* CWK; bf16_t* CWVT; bf16_t* CDK; bf16_t* CDVT;
  bf16_t* H; bf16_t* P; float* NKK; float* AW; float* AB; float* AKD; float* YA; float* LA; float* LU;
  bf16_t* QBR; bf16_t* KBR; bf16_t* QDR; bf16_t* KDR; bf16_t* VBT; bf16_t* VDT; float* OB; float* OD; float* Y2; float* LC; unsigned* bar; bf16_t* RWT; bf16_t* LWT;
  int rep[8];
  int rep2[8];
};

DI void lds_barrier() { asm volatile("s_waitcnt lgkmcnt(0)\n\ts_barrier" ::: "memory"); }
DI int tid_opaque() { int t = threadIdx.x; asm volatile("" : "+v"(t)); return t; }
DI bf16_t f2bf(float x) { unsigned u = __float_as_uint(x); u += 0x7fffu + ((u >> 16) & 1u); return (bf16_t)(u >> 16); }
DI float bf2f(bf16_t b) { return __uint_as_float(((unsigned)b) << 16); }
typedef float f32x2_ __attribute__((ext_vector_type(2)));
typedef __bf16 bf16x2_t __attribute__((ext_vector_type(2)));
DI unsigned pack2(float a, float b) { f32x2_ v = {a, b}; bf16x2_t r = __builtin_convertvector(v, bf16x2_t); return __builtin_bit_cast(unsigned, r); }
DI float bflo(unsigned u) { return __uint_as_float(u << 16); }
DI float bfhi(unsigned u) { return __uint_as_float(u & 0xffff0000u); }
DI void ld4bf(const bf16_t* q, float (&o)[4]) { u32x2 u = *(const u32x2*)q; o[0] = bflo(u.x); o[1] = bfhi(u.x); o[2] = bflo(u.y); o[3] = bfhi(u.y); }
DI void st4bf(bf16_t* q, const float (&v)[4]) { u32x2 u; u.x = pack2(v[0], v[1]); u.y = pack2(v[2], v[3]); *(u32x2*)q = u; }
DI float wave_sum(float v) { for (int o = 32; o > 0; o >>= 1) v += __shfl_xor(v, o); return v; }
DI float sigmoidf_(float x) { return 1.0f / (1.0f + expf(-x)); }
DI float fsigmoid(float x) { return __builtin_amdgcn_rcpf(1.0f + __expf(-x)); }
DI float wave_sum_dpp(float v) {
  v += __builtin_bit_cast(float, __builtin_amdgcn_update_dpp(0, __builtin_bit_cast(int, v), 0xB1, 0xf, 0xf, true));
  v += __builtin_bit_cast(float, __builtin_amdgcn_update_dpp(0, __builtin_bit_cast(int, v), 0x4E, 0xf, 0xf, true));
  v += __builtin_bit_cast(float, __builtin_amdgcn_update_dpp(0, __builtin_bit_cast(int, v), 0x141, 0xf, 0xf, true));
  v += __builtin_bit_cast(float, __builtin_amdgcn_update_dpp(0, __builtin_bit_cast(int, v), 0x140, 0xf, 0xf, true));
  const int iv = __builtin_bit_cast(int, v);
  return __builtin_bit_cast(float, __builtin_amdgcn_readlane(iv, 0)) + __builtin_bit_cast(float, __builtin_amdgcn_readlane(iv, 16)) + __builtin_bit_cast(float, __builtin_amdgcn_readlane(iv, 32)) + __builtin_bit_cast(float, __builtin_amdgcn_readlane(iv, 48));
}
DI float siluf_(float x) { return x * __builtin_amdgcn_rcpf(1.0f + __expf(-x)); }
DI float softplusf_(float z) { return z > 20.f ? z : log1pf(expf(z)); }
DI f32x4 mfma16(bf16x8 a, bf16x8 b, f32x4 c) { return __builtin_amdgcn_mfma_f32_16x16x32_bf16(a, b, c, 0, 0, 0); }
DI float quad_sum(float v) {
  v += __builtin_bit_cast(float, __builtin_amdgcn_update_dpp(0, __builtin_bit_cast(int, v), 0xB1, 0xf, 0xf, true));
  v += __builtin_bit_cast(float, __builtin_amdgcn_update_dpp(0, __builtin_bit_cast(int, v), 0x4E, 0xf, 0xf, true));
  return v;
}


#define XB_TMO      128
#define XB_XCNT(j)  (256  + 64 * (j))
#define XB_XSUB(j)  (1280 + 64 * (j))
#define XB_XGEN(j)  (2304 + 64 * (j))
#define XB_TOP      3328
#define XB_TOPGEN   3392
#define XCD_BAR_WORDS 3456
#define XB_SPIN_CAP (1u << 18)
#define LAS __attribute__((address_space(3)))
DI unsigned xb_ld(unsigned* p)              { return __hip_atomic_load(p, __ATOMIC_RELAXED, __HIP_MEMORY_SCOPE_AGENT); }
DI unsigned xb_add(unsigned* p, unsigned v) { return __hip_atomic_fetch_add(p, v, __ATOMIC_RELAXED, __HIP_MEMORY_SCOPE_AGENT); }
DI unsigned xb_xcc_id() { return (unsigned)__builtin_amdgcn_s_getreg((3 << 11) | 20) & 0xFu; }
#define XB_SPIN(cond, bar) do { unsigned _sp = 0; while (cond) { __builtin_amdgcn_s_sleep(1); \
    if ((++_sp & 255u) == 0u) { if (xb_ld(&(bar)[XB_TMO])) break; if (_sp > XB_SPIN_CAP) { atomicAdd(&(bar)[XB_TMO], 1u); break; } } } } while (0)
struct XcdBarrier { unsigned* bar; unsigned x; volatile LAS unsigned* st; };
DI XcdBarrier xcd_barrier_post(unsigned* bar, volatile LAS unsigned* st) {
    XcdBarrier b; b.bar = bar; b.x = xb_xcc_id(); b.st = st;
    if (threadIdx.x == 0) (void)xb_add(&bar[XB_XCNT(b.x)], 1u);
    return b;
}
DI void xcd_barrier_complete(unsigned* bar, unsigned x, unsigned& nloc, unsigned& nx) {
    const unsigned G = gridDim.x * gridDim.y * gridDim.z;
    unsigned sum, cnt, mine, sp = 0u;
    for (;;) {
        sum = 0u; cnt = 0u; mine = 0u;
#pragma unroll
        for (unsigned j = 0; j < 16; ++j) { const unsigned c = xb_ld(&bar[XB_XCNT(j)]); sum += c; cnt += (c > 0u) ? 1u : 0u; mine = (j == x) ? c : mine; }
        if (sum == G) break;
        __builtin_amdgcn_s_sleep(1);
        if ((++sp & 255u) == 0u) { if (xb_ld(&bar[XB_TMO])) break; if (sp > XB_SPIN_CAP) { atomicAdd(&bar[XB_TMO], 1u); break; } }
    }
    nloc = mine > 0u ? mine : 1u; nx = cnt > 0u ? cnt : 1u;
}
DI void xcd_barrier(const XcdBarrier& b) {
    asm volatile("s_waitcnt vmcnt(0)" ::: "memory");
    __syncthreads();
    if (threadIdx.x == 0) {
        unsigned* bar = b.bar;
        unsigned bx = xb_xcc_id();
        __builtin_amdgcn_s_waitcnt(0);
        unsigned nloc = b.st[0], nx = b.st[1];
        if (nloc == 0u) { xcd_barrier_complete(bar, bx, nloc, nx); b.st[0] = nloc; b.st[1] = nx; }
        const unsigned old = xb_add(&bar[XB_XSUB(bx)], 1u);
        const unsigned gen = old / nloc;
        if (old + 1u == (gen + 1u) * nloc) {
            __builtin_amdgcn_fence(__ATOMIC_RELEASE, "agent");
            asm volatile("s_waitcnt vmcnt(0)" ::: "memory");
            const unsigned og = xb_add(&bar[XB_TOP], 1u);
            const unsigned tg = og / nx;
            if (og + 1u == (tg + 1u) * nx) xb_add(&bar[XB_TOPGEN], 1u);
            else XB_SPIN(xb_ld(&bar[XB_TOPGEN]) == tg, bar);
            __builtin_amdgcn_fence(__ATOMIC_ACQUIRE, "agent");
            xb_add(&bar[XB_XGEN(bx)], 1u);
            asm volatile("s_waitcnt vmcnt(0)" ::: "memory");
        } else {
            XB_SPIN(xb_ld(&bar[XB_XGEN(bx)]) == gen, bar);
            __builtin_amdgcn_fence(__ATOMIC_ACQUIRE, "agent");
            asm volatile("s_waitcnt vmcnt(0)" ::: "memory");
        }
    }
    __syncthreads();
}

template <typename T> DI float ldval(const T* p);
template <> DI float ldval<float>(const float* p) { return *p; }
template <> DI float ldval<bf16_t>(const bf16_t* p) { return bf2f(*p); }
template <typename T>
DI void transpose_tile(const T* src, int src_ld, bf16_t* dst, int dst_ld, float* lds) {
  const int tid = tid_opaque();
#pragma unroll 8
  for (int i = 0; i < 16; ++i) { int r = (tid >> 6) + 4 * i, c = tid & 63; lds[r * 65 + c] = ldval<T>(src + (size_t)r * src_ld + c); }
  __syncthreads();
#pragma unroll 4
  for (int i = 0; i < 16; ++i) { int c = (tid >> 6) + 4 * i, r = tid & 63; dst[(size_t)c * dst_ld + r] = f2bf(lds[r * 65 + c]); }
  __syncthreads();
}

__device__ __forceinline__ void phase_prologue(const Params& p, unsigned char* smem) {
  float* lds = (float*)smem;
  const int n0 = 1728, n1 = n0 + 512, n2 = n1 + 192, n3 = n2 + 64, n4 = n3 + 128, n5 = n4 + 192, n6 = n5 + 32, n7 = n6 + 32;
#pragma unroll 1
  for (int it = blockIdx.x; it < n7; it += gridDim.x) {
    const int tid = tid_opaque();
    if (it < n0) {
      int l = it / 864, r = it % 864, kt = r / 54, nt = r % 54;
      transpose_tile<float>(p.w_in + (size_t)l * 1024 * PW + (size_t)kt * 64 * PW + nt * 64, PW,
                            p.WINT + (size_t)l * PW * LDK + (size_t)nt * 64 * LDK + kt * 64, LDK, lds);
    } else if (it < n1) {
      int i2 = it - n0; int l = i2 / 256, r = i2 % 256, kt = r / 16, nt = r % 16;
      transpose_tile<float>(p.w_out + (size_t)l * 1024 * 1024 + (size_t)kt * 64 * 1024 + nt * 64, 1024,
                            p.WOUTT + (size_t)l * 1024 * LDK + (size_t)nt * 64 * LDK + kt * 64, LDK, lds);
    } else if (it < n2) {
      int i2 = it - n1; int l = i2 / 96, nb = (i2 % 96) * 32;
      float* sc = lds;
      float* red = lds + 5 * 1024;
      for (int i = tid; i < 5 * 1024; i += 256) { int v = i >> 10, k = i & 1023; float x = v == 0 ? p.c_ctx[k] : p.c[(v - 1) * 1024 + k]; sc[i] = siluf_(x); }
      __syncthreads();
      int n = tid & 31, kg = tid >> 5;
      float a0 = 0, a1 = 0, a2 = 0, a3 = 0, a4 = 0;
      const float* wp = p.w_mod + (size_t)l * 1024 * 3072 + nb + n;
      for (int k = kg * 128; k < kg * 128 + 128; ++k) {
        float w = wp[(size_t)k * 3072];
        a0 += sc[k] * w; a1 += sc[1024 + k] * w; a2 += sc[2048 + k] * w; a3 += sc[3072 + k] * w; a4 += sc[4096 + k] * w;
      }
      red[(kg * 5 + 0) * 32 + n] = a0; red[(kg * 5 + 1) * 32 + n] = a1; red[(kg * 5 + 2) * 32 + n] = a2; red[(kg * 5 + 3) * 32 + n] = a3; red[(kg * 5 + 4) * 32 + n] = a4;
      __syncthreads();
      if (tid < 160) { int v = tid >> 5, nn = tid & 31; float s = p.b_mod[l * 3072 + nb + nn]; for (int q = 0; q < 8; ++q) s += red[(q * 5 + v) * 32 + nn]; p.MOD[(size_t)(l * 5 + v) * 3072 + nb + nn] = s; }
      __syncthreads();
    } else if (it < n3) {
      int i2 = it - n2; int bl = i2 >> 3, r = i2 & 7, pt = r >> 1, ct = r & 1;
      transpose_tile<float>(p.cwv + (size_t)bl * 256 * 128 + (size_t)pt * 64 * 128 + ct * 64, 128,
                            p.CWVT + (size_t)bl * 128 * 256 + (size_t)ct * 64 * 256 + pt * 64, 256, lds);
    } else if (it < n4) {
      int i2 = it - n3; int bl = i2 >> 4, r = i2 & 15, pt = r >> 2, ct = r & 3;
      transpose_tile<float>(p.cdv + (size_t)bl * 256 * 256 + (size_t)pt * 64 * 256 + ct * 64, 256,
                            p.CDVT + (size_t)bl * 256 * 256 + (size_t)ct * 64 * 256 + pt * 64, 256, lds);
    } else if (it >= n6) {
      int i2 = it - n6; int l = i2 >> 4, mat = (i2 >> 2) & 3, n = i2 & 3;
      const float* src = (mat < 2 ? p.lru_wa : p.lru_wx) + (size_t)(((l * 2 + (mat & 1)) * 4 + n)) * 4096;
      transpose_tile<float>(src, 64, p.LWT + (size_t)(((l * 4 + mat) * 4 + n)) * 4096, 64, lds);
    } else if (it >= n5) {
      int i2 = it - n5; int l = i2 >> 4, mat = (i2 >> 2) & 3, ct = i2 & 3;
      const float* src = (mat < 2 ? p.rw_wup : p.rw_aup) + (size_t)(l * 2 + (mat & 1)) * 64 * 256 + ct * 64;
      transpose_tile<float>(src, 256, p.RWT + ((size_t)(l * 4 + mat) * 256 + ct * 64) * 64, 64, lds);
    } else {
      int i2 = it - n4;
      const float* src; bf16_t* dst;
      if (i2 < 64) { src = p.cwk + (size_t)i2 * 4096; dst = p.CWK + (size_t)i2 * 4096; }
      else { src = p.cdk + (size_t)(i2 - 64) * 4096; dst = p.CDK + (size_t)(i2 - 64) * 4096; }
      for (int i = tid * 4; i < 4096; i += 1024) { float4 v = *(const float4*)(src + i); uint2 o; o.x = pack2(v.x, v.y); o.y = pack2(v.z, v.w); *(uint2*)(dst + i) = o; }
    }
  }
}

__device__ __forceinline__ void phase_norm(const Params& p, int stage) {
  const int tid0 = tid_opaque();
  const int lane = tid0 & 63, wave = tid0 >> 6;
#pragma unroll 1
  for (int tok = blockIdx.x * 4 + wave; tok < NTOK; tok += gridDim.x * 4) {
    const int mv = tok < 4096 ? 0 : 1 + ((tok - 4096) >> 10);
    const float* xin;
    if (stage <= 1) xin = tok < 4096 ? p.x_prompt + (size_t)tok * 1024 : p.x_sample + (size_t)(tok - 4096) * 1024;
    else xin = p.out + (size_t)tok * 1024;
    f32x4 x[4], gt[4], gq[4], sh[4], sc[4], gpre[4]; u32x2 yb[4];
    const int lp = stage >= 1 ? stage - 1 : 0, ln = stage <= 1 ? stage : 0;
    const float* gate = p.MOD + (size_t)(lp * 5 + mv) * 3072 + 2048;
    const float* gpo = p.g_post + lp * 1024;
    const float* md = p.MOD + (size_t)(ln * 5 + mv) * 3072;
    const float* gpr = p.g_pre + ln * 1024;
#pragma unroll
    for (int i = 0; i < 4; ++i) {
      const int col = i * 256 + lane * 4;
      x[i] = *(const f32x4*)(xin + col);
      if (stage >= 1) { yb[i] = *(const u32x2*)((const bf16_t*)p.Y2 + (size_t)tok * 1024 + col); gt[i] = *(const f32x4*)(gate + col); gq[i] = *(const f32x4*)(gpo + col); }
      if (stage <= 1) { sh[i] = *(const f32x4*)(md + col); sc[i] = *(const f32x4*)(md + 1024 + col); gpre[i] = *(const f32x4*)(gpr + col); }
    }
    __builtin_amdgcn_sched_barrier(0);
    if (stage >= 1) {
      f32x4 y[4]; float ss = 0.f;
#pragma unroll
      for (int i = 0; i < 4; ++i) { y[i] = (f32x4){bflo(yb[i].x), bfhi(yb[i].x), bflo(yb[i].y), bfhi(yb[i].y)}; ss += y[i][0] * y[i][0] + y[i][1] * y[i][1] + y[i][2] * y[i][2] + y[i][3] * y[i][3]; }
      ss = wave_sum(ss);
      const float rstd = rsqrtf(ss * (1.0f / 1024.0f) + 1e-6f);
#pragma unroll
      for (int i = 0; i < 4; ++i) {
        const int col = i * 256 + lane * 4;
        x[i] += gt[i] * (y[i] * rstd * gq[i]);
        *(f32x4*)(p.out + (size_t)tok * 1024 + col) = x[i];
      }
    }
    if (stage <= 1) {
      float ss = 0.f;
#pragma unroll
      for (int i = 0; i < 4; ++i) ss += x[i][0] * x[i][0] + x[i][1] * x[i][1] + x[i][2] * x[i][2] + x[i][3] * x[i][3];
      ss = wave_sum(ss);
      const float rstd = rsqrtf(ss * (1.0f / 1024.0f) + 1e-6f);
#pragma unroll
      for (int i = 0; i < 4; ++i) {
        const int col = i * 256 + lane * 4;
        const f32x4 hv = x[i] * rstd * gpre[i] * (sc[i] + 1.f) + sh[i];
        u32x2 o; o.x = pack2(hv[0], hv[1]); o.y = pack2(hv[2], hv[3]);
        *(u32x2*)(p.H + (size_t)tok * LDK + col) = o;
      }
    }
  }
}

template <int MODE>
__device__ __forceinline__ void phase_gemm(const Params& p, int l, unsigned char* smem, int vb) {
  const bf16_t* A = p.H;
  const bf16_t* Bt = MODE == 0 ? p.WINT + (size_t)l * PW * LDK : p.WOUTT + (size_t)l * 1024 * LDK;
  const int N = MODE == 0 ? PW : 1024, K = LDK;
  const int NTN = N / 128;
  bf16_t* As = (bf16_t*)smem; bf16_t* Bs = As + 128 * 64;
  const int per = gridDim.x >> 3;
  const bool even8 = (gridDim.x & 7) == 0;
  const int xcd = even8 ? vb / per : (vb & 7), slot = even8 ? vb % per : (vb >> 3), nslot = even8 ? per : (int)((gridDim.x + 7 - xcd) >> 3);
  const int nx = (NTN - xcd + 7) >> 3;
#pragma unroll 1
  for (int j = slot; j < 64 * nx; j += nslot) {
    const int tid = tid_opaque(), lane = tid & 63, wave = tid >> 6, wm = wave >> 1, wn = wave & 1, r16 = lane & 15, quad = lane >> 4;
    const int tm = j / nx, tn = xcd + 8 * (j % nx), m0 = tm * 128, n0 = tn * 128;
    f32x4 acc[4][4];
#pragma unroll
    for (int i = 0; i < 4; ++i)
#pragma unroll
      for (int j = 0; j < 4; ++j) acc[i][j] = (f32x4){0.f, 0.f, 0.f, 0.f};
    u32x4 ra0[4], rb0[4];
    const int lrow = tid >> 3, lc8 = tid & 7;
    const bf16_t* ga = A + (size_t)(m0 + lrow) * K + lc8 * 8;
    const bf16_t* gb = Bt + (size_t)(n0 + lrow) * K + lc8 * 8;
    const int swz_w = (lc8 ^ ((lrow >> 1) & 7)) * 8, swz_r = (r16 >> 1) & 7;
    bf16_t* const sa_ = As + lrow * 64 + swz_w; bf16_t* const sb_ = Bs + lrow * 64 + swz_w;
#define G_LOAD(RA, RB, KT) { _Pragma("unroll") for (int i = 0; i < 4; ++i) { RA[i] = *(const u32x4*)(ga + (size_t)i * 32 * K + (KT) * 64); RB[i] = *(const u32x4*)(gb + (size_t)i * 32 * K + (KT) * 64); } }
#define G_STORE(RA, RB) { _Pragma("unroll") for (int i = 0; i < 4; ++i) { *(u32x4*)(sa_ + i * 32 * 64) = RA[i]; *(u32x4*)(sb_ + i * 32 * 64) = RB[i]; } }
#define G_COMPUTE() { _Pragma("unroll") for (int ks = 0; ks < 2; ++ks) { bf16x8 af[4], bfr[4]; \
      _Pragma("unroll") for (int i = 0; i < 4; ++i) { af[i] = *(const bf16x8*)(As + (wm * 64 + i * 16 + r16) * 64 + (((ks * 4 + quad) ^ swz_r) * 8)); bfr[i] = *(const bf16x8*)(Bs + (wn * 64 + i * 16 + r16) * 64 + (((ks * 4 + quad) ^ swz_r) * 8)); } \
      _Pragma("unroll") for (int mi = 0; mi < 4; ++mi) _Pragma("unroll") for (int ni = 0; ni < 4; ++ni) acc[mi][ni] = mfma16(bfr[ni], af[mi], acc[mi][ni]); } }
    G_LOAD(ra0, rb0, 0);
    G_STORE(ra0, rb0);
    __syncthreads();
#pragma unroll 1
    for (int kt = 0; kt < 16; ++kt) {
      if (kt + 1 < 16) G_LOAD(ra0, rb0, kt + 1);
      __builtin_amdgcn_sched_barrier(0);
      G_COMPUTE();
      lds_barrier();
      if (kt + 1 < 16) { G_STORE(ra0, rb0); lds_barrier(); }
    }
#undef G_LOAD
#undef G_STORE
#undef G_COMPUTE
#pragma unroll
    for (int mi = 0; mi < 4; ++mi)
#pragma unroll
      for (int ni = 0; ni < 4; ++ni) {
        const int m = m0 + wm * 64 + mi * 16 + r16, n = n0 + wn * 64 + ni * 16 + quad * 4;
        const f32x4 v = acc[mi][ni];
        if (MODE == 0) {
          uint2 o; o.x = pack2(v[0], v[1]); o.y = pack2(v[2], v[3]);
          *(uint2*)(p.P + (size_t)m * PW + n) = o;
          if (m0 < 4096) {
            const int row = ((m >> 8) * 2 + l) * 256 + (m & 255);
            float* dst = nullptr;
            if (tn == 11) dst = p.out + O_NWK + (size_t)row * 128 + (n - 1408);
            else if (tn == 12) dst = p.out + O_NWV + (size_t)row * 128 + (n - 1536);
            else if (tn == 21 || tn == 22) dst = p.out + O_NDK + (size_t)row * 256 + (n - 2688);
            else if (tn == 23 || tn == 24) dst = p.out + O_NDV + (size_t)row * 256 + (n - 2944);
            if (dst) *(float4*)dst = (float4){v[0], v[1], v[2], v[3]};
          }
        } else {
          { u32x2 o; o.x = pack2(v[0], v[1]); o.y = pack2(v[2], v[3]); *(u32x2*)((bf16_t*)p.Y2 + (size_t)m * 1024 + n) = o; }
        }
      }
  }
}

DI void unpack8(u32x4 u, float (&o)[8]) { o[0] = bflo(u.x); o[1] = bfhi(u.x); o[2] = bflo(u.y); o[3] = bfhi(u.y); o[4] = bflo(u.z); o[5] = bfhi(u.z); o[6] = bflo(u.w); o[7] = bfhi(u.w); }
DI bf16x8 pack8(const float (&o)[8]) { u32x4 u; u.x = pack2(o[0], o[1]); u.y = pack2(o[2], o[3]); u.z = pack2(o[4], o[5]); u.w = pack2(o[6], o[7]); return __builtin_bit_cast(bf16x8, u); }

__device__ __forceinline__ void pre_rwkv(const Params& p, int l, int item) {
  const int tid = tid_opaque(), lane = tid & 63, h = tid >> 6, r16 = lane & 15, quad = lane >> 4;
  const int tok = item * 16 + r16;
  const bf16_t* pr = p.P + (size_t)tok * PW;
  bf16x8 wdf[2], adf[2];
#pragma unroll
  for (int ks = 0; ks < 2; ++ks) {
    float o[8]; unpack8(*(const u32x4*)(pr + 768 + ks * 32 + quad * 8), o);
#pragma unroll
    for (int j = 0; j < 8; ++j) o[j] = 1.0f - 2.0f * __builtin_amdgcn_rcpf(1.0f + __expf(2.0f * o[j]));
    wdf[ks] = pack8(o);
    adf[ks] = *(const bf16x8*)(pr + 832 + ks * 32 + quad * 8);
  }
  float kv[4][4];
#pragma unroll
  for (int ct = 0; ct < 4; ++ct) ld4bf(pr + 256 + h * 64 + ct * 16 + quad * 4, kv[ct]);
  const bf16_t* wt = p.RWT + (size_t)l * 4 * 256 * 64;
  float ss = 0.f;
#pragma unroll
  for (int ct = 0; ct < 4; ++ct) {
    const f32x4 kkc = *(const f32x4*)(p.rw_kk + l * 256 + h * 64 + ct * 16 + quad * 4);
#pragma unroll
    for (int r = 0; r < 4; ++r) { const float q = kv[ct][r] * kkc[r]; ss += q * q; }
  }
  ss += __shfl_xor(ss, 16); ss += __shfl_xor(ss, 32);
  const float rn = rsqrtf(ss + 1e-12f);
#pragma unroll
  for (int ct = 0; ct < 4; ++ct) {
    f32x4 acc[4];
    const int c0 = h * 64 + ct * 16 + quad * 4;
    bf16x8 wfr[4][2];
#pragma unroll
    for (int mat = 0; mat < 4; ++mat)
#pragma unroll
      for (int ks = 0; ks < 2; ++ks) wfr[mat][ks] = *(const bf16x8*)(wt + ((size_t)mat * 256 + h * 64 + ct * 16 + r16) * 64 + ks * 32 + quad * 8);
    const f32x4 kkc = *(const f32x4*)(p.rw_kk + l * 256 + c0), kac = *(const f32x4*)(p.rw_ka + l * 256 + c0);
    const f32x4 w00 = *(const f32x4*)(p.rw_w0 + (l * 2 + 0) * 256 + c0), w01 = *(const f32x4*)(p.rw_w0 + (l * 2 + 1) * 256 + c0);
    const f32x4 a00 = *(const f32x4*)(p.rw_a0 + (l * 2 + 0) * 256 + c0), a01 = *(const f32x4*)(p.rw_a0 + (l * 2 + 1) * 256 + c0);
    __builtin_amdgcn_sched_barrier(0);
#pragma unroll
    for (int mat = 0; mat < 4; ++mat) {
      f32x4 a = {0.f, 0.f, 0.f, 0.f};
#pragma unroll
      for (int ks = 0; ks < 2; ++ks) a = mfma16(wfr[mat][ks], mat < 2 ? wdf[ks] : adf[ks], a);
      acc[mat] = a;
    }
    f32x4 nkk, w0v, w1v, b0v, b1v, k0v, k1v;
#pragma unroll
    for (int r = 0; r < 4; ++r) {
      const float k = kv[ct][r];
      const float kkn = k * kkc[r] * rn;
      nkk[r] = -kkn;
#pragma unroll
      for (int d = 0; d < 2; ++d) {
        const float wl = (d ? w01[r] : w00[r]) + acc[d][r];
        const float w_log = -__logf(1.0f + __expf(-wl)) - 0.5f;
        const float decay = __expf(-__expf(w_log));
        const float a = fsigmoid((d ? a01[r] : a00[r]) + acc[2 + d][r]);
        const float kd = k * (1.f + (a - 1.f) * kac[r]);
        if (d) { w1v[r] = decay; b1v[r] = kkn * a; k1v[r] = kd; } else { w0v[r] = decay; b0v[r] = kkn * a; k0v[r] = kd; }
      }
    }
    const size_t o0 = (size_t)tok * 256 + c0, o1 = ((size_t)NTOK + tok) * 256 + c0;
    *(f32x4*)(p.NKK + o0) = nkk;
    *(f32x4*)(p.AW + o0) = w0v; *(f32x4*)(p.AW + o1) = w1v;
    *(f32x4*)(p.AB + o0) = b0v; *(f32x4*)(p.AB + o1) = b1v;
    *(f32x4*)(p.AKD + o0) = k0v; *(f32x4*)(p.AKD + o1) = k1v;
  }
}

#define LSCAN_STEP(A, H, CTRL) { \
    const float Ap = __builtin_bit_cast(float, __builtin_amdgcn_update_dpp(0x3f800000, __builtin_bit_cast(int, A), CTRL, 0xf, 0xf, false)); \
    const float Hp = __builtin_bit_cast(float, __builtin_amdgcn_update_dpp(0, __builtin_bit_cast(int, H), CTRL, 0xf, 0xf, true)); \
    H = A * Hp + H; A = A * Ap; }

__device__ __forceinline__ void pre_lru(const Params& p, int l, int item) {
  const int tid = tid_opaque(), lane = tid & 63, n = tid >> 6, r16 = lane & 15, quad = lane >> 4;
  const int tok0 = item * 16;
  int T, sb, t0;
  if (tok0 < 4096) { T = 256; sb = tok0 & ~255; t0 = tok0 & 255; } else { T = 1024; sb = 4096 + ((tok0 - 4096) & ~1023); t0 = (tok0 - 4096) & 1023; }
  const int t = t0 + r16, tok = tok0 + r16;
  bf16x8 xf[2];
  float xo[2][8];
#pragma unroll
  for (int ks = 0; ks < 2; ++ks) {
    const int cb = n * 64 + ks * 32 + quad * 8;
    float o[8];
    { const f32x4 b0 = *(const f32x4*)(p.lru_cb + l * 256 + cb), b1 = *(const f32x4*)(p.lru_cb + l * 256 + cb + 4);
      o[0] = b0[0]; o[1] = b0[1]; o[2] = b0[2]; o[3] = b0[3]; o[4] = b1[0]; o[5] = b1[1]; o[6] = b1[2]; o[7] = b1[3]; }
#pragma unroll
    for (int i = 0; i < 4; ++i) {
      const int tt = t - 2 + i;
      u32x4 xr = {0u, 0u, 0u, 0u};
      if (tt >= 0 && tt < T) xr = *(const u32x4*)(p.P + (size_t)(sb + tt) * PW + 1920 + cb);
      float x[8]; unpack8(xr, x);
      const f32x4 w0 = *(const f32x4*)(p.lru_cw + (l * 4 + i) * 256 + cb), w1 = *(const f32x4*)(p.lru_cw + (l * 4 + i) * 256 + cb + 4);
      o[0] += w0[0] * x[0]; o[1] += w0[1] * x[1]; o[2] += w0[2] * x[2]; o[3] += w0[3] * x[3];
      o[4] += w1[0] * x[4]; o[5] += w1[1] * x[5]; o[6] += w1[2] * x[6]; o[7] += w1[3] * x[7];
    }
    xf[ks] = pack8(o);
#pragma unroll
    for (int j = 0; j < 8; ++j) xo[ks][j] = o[j];
  }
#pragma unroll
  for (int et = 0; et < 4; ++et) {
    f32x4 acc[4];
    const int c0 = n * 64 + (et >> 1) * 32 + quad * 8 + (et & 1) * 4;
    const int erow = (et >> 1) * 32 + (r16 >> 2) * 8 + (et & 1) * 4 + (r16 & 3);
    bf16x8 wfr[4][2];
#pragma unroll
    for (int mat = 0; mat < 4; ++mat)
#pragma unroll
      for (int ks = 0; ks < 2; ++ks) wfr[mat][ks] = *(const bf16x8*)(p.LWT + ((size_t)((l * 4 + mat) * 4 + n) * 64 + erow) * 64 + ks * 32 + quad * 8);
    const f32x4 ba0 = *(const f32x4*)(p.lru_ba + (l * 2 + 0) * 256 + c0), ba1 = *(const f32x4*)(p.lru_ba + (l * 2 + 1) * 256 + c0);
    const f32x4 bx0 = *(const f32x4*)(p.lru_bx + (l * 2 + 0) * 256 + c0), bx1 = *(const f32x4*)(p.lru_bx + (l * 2 + 1) * 256 + c0);
    const f32x4 lm0 = *(const f32x4*)(p.lru_lam + (l * 2 + 0) * 256 + c0), lm1 = *(const f32x4*)(p.lru_lam + (l * 2 + 1) * 256 + c0);
    __builtin_amdgcn_sched_barrier(0);
#pragma unroll
    for (int mat = 0; mat < 4; ++mat) {
      f32x4 a = {0.f, 0.f, 0.f, 0.f};
#pragma unroll
      for (int ks = 0; ks < 2; ++ks) a = mfma16(wfr[mat][ks], xf[ks], a);
      acc[mat] = a;
    }
    f32x4 A0, H0, A1, H1;
#pragma unroll
    for (int r = 0; r < 4; ++r) {
      const float x = xo[et >> 1][(et & 1) * 4 + r];
#pragma unroll
      for (int d = 0; d < 2; ++d) {
        const float ga = fsigmoid(acc[d][r] + (d ? ba1[r] : ba0[r]));
        const float gx = fsigmoid(acc[2 + d][r] + (d ? bx1[r] : bx0[r]));
        const float e_ = __expf(-(d ? lm1[r] : lm0[r]));
        const float sp = e_ < 0.05f ? e_ * (1.0f - e_ * (0.5f - e_ * (0.33333334f - 0.25f * e_))) : __logf(1.0f + e_);
        const float log_a = -8.0f * ga * sp;
        float a = __expf(log_a);
        const float x2 = 2.0f * log_a;
        const float om = x2 > -0.05f ? -(x2 * (1.0f + x2 * (0.5f + x2 * (0.16666667f + x2 * 0.041666667f)))) : 1.0f - __expf(x2);
        float u = __fsqrt_rn(om) * (gx * x);
        if (d == 0) { LSCAN_STEP(a, u, 0x111) LSCAN_STEP(a, u, 0x112) LSCAN_STEP(a, u, 0x114) LSCAN_STEP(a, u, 0x118) A0[r] = a; H0[r] = u; }
        else        { LSCAN_STEP(a, u, 0x101) LSCAN_STEP(a, u, 0x102) LSCAN_STEP(a, u, 0x104) LSCAN_STEP(a, u, 0x108) A1[r] = a; H1[r] = u; }
      }
    }
    const size_t o0 = (size_t)tok * 256 + c0, o1 = ((size_t)NTOK + tok) * 256 + c0;
    *(f32x4*)(p.LA + o0) = A0; *(f32x4*)(p.LU + o0) = H0;
    *(f32x4*)(p.LA + o1) = A1; *(f32x4*)(p.LU + o1) = H1;
  }
}

__device__ __forceinline__ void pre_rope(const Params& p, int item) {
  const int tid = tid_opaque();
  const int ts0 = item * 16;
#pragma unroll 1
  for (int pp = tid; pp < 448; pp += 256) {
    int scol, d1, d2, half, i, dstride; bf16_t* dst; float inv;
    if (pp < 192) {
      int q = pp < 128 ? pp : pp - 128; int vec = q >> 5, pi = q & 31; half = pi >> 4; i = pi & 15;
      d1 = half * 32 + i; d2 = d1 + 16; inv = exp2f(-(float)i * (13.287712379549449f / 16.0f));
      if (pp < 128) { scol = 1152 + vec * 64; dst = p.QBR + vec * 64; dstride = 256; }
      else { scol = 1408 + vec * 64; dst = p.KBR + vec * 64; dstride = 128; }
    } else {
      int q = pp < 320 ? pp - 192 : pp - 320; int vec = q >> 4, pi = q & 15; half = pi >> 3; i = pi & 7;
      d1 = half * 16 + i; d2 = d1 + 8; inv = exp2f(-(float)i * (13.287712379549449f / 8.0f));
      if (pp < 320) { scol = 2432 + vec * 32; dst = p.QDR + vec * 32; dstride = 256; }
      else { scol = 2688 + vec * 32; dst = p.KDR + vec * 32; dstride = 256; }
    }
    float x1[16], x2[16];
#pragma unroll
    for (int tt = 0; tt < 16; ++tt) { const bf16_t* src = p.P + (size_t)(4096 + ts0 + tt) * PW + scol; x1[tt] = bf2f(src[d1]); x2[tt] = bf2f(src[d2]); }
#pragma unroll
    for (int tt = 0; tt < 16; ++tt) {
      const int t = (ts0 + tt) & 1023;
      const float ang = (float)(half ? (t & 63) : (t >> 6)) * inv;
      const float sn = __sinf(ang), cs = __cosf(ang);
      const float a = x1[tt], b = x2[tt];
      bf16_t* o = dst + (size_t)(ts0 + tt) * dstride;
      o[d1] = f2bf(a * cs - b * sn); o[d2] = f2bf(a * sn + b * cs);
    }
  }
}

__device__ __forceinline__ void phase_pre(const Params& p, int l, unsigned char* smem) {
  const int n0 = 512, n1 = n0 + 512, n2 = n1 + 256, n3 = n2 + 256, n4 = n3 + 512;
#pragma unroll 1
  for (int it = blockIdx.x; it < n4; it += gridDim.x) {
    if (it < n0) pre_rwkv(p, l, it);
    else if (it < n1) pre_lru(p, l, it - n0);
    else if (it < n2) pre_rope(p, it - n1);
    else if (it < n3) {
      int i2 = it - n2; int tt = i2 >> 1, ct = i2 & 1; int tok0 = tt * 64;
      int T, sb; if (tok0 < 4096) { T = 256; sb = tok0 & ~255; } else { T = 1024; sb = 4096 + ((tok0 - 4096) & ~1023); }
      transpose_tile<bf16_t>(p.P + (size_t)tok0 * PW + 1536 + ct * 64, PW, p.VBT + (size_t)sb * 128 + (size_t)(ct * 64) * T + (tok0 - sb), T, (float*)smem);
    } else {
      int i2 = it - n3; int tt = i2 >> 2, ct = i2 & 3; int tok0 = tt * 64;
      int T, sb; if (tok0 < 4096) { T = 256; sb = tok0 & ~255; } else { T = 1024; sb = 4096 + ((tok0 - 4096) & ~1023); }
      transpose_tile<bf16_t>(p.P + (size_t)tok0 * PW + 2944 + ct * 64, PW, p.VDT + (size_t)sb * 256 + (size_t)(ct * 64) * T + (tok0 - sb), T, (float*)smem);
    }
  }
}

template <int LR> DI float group_sum(float v) {
  v += __builtin_bit_cast(float, __builtin_amdgcn_update_dpp(0, __builtin_bit_cast(int, v), 0xB1, 0xf, 0xf, true));
  v += __builtin_bit_cast(float, __builtin_amdgcn_update_dpp(0, __builtin_bit_cast(int, v), 0x4E, 0xf, 0xf, true));
  if (LR >= 8) v += __builtin_bit_cast(float, __builtin_amdgcn_update_dpp(0, __builtin_bit_cast(int, v), 0x141, 0xf, 0xf, true));
  if (LR >= 16) v += __builtin_bit_cast(float, __builtin_amdgcn_update_dpp(0, __builtin_bit_cast(int, v), 0x140, 0xf, 0xf, true));
  return v;
}
typedef float f32x2 __attribute__((ext_vector_type(2)));
template <int E> struct RwOps { f32x4 nk[E / 4], ww[E / 4], bb[E / 4], kk[E / 4], rr[E / 4]; float vi; };
template <int E> DI void rw_load(const float* ob, int g, int i, RwOps<E>& o) {
  constexpr int LR = 64 / E, NM = E / 4;
#pragma unroll
  for (int m = 0; m < NM; ++m) {
    const int off = 4 * (g + LR * m);
    o.nk[m] = *(const f32x4*)(ob + off); o.ww[m] = *(const f32x4*)(ob + 64 + off); o.bb[m] = *(const f32x4*)(ob + 128 + off);
    o.kk[m] = *(const f32x4*)(ob + 192 + off); o.rr[m] = *(const f32x4*)(ob + 256 + off);
  }
  o.vi = ob[320 + i];
}
template <int E> DI float rw_step(f32x2 (&S)[E / 2], const RwOps<E>& o) {
  constexpr int LR = 64 / E, NM = E / 4;
  f32x2 p2 = S[0] * o.nk[0].xy;
  p2 = S[1] * o.nk[0].zw + p2;
#pragma unroll
  for (int m = 1; m < NM; ++m) { p2 = S[2 * m] * o.nk[m].xy + p2; p2 = S[2 * m + 1] * o.nk[m].zw + p2; }
  const float sa = group_sum<LR>(p2.x + p2.y);
  const f32x2 sa2 = {sa, sa}, v2 = {o.vi, o.vi};
  f32x2 y2 = {0.f, 0.f};
#pragma unroll
  for (int m = 0; m < NM; ++m) {
    S[2 * m] = S[2 * m] * o.ww[m].xy + (sa2 * o.bb[m].xy + v2 * o.kk[m].xy);
    S[2 * m + 1] = S[2 * m + 1] * o.ww[m].zw + (sa2 * o.bb[m].zw + v2 * o.kk[m].zw);
    y2 = S[2 * m] * o.rr[m].xy + y2; y2 = S[2 * m + 1] * o.rr[m].zw + y2;
  }
  return group_sum<LR>(y2.x + y2.y);
}
template <int E>
__device__ __forceinline__ void rwkv_chain(const Params& p, int l, int chain, int part, unsigned char* smem) {
  constexpr int LR = 64 / E, NM = E / 4;
  const int tid = tid_opaque(), lane = tid & 63, wave = tid >> 6;
  int seq, d, h;
  if (chain < 32) { seq = 16 + (chain >> 3); d = (chain >> 2) & 1; h = chain & 3; }
  else { int c2 = chain - 32; seq = c2 >> 3; d = (c2 >> 2) & 1; h = c2 & 3; }
  const int T = seq < 16 ? 256 : 1024, tokb = seq < 16 ? seq * 256 : 4096 + (seq - 16) * 1024;
  const int g = lane % LR, rl = lane / LR, i = part * 4 * E + wave * E + rl;
  f32x2 S[E / 2];
  if (seq >= 16) {
    const float* s0 = p.st_rwkv + ((((size_t)(seq - 16) * 2 + l) * 2 + d) * 4 + h) * 4096 + i * 64;
#pragma unroll
    for (int m = 0; m < NM; ++m) { f32x4 t = *(const f32x4*)(s0 + 4 * (g + LR * m)); S[2 * m] = t.xy; S[2 * m + 1] = t.zw; }
  } else {
#pragma unroll
    for (int j = 0; j < E / 2; ++j) S[j] = (f32x2){0.f, 0.f};
  }
  float* buf = (float*)smem;
  const int lvec = (tid >> 4) & 3, lc4 = tid & 15, ls = tid >> 6;
  const float* fsrc = (lvec == 0 ? p.NKK : lvec == 1 ? p.AW + (size_t)d * NTOK * 256 : lvec == 2 ? p.AB + (size_t)d * NTOK * 256 : p.AKD + (size_t)d * NTOK * 256) + h * 64 + lc4 * 4;
  const int bs = tid >> 4, bvec = (tid >> 3) & 1, bc8 = tid & 7;
  const bf16_t* bsrc = p.P + (bvec ? 512 : 0) + h * 64 + bc8 * 8;
  f32x4 rfA[4], rfB[4]; u32x4 rbA, rbB;
  const int nch = T / 16;
#define RW_GLOAD(RF, RB, CK) { _Pragma("unroll") for (int i4 = 0; i4 < 4; ++i4) { int step = (CK) * 16 + ls + 4 * i4; int t = d ? T - 1 - step : step; RF[i4] = *(const f32x4*)(fsrc + (size_t)(tokb + t) * 256); } \
    { int step = (CK) * 16 + bs; int t = d ? T - 1 - step : step; RB = *(const u32x4*)(bsrc + (size_t)(tokb + t) * PW); } }
#define RW_SSTORE(RF, RB, BI) { float* b_ = buf + (BI) * 16 * 384; \
    _Pragma("unroll") for (int i4 = 0; i4 < 4; ++i4) *(f32x4*)(b_ + (ls + 4 * i4) * 384 + lvec * 64 + lc4 * 4) = RF[i4]; \
    float* q_ = b_ + bs * 384 + (4 + bvec) * 64 + bc8 * 8; \
    *(f32x4*)q_ = (f32x4){bflo(RB.x), bfhi(RB.x), bflo(RB.y), bfhi(RB.y)}; \
    *(f32x4*)(q_ + 4) = (f32x4){bflo(RB.z), bfhi(RB.z), bflo(RB.w), bfhi(RB.w)}; }
  float* yout = p.YA + ((size_t)d * NTOK + tokb) * 256 + h * 64 + i;
  constexpr int NY = 16 / LR;
  auto compute = [&](int ck) {
    const float* cb = buf + (ck & 1) * 16 * 384;
    float yk[NY];
#pragma unroll
    for (int q = 0; q < NY; ++q) yk[q] = 0.f;
    constexpr int NSET = (E == 4) ? 4 : 2;
    RwOps<E> ops[NSET];
#pragma unroll
    for (int q = 0; q < NSET - 1; ++q) rw_load<E>(cb + q * 384, g, i, ops[q]);
#pragma unroll 1
    for (int s = 0; s < 16; s += NSET) {
#pragma unroll
      for (int u = 0; u < NSET; ++u) {
        const int sn = s + u + NSET - 1;
        if (sn < 16) rw_load<E>(cb + sn * 384, g, i, ops[(u + NSET - 1) % NSET]);
        const float y0 = rw_step<E>(S, ops[u]);
#pragma unroll
        for (int q = 0; q < NY; ++q) yk[q] = (s + u == q * LR + g) ? y0 : yk[q];
      }
    }
#pragma unroll
    for (int q = 0; q < NY; ++q) { const int step = ck * 16 + q * LR + g; const int t = d ? T - 1 - step : step; yout[(size_t)t * 256] = yk[q]; }
  };
  __builtin_amdgcn_s_setprio(2);
  RW_GLOAD(rfA, rbA, 0); RW_SSTORE(rfA, rbA, 0); RW_GLOAD(rfA, rbA, 1); RW_GLOAD(rfB, rbB, 2);
  __syncthreads();
#pragma unroll 1
  for (int ck = 0; ck < nch; ck += 2) {
    compute(ck);
    RW_SSTORE(rfA, rbA, 1);
    if (ck + 3 < nch) RW_GLOAD(rfA, rbA, ck + 3);
    lds_barrier();
    compute(ck + 1);
    if (ck + 2 < nch) RW_SSTORE(rfB, rbB, 0);
    if (ck + 4 < nch) RW_GLOAD(rfB, rbB, ck + 4);
    lds_barrier();
  }
  __builtin_amdgcn_s_setprio(0);
#undef RW_GLOAD
#undef RW_SSTORE
  if (seq < 16) {
    float* so = p.out + O_NSR + ((((size_t)seq * 2 + l) * 2 + d) * 4 + h) * 4096 + i * 64;
#pragma unroll
    for (int m = 0; m < NM; ++m) *(f32x4*)(so + 4 * (g + LR * m)) = (f32x4){S[2 * m].x, S[2 * m].y, S[2 * m + 1].x, S[2 * m + 1].y};
  }
}

__device__ __forceinline__ void lru_scan(const Params& p, int l, int item) {
  const int c = tid_opaque();
  int seq, d;
  if (item < 8) { seq = 16 + (item >> 1); d = item & 1; } else { seq = (item - 8) >> 1; d = item & 1; }
  const int T = seq < 16 ? 256 : 1024, tokb = seq < 16 ? seq * 256 : 4096 + (seq - 16) * 1024;
  const int NC = T >> 4;
  float h = seq >= 16 ? p.st_lru[(((seq - 16) * 2 + l) * 2 + d) * 256 + c] : 0.f;
  const float* la = p.LA + (size_t)d * NTOK * 256 + c; const float* lu = p.LU + (size_t)d * NTOK * 256 + c;
  float* lc = p.LC + (size_t)d * 512 * 256 + (size_t)(tokb >> 4) * 256 + c;
  for (int k0 = 0; k0 < NC; k0 += 8) {
    float a[8], u[8];
#pragma unroll
    for (int q = 0; q < 8; ++q) { const int k = d ? NC - 1 - (k0 + q) : k0 + q; const size_t idx = (size_t)(tokb + k * 16 + (d ? 0 : 15)) * 256; a[q] = la[idx]; u[q] = lu[idx]; }
#pragma unroll
    for (int q = 0; q < 8; ++q) { const int k = d ? NC - 1 - (k0 + q) : k0 + q; lc[(size_t)k * 256] = h; h = a[q] * h + u[q]; }
  }
  if (seq < 16) p.out[O_NSL + ((seq * 2 + l) * 2 + d) * 256 + c] = h;
}

template <bool DIFF>
__device__ __forceinline__ void attn_item(const Params& p, int l, bool sample, int sq  , int h, int qt, unsigned char* smem) {
  constexpr int NS = DIFF ? 2 : 1;
  const int tid = tid_opaque();
  const int lane = tid & 63, wave = tid >> 6, r16 = lane & 15, quad = lane >> 4;
  const int T = sample ? 1024 : 256;
  const int tokb = sample ? 4096 + sq * 1024 : sq * 256;
  const int q0 = qt * 64 + wave * 16;
  const int qpos = q0 + r16;
  const int kvh = DIFF ? h : (h >> 1);
  bf16x8 qf[2];
  {
    const bf16_t* qp;
    if (sample) qp = (DIFF ? p.QDR : p.QBR) + (size_t)(sq * 1024 + qpos) * 256 + h * 64;
    else qp = p.P + (size_t)(tokb + qpos) * PW + (DIFF ? 2432 : 1152) + h * 64;
    qf[0] = *(const bf16x8*)(qp + quad * 8); qf[1] = *(const bf16x8*)(qp + 32 + quad * 8);
  }
  float m[2] = {-3.0e38f, -3.0e38f}, lsum[2] = {0.f, 0.f};
  f32x4 o[2][4];
#pragma unroll
  for (int a = 0; a < 2; ++a)
#pragma unroll
    for (int b = 0; b < 4; ++b) o[a][b] = (f32x4){0.f, 0.f, 0.f, 0.f};
  const float scale_log2 = (DIFF ? 0.17677669529663687f : 0.125f) * 1.4426950408889634f;
  const int nctx = sample ? 4 : 0;
  const bf16_t* Kc = nullptr; const bf16_t* Vc = nullptr; int ksc = 0;
  if (sample) {
    const int bl = sq * 2 + l;
    if (DIFF) { Kc = p.CDK + (size_t)bl * 256 * 256 + h * 64; ksc = 256; Vc = p.CDVT + (size_t)bl * 256 * 256 + (size_t)(h * 64) * 256; }
    else { Kc = p.CWK + (size_t)bl * 256 * 128 + kvh * 64; ksc = 128; Vc = p.CWVT + (size_t)bl * 128 * 256 + (size_t)(kvh * 64) * 256; }
  }
  const bf16_t* Kl; const bf16_t* Vl; int ksl;
  if (sample) {
    if (DIFF) { Kl = p.KDR + (size_t)(sq * 1024) * 256 + h * 64; ksl = 256; Vl = p.VDT + (size_t)tokb * 256 + (size_t)(h * 64) * T; }
    else { Kl = p.KBR + (size_t)(sq * 1024) * 128 + kvh * 64; ksl = 128; Vl = p.VBT + (size_t)tokb * 128 + (size_t)(kvh * 64) * T; }
  } else {
    if (DIFF) { Kl = p.P + (size_t)tokb * PW + 2688 + h * 64; ksl = PW; Vl = p.VDT + (size_t)tokb * 256 + (size_t)(h * 64) * T; }
    else { Kl = p.P + (size_t)tokb * PW + 1408 + kvh * 64; ksl = PW; Vl = p.VBT + (size_t)tokb * 128 + (size_t)(kvh * 64) * T; }
  }
  int kb0 = 0, kb1 = T; bool lmask = false;
  if (sample && !DIFF) { const int qb = qt * 64; kb0 = qb - 128 < 0 ? 0 : qb - 128; kb1 = qb + 192 > T ? T : qb + 192; lmask = true; }
  const int nt = nctx + ((kb1 - kb0) >> 6);
  bf16_t* const lds = (bf16_t*)smem;
  const int lrow = tid >> 2, lch = (tid & 3) * 16;
  auto gsrc = [&](int t, const bf16_t*& kp, const bf16_t*& vp) {
    if (t < nctx) { kp = Kc + (size_t)(t * 64 + lrow) * ksc + lch; vp = Vc + (size_t)lrow * 256 + t * 64 + lch; }
    else { const int kb = kb0 + (t - nctx) * 64; kp = Kl + (size_t)(kb + lrow) * ksl + lch; vp = Vl + (size_t)lrow * T + kb + lch; }
  };
  u32x4 rk0, rk1, rv0, rv1;
  { const bf16_t* kp; const bf16_t* vp; gsrc(0, kp, vp); rk0 = *(const u32x4*)kp; rk1 = *(const u32x4*)(kp + 8); rv0 = *(const u32x4*)vp; rv1 = *(const u32x4*)(vp + 8); }
  __syncthreads();
  { bf16_t* d = lds + lrow * 72 + lch; *(u32x4*)d = rk0; *(u32x4*)(d + 8) = rk1; *(u32x4*)(d + 64 * 72) = rv0; *(u32x4*)(d + 64 * 72 + 8) = rv1; }
  __syncthreads();
  const f32x4 z4 = {0.f, 0.f, 0.f, 0.f};
  const int krow = 8 * (r16 >> 2) + (r16 & 3);
#pragma unroll 1
  for (int t = 0; t < nt; ++t) {
    const bool isctx = t < nctx;
    const bool masked = !isctx && lmask;
    const int kpos0 = kb0 + (t - nctx) * 64;
    if (t + 1 < nt) { const bf16_t* kp; const bf16_t* vp; gsrc(t + 1, kp, vp); rk0 = *(const u32x4*)kp; rk1 = *(const u32x4*)(kp + 8); rv0 = *(const u32x4*)vp; rv1 = *(const u32x4*)(vp + 8); }
    const bf16_t* Ks = lds + (t & 1) * (2 * 64 * 72);
    const bf16_t* Vs = Ks + 64 * 72;
    bf16x8 pf[NS][2];
#pragma unroll
    for (int st = 0; st < NS; ++st) {
      f32x4 sc[4];
#pragma unroll
      for (int kt = 0; kt < 4; ++kt) {
        const bf16_t* kr = Ks + (32 * (kt >> 1) + 4 * (kt & 1) + krow) * 72 + quad * 8;
        if (!DIFF) { sc[kt] = mfma16(*(const bf16x8*)kr, qf[0], z4); sc[kt] = mfma16(*(const bf16x8*)(kr + 32), qf[1], sc[kt]); }
        else sc[kt] = mfma16(*(const bf16x8*)(kr + 32 * st), qf[st], z4);
      }
      float mx = -3.0e38f;
#pragma unroll
      for (int kt = 0; kt < 4; ++kt)
#pragma unroll
        for (int r = 0; r < 4; ++r) {
          float x = sc[kt][r] * scale_log2;
          if (masked) { const int kp = kpos0 + 32 * (kt >> 1) + 8 * quad + 4 * (kt & 1) + r; const int dd = kp - qpos; if (dd > 128 || dd < -128) x = -1.0e30f; }
          sc[kt][r] = x; mx = fmaxf(mx, x);
        }
      mx = fmaxf(mx, __shfl_xor(mx, 16)); mx = fmaxf(mx, __shfl_xor(mx, 32));
      const float mnew = fmaxf(m[st], mx);
      const float alpha = __builtin_amdgcn_exp2f(m[st] - mnew);
      m[st] = mnew;
      float ps = 0.f;
#pragma unroll
      for (int kt = 0; kt < 4; ++kt)
#pragma unroll
        for (int r = 0; r < 4; ++r) { const float e = __builtin_amdgcn_exp2f(sc[kt][r] - mnew); sc[kt][r] = e; ps += e; }
      lsum[st] = lsum[st] * alpha + ps;
#pragma unroll
      for (int dt = 0; dt < 4; ++dt) o[st][dt] *= alpha;
#pragma unroll
      for (int s2 = 0; s2 < 2; ++s2) {
        u32x4 tt;
        tt.x = pack2(sc[2 * s2][0], sc[2 * s2][1]); tt.y = pack2(sc[2 * s2][2], sc[2 * s2][3]);
        tt.z = pack2(sc[2 * s2 + 1][0], sc[2 * s2 + 1][1]); tt.w = pack2(sc[2 * s2 + 1][2], sc[2 * s2 + 1][3]);
        pf[st][s2] = __builtin_bit_cast(bf16x8, tt);
      }
    }
#pragma unroll
    for (int dt = 0; dt < 4; ++dt)
#pragma unroll
      for (int s2 = 0; s2 < 2; ++s2) {
        const bf16x8 vf = *(const bf16x8*)(Vs + (dt * 16 + r16) * 72 + 32 * s2 + 8 * quad);
#pragma unroll
        for (int st = 0; st < NS; ++st) o[st][dt] = mfma16(vf, pf[st][s2], o[st][dt]);
      }
    if (t + 1 < nt) {
      bf16_t* d = lds + ((t + 1) & 1) * (2 * 64 * 72) + lrow * 72 + lch;
      *(u32x4*)d = rk0; *(u32x4*)(d + 8) = rk1; *(u32x4*)(d + 64 * 72) = rv0; *(u32x4*)(d + 64 * 72 + 8) = rv1;
    }
    __syncthreads();
  }
  float l0 = lsum[0]; l0 += __shfl_xor(l0, 16); l0 += __shfl_xor(l0, 32);
  const int tok = tokb + qpos;
  if (!DIFF) {
    l0 += __builtin_amdgcn_exp2f(p.win_sink[l * 4 + h] * 1.4426950408889634f - m[0]);
    const float inv = 1.0f / l0;
#pragma unroll
    for (int dt = 0; dt < 4; ++dt) {
      f32x4 v = o[0][dt] * inv;
      *(f32x4*)(p.OB + (size_t)tok * 256 + h * 64 + dt * 16 + quad * 4) = v;
    }
  } else {
    float l1 = lsum[1]; l1 += __shfl_xor(l1, 16); l1 += __shfl_xor(l1, 32);
    float d1 = 0.f, d2 = 0.f;
    const float* dl = p.diff_lam + l * 128;
    for (int j = 0; j < 32; ++j) { d1 += dl[j] * dl[32 + j]; d2 += dl[64 + j] * dl[96 + j]; }
    const float lam_init = 0.8f - 0.6f * expf(-0.3f * (float)l);
    const float lam = expf(d1) - expf(d2) + lam_init;
    const float i0 = 1.0f / l0, i1 = lam / l1;
    f32x4 v[4]; float ss = 0.f;
#pragma unroll
    for (int dt = 0; dt < 4; ++dt) { v[dt] = o[0][dt] * i0 - o[1][dt] * i1; ss += v[dt][0] * v[dt][0] + v[dt][1] * v[dt][1] + v[dt][2] * v[dt][2] + v[dt][3] * v[dt][3]; }
    ss += __shfl_xor(ss, 16); ss += __shfl_xor(ss, 32);
    const float rstd = rsqrtf(ss * (1.0f / 64.0f) + 1e-6f) * (1.0f - lam_init);
#pragma unroll
    for (int dt = 0; dt < 4; ++dt) {
      const f32x4 g = *(const f32x4*)(p.diff_g + l * 64 + dt * 16 + quad * 4);
      *(f32x4*)(p.OD + (size_t)tok * 256 + h * 64 + dt * 16 + quad * 4) = v[dt] * rstd * g;
    }
  }
}

__device__ __forceinline__ void mix_other(const Params& p, int l, int it, unsigned char* smem) {
  if (it < 256) { attn_item<true>(p, l, true, it >> 6, (it >> 4) & 3, it & 15, smem); return; }
  it -= 256;
  if (it < 40) { lru_scan(p, l, it); return; }
  it -= 40;
  if (it < 256) { attn_item<false>(p, l, true, it >> 6, (it >> 4) & 3, it & 15, smem); return; }
  it -= 256;
  if (it < 256) { attn_item<true>(p, l, false, it >> 4, (it >> 2) & 3, it & 3, smem); return; }
  it -= 256;
  attn_item<false>(p, l, false, it >> 4, (it >> 2) & 3, it & 3, smem);
}

#define ES 4
#define EP 8
__device__ __forceinline__ void mix_item(const Params& p, int l, int it, unsigned char* smem) {
  constexpr int NPS = 16 / ES, NPP = 16 / EP, NS = 32 * NPS, NP = 128 * NPP;
  if (it < NS) {
#pragma unroll 1
    for (int r = 0; r < p.rep2[0]; ++r) rwkv_chain<ES>(p, l, it / NPS, it % NPS, smem);
    return;
  }
  it -= NS;
  if (it < NP) {
#pragma unroll 1
    for (int r = 0; r < p.rep2[1]; ++r) rwkv_chain<EP>(p, l, 32 + it / NPP, it % NPP, smem);
    return;
  }
  it -= NP;
#pragma unroll 1
  for (int r = 0; r < p.rep2[2]; ++r) mix_other(p, l, it, smem);
}
__device__ __forceinline__ void phase_mix(const Params& p, int l, unsigned char* smem) {
  constexpr int NS = 32 * (16 / ES), NP = 128 * (16 / EP), NALL = NS + NP + 1064;
  const int G = gridDim.x, b = blockIdx.x;
  if (G >= 2 * NS) {
    if (b < NS) mix_item(p, l, b, smem);
    else {
#pragma unroll 1
      for (int it = NS + (b - NS); it < NALL; it += G - NS) mix_item(p, l, it, smem);
    }
  } else {
#pragma unroll 1
    for (int it = b; it < NALL; it += G) mix_item(p, l, it, smem);
  }
}

DI float sum16(float v) { v += __shfl_xor(v, 1); v += __shfl_xor(v, 2); v += __shfl_xor(v, 4); v += __shfl_xor(v, 8); return v; }

__device__ __forceinline__ void phase_post(const Params& p, int l) {
  const int tid0 = tid_opaque();
  const int lane = tid0 & 63, wave = tid0 >> 6;
  const int c = lane * 4;
#pragma unroll 1
  for (int tok = blockIdx.x * 4 + wave; tok < NTOK; tok += gridDim.x * 4) {
    const bf16_t* pr = p.P + (size_t)tok * PW;
    const f32x4 ya0 = *(const f32x4*)(p.YA + (size_t)tok * 256 + c), ya1 = *(const f32x4*)(p.YA + ((size_t)NTOK + tok) * 256 + c);
    const u32x2 r_ = *(const u32x2*)(pr + c), k_ = *(const u32x2*)(pr + 256 + c), v_ = *(const u32x2*)(pr + 512 + c), ga_ = *(const u32x2*)(pr + 896 + c);
    const u32x2 gb_ = *(const u32x2*)(pr + 1664 + c), gc_ = *(const u32x2*)(pr + 2176 + c), gd_ = *(const u32x2*)(pr + 3200 + c);
    const f32x4 rk = *(const f32x4*)(p.rw_rk + l * 256 + c), gg = *(const f32x4*)(p.rw_gng + l * 256 + c), gbias = *(const f32x4*)(p.rw_gnb + l * 256 + c);
    const f32x4 ob = *(const f32x4*)(p.OB + (size_t)tok * 256 + c), od = *(const f32x4*)(p.OD + (size_t)tok * 256 + c);
    const f32x4 h0 = *(const f32x4*)(p.LU + (size_t)tok * 256 + c), h1 = *(const f32x4*)(p.LU + ((size_t)NTOK + tok) * 256 + c);
    const f32x4 A0 = *(const f32x4*)(p.LA + (size_t)tok * 256 + c), A1 = *(const f32x4*)(p.LA + ((size_t)NTOK + tok) * 256 + c);
    const f32x4 c0 = *(const f32x4*)(p.LC + (size_t)(tok >> 4) * 256 + c), c1 = *(const f32x4*)(p.LC + ((size_t)512 + (tok >> 4)) * 256 + c);
    __builtin_amdgcn_sched_barrier(0);
    float out[4];
    {
      const f32x4 y = ya0 + ya1;
      const float mu = sum16(y[0] + y[1] + y[2] + y[3]) * (1.0f / 64.0f);
      const f32x4 dv = y - mu;
      const float var = sum16(dv[0] * dv[0] + dv[1] * dv[1] + dv[2] * dv[2] + dv[3] * dv[3]) * (1.0f / 64.0f);
      const float rstd = rsqrtf(var + 64e-5f);
      const float r[4] = {bflo(r_.x), bfhi(r_.x), bflo(r_.y), bfhi(r_.y)}, k[4] = {bflo(k_.x), bfhi(k_.x), bflo(k_.y), bfhi(k_.y)};
      const float v[4] = {bflo(v_.x), bfhi(v_.x), bflo(v_.y), bfhi(v_.y)}, g[4] = {bflo(ga_.x), bfhi(ga_.x), bflo(ga_.y), bfhi(ga_.y)};
      const float bs = sum16(r[0] * k[0] * rk[0] + r[1] * k[1] * rk[1] + r[2] * k[2] * rk[2] + r[3] * k[3] * rk[3]);
#pragma unroll
      for (int q = 0; q < 4; ++q) out[q] = (dv[q] * rstd * gg[q] + gbias[q] + bs * v[q]) * siluf_(g[q]);
      st4bf(p.H + (size_t)tok * LDK + c, out);
    }
    {
      const float g[4] = {bflo(gb_.x), bfhi(gb_.x), bflo(gb_.y), bfhi(gb_.y)};
#pragma unroll
      for (int q = 0; q < 4; ++q) out[q] = ob[q] * siluf_(g[q]);
      st4bf(p.H + (size_t)tok * LDK + 256 + c, out);
    }
    {
      const float g[4] = {bflo(gc_.x), bfhi(gc_.x), bflo(gc_.y), bfhi(gc_.y)};
#pragma unroll
      for (int q = 0; q < 4; ++q) out[q] = (h0[q] + A0[q] * c0[q] + h1[q] + A1[q] * c1[q]) * siluf_(g[q]);
      st4bf(p.H + (size_t)tok * LDK + 512 + c, out);
    }
    {
      const float g[4] = {bflo(gd_.x), bfhi(gd_.x), bflo(gd_.y), bfhi(gd_.y)};
#pragma unroll
      for (int q = 0; q < 4; ++q) out[q] = od[q] * siluf_(g[q]);
      st4bf(p.H + (size_t)tok * LDK + 768 + c, out);
    }
  }
}

__global__ void __launch_bounds__(256, 2) fwd_megakernel(Params p) {
  __shared__ __attribute__((aligned(16))) unsigned char smem[49152];
  __shared__ uint4 xb_words;
  if (threadIdx.x == 0) xb_words = make_uint4(0u, 0u, 0u, 0u);
  __syncthreads();
  XcdBarrier xb = xcd_barrier_post(p.bar, (volatile LAS unsigned*)&xb_words);
  if (threadIdx.x == 0) ((volatile LAS unsigned*)&xb_words)[3] = xb_add(&p.bar[xb_xcc_id()], 1u);
#pragma unroll 1
  for (int r = 0; r < p.rep[0]; ++r) phase_prologue(p, smem);
  xcd_barrier(xb);
  if (threadIdx.x == 0) {
    const unsigned x = xb_xcc_id(); unsigned pre = 0;
    for (unsigned j = 0; j < 16; ++j) { const unsigned c = xb_ld(&p.bar[XB_XCNT(j)]); pre += (j < x) ? c : 0u; }
    ((volatile LAS unsigned*)&xb_words)[2] = pre + ((volatile LAS unsigned*)&xb_words)[3];
  }
  __syncthreads();
#pragma unroll 1
  for (int r = 0; r < p.rep[1]; ++r) phase_norm(p, 0);
  xcd_barrier(xb);
#pragma unroll 1
  for (int l = 0; l < 2; ++l) {
#pragma unroll 1
    for (int r = 0; r < p.rep[2]; ++r) phase_gemm<0>(p, l, smem, (int)((volatile LAS unsigned*)&xb_words)[2]);
    xcd_barrier(xb);
#pragma unroll 1
    for (int r = 0; r < p.rep[3]; ++r) phase_pre(p, l, smem);
    xcd_barrier(xb);
#pragma unroll 1
    for (int r = 0; r < p.rep[4]; ++r) phase_mix(p, l, smem);
    xcd_barrier(xb);
#pragma unroll 1
    for (int r = 0; r < p.rep[5]; ++r) phase_post(p, l);
    xcd_barrier(xb);
#pragma unroll 1
    for (int r = 0; r < p.rep[6]; ++r) phase_gemm<1>(p, l, smem, (int)((volatile LAS unsigned*)&xb_words)[2]);
    xcd_barrier(xb);
    phase_norm(p, l + 1);
    if (l == 0) xcd_barrier(xb);
#pragma unroll 1
    for (int r = 1; r < p.rep[7]; ++r) xcd_barrier(xb);
  }
}

extern "C" void kernel_launch(void* const* d_in, const int* in_sizes, int n_in, void* d_out, int out_size, void* d_ws, size_t ws_size, hipStream_t stream) {
  static int grid_blocks = 0;
  if (!grid_blocks) {
    int dev = 0, cus = 0, per_cu = 0;
    hipGetDevice(&dev);
    hipDeviceGetAttribute(&cus, hipDeviceAttributeMultiprocessorCount, dev);
    hipOccupancyMaxActiveBlocksPerMultiprocessor(&per_cu, (const void*)fwd_megakernel, 256, 0);
    if (per_cu < 1) per_cu = 1;
    if (per_cu > 2) per_cu = 2;
    grid_blocks = cus * per_cu;
  }
  Params p{};
  const float** f = (const float**)&p;
  for (int i = 0; i < 35; ++i) f[i] = (const float*)d_in[i];
  p.out = (float*)d_out;
  size_t off = 0;
  auto take = [&](size_t bytes) { void* r = (char*)d_ws + off; off += (bytes + 255) & ~(size_t)255; return r; };
  p.MOD = (float*)take(2 * 5 * 3072 * 4);
  p.WINT = (bf16_t*)take((size_t)2 * PW * LDK * 2);
  p.WOUTT = (bf16_t*)take((size_t)2 * 1024 * LDK * 2);
  p.CWK = (bf16_t*)take((size_t)4 * 2 * 256 * 128 * 2);
  p.CWVT = (bf16_t*)take((size_t)4 * 2 * 256 * 128 * 2);
  p.CDK = (bf16_t*)take((size_t)4 * 2 * 256 * 256 * 2);
  p.CDVT = (bf16_t*)take((size_t)4 * 2 * 256 * 256 * 2);
  p.H = (bf16_t*)take((size_t)NTOK * LDK * 2);
  p.P = (bf16_t*)take((size_t)NTOK * PW * 2);
  p.NKK = (float*)take((size_t)NTOK * 256 * 4);
  p.AW = (float*)take((size_t)2 * NTOK * 256 * 4);
  p.AB = (float*)take((size_t)2 * NTOK * 256 * 4);
  p.AKD = (float*)take((size_t)2 * NTOK * 256 * 4);
  p.Y2 = p.NKK;
  p.YA = (float*)take((size_t)2 * NTOK * 256 * 4);
  p.LA = (float*)take((size_t)2 * NTOK * 256 * 4);
  p.LU = (float*)take((size_t)2 * NTOK * 256 * 4);
  p.QBR = (bf16_t*)take((size_t)4096 * 256 * 2);
  p.KBR = (bf16_t*)take((size_t)4096 * 128 * 2);
  p.QDR = (bf16_t*)take((size_t)4096 * 256 * 2);
  p.KDR = (bf16_t*)take((size_t)4096 * 256 * 2);
  p.VBT = (bf16_t*)take((size_t)NTOK * 128 * 2);
  p.VDT = (bf16_t*)take((size_t)NTOK * 256 * 2);
  p.OB = (float*)take((size_t)NTOK * 256 * 4);
  p.OD = (float*)take((size_t)NTOK * 256 * 4);
  p.LC = (float*)take((size_t)2 * 512 * 256 * 4);
  p.bar = (unsigned*)take((size_t)XCD_BAR_WORDS * 4);
  p.RWT = (bf16_t*)take((size_t)2 * 4 * 256 * 64 * 2);
  p.LWT = (bf16_t*)take((size_t)2 * 4 * 4 * 64 * 64 * 2);
  if (off > ws_size) { fprintf(stderr, "workspace too small: need %zu have %zu\n", off, ws_size); return; }
  static const int REPS[8] = {1, 1, 1, 1, 1, 1, 1, 1};
  for (int i = 0; i < 8; ++i) p.rep[i] = REPS[i];
  static const int REPS2[8] = {1, 1, 1, 1, 1, 1, 1, 1};
  for (int i = 0; i < 8; ++i) p.rep2[i] = REPS2[i];
  hipMemsetAsync(p.bar, 0, (size_t)XCD_BAR_WORDS * 4, stream);
  void* args[] = {&p};
  hipError_t e = hipLaunchCooperativeKernel((const void*)fwd_megakernel, dim3(grid_blocks), dim3(256), args, 0, stream);
  if (e != hipSuccess) fprintf(stderr, "cooperative launch failed: %s (grid %d)\n", hipGetErrorString(e), grid_blocks);
}
```

```cpp
#include <hip/hip_runtime.h>
#include <cstdio>
#include <cstdint>

typedef unsigned short bf16_t;
typedef short bf16x8 __attribute__((ext_vector_type(8)));
typedef float f32x4 __attribute__((ext_vector_type(4)));
typedef unsigned u32x4 __attribute__((ext_vector_type(4)));
typedef unsigned u32x2 __attribute__((ext_vector_type(2)));
#define DI __device__ __forceinline__

#define O_YP 0
#define O_NWK 8388608
#define O_NWV 9437184
#define O_NDK 10485760
#define O_NDV 12582912
#define O_NSR 14680064
#define O_NSL 15728640

#define NTOK 8192
#define PW 3456
#define LDK 1088

struct Params {
  const float *x_prompt, *x_sample, *c, *cwk, *cwv, *cdk, *cdv, *st_rwkv, *st_lru, *c_ctx, *w_mod, *b_mod, *g_pre, *g_post, *w_in, *w_out;
  const float *rw_w0, *rw_wup, *rw_a0, *rw_aup, *rw_kk, *rw_ka, *rw_rk, *rw_gng, *rw_gnb, *win_sink;
  const float *lru_cw, *lru_cb, *lru_wa, *lru_ba, *lru_wx, *lru_bx, *lru_lam, *diff_lam, *diff_g;
  float* out;
  float* MOD; bf16_t* WINT; bf16_t* WOUTT; bf16_t* CWK; bf16_t* CWVT; bf16_t* CDK; bf16_t* CDVT;
  bf16_t* H; bf16_t* P; float* NKK; float* AW; float* AB; float* AKD; float* YA; float* LA; float* LU;
  bf16_t* QBR; bf16_t* KBR; bf16_t* QDR; bf16_t* KDR; bf16_t* VBT; bf16_t* VDT; float* OB; float* OD; float* Y2; float* LC; unsigned* bar; bf16_t* RWT; bf16_t* LWT;
  int rep[8];
  int rep2[8];
};

DI void lds_barrier() { asm volatile("s_waitcnt lgkmcnt(0)\n\ts_barrier" ::: "memory"); }
DI int tid_opaque() { int t = threadIdx.x; asm volatile("" : "+v"(t)); return t; }
DI bf16_t f2bf(float x) { unsigned u = __float_as_uint(x); u += 0x7fffu + ((u >> 16) & 1u); return (bf16_t)(u >> 16); }
DI float bf2f(bf16_t b) { return __uint_as_float(((unsigned)b) << 16); }
typedef float f32x2_ __attribute__((ext_vector_type(2)));
typedef __bf16 bf16x2_t __attribute__((ext_vector_type(2)));
DI unsigned pack2(float a, float b) { f32x2_ v = {a, b}; bf16x2_t r = __builtin_convertvector(v, bf16x2_t); return __builtin_bit_cast(unsigned, r); }
DI float bflo(unsigned u) { return __uint_as_float(u << 16); }
DI float bfhi(unsigned u) { return __uint_as_float(u & 0xffff0000u); }
DI void ld4bf(const bf16_t* q, float (&o)[4]) { u32x2 u = *(const u32x2*)q; o[0] = bflo(u.x); o[1] = bfhi(u.x); o[2] = bflo(u.y); o[3] = bfhi(u.y); }
DI void st4bf(bf16_t* q, const float (&v)[4]) { u32x2 u; u.x = pack2(v[0], v[1]); u.y = pack2(v[2], v[3]); *(u32x2*)q = u; }
DI float wave_sum(float v) { for (int o = 32; o > 0; o >>= 1) v += __shfl_xor(v, o); return v; }
DI float sigmoidf_(float x) { return 1.0f / (1.0f + expf(-x)); }
DI float fsigmoid(float x) { return __builtin_amdgcn_rcpf(1.0f + __expf(-x)); }
DI float wave_sum_dpp(float v) {
  v += __builtin_bit_cast(float, __builtin_amdgcn_update_dpp(0, __builtin_bit_cast(int, v), 0xB1, 0xf, 0xf, true));
  v += __builtin_bit_cast(float, __builtin_amdgcn_update_dpp(0, __builtin_bit_cast(int, v), 0x4E, 0xf, 0xf, true));
  v += __builtin_bit_cast(float, __builtin_amdgcn_update_dpp(0, __builtin_bit_cast(int, v), 0x141, 0xf, 0xf, true));
  v += __builtin_bit_cast(float, __builtin_amdgcn_update_dpp(0, __builtin_bit_cast(int, v), 0x140, 0xf, 0xf, true));
  const int iv = __builtin_bit_cast(int, v);
  return __builtin_bit_cast(float, __builtin_amdgcn_readlane(iv, 0)) + __builtin_bit_cast(float, __builtin_amdgcn_readlane(iv, 16)) + __builtin_bit_cast(float, __builtin_amdgcn_readlane(iv, 32)) + __builtin_bit_cast(float, __builtin_amdgcn_readlane(iv, 48));
}
DI float siluf_(float x) { return x * __builtin_amdgcn_rcpf(1.0f + __expf(-x)); }
DI float softplusf_(float z) { return z > 20.f ? z : log1pf(expf(z)); }
DI f32x4 mfma16(bf16x8 a, bf16x8 b, f32x4 c) { return __builtin_amdgcn_mfma_f32_16x16x32_bf16(a, b, c, 0, 0, 0); }
DI float quad_sum(float v) {
  v += __builtin_bit_cast(float, __builtin_amdgcn_update_dpp(0, __builtin_bit_cast(int, v), 0xB1, 0xf, 0xf, true));
  v += __builtin_bit_cast(float, __builtin_amdgcn_update_dpp(0, __builtin_bit_cast(int, v), 0x4E, 0xf, 0xf, true));
  return v;
}


#define XB_TMO      128
#define XB_XCNT(j)  (256  + 64 * (j))
#define XB_XSUB(j)  (1280 + 64 * (j))
#define XB_XGEN(j)  (2304 + 64 * (j))
#define XB_TOP      3328
#define XB_TOPGEN   3392
#define XCD_BAR_WORDS 3456
#define XB_SPIN_CAP (1u << 18)
#define LAS __attribute__((address_space(3)))
DI unsigned xb_ld(unsigned* p)              { return __hip_atomic_load(p, __ATOMIC_RELAXED, __HIP_MEMORY_SCOPE_AGENT); }
DI unsigned xb_add(unsigned* p, unsigned v) { return __hip_atomic_fetch_add(p, v, __ATOMIC_RELAXED, __HIP_MEMORY_SCOPE_AGENT); }
DI unsigned xb_xcc_id() { return (unsigned)__builtin_amdgcn_s_getreg((3 << 11) | 20) & 0xFu; }
#define XB_SPIN(cond, bar) do { unsigned _sp = 0; while (cond) { __builtin_amdgcn_s_sleep(1); \
    if ((++_sp & 255u) == 0u) { if (xb_ld(&(bar)[XB_TMO])) break; if (_sp > XB_SPIN_CAP) { atomicAdd(&(bar)[XB_TMO], 1u); break; } } } } while (0)
struct XcdBarrier { unsigned* bar; unsigned x; volatile LAS unsigned* st; };
DI XcdBarrier xcd_barrier_post(unsigned* bar, volatile LAS unsigned* st) {
    XcdBarrier b; b.bar = bar; b.x = xb_xcc_id(); b.st = st;
    if (threadIdx.x == 0) (void)xb_add(&bar[XB_XCNT(b.x)], 1u);
    return b;
}
DI void xcd_barrier_complete(unsigned* bar, unsigned x, unsigned& nloc, unsigned& nx) {
    const unsigned G = gridDim.x * gridDim.y * gridDim.z;
    unsigned sum, cnt, mine, sp = 0u;
    for (;;) {
        sum = 0u; cnt = 0u; mine = 0u;
#pragma unroll
        for (unsigned j = 0; j < 16; ++j) { const unsigned c = xb_ld(&bar[XB_XCNT(j)]); sum += c; cnt += (c > 0u) ? 1u : 0u; mine = (j == x) ? c : mine; }
        if (sum == G) break;
        __builtin_amdgcn_s_sleep(1);
        if ((++sp & 255u) == 0u) { if (xb_ld(&bar[XB_TMO])) break; if (sp > XB_SPIN_CAP) { atomicAdd(&bar[XB_TMO], 1u); break; } }
    }
    nloc = mine > 0u ? mine : 1u; nx = cnt > 0u ? cnt : 1u;
}
DI void xcd_barrier(const XcdBarrier& b) {
    asm volatile("s_waitcnt vmcnt(0)" ::: "memory");
    __syncthreads();
    if (threadIdx.x == 0) {
        unsigned* bar = b.bar;
        unsigned bx = xb_xcc_id();
        __builtin_amdgcn_s_waitcnt(0);
        unsigned nloc = b.st[0], nx = b.st[1];
        if (nloc == 0u) { xcd_barrier_complete(bar, bx, nloc, nx); b.st[0] = nloc; b.st[1] = nx; }
        const unsigned old = xb_add(&bar[XB_XSUB(bx)], 1u);
        const unsigned gen = old / nloc;
        if (old + 1u == (gen + 1u) * nloc) {
            __builtin_amdgcn_fence(__ATOMIC_RELEASE, "agent");
            asm volatile("s_waitcnt vmcnt(0)" ::: "memory");
            const unsigned og = xb_add(&bar[XB_TOP], 1u);
            const unsigned tg = og / nx;
            if (og + 1u == (tg + 1u) * nx) xb_add(&bar[XB_TOPGEN], 1u);
            else XB_SPIN(xb_ld(&bar[XB_TOPGEN]) == tg, bar);
            __builtin_amdgcn_fence(__ATOMIC_ACQUIRE, "agent");
            xb_add(&bar[XB_XGEN(bx)], 1u);
            asm volatile("s_waitcnt vmcnt(0)" ::: "memory");
        } else {
            XB_SPIN(xb_ld(&bar[XB_XGEN(bx)]) == gen, bar);
            __builtin_amdgcn_fence(__ATOMIC_ACQUIRE, "agent");
            asm volatile("s_waitcnt vmcnt(0)" ::: "memory");
        }
    }
    __syncthreads();
}

template <typename T> DI float ldval(const T* p);
template <> DI float ldval<float>(const float* p) { return *p; }
template <> DI float ldval<bf16_t>(const bf16_t* p) { return bf2f(*p); }
template <typename T>
DI void transpose_tile(const T* src, int src_ld, bf16_t* dst, int dst_ld, float* lds) {
  const int tid = tid_opaque();
#pragma unroll 8
  for (int i = 0; i < 16; ++i) { int r = (tid >> 6) + 4 * i, c = tid & 63; lds[r * 65 + c] = ldval<T>(src + (size_t)r * src_ld + c); }
  __syncthreads();
#pragma unroll 4
  for (int i = 0; i < 16; ++i) { int c = (tid >> 6) + 4 * i, r = tid & 63; dst[(size_t)c * dst_ld + r] = f2bf(lds[r * 65 + c]); }
  __syncthreads();
}

__device__ __forceinline__ void phase_prologue(const Params& p, unsigned char* smem) {
  float* lds = (float*)smem;
  const int n0 = 1728, n1 = n0 + 512, n2 = n1 + 192, n3 = n2 + 64, n4 = n3 + 128, n5 = n4 + 192, n6 = n5 + 32, n7 = n6 + 32;
#pragma unroll 1
  for (int it = blockIdx.x; it < n7; it += gridDim.x) {
    const int tid = tid_opaque();
    if (it < n0) {
      int l = it / 864, r = it % 864, kt = r / 54, nt = r % 54;
      transpose_tile<float>(p.w_in + (size_t)l * 1024 * PW + (size_t)kt * 64 * PW + nt * 64, PW,
                            p.WINT + (size_t)l * PW * LDK + (size_t)nt * 64 * LDK + kt * 64, LDK, lds);
    } else if (it < n1) {
      int i2 = it - n0; int l = i2 / 256, r = i2 % 256, kt = r / 16, nt = r % 16;
      transpose_tile<float>(p.w_out + (size_t)l * 1024 * 1024 + (size_t)kt * 64 * 1024 + nt * 64, 1024,
                            p.WOUTT + (size_t)l * 1024 * LDK + (size_t)nt * 64 * LDK + kt * 64, LDK, lds);
    } else if (it < n2) {
      int i2 = it - n1; int l = i2 / 96, nb = (i2 % 96) * 32;
      float* sc = lds;
      float* red = lds + 5 * 1024;
      for (int i = tid; i < 5 * 1024; i += 256) { int v = i >> 10, k = i & 1023; float x = v == 0 ? p.c_ctx[k] : p.c[(v - 1) * 1024 + k]; sc[i] = siluf_(x); }
      __syncthreads();
      int n = tid & 31, kg = tid >> 5;
      float a0 = 0, a1 = 0, a2 = 0, a3 = 0, a4 = 0;
      const float* wp = p.w_mod + (size_t)l * 1024 * 3072 + nb + n;
      for (int k = kg * 128; k < kg * 128 + 128; ++k) {
        float w = wp[(size_t)k * 3072];
        a0 += sc[k] * w; a1 += sc[1024 + k] * w; a2 += sc[2048 + k] * w; a3 += sc[3072 + k] * w; a4 += sc[4096 + k] * w;
      }
      red[(kg * 5 + 0) * 32 + n] = a0; red[(kg * 5 + 1) * 32 + n] = a1; red[(kg * 5 + 2) * 32 + n] = a2; red[(kg * 5 + 3) * 32 + n] = a3; red[(kg * 5 + 4) * 32 + n] = a4;
      __syncthreads();
      if (tid < 160) { int v = tid >> 5, nn = tid & 31; float s = p.b_mod[l * 3072 + nb + nn]; for (int q = 0; q < 8; ++q) s += red[(q * 5 + v) * 32 + nn]; p.MOD[(size_t)(l * 5 + v) * 3072 + nb + nn] = s; }
      __syncthreads();
    } else if (it < n3) {
      int i2 = it - n2; int bl = i2 >> 3, r = i2 & 7, pt = r >> 1, ct = r & 1;
      transpose_tile<float>(p.cwv + (size_t)bl * 256 * 128 + (size_t)pt * 64 * 128 + ct * 64, 128,
                            p.CWVT + (size_t)bl * 128 * 256 + (size_t)ct * 64 * 256 + pt * 64, 256, lds);
    } else if (it < n4) {
      int i2 = it - n3; int bl = i2 >> 4, r = i2 & 15, pt = r >> 2, ct = r & 3;
      transpose_tile<float>(p.cdv + (size_t)bl * 256 * 256 + (size_t)pt * 64 * 256 + ct * 64, 256,
                            p.CDVT + (size_t)bl * 256 * 256 + (size_t)ct * 64 * 256 + pt * 64, 256, lds);
    } else if (it >= n6) {
      int i2 = it - n6; int l = i2 >> 4, mat = (i2 >> 2) & 3, n = i2 & 3;
      const float* src = (mat < 2 ? p.lru_wa : p.lru_wx) + (size_t)(((l * 2 + (mat & 1)) * 4 + n)) * 4096;
      transpose_tile<float>(src, 64, p.LWT + (size_t)(((l * 4 + mat) * 4 + n)) * 4096, 64, lds);
    } else if (it >= n5) {
      int i2 = it - n5; int l = i2 >> 4, mat = (i2 >> 2) & 3, ct = i2 & 3;
      const float* src = (mat < 2 ? p.rw_wup : p.rw_aup) + (size_t)(l * 2 + (mat & 1)) * 64 * 256 + ct * 64;
      transpose_tile<float>(src, 256, p.RWT + ((size_t)(l * 4 + mat) * 256 + ct * 64) * 64, 64, lds);
    } else {
      int i2 = it - n4;
      const float* src; bf16_t* dst;
      if (i2 < 64) { src = p.cwk + (size_t)i2 * 4096; dst = p.CWK + (size_t)i2 * 4096; }
      else { src = p.cdk + (size_t)(i2 - 64) * 4096; dst = p.CDK + (size_t)(i2 - 64) * 4096; }
      for (int i = tid * 4; i < 4096; i += 1024) { float4 v = *(const float4*)(src + i); uint2 o; o.x = pack2(v.x, v.y); o.y = pack2(v.z, v.w); *(uint2*)(dst + i) = o; }
    }
  }
}

__device__ __forceinline__ void phase_norm(const Params& p, int stage) {
  const int tid0 = tid_opaque();
  const int lane = tid0 & 63, wave = tid0 >> 6;
#pragma unroll 1
  for (int tok = blockIdx.x * 4 + wave; tok < NTOK; tok += gridDim.x * 4) {
    const int mv = tok < 4096 ? 0 : 1 + ((tok - 4096) >> 10);
    const float* xin;
    if (stage <= 1) xin = tok < 4096 ? p.x_prompt + (size_t)tok * 1024 : p.x_sample + (size_t)(tok - 4096) * 1024;
    else xin = p.out + (size_t)tok * 1024;
    f32x4 x[4], gt[4], gq[4], sh[4], sc[4], gpre[4]; u32x2 yb[4];
    const int lp = stage >= 1 ? stage - 1 : 0, ln = stage <= 1 ? stage : 0;
    const float* gate = p.MOD + (size_t)(lp * 5 + mv) * 3072 + 2048;
    const float* gpo = p.g_post + lp * 1024;
    const float* md = p.MOD + (size_t)(ln * 5 + mv) * 3072;
    const float* gpr = p.g_pre + ln * 1024;
#pragma unroll
    for (int i = 0; i < 4; ++i) {
      const int col = i * 256 + lane * 4;
      x[i] = *(const f32x4*)(xin + col);
      if (stage >= 1) { yb[i] = *(const u32x2*)((const bf16_t*)p.Y2 + (size_t)tok * 1024 + col); gt[i] = *(const f32x4*)(gate + col); gq[i] = *(const f32x4*)(gpo + col); }
      if (stage <= 1) { sh[i] = *(const f32x4*)(md + col); sc[i] = *(const f32x4*)(md + 1024 + col); gpre[i] = *(const f32x4*)(gpr + col); }
    }
    __builtin_amdgcn_sched_barrier(0);
    if (stage >= 1) {
      f32x4 y[4]; float ss = 0.f;
#pragma unroll
      for (int i = 0; i < 4; ++i) { y[i] = (f32x4){bflo(yb[i].x), bfhi(yb[i].x), bflo(yb[i].y), bfhi(yb[i].y)}; ss += y[i][0] * y[i][0] + y[i][1] * y[i][1] + y[i][2] * y[i][2] + y[i][3] * y[i][3]; }
      ss = wave_sum(ss);
      const float rstd = rsqrtf(ss * (1.0f / 1024.0f) + 1e-6f);
#pragma unroll
      for (int i = 0; i < 4; ++i) {
        const int col = i * 256 + lane * 4;
        x[i] += gt[i] * (y[i] * rstd * gq[i]);
        *(f32x4*)(p.out + (size_t)tok * 1024 + col) = x[i];
      }
    }
    if (stage <= 1) {
      float ss = 0.f;
#pragma unroll
      for (int i = 0; i < 4; ++i) ss += x[i][0] * x[i][0] + x[i][1] * x[i][1] + x[i][2] * x[i][2] + x[i][3] * x[i][3];
      ss = wave_sum(ss);
      const float rstd = rsqrtf(ss * (1.0f / 1024.0f) + 1e-6f);
#pragma unroll
      for (int i = 0; i < 4; ++i) {
        const int col = i * 256 + lane * 4;
        const f32x4 hv = x[i] * rstd * gpre[i] * (sc[i] + 1.f) + sh[i];
        u32x2 o; o.x = pack2(hv[0], hv[1]); o.y = pack2(hv[2], hv[3]);
        *(u32x2*)(p.H + (size_t)tok * LDK + col) = o;
      }
    }
  }
}

template <int MODE>
__device__ __forceinline__ void phase_gemm(const Params& p, int l, unsigned char* smem, int vb) {
  const bf16_t* A = p.H;
  const bf16_t* Bt = MODE == 0 ? p.WINT + (size_t)l * PW * LDK : p.WOUTT + (size_t)l * 1024 * LDK;
  const int N = MODE == 0 ? PW : 1024, K = LDK;
  const int NTN = N / 128;
  bf16_t* As = (bf16_t*)smem; bf16_t* Bs = As + 128 * 64;
  const int per = gridDim.x >> 3;
  const bool even8 = (gridDim.x & 7) == 0;
  const int xcd = even8 ? vb / per : (vb & 7), slot = even8 ? vb % per : (vb >> 3), nslot = even8 ? per : (int)((gridDim.x + 7 - xcd) >> 3);
  const int nx = (NTN - xcd + 7) >> 3;
#pragma unroll 1
  for (int j = slot; j < 64 * nx; j += nslot) {
    const int tid = tid_opaque(), lane = tid & 63, wave = tid >> 6, wm = wave >> 1, wn = wave & 1, r16 = lane & 15, quad = lane >> 4;
    const int tm = j / nx, tn = xcd + 8 * (j % nx), m0 = tm * 128, n0 = tn * 128;
    f32x4 acc[4][4];
#pragma unroll
    for (int i = 0; i < 4; ++i)
#pragma unroll
      for (int j = 0; j < 4; ++j) acc[i][j] = (f32x4){0.f, 0.f, 0.f, 0.f};
    u32x4 ra0[4], rb0[4];
    const int lrow = tid >> 3, lc8 = tid & 7;
    const bf16_t* ga = A + (size_t)(m0 + lrow) * K + lc8 * 8;
    const bf16_t* gb = Bt + (size_t)(n0 + lrow) * K + lc8 * 8;
    const int swz_w = (lc8 ^ ((lrow >> 1) & 7)) * 8, swz_r = (r16 >> 1) & 7;
    bf16_t* const sa_ = As + lrow * 64 + swz_w; bf16_t* const sb_ = Bs + lrow * 64 + swz_w;
#define G_LOAD(RA, RB, KT) { _Pragma("unroll") for (int i = 0; i < 4; ++i) { RA[i] = *(const u32x4*)(ga + (size_t)i * 32 * K + (KT) * 64); RB[i] = *(const u32x4*)(gb + (size_t)i * 32 * K + (KT) * 64); } }
#define G_STORE(RA, RB) { _Pragma("unroll") for (int i = 0; i < 4; ++i) { *(u32x4*)(sa_ + i * 32 * 64) = RA[i]; *(u32x4*)(sb_ + i * 32 * 64) = RB[i]; } }
#define G_COMPUTE() { _Pragma("unroll") for (int ks = 0; ks < 2; ++ks) { bf16x8 af[4], bfr[4]; \
      _Pragma("unroll") for (int i = 0; i < 4; ++i) { af[i] = *(const bf16x8*)(As + (wm * 64 + i * 16 + r16) * 64 + (((ks * 4 + quad) ^ swz_r) * 8)); bfr[i] = *(const bf16x8*)(Bs + (wn * 64 + i * 16 + r16) * 64 + (((ks * 4 + quad) ^ swz_r) * 8)); } \
      _Pragma("unroll") for (int mi = 0; mi < 4; ++mi) _Pragma("unroll") for (int ni = 0; ni < 4; ++ni) acc[mi][ni] = mfma16(bfr[ni], af[mi], acc[mi][ni]); } }
    G_LOAD(ra0, rb0, 0);
    G_STORE(ra0, rb0);
    __syncthreads();
#pragma unroll 1
    for (int kt = 0; kt < 16; ++kt) {
      if (kt + 1 < 16) G_LOAD(ra0, rb0, kt + 1);
      __builtin_amdgcn_sched_barrier(0);
      G_COMPUTE();
      lds_barrier();
      if (kt + 1 < 16) { G_STORE(ra0, rb0); lds_barrier(); }
    }
#undef G_LOAD
#undef G_STORE
#undef G_COMPUTE
#pragma unroll
    for (int mi = 0; mi < 4; ++mi)
#pragma unroll
      for (int ni = 0; ni < 4; ++ni) {
        const int m = m0 + wm * 64 + mi * 16 + r16, n = n0 + wn * 64 + ni * 16 + quad * 4;
        const f32x4 v = acc[mi][ni];
        if (MODE == 0) {
          uint2 o; o.x = pack2(v[0], v[1]); o.y = pack2(v[2], v[3]);
          *(uint2*)(p.P + (size_t)m * PW + n) = o;
          if (m0 < 4096) {
            const int row = ((m >> 8) * 2 + l) * 256 + (m & 255);
            float* dst = nullptr;
            if (tn == 11) dst = p.out + O_NWK + (size_t)row * 128 + (n - 1408);
            else if (tn == 12) dst = p.out + O_NWV + (size_t)row * 128 + (n - 1536);
            else if (tn == 21 || tn == 22) dst = p.out + O_NDK + (size_t)row * 256 + (n - 2688);
            else if (tn == 23 || tn == 24) dst = p.out + O_NDV + (size_t)row * 256 + (n - 2944);
            if (dst) *(float4*)dst = (float4){v[0], v[1], v[2], v[3]};
          }
        } else {
          { u32x2 o; o.x = pack2(v[0], v[1]); o.y = pack2(v[2], v[3]); *(u32x2*)((bf16_t*)p.Y2 + (size_t)m * 1024 + n) = o; }
        }
      }
  }
}

DI void unpack8(u32x4 u, float (&o)[8]) { o[0] = bflo(u.x); o[1] = bfhi(u.x); o[2] = bflo(u.y); o[3] = bfhi(u.y); o[4] = bflo(u.z); o[5] = bfhi(u.z); o[6] = bflo(u.w); o[7] = bfhi(u.w); }
DI bf16x8 pack8(const float (&o)[8]) { u32x4 u; u.x = pack2(o[0], o[1]); u.y = pack2(o[2], o[3]); u.z = pack2(o[4], o[5]); u.w = pack2(o[6], o[7]); return __builtin_bit_cast(bf16x8, u); }

__device__ __forceinline__ void pre_rwkv(const Params& p, int l, int item) {
  const int tid = tid_opaque(), lane = tid & 63, h = tid >> 6, r16 = lane & 15, quad = lane >> 4;
  const int tok = item * 16 + r16;
  const bf16_t* pr = p.P + (size_t)tok * PW;
  bf16x8 wdf[2], adf[2];
#pragma unroll
  for (int ks = 0; ks < 2; ++ks) {
    float o[8]; unpack8(*(const u32x4*)(pr + 768 + ks * 32 + quad * 8), o);
#pragma unroll
    for (int j = 0; j < 8; ++j) o[j] = 1.0f - 2.0f * __builtin_amdgcn_rcpf(1.0f + __expf(2.0f * o[j]));
    wdf[ks] = pack8(o);
    adf[ks] = *(const bf16x8*)(pr + 832 + ks * 32 + quad * 8);
  }
  float kv[4][4];
#pragma unroll
  for (int ct = 0; ct < 4; ++ct) ld4bf(pr + 256 + h * 64 + ct * 16 + quad * 4, kv[ct]);
  const bf16_t* wt = p.RWT + (size_t)l * 4 * 256 * 64;
  float ss = 0.f;
#pragma unroll
  for (int ct = 0; ct < 4; ++ct) {
    const f32x4 kkc = *(const f32x4*)(p.rw_kk + l * 256 + h * 64 + ct * 16 + quad * 4);
#pragma unroll
    for (int r = 0; r < 4; ++r) { const float q = kv[ct][r] * kkc[r]; ss += q * q; }
  }
  ss += __shfl_xor(ss, 16); ss += __shfl_xor(ss, 32);
  const float rn = rsqrtf(ss + 1e-12f);
#pragma unroll
  for (int ct = 0; ct < 4; ++ct) {
    f32x4 acc[4];
    const int c0 = h * 64 + ct * 16 + quad * 4;
    bf16x8 wfr[4][2];
#pragma unroll
    for (int mat = 0; mat < 4; ++mat)
#pragma unroll
      for (int ks = 0; ks < 2; ++ks) wfr[mat][ks] = *(const bf16x8*)(wt + ((size_t)mat * 256 + h * 64 + ct * 16 + r16) * 64 + ks * 32 + quad * 8);
    const f32x4 kkc = *(const f32x4*)(p.rw_kk + l * 256 + c0), kac = *(const f32x4*)(p.rw_ka + l * 256 + c0);
    const f32x4 w00 = *(const f32x4*)(p.rw_w0 + (l * 2 + 0) * 256 + c0), w01 = *(const f32x4*)(p.rw_w0 + (l * 2 + 1) * 256 + c0);
    const f32x4 a00 = *(const f32x4*)(p.rw_a0 + (l * 2 + 0) * 256 + c0), a01 = *(const f32x4*)(p.rw_a0 + (l * 2 + 1) * 256 + c0);
    __builtin_amdgcn_sched_barrier(0);
#pragma unroll
    for (int mat = 0; mat < 4; ++mat) {
      f32x4 a = {0.f, 0.f, 0.f, 0.f};
#pragma unroll
      for (int ks = 0; ks < 2; ++ks) a = mfma16(wfr[mat][ks], mat < 2 ? wdf[ks] : adf[ks], a);
      acc[mat] = a;
    }
    f32x4 nkk, w0v, w1v, b0v, b1v, k0v, k1v;
#pragma unroll
    for (int r = 0; r < 4; ++r) {
      const float k = kv[ct][r];
      const float kkn = k * kkc[r] * rn;
      nkk[r] = -kkn;
#pragma unroll
      for (int d = 0; d < 2; ++d) {
        const float wl = (d ? w01[r] : w00[r]) + acc[d][r];
        const float w_log = -__logf(1.0f + __expf(-wl)) - 0.5f;
        const float decay = __expf(-__expf(w_log));
        const float a = fsigmoid((d ? a01[r] : a00[r]) + acc[2 + d][r]);
        const float kd = k * (1.f + (a - 1.f) * kac[r]);
        if (d) { w1v[r] = decay; b1v[r] = kkn * a; k1v[r] = kd; } else { w0v[r] = decay; b0v[r] = kkn * a; k0v[r] = kd; }
      }
    }
    const size_t o0 = (size_t)tok * 256 + c0, o1 = ((size_t)NTOK + tok) * 256 + c0;
    *(f32x4*)(p.NKK + o0) = nkk;
    *(f32x4*)(p.AW + o0) = w0v; *(f32x4*)(p.AW + o1) = w1v;
    *(f32x4*)(p.AB + o0) = b0v; *(f32x4*)(p.AB + o1) = b1v;
    *(f32x4*)(p.AKD + o0) = k0v; *(f32x4*)(p.AKD + o1) = k1v;
  }
}

#define LSCAN_STEP(A, H, CTRL) { \
    const float Ap = __builtin_bit_cast(float, __builtin_amdgcn_update_dpp(0x3f800000, __builtin_bit_cast(int, A), CTRL, 0xf, 0xf, false)); \
    const float Hp = __builtin_bit_cast(float, __builtin_amdgcn_update_dpp(0, __builtin_bit_cast(int, H), CTRL, 0xf, 0xf, true)); \
    H = A * Hp + H; A = A * Ap; }

__device__ __forceinline__ void pre_lru(const Params& p, int l, int item) {
  const int tid = tid_opaque(), lane = tid & 63, n = tid >> 6, r16 = lane & 15, quad = lane >> 4;
  const int tok0 = item * 16;
  int T, sb, t0;
  if (tok0 < 4096) { T = 256; sb = tok0 & ~255; t0 = tok0 & 255; } else { T = 1024; sb = 4096 + ((tok0 - 4096) & ~1023); t0 = (tok0 - 4096) & 1023; }
  const int t = t0 + r16, tok = tok0 + r16;
  bf16x8 xf[2];
  float xo[2][8];
#pragma unroll
  for (int ks = 0; ks < 2; ++ks) {
    const int cb = n * 64 + ks * 32 + quad * 8;
    float o[8];
    { const f32x4 b0 = *(const f32x4*)(p.lru_cb + l * 256 + cb), b1 = *(const f32x4*)(p.lru_cb + l * 256 + cb + 4);
      o[0] = b0[0]; o[1] = b0[1]; o[2] = b0[2]; o[3] = b0[3]; o[4] = b1[0]; o[5] = b1[1]; o[6] = b1[2]; o[7] = b1[3]; }
#pragma unroll
    for (int i = 0; i < 4; ++i) {
      const int tt = t - 2 + i;
      u32x4 xr = {0u, 0u, 0u, 0u};
      if (tt >= 0 && tt < T) xr = *(const u32x4*)(p.P + (size_t)(sb + tt) * PW + 1920 + cb);
      float x[8]; unpack8(xr, x);
      const f32x4 w0 = *(const f32x4*)(p.lru_cw + (l * 4 + i) * 256 + cb), w1 = *(const f32x4*)(p.lru_cw + (l * 4 + i) * 256 + cb + 4);
      o[0] += w0[0] * x[0]; o[1] += w0[1] * x[1]; o[2] += w0[2] * x[2]; o[3] += w0[3] * x[3];
      o[4] += w1[0] * x[4]; o[5] += w1[1] * x[5]; o[6] += w1[2] * x[6]; o[7] += w1[3] * x[7];
    }
    xf[ks] = pack8(o);
#pragma unroll
    for (int j = 0; j < 8; ++j) xo[ks][j] = o[j];
  }
#pragma unroll
  for (int et = 0; et < 4; ++et) {
    f32x4 acc[4];
    const int c0 = n * 64 + (et >> 1) * 32 + quad * 8 + (et & 1) * 4;
    const int erow = (et >> 1) * 32 + (r16 >> 2) * 8 + (et & 1) * 4 + (r16 & 3);
    bf16x8 wfr[4][2];
#pragma unroll
    for (int mat = 0; mat < 4; ++mat)
#pragma unroll
      for (int ks = 0; ks < 2; ++ks) wfr[mat][ks] = *(const bf16x8*)(p.LWT + ((size_t)((l * 4 + mat) * 4 + n) * 64 + erow) * 64 + ks * 32 + quad * 8);
    const f32x4 ba0 = *(const f32x4*)(p.lru_ba + (l * 2 + 0) * 256 + c0), ba1 = *(const f32x4*)(p.lru_ba + (l * 2 + 1) * 256 + c0);
    const f32x4 bx0 = *(const f32x4*)(p.lru_bx + (l * 2 + 0) * 256 + c0), bx1 = *(const f32x4*)(p.lru_bx + (l * 2 + 1) * 256 + c0);
    const f32x4 lm0 = *(const f32x4*)(p.lru_lam + (l * 2 + 0) * 256 + c0), lm1 = *(const f32x4*)(p.lru_lam + (l * 2 + 1) * 256 + c0);
    __builtin_amdgcn_sched_barrier(0);
#pragma unroll
    for (int mat = 0; mat < 4; ++mat) {
      f32x4 a = {0.f, 0.f, 0.f, 0.f};
#pragma unroll
      for (int ks = 0; ks < 2; ++ks) a = mfma16(wfr[mat][ks], xf[ks], a);
      acc[mat] = a;
    }
    f32x4 A0, H0, A1, H1;
#pragma unroll
    for (int r = 0; r < 4; ++r) {
      const float x = xo[et >> 1][(et & 1) * 4 + r];
#pragma unroll
      for (int d = 0; d < 2; ++d) {
        const float ga = fsigmoid(acc[d][r] + (d ? ba1[r] : ba0[r]));
        const float gx = fsigmoid(acc[2 + d][r] + (d ? bx1[r] : bx0[r]));
        const float e_ = __expf(-(d ? lm1[r] : lm0[r]));
        const float sp = e_ < 0.05f ? e_ * (1.0f - e_ * (0.5f - e_ * (0.33333334f - 0.25f * e_))) : __logf(1.0f + e_);
        const float log_a = -8.0f * ga * sp;
        float a = __expf(log_a);
        const float x2 = 2.0f * log_a;
        const float om = x2 > -0.05f ? -(x2 * (1.0f + x2 * (0.5f + x2 * (0.16666667f + x2 * 0.041666667f)))) : 1.0f - __expf(x2);
        float u = __fsqrt_rn(om) * (gx * x);
        if (d == 0) { LSCAN_STEP(a, u, 0x111) LSCAN_STEP(a, u, 0x112) LSCAN_STEP(a, u, 0x114) LSCAN_STEP(a, u, 0x118) A0[r] = a; H0[r] = u; }
        else        { LSCAN_STEP(a, u, 0x101) LSCAN_STEP(a, u, 0x102) LSCAN_STEP(a, u, 0x104) LSCAN_STEP(a, u, 0x108) A1[r] = a; H1[r] = u; }
      }
    }
    const size_t o0 = (size_t)tok * 256 + c0, o1 = ((size_t)NTOK + tok) * 256 + c0;
    *(f32x4*)(p.LA + o0) = A0; *(f32x4*)(p.LU + o0) = H0;
    *(f32x4*)(p.LA + o1) = A1; *(f32x4*)(p.LU + o1) = H1;
  }
}

__device__ __forceinline__ void pre_rope(const Params& p, int item) {
  const int tid = tid_opaque();
  const int ts0 = item * 16;
#pragma unroll 1
  for (int pp = tid; pp < 448; pp += 256) {
    int scol, d1, d2, half, i, dstride; bf16_t* dst; float inv;
    if (pp < 192) {
      int q = pp < 128 ? pp : pp - 128; int vec = q >> 5, pi = q & 31; half = pi >> 4; i = pi & 15;
      d1 = half * 32 + i; d2 = d1 + 16; inv = exp2f(-(float)i * (13.287712379549449f / 16.0f));
      if (pp < 128) { scol = 1152 + vec * 64; dst = p.QBR + vec * 64; dstride = 256; }
      else { scol = 1408 + vec * 64; dst = p.KBR + vec * 64; dstride = 128; }
    } else {
      int q = pp < 320 ? pp - 192 : pp - 320; int vec = q >> 4, pi = q & 15; half = pi >> 3; i = pi & 7;
      d1 = half * 16 + i; d2 = d1 + 8; inv = exp2f(-(float)i * (13.287712379549449f / 8.0f));
      if (pp < 320) { scol = 2432 + vec * 32; dst = p.QDR + vec * 32; dstride = 256; }
      else { scol = 2688 + vec * 32; dst = p.KDR + vec * 32; dstride = 256; }
    }
    float x1[16], x2[16];
#pragma unroll
    for (int tt = 0; tt < 16; ++tt) { const bf16_t* src = p.P + (size_t)(4096 + ts0 + tt) * PW + scol; x1[tt] = bf2f(src[d1]); x2[tt] = bf2f(src[d2]); }
#pragma unroll
    for (int tt = 0; tt < 16; ++tt) {
      const int t = (ts0 + tt) & 1023;
      const float ang = (float)(half ? (t & 63) : (t >> 6)) * inv;
      const float sn = __sinf(ang), cs = __cosf(ang);
      const float a = x1[tt], b = x2[tt];
      bf16_t* o = dst + (size_t)(ts0 + tt) * dstride;
      o[d1] = f2bf(a * cs - b * sn); o[d2] = f2bf(a * sn + b * cs);
    }
  }
}

__device__ __forceinline__ void phase_pre(const Params& p, int l, unsigned char* smem) {
  const int n0 = 512, n1 = n0 + 512, n2 = n1 + 256, n3 = n2 + 256, n4 = n3 + 512;
#pragma unroll 1
  for (int it = blockIdx.x; it < n4; it += gridDim.x) {
    if (it < n0) pre_rwkv(p, l, it);
    else if (it < n1) pre_lru(p, l, it - n0);
    else if (it < n2) pre_rope(p, it - n1);
    else if (it < n3) {
      int i2 = it - n2; int tt = i2 >> 1, ct = i2 & 1; int tok0 = tt * 64;
      int T, sb; if (tok0 < 4096) { T = 256; sb = tok0 & ~255; } else { T = 1024; sb = 4096 + ((tok0 - 4096) & ~1023); }
      transpose_tile<bf16_t>(p.P + (size_t)tok0 * PW + 1536 + ct * 64, PW, p.VBT + (size_t)sb * 128 + (size_t)(ct * 64) * T + (tok0 - sb), T, (float*)smem);
    } else {
      int i2 = it - n3; int tt = i2 >> 2, ct = i2 & 3; int tok0 = tt * 64;
      int T, sb; if (tok0 < 4096) { T = 256; sb = tok0 & ~255; } else { T = 1024; sb = 4096 + ((tok0 - 4096) & ~1023); }
      transpose_tile<bf16_t>(p.P + (size_t)tok0 * PW + 2944 + ct * 64, PW, p.VDT + (size_t)sb * 256 + (size_t)(ct * 64) * T + (tok0 - sb), T, (float*)smem);
    }
  }
}

template <int LR> DI float group_sum(float v) {
  v += __builtin_bit_cast(float, __builtin_amdgcn_update_dpp(0, __builtin_bit_cast(int, v), 0xB1, 0xf, 0xf, true));
  v += __builtin_bit_cast(float, __builtin_amdgcn_update_dpp(0, __builtin_bit_cast(int, v), 0x4E, 0xf, 0xf, true));
  if (LR >= 8) v += __builtin_bit_cast(float, __builtin_amdgcn_update_dpp(0, __builtin_bit_cast(int, v), 0x141, 0xf, 0xf, true));
  if (LR >= 16) v += __builtin_bit_cast(float, __builtin_amdgcn_update_dpp(0, __builtin_bit_cast(int, v), 0x140, 0xf, 0xf, true));
  return v;
}
typedef float f32x2 __attribute__((ext_vector_type(2)));
template <int E> struct RwOps { f32x4 nk[E / 4], ww[E / 4], bb[E / 4], kk[E / 4], rr[E / 4]; float vi; };
template <int E> DI void rw_load(const float* ob, int g, int i, RwOps<E>& o) {
  constexpr int LR = 64 / E, NM = E / 4;
#pragma unroll
  for (int m = 0; m < NM; ++m) {
    const int off = 4 * (g + LR * m);
    o.nk[m] = *(const f32x4*)(ob + off); o.ww[m] = *(const f32x4*)(ob + 64 + off); o.bb[m] = *(const f32x4*)(ob + 128 + off);
    o.kk[m] = *(const f32x4*)(ob + 192 + off); o.rr[m] = *(const f32x4*)(ob + 256 + off);
  }
  o.vi = ob[320 + i];
}
#define DPP_ADD(V, CTRL) V += __builtin_bit_cast(float, __builtin_amdgcn_update_dpp(0, __builtin_bit_cast(int, V), CTRL, 0xf, 0xf, true))
template <int E> DI float rw_step(f32x2 (&S)[E / 2], const RwOps<E>& o, float& ypart) {
  constexpr int LR = 64 / E, NM = E / 4;
  f32x2 p2 = S[0] * o.nk[0].xy;
  p2 = S[1] * o.nk[0].zw + p2;
#pragma unroll
  for (int m = 1; m < NM; ++m) { p2 = S[2 * m] * o.nk[m].xy + p2; p2 = S[2 * m + 1] * o.nk[m].zw + p2; }
  float sa = p2.x + p2.y, yr = ypart;
  DPP_ADD(sa, 0xB1); DPP_ADD(yr, 0xB1);
  DPP_ADD(sa, 0x4E); DPP_ADD(yr, 0x4E);
  if (LR >= 8) { DPP_ADD(sa, 0x141); DPP_ADD(yr, 0x141); }
  if (LR >= 16) { DPP_ADD(sa, 0x140); DPP_ADD(yr, 0x140); }
  const f32x2 sa2 = {sa, sa}, v2 = {o.vi, o.vi};
  f32x2 y2 = {0.f, 0.f};
#pragma unroll
  for (int m = 0; m < NM; ++m) {
    S[2 * m] = S[2 * m] * o.ww[m].xy + (sa2 * o.bb[m].xy + v2 * o.kk[m].xy);
    S[2 * m + 1] = S[2 * m + 1] * o.ww[m].zw + (sa2 * o.bb[m].zw + v2 * o.kk[m].zw);
    y2 = S[2 * m] * o.rr[m].xy + y2; y2 = S[2 * m + 1] * o.rr[m].zw + y2;
  }
  ypart = y2.x + y2.y;
  return yr;
}
template <int E>
__device__ __forceinline__ void rwkv_chain(const Params& p, int l, int chain, int part, unsigned char* smem) {
  constexpr int LR = 64 / E, NM = E / 4;
  const int tid = tid_opaque(), lane = tid & 63, wave = tid >> 6;
  int seq, d, h;
  if (chain < 32) { seq = 16 + (chain >> 3); d = (chain >> 2) & 1; h = chain & 3; }
  else { int c2 = chain - 32; seq = c2 >> 3; d = (c2 >> 2) & 1; h = c2 & 3; }
  const int T = seq < 16 ? 256 : 1024, tokb = seq < 16 ? seq * 256 : 4096 + (seq - 16) * 1024;
  const int g = lane % LR, rl = lane / LR, i = part * 4 * E + wave * E + rl;
  f32x2 S[E / 2];
  if (seq >= 16) {
    const float* s0 = p.st_rwkv + ((((size_t)(seq - 16) * 2 + l) * 2 + d) * 4 + h) * 4096 + i * 64;
#pragma unroll
    for (int m = 0; m < NM; ++m) { f32x4 t = *(const f32x4*)(s0 + 4 * (g + LR * m)); S[2 * m] = t.xy; S[2 * m + 1] = t.zw; }
  } else {
#pragma unroll
    for (int j = 0; j < E / 2; ++j) S[j] = (f32x2){0.f, 0.f};
  }
  float* buf = (float*)smem;
  const int lvec = (tid >> 4) & 3, lc4 = tid & 15, ls = tid >> 6;
  const float* fsrc = (lvec == 0 ? p.NKK : lvec == 1 ? p.AW + (size_t)d * NTOK * 256 : lvec == 2 ? p.AB + (size_t)d * NTOK * 256 : p.AKD + (size_t)d * NTOK * 256) + h * 64 + lc4 * 4;
  const int bs = tid >> 4, bvec = (tid >> 3) & 1, bc8 = tid & 7;
  const bf16_t* bsrc = p.P + (bvec ? 512 : 0) + h * 64 + bc8 * 8;
  f32x4 rfA[4], rfB[4]; u32x4 rbA, rbB;
  const int nch = T / 16;
#define RW_GLOAD(RF, RB, CK) { _Pragma("unroll") for (int i4 = 0; i4 < 4; ++i4) { int step = (CK) * 16 + ls + 4 * i4; int t = d ? T - 1 - step : step; RF[i4] = *(const f32x4*)(fsrc + (size_t)(tokb + t) * 256); } \
    { int step = (CK) * 16 + bs; int t = d ? T - 1 - step : step; RB = *(const u32x4*)(bsrc + (size_t)(tokb + t) * PW); } }
#define RW_SSTORE(RF, RB, BI) { float* b_ = buf + (BI) * 16 * 384; \
    _Pragma("unroll") for (int i4 = 0; i4 < 4; ++i4) *(f32x4*)(b_ + (ls + 4 * i4) * 384 + lvec * 64 + lc4 * 4) = RF[i4]; \
    float* q_ = b_ + bs * 384 + (4 + bvec) * 64 + bc8 * 8; \
    *(f32x4*)q_ = (f32x4){bflo(RB.x), bfhi(RB.x), bflo(RB.y), bfhi(RB.y)}; \
    *(f32x4*)(q_ + 4) = (f32x4){bflo(RB.z), bfhi(RB.z), bflo(RB.w), bfhi(RB.w)}; }
  float* yout = p.YA + ((size_t)d * NTOK + tokb) * 256 + h * 64 + i;
  constexpr int NY = 16 / LR;
  auto compute = [&](int ck) {
    const float* cb = buf + (ck & 1) * 16 * 384;
    float yk[NY];
#pragma unroll
    for (int q = 0; q < NY; ++q) yk[q] = 0.f;
    constexpr int NSET = (E == 4) ? 4 : 2;
    float ypart = 0.f;
    RwOps<E> ops[NSET];
#pragma unroll
    for (int q = 0; q < NSET - 1; ++q) rw_load<E>(cb + q * 384, g, i, ops[q]);
#pragma unroll 1
    for (int s = 0; s < 16; s += NSET) {
#pragma unroll
      for (int u = 0; u < NSET; ++u) {
        const int sn = s + u + NSET - 1;
        rw_load<E>(buf + (((ck & 1) * 16 + sn) & 31) * 384, g, i, ops[(u + NSET - 1) % NSET]);
        const float y0 = rw_step<E>(S, ops[u], ypart);
#pragma unroll
        for (int q = 0; q < NY; ++q) yk[q] = (s + u - 1 == q * LR + g) ? y0 : yk[q];
      }
    }
    {
      const float y15 = group_sum<LR>(ypart);
#pragma unroll
      for (int q = 0; q < NY; ++q) yk[q] = (15 == q * LR + g) ? y15 : yk[q];
    }
#pragma unroll
    for (int q = 0; q < NY; ++q) { const int step = ck * 16 + q * LR + g; const int t = d ? T - 1 - step : step; yout[(size_t)t * 256] = yk[q]; }
  };
  __builtin_amdgcn_s_setprio(2);
  RW_GLOAD(rfA, rbA, 0); RW_SSTORE(rfA, rbA, 0); RW_GLOAD(rfA, rbA, 1); RW_GLOAD(rfB, rbB, 2);
  __syncthreads();
#pragma unroll 1
  for (int ck = 0; ck < nch; ck += 2) {
    compute(ck);
    RW_SSTORE(rfA, rbA, 1);
    if (ck + 3 < nch) RW_GLOAD(rfA, rbA, ck + 3);
    lds_barrier();
    compute(ck + 1);
    if (ck + 2 < nch) RW_SSTORE(rfB, rbB, 0);
    if (ck + 4 < nch) RW_GLOAD(rfB, rbB, ck + 4);
    lds_barrier();
  }
  __builtin_amdgcn_s_setprio(0);
#undef RW_GLOAD
#undef RW_SSTORE
  if (seq < 16) {
    float* so = p.out + O_NSR + ((((size_t)seq * 2 + l) * 2 + d) * 4 + h) * 4096 + i * 64;
#pragma unroll
    for (int m = 0; m < NM; ++m) *(f32x4*)(so + 4 * (g + LR * m)) = (f32x4){S[2 * m].x, S[2 * m].y, S[2 * m + 1].x, S[2 * m + 1].y};
  }
}

__device__ __forceinline__ void lru_scan(const Params& p, int l, int item) {
  const int c = tid_opaque();
  int seq, d;
  if (item < 8) { seq = 16 + (item >> 1); d = item & 1; } else { seq = (item - 8) >> 1; d = item & 1; }
  const int T = seq < 16 ? 256 : 1024, tokb = seq < 16 ? seq * 256 : 4096 + (seq - 16) * 1024;
  const int NC = T >> 4;
  float h = seq >= 16 ? p.st_lru[(((seq - 16) * 2 + l) * 2 + d) * 256 + c] : 0.f;
  const float* la = p.LA + (size_t)d * NTOK * 256 + c; const float* lu = p.LU + (size_t)d * NTOK * 256 + c;
  float* lc = p.LC + (size_t)d * 512 * 256 + (size_t)(tokb >> 4) * 256 + c;
  for (int k0 = 0; k0 < NC; k0 += 8) {
    float a[8], u[8];
#pragma unroll
    for (int q = 0; q < 8; ++q) { const int k = d ? NC - 1 - (k0 + q) : k0 + q; const size_t idx = (size_t)(tokb + k * 16 + (d ? 0 : 15)) * 256; a[q] = la[idx]; u[q] = lu[idx]; }
#pragma unroll
    for (int q = 0; q < 8; ++q) { const int k = d ? NC - 1 - (k0 + q) : k0 + q; lc[(size_t)k * 256] = h; h = a[q] * h + u[q]; }
  }
  if (seq < 16) p.out[O_NSL + ((seq * 2 + l) * 2 + d) * 256 + c] = h;
}

template <bool DIFF>
__device__ __forceinline__ void attn_item(const Params& p, int l, bool sample, int sq  , int h, int qt, unsigned char* smem) {
  constexpr int NS = DIFF ? 2 : 1;
  const int tid = tid_opaque();
  const int lane = tid & 63, wave = tid >> 6, r16 = lane & 15, quad = lane >> 4;
  const int T = sample ? 1024 : 256;
  const int tokb = sample ? 4096 + sq * 1024 : sq * 256;
  const int q0 = qt * 64 + wave * 16;
  const int qpos = q0 + r16;
  const int kvh = DIFF ? h : (h >> 1);
  bf16x8 qf[2];
  {
    const bf16_t* qp;
    if (sample) qp = (DIFF ? p.QDR : p.QBR) + (size_t)(sq * 1024 + qpos) * 256 + h * 64;
    else qp = p.P + (size_t)(tokb + qpos) * PW + (DIFF ? 2432 : 1152) + h * 64;
    qf[0] = *(const bf16x8*)(qp + quad * 8); qf[1] = *(const bf16x8*)(qp + 32 + quad * 8);
  }
  float m[2] = {-3.0e38f, -3.0e38f}, lsum[2] = {0.f, 0.f};
  f32x4 o[2][4];
#pragma unroll
  for (int a = 0; a < 2; ++a)
#pragma unroll
    for (int b = 0; b < 4; ++b) o[a][b] = (f32x4){0.f, 0.f, 0.f, 0.f};
  const float scale_log2 = (DIFF ? 0.17677669529663687f : 0.125f) * 1.4426950408889634f;
  const int nctx = sample ? 4 : 0;
  const bf16_t* Kc = nullptr; const bf16_t* Vc = nullptr; int ksc = 0;
  if (sample) {
    const int bl = sq * 2 + l;
    if (DIFF) { Kc = p.CDK + (size_t)bl * 256 * 256 + h * 64; ksc = 256; Vc = p.CDVT + (size_t)bl * 256 * 256 + (size_t)(h * 64) * 256; }
    else { Kc = p.CWK + (size_t)bl * 256 * 128 + kvh * 64; ksc = 128; Vc = p.CWVT + (size_t)bl * 128 * 256 + (size_t)(kvh * 64) * 256; }
  }
  const bf16_t* Kl; const bf16_t* Vl; int ksl;
  if (sample) {
    if (DIFF) { Kl = p.KDR + (size_t)(sq * 1024) * 256 + h * 64; ksl = 256; Vl = p.VDT + (size_t)tokb * 256 + (size_t)(h * 64) * T; }
    else { Kl = p.KBR + (size_t)(sq * 1024) * 128 + kvh * 64; ksl = 128; Vl = p.VBT + (size_t)tokb * 128 + (size_t)(kvh * 64) * T; }
  } else {
    if (DIFF) { Kl = p.P + (size_t)tokb * PW + 2688 + h * 64; ksl = PW; Vl = p.VDT + (size_t)tokb * 256 + (size_t)(h * 64) * T; }
    else { Kl = p.P + (size_t)tokb * PW + 1408 + kvh * 64; ksl = PW; Vl = p.VBT + (size_t)tokb * 128 + (size_t)(kvh * 64) * T; }
  }
  int kb0 = 0, kb1 = T; bool lmask = false;
  if (sample && !DIFF) { const int qb = qt * 64; kb0 = qb - 128 < 0 ? 0 : qb - 128; kb1 = qb + 192 > T ? T : qb + 192; lmask = true; }
  const int nt = nctx + ((kb1 - kb0) >> 6);
  bf16_t* const lds = (bf16_t*)smem;
  const int lrow = tid >> 2, lch = (tid & 3) * 16;
  auto gsrc = [&](int t, const bf16_t*& kp, const bf16_t*& vp) {
    if (t < nctx) { kp = Kc + (size_t)(t * 64 + lrow) * ksc + lch; vp = Vc + (size_t)lrow * 256 + t * 64 + lch; }
    else { const int kb = kb0 + (t - nctx) * 64; kp = Kl + (size_t)(kb + lrow) * ksl + lch; vp = Vl + (size_t)lrow * T + kb + lch; }
  };
  u32x4 rk0, rk1, rv0, rv1;
  { const bf16_t* kp; const bf16_t* vp; gsrc(0, kp, vp); rk0 = *(const u32x4*)kp; rk1 = *(const u32x4*)(kp + 8); rv0 = *(const u32x4*)vp; rv1 = *(const u32x4*)(vp + 8); }
  __syncthreads();
  { bf16_t* d = lds + lrow * 72 + lch; *(u32x4*)d = rk0; *(u32x4*)(d + 8) = rk1; *(u32x4*)(d + 64 * 72) = rv0; *(u32x4*)(d + 64 * 72 + 8) = rv1; }
  __syncthreads();
  const f32x4 z4 = {0.f, 0.f, 0.f, 0.f};
  const int krow = 8 * (r16 >> 2) + (r16 & 3);
#pragma unroll 1
  for (int t = 0; t < nt; ++t) {
    const bool isctx = t < nctx;
    const bool masked = !isctx && lmask;
    const int kpos0 = kb0 + (t - nctx) * 64;
    if (t + 1 < nt) { const bf16_t* kp; const bf16_t* vp; gsrc(t + 1, kp, vp); rk0 = *(const u32x4*)kp; rk1 = *(const u32x4*)(kp + 8); rv0 = *(const u32x4*)vp; rv1 = *(const u32x4*)(vp + 8); }
    const bf16_t* Ks = lds + (t & 1) * (2 * 64 * 72);
    const bf16_t* Vs = Ks + 64 * 72;
    bf16x8 pf[NS][2];
#pragma unroll
    for (int st = 0; st < NS; ++st) {
      f32x4 sc[4];
#pragma unroll
      for (int kt = 0; kt < 4; ++kt) {
        const bf16_t* kr = Ks + (32 * (kt >> 1) + 4 * (kt & 1) + krow) * 72 + quad * 8;
        if (!DIFF) { sc[kt] = mfma16(*(const bf16x8*)kr, qf[0], z4); sc[kt] = mfma16(*(const bf16x8*)(kr + 32), qf[1], sc[kt]); }
        else sc[kt] = mfma16(*(const bf16x8*)(kr + 32 * st), qf[st], z4);
      }
      float mx = -3.0e38f;
#pragma unroll
      for (int kt = 0; kt < 4; ++kt)
#pragma unroll
        for (int r = 0; r < 4; ++r) {
          float x = sc[kt][r] * scale_log2;
          if (masked) { const int kp = kpos0 + 32 * (kt >> 1) + 8 * quad + 4 * (kt & 1) + r; const int dd = kp - qpos; if (dd > 128 || dd < -128) x = -1.0e30f; }
          sc[kt][r] = x; mx = fmaxf(mx, x);
        }
      mx = fmaxf(mx, __shfl_xor(mx, 16)); mx = fmaxf(mx, __shfl_xor(mx, 32));
      const float mnew = fmaxf(m[st], mx);
      const float alpha = __builtin_amdgcn_exp2f(m[st] - mnew);
      m[st] = mnew;
      float ps = 0.f;
#pragma unroll
      for (int kt = 0; kt < 4; ++kt)
#pragma unroll
        for (int r = 0; r < 4; ++r) { const float e = __builtin_amdgcn_exp2f(sc[kt][r] - mnew); sc[kt][r] = e; ps += e; }
      lsum[st] = lsum[st] * alpha + ps;
#pragma unroll
      for (int dt = 0; dt < 4; ++dt) o[st][dt] *= alpha;
#pragma unroll
      for (int s2 = 0; s2 < 2; ++s2) {
        u32x4 tt;
        tt.x = pack2(sc[2 * s2][0], sc[2 * s2][1]); tt.y = pack2(sc[2 * s2][2], sc[2 * s2][3]);
        tt.z = pack2(sc[2 * s2 + 1][0], sc[2 * s2 + 1][1]); tt.w = pack2(sc[2 * s2 + 1][2], sc[2 * s2 + 1][3]);
        pf[st][s2] = __builtin_bit_cast(bf16x8, tt);
      }
    }
#pragma unroll
    for (int dt = 0; dt < 4; ++dt)
#pragma unroll
      for (int s2 = 0; s2 < 2; ++s2) {
        const bf16x8 vf = *(const bf16x8*)(Vs + (dt * 16 + r16) * 72 + 32 * s2 + 8 * quad);
#pragma unroll
        for (int st = 0; st < NS; ++st) o[st][dt] = mfma16(vf, pf[st][s2], o[st][dt]);
      }
    if (t + 1 < nt) {
      bf16_t* d = lds + ((t + 1) & 1) * (2 * 64 * 72) + lrow * 72 + lch;
      *(u32x4*)d = rk0; *(u32x4*)(d + 8) = rk1; *(u32x4*)(d + 64 * 72) = rv0; *(u32x4*)(d + 64 * 72 + 8) = rv1;
    }
    __syncthreads();
  }
  float l0 = lsum[0]; l0 += __shfl_xor(l0, 16); l0 += __shfl_xor(l0, 32);
  const int tok = tokb + qpos;
  if (!DIFF) {
    l0 += __builtin_amdgcn_exp2f(p.win_sink[l * 4 + h] * 1.4426950408889634f - m[0]);
    const float inv = 1.0f / l0;
#pragma unroll
    for (int dt = 0; dt < 4; ++dt) {
      f32x4 v = o[0][dt] * inv;
      *(f32x4*)(p.OB + (size_t)tok * 256 + h * 64 + dt * 16 + quad * 4) = v;
    }
  } else {
    float l1 = lsum[1]; l1 += __shfl_xor(l1, 16); l1 += __shfl_xor(l1, 32);
    float d1 = 0.f, d2 = 0.f;
    const float* dl = p.diff_lam + l * 128;
    for (int j = 0; j < 32; ++j) { d1 += dl[j] * dl[32 + j]; d2 += dl[64 + j] * dl[96 + j]; }
    const float lam_init = 0.8f - 0.6f * expf(-0.3f * (float)l);
    const float lam = expf(d1) - expf(d2) + lam_init;
    const float i0 = 1.0f / l0, i1 = lam / l1;
    f32x4 v[4]; float ss = 0.f;
#pragma unroll
    for (int dt = 0; dt < 4; ++dt) { v[dt] = o[0][dt] * i0 - o[1][dt] * i1; ss += v[dt][0] * v[dt][0] + v[dt][1] * v[dt][1] + v[dt][2] * v[dt][2] + v[dt][3] * v[dt][3]; }
    ss += __shfl_xor(ss, 16); ss += __shfl_xor(ss, 32);
    const float rstd = rsqrtf(ss * (1.0f / 64.0f) + 1e-6f) * (1.0f - lam_init);
#pragma unroll
    for (int dt = 0; dt < 4; ++dt) {
      const f32x4 g = *(const f32x4*)(p.diff_g + l * 64 + dt * 16 + quad * 4);
      *(f32x4*)(p.OD + (size_t)tok * 256 + h * 64 + dt * 16 + quad * 4) = v[dt] * rstd * g;
    }
  }
}

__device__ __forceinline__ void mix_other(const Params& p, int l, int it, unsigned char* smem) {
  if (it < 256) { attn_item<true>(p, l, true, it >> 6, (it >> 4) & 3, it & 15, smem); return; }
  it -= 256;
  if (it < 40) { lru_scan(p, l, it); return; }
  it -= 40;
  if (it < 256) { attn_item<false>(p, l, true, it >> 6, (it >> 4) & 3, it & 15, smem); return; }
  it -= 256;
  if (it < 256) { attn_item<true>(p, l, false, it >> 4, (it >> 2) & 3, it & 3, smem); return; }
  it -= 256;
  attn_item<false>(p, l, false, it >> 4, (it >> 2) & 3, it & 3, smem);
}

#define ES 4
#define EP 8
__device__ __forceinline__ void mix_item(const Params& p, int l, int it, unsigned char* smem) {
  constexpr int NPS = 16 / ES, NPP = 16 / EP, NS = 32 * NPS, NP = 128 * NPP;
  if (it < NS) {
#pragma unroll 1
    for (int r = 0; r < p.rep2[0]; ++r) rwkv_chain<ES>(p, l, it / NPS, it % NPS, smem);
    return;
  }
  it -= NS;
  if (it < NP) {
#pragma unroll 1
    for (int r = 0; r < p.rep2[1]; ++r) rwkv_chain<EP>(p, l, 32 + it / NPP, it % NPP, smem);
    return;
  }
  it -= NP;
#pragma unroll 1
  for (int r = 0; r < p.rep2[2]; ++r) mix_other(p, l, it, smem);
}
__device__ __forceinline__ void phase_mix(const Params& p, int l, unsigned char* smem) {
  constexpr int NS = 32 * (16 / ES), NP = 128 * (16 / EP), NALL = NS + NP + 1064;
  const int G = gridDim.x, b = blockIdx.x;
  if (G >= 2 * NS) {
    if (b < NS) mix_item(p, l, b, smem);
    else {
#pragma unroll 1
      for (int it = NS + (b - NS); it < NALL; it += G - NS) mix_item(p, l, it, smem);
    }
  } else {
#pragma unroll 1
    for (int it = b; it < NALL; it += G) mix_item(p, l, it, smem);
  }
}

DI float sum16(float v) { v += __shfl_xor(v, 1); v += __shfl_xor(v, 2); v += __shfl_xor(v, 4); v += __shfl_xor(v, 8); return v; }

__device__ __forceinline__ void phase_post(const Params& p, int l) {
  const int tid0 = tid_opaque();
  const int lane = tid0 & 63, wave = tid0 >> 6;
  const int c = lane * 4;
#pragma unroll 1
  for (int tok = blockIdx.x * 4 + wave; tok < NTOK; tok += gridDim.x * 4) {
    const bf16_t* pr = p.P + (size_t)tok * PW;
    const f32x4 ya0 = *(const f32x4*)(p.YA + (size_t)tok * 256 + c), ya1 = *(const f32x4*)(p.YA + ((size_t)NTOK + tok) * 256 + c);
    const u32x2 r_ = *(const u32x2*)(pr + c), k_ = *(const u32x2*)(pr + 256 + c), v_ = *(const u32x2*)(pr + 512 + c), ga_ = *(const u32x2*)(pr + 896 + c);
    const u32x2 gb_ = *(const u32x2*)(pr + 1664 + c), gc_ = *(const u32x2*)(pr + 2176 + c), gd_ = *(const u32x2*)(pr + 3200 + c);
    const f32x4 rk = *(const f32x4*)(p.rw_rk + l * 256 + c), gg = *(const f32x4*)(p.rw_gng + l * 256 + c), gbias = *(const f32x4*)(p.rw_gnb + l * 256 + c);
    const f32x4 ob = *(const f32x4*)(p.OB + (size_t)tok * 256 + c), od = *(const f32x4*)(p.OD + (size_t)tok * 256 + c);
    const f32x4 h0 = *(const f32x4*)(p.LU + (size_t)tok * 256 + c), h1 = *(const f32x4*)(p.LU + ((size_t)NTOK + tok) * 256 + c);
    const f32x4 A0 = *(const f32x4*)(p.LA + (size_t)tok * 256 + c), A1 = *(const f32x4*)(p.LA + ((size_t)NTOK + tok) * 256 + c);
    const f32x4 c0 = *(const f32x4*)(p.LC + (size_t)(tok >> 4) * 256 + c), c1 = *(const f32x4*)(p.LC + ((size_t)512 + (tok >> 4)) * 256 + c);
    __builtin_amdgcn_sched_barrier(0);
    float out[4];
    {
      const f32x4 y = ya0 + ya1;
      const float mu = sum16(y[0] + y[1] + y[2] + y[3]) * (1.0f / 64.0f);
      const f32x4 dv = y - mu;
      const float var = sum16(dv[0] * dv[0] + dv[1] * dv[1] + dv[2] * dv[2] + dv[3] * dv[3]) * (1.0f / 64.0f);
      const float rstd = rsqrtf(var + 64e-5f);
      const float r[4] = {bflo(r_.x), bfhi(r_.x), bflo(r_.y), bfhi(r_.y)}, k[4] = {bflo(k_.x), bfhi(k_.x), bflo(k_.y), bfhi(k_.y)};
      const float v[4] = {bflo(v_.x), bfhi(v_.x), bflo(v_.y), bfhi(v_.y)}, g[4] = {bflo(ga_.x), bfhi(ga_.x), bflo(ga_.y), bfhi(ga_.y)};
      const float bs = sum16(r[0] * k[0] * rk[0] + r[1] * k[1] * rk[1] + r[2] * k[2] * rk[2] + r[3] * k[3] * rk[3]);
#pragma unroll
      for (int q = 0; q < 4; ++q) out[q] = (dv[q] * rstd * gg[q] + gbias[q] + bs * v[q]) * siluf_(g[q]);
      st4bf(p.H + (size_t)tok * LDK + c, out);
    }
    {
      const float g[4] = {bflo(gb_.x), bfhi(gb_.x), bflo(gb_.y), bfhi(gb_.y)};
#pragma unroll
      for (int q = 0; q < 4; ++q) out[q] = ob[q] * siluf_(g[q]);
      st4bf(p.H + (size_t)tok * LDK + 256 + c, out);
    }
    {
      const float g[4] = {bflo(gc_.x), bfhi(gc_.x), bflo(gc_.y), bfhi(gc_.y)};
#pragma unroll
      for (int q = 0; q < 4; ++q) out[q] = (h0[q] + A0[q] * c0[q] + h1[q] + A1[q] * c1[q]) * siluf_(g[q]);
      st4bf(p.H + (size_t)tok * LDK + 512 + c, out);
    }
    {
      const float g[4] = {bflo(gd_.x), bfhi(gd_.x), bflo(gd_.y), bfhi(gd_.y)};
#pragma unroll
      for (int q = 0; q < 4; ++q) out[q] = od[q] * siluf_(g[q]);
      st4bf(p.H + (size_t)tok * LDK + 768 + c, out);
    }
  }
}

__global__ void __launch_bounds__(256, 2) fwd_megakernel(Params p) {
  __shared__ __attribute__((aligned(16))) unsigned char smem[49152];
  __shared__ uint4 xb_words;
  if (threadIdx.x == 0) xb_words = make_uint4(0u, 0u, 0u, 0u);
  __syncthreads();
  XcdBarrier xb = xcd_barrier_post(p.bar, (volatile LAS unsigned*)&xb_words);
  if (threadIdx.x == 0) ((volatile LAS unsigned*)&xb_words)[3] = xb_add(&p.bar[xb_xcc_id()], 1u);
#pragma unroll 1
  for (int r = 0; r < p.rep[0]; ++r) phase_prologue(p, smem);
  xcd_barrier(xb);
  if (threadIdx.x == 0) {
    const unsigned x = xb_xcc_id(); unsigned pre = 0;
    for (unsigned j = 0; j < 16; ++j) { const unsigned c = xb_ld(&p.bar[XB_XCNT(j)]); pre += (j < x) ? c : 0u; }
    ((volatile LAS unsigned*)&xb_words)[2] = pre + ((volatile LAS unsigned*)&xb_words)[3];
  }
  __syncthreads();
#pragma unroll 1
  for (int r = 0; r < p.rep[1]; ++r) phase_norm(p, 0);
  xcd_barrier(xb);
#pragma unroll 1
  for (int l = 0; l < 2; ++l) {
#pragma unroll 1
    for (int r = 0; r < p.rep[2]; ++r) phase_gemm<0>(p, l, smem, (int)((volatile LAS unsigned*)&xb_words)[2]);
    xcd_barrier(xb);
#pragma unroll 1
    for (int r = 0; r < p.rep[3]; ++r) phase_pre(p, l, smem);
    xcd_barrier(xb);
#pragma unroll 1
    for (int r = 0; r < p.rep[4]; ++r) phase_mix(p, l, smem);
    xcd_barrier(xb);
#pragma unroll 1
    for (int r = 0; r < p.rep[5]; ++r) phase_post(p, l);
    xcd_barrier(xb);
#pragma unroll 1
    for (int r = 0; r < p.rep[6]; ++r) phase_gemm<1>(p, l, smem, (int)((volatile LAS unsigned*)&xb_words)[2]);
    xcd_barrier(xb);
    phase_norm(p, l + 1);
    if (l == 0) xcd_barrier(xb);
#pragma unroll 1
    for (int r = 1; r < p.rep[7]; ++r) xcd_barrier(xb);
  }
}

extern "C" void kernel_launch(void* const* d_in, const int* in_sizes, int n_in, void* d_out, int out_size, void* d_ws, size_t ws_size, hipStream_t stream) {
  static int grid_blocks = 0;
  if (!grid_blocks) {
    int dev = 0, cus = 0, per_cu = 0;
    hipGetDevice(&dev);
    hipDeviceGetAttribute(&cus, hipDeviceAttributeMultiprocessorCount, dev);
    hipOccupancyMaxActiveBlocksPerMultiprocessor(&per_cu, (const void*)fwd_megakernel, 256, 0);
    if (per_cu < 1) per_cu = 1;
    if (per_cu > 2) per_cu = 2;
    grid_blocks = cus * per_cu;
  }
  Params p{};
  const float** f = (const float**)&p;
  for (int i = 0; i < 35; ++i) f[i] = (const float*)d_in[i];
  p.out = (float*)d_out;
  size_t off = 0;
  auto take = [&](size_t bytes) { void* r = (char*)d_ws + off; off += (bytes + 255) & ~(size_t)255; return r; };
  p.MOD = (float*)take(2 * 5 * 3072 * 4);
  p.WINT = (bf16_t*)take((size_t)2 * PW * LDK * 2);
  p.WOUTT = (bf16_t*)take((size_t)2 * 1024 * LDK * 2);
  p.CWK = (bf16_t*)take((size_t)4 * 2 * 256 * 128 * 2);
  p.CWVT = (bf16_t*)take((size_t)4 * 2 * 256 * 128 * 2);
  p.CDK = (bf16_t*)take((size_t)4 * 2 * 256 * 256 * 2);
  p.CDVT = (bf16_t*)take((size_t)4 * 2 * 256 * 256 * 2);
  p.H = (bf16_t*)take((size_t)NTOK * LDK * 2);
  p.P = (bf16_t*)take((size_t)NTOK * PW * 2);
  p.NKK = (float*)take((size_t)NTOK * 256 * 4);
  p.AW = (float*)take((size_t)2 * NTOK * 256 * 4);
  p.AB = (float*)take((size_t)2 * NTOK * 256 * 4);
  p.AKD = (float*)take((size_t)2 * NTOK * 256 * 4);
  p.Y2 = p.NKK;
  p.YA = (float*)take((size_t)2 * NTOK * 256 * 4);
  p.LA = (float*)take((size_t)2 * NTOK * 256 * 4);
  p.LU = (float*)take((size_t)2 * NTOK * 256 * 4);
  p.QBR = (bf16_t*)take((size_t)4096 * 256 * 2);
  p.KBR = (bf16_t*)take((size_t)4096 * 128 * 2);
  p.QDR = (bf16_t*)take((size_t)4096 * 256 * 2);
  p.KDR = (bf16_t*)take((size_t)4096 * 256 * 2);
  p.VBT = (bf16_t*)take((size_t)NTOK * 128 * 2);
  p.VDT = (bf16_t*)take((size_t)NTOK * 256 * 2);
  p.OB = (float*)take((size_t)NTOK * 256 * 4);
  p.OD = (float*)take((size_t)NTOK * 256 * 4);
  p.LC = (float*)take((size_t)2 * 512 * 256 * 4);
  p.bar = (unsigned*)take((size_t)XCD_BAR_WORDS * 4);
  p.RWT = (bf16_t*)take((size_t)2 * 4 * 256 * 64 * 2);
  p.LWT = (bf16_t*)take((size_t)2 * 4 * 4 * 64 * 64 * 2);
  if (off > ws_size) { fprintf(stderr, "workspace too small: need %zu have %zu\n", off, ws_size); return; }
  static const int REPS[8] = {1, 1, 1, 1, 1, 1, 1, 1};
  for (int i = 0; i < 8; ++i) p.rep[i] = REPS[i];
  static const int REPS2[8] = {1, 1, 1, 1, 1, 1, 1, 1};
  for (int i = 0; i < 8; ++i) p.rep2[i] = REPS2[i];
  hipMemsetAsync(p.bar, 0, (size_t)XCD_BAR_WORDS * 4, stream);
  void* args[] = {&p};
  hipError_t e = hipLaunchCooperativeKernel((const void*)fwd_megakernel, dim3(grid_blocks), dim3(256), args, 0, stream);
  if (e != hipSuccess) fprintf(stderr, "cooperative launch failed: %s (grid %d)\n", hipGetErrorString(e), grid_blocks);
}
```

```cpp
#include <hip/hip_runtime.h>
#include <cstdio>
#include <cstdint>

typedef unsigned short bf16_t;
typedef short bf16x8 __attribute__((ext_vector_type(8)));
typedef float f32x4 __attribute__((ext_vector_type(4)));
typedef unsigned u32x4 __attribute__((ext_vector_type(4)));
typedef unsigned u32x2 __attribute__((ext_vector_type(2)));
#define DI __device__ __forceinline__

#define O_YP 0
#define O_NWK 8388608
#define O_NWV 9437184
#define O_NDK 10485760
#define O_NDV 12582912
#define O_NSR 14680064
#define O_NSL 15728640

#define NTOK 8192
#define PW 3456
#define LDK 1088

struct Params {
  const float *x_prompt, *x_sample, *c, *cwk, *cwv, *cdk, *cdv, *st_rwkv, *st_lru, *c_ctx, *w_mod, *b_mod, *g_pre, *g_post, *w_in, *w_out;
  const float *rw_w0, *rw_wup, *rw_a0, *rw_aup, *rw_kk, *rw_ka, *rw_rk, *rw_gng, *rw_gnb, *win_sink;
  const float *lru_cw, *lru_cb, *lru_wa, *lru_ba, *lru_wx, *lru_bx, *lru_lam, *diff_lam, *diff_g;
  float* out;
  float* MOD; bf16_t* WINT; bf16_t* WOUTT; bf16_t* CWK; bf16_t* CWVT; bf16_t* CDK; bf16_t* CDVT;
  bf16_t* H; bf16_t* P; float* NKK; float* AW; float* AB; float* AKD; float* YA; float* LA; float* LU;
  bf16_t* QBR; bf16_t* KBR; bf16_t* QDR; bf16_t* KDR; bf16_t* VBT; bf16_t* VDT; float* OB; float* OD; float* Y2; float* LC; unsigned* bar; bf16_t* RWT; bf16_t* LWT;
  int rep[8];
  int rep2[8];
};

DI void lds_barrier() { asm volatile("s_waitcnt lgkmcnt(0)\n\ts_barrier" ::: "memory"); }
DI int tid_opaque() { int t = threadIdx.x; asm volatile("" : "+v"(t)); return t; }
DI bf16_t f2bf(float x) { unsigned u = __float_as_uint(x); u += 0x7fffu + ((u >> 16) & 1u); return (bf16_t)(u >> 16); }
DI float bf2f(bf16_t b) { return __uint_as_float(((unsigned)b) << 16); }
typedef float f32x2_ __attribute__((ext_vector_type(2)));
typedef __bf16 bf16x2_t __attribute__((ext_vector_type(2)));
DI unsigned pack2(float a, float b) { f32x2_ v = {a, b}; bf16x2_t r = __builtin_convertvector(v, bf16x2_t); return __builtin_bit_cast(unsigned, r); }
DI float bflo(unsigned u) { return __uint_as_float(u << 16); }
DI float bfhi(unsigned u) { return __uint_as_float(u & 0xffff0000u); }
DI void ld4bf(const bf16_t* q, float (&o)[4]) { u32x2 u = *(const u32x2*)q; o[0] = bflo(u.x); o[1] = bfhi(u.x); o[2] = bflo(u.y); o[3] = bfhi(u.y); }
DI void st4bf(bf16_t* q, const float (&v)[4]) { u32x2 u; u.x = pack2(v[0], v[1]); u.y = pack2(v[2], v[3]); *(u32x2*)q = u; }
DI float wave_sum(float v) { for (int o = 32; o > 0; o >>= 1) v += __shfl_xor(v, o); return v; }
DI float sigmoidf_(float x) { return 1.0f / (1.0f + expf(-x)); }
DI float fsigmoid(float x) { return __builtin_amdgcn_rcpf(1.0f + __expf(-x)); }
DI float wave_sum_dpp(float v) {
  v += __builtin_bit_cast(float, __builtin_amdgcn_update_dpp(0, __builtin_bit_cast(int, v), 0xB1, 0xf, 0xf, true));
  v += __builtin_bit_cast(float, __builtin_amdgcn_update_dpp(0, __builtin_bit_cast(int, v), 0x4E, 0xf, 0xf, true));
  v += __builtin_bit_cast(float, __builtin_amdgcn_update_dpp(0, __builtin_bit_cast(int, v), 0x141, 0xf, 0xf, true));
  v += __builtin_bit_cast(float, __builtin_amdgcn_update_dpp(0, __builtin_bit_cast(int, v), 0x140, 0xf, 0xf, true));
  const int iv = __builtin_bit_cast(int, v);
  return __builtin_bit_cast(float, __builtin_amdgcn_readlane(iv, 0)) + __builtin_bit_cast(float, __builtin_amdgcn_readlane(iv, 16)) + __builtin_bit_cast(float, __builtin_amdgcn_readlane(iv, 32)) + __builtin_bit_cast(float, __builtin_amdgcn_readlane(iv, 48));
}
DI float siluf_(float x) { return x * __builtin_amdgcn_rcpf(1.0f + __expf(-x)); }
DI float softplusf_(float z) { return z > 20.f ? z : log1pf(expf(z)); }
DI f32x4 mfma16(bf16x8 a, bf16x8 b, f32x4 c) { return __builtin_amdgcn_mfma_f32_16x16x32_bf16(a, b, c, 0, 0, 0); }
DI float quad_sum(float v) {
  v += __builtin_bit_cast(float, __builtin_amdgcn_update_dpp(0, __builtin_bit_cast(int, v), 0xB1, 0xf, 0xf, true));
  v += __builtin_bit_cast(float, __builtin_amdgcn_update_dpp(0, __builtin_bit_cast(int, v), 0x4E, 0xf, 0xf, true));
  return v;
}


#define XB_TMO      128
#define XB_XCNT(j)  (256  + 64 * (j))
#define XB_XSUB(j)  (1280 + 64 * (j))
#define XB_XGEN(j)  (2304 + 64 * (j))
#define XB_TOP      3328
#define XB_TOPGEN   3392
#define XCD_BAR_WORDS 3456
#define XB_SPIN_CAP (1u << 18)
#define LAS __attribute__((address_space(3)))
DI unsigned xb_ld(unsigned* p)              { return __hip_atomic_load(p, __ATOMIC_RELAXED, __HIP_MEMORY_SCOPE_AGENT); }
DI unsigned xb_add(unsigned* p, unsigned v) { return __hip_atomic_fetch_add(p, v, __ATOMIC_RELAXED, __HIP_MEMORY_SCOPE_AGENT); }
DI unsigned xb_xcc_id() { return (unsigned)__builtin_amdgcn_s_getreg((3 << 11) | 20) & 0xFu; }
#define XB_SPIN(cond, bar) do { unsigned _sp = 0; while (cond) { __builtin_amdgcn_s_sleep(1); \
    if ((++_sp & 255u) == 0u) { if (xb_ld(&(bar)[XB_TMO])) break; if (_sp > XB_SPIN_CAP) { atomicAdd(&(bar)[XB_TMO], 1u); break; } } } } while (0)
struct XcdBarrier { unsigned* bar; unsigned x; volatile LAS unsigned* st; };
DI XcdBarrier xcd_barrier_post(unsigned* bar, volatile LAS unsigned* st) {
    XcdBarrier b; b.bar = bar; b.x = xb_xcc_id(); b.st = st;
    if (threadIdx.x == 0) (void)xb_add(&bar[XB_XCNT(b.x)], 1u);
    return b;
}
DI void xcd_barrier_complete(unsigned* bar, unsigned x, unsigned& nloc, unsigned& nx) {
    const unsigned G = gridDim.x * gridDim.y * gridDim.z;
    unsigned sum, cnt, mine, sp = 0u;
    for (;;) {
        sum = 0u; cnt = 0u; mine = 0u;
#pragma unroll
        for (unsigned j = 0; j < 16; ++j) { const unsigned c = xb_ld(&bar[XB_XCNT(j)]); sum += c; cnt += (c > 0u) ? 1u : 0u; mine = (j == x) ? c : mine; }
        if (sum == G) break;
        __builtin_amdgcn_s_sleep(1);
        if ((++sp & 255u) == 0u) { if (xb_ld(&bar[XB_TMO])) break; if (sp > XB_SPIN_CAP) { atomicAdd(&bar[XB_TMO], 1u); break; } }
    }
    nloc = mine > 0u ? mine : 1u; nx = cnt > 0u ? cnt : 1u;
}
DI void xcd_barrier(const XcdBarrier& b) {
    asm volatile("s_waitcnt vmcnt(0)" ::: "memory");
    __syncthreads();
    if (threadIdx.x == 0) {
        unsigned* bar = b.bar;
        unsigned bx = xb_xcc_id();
        __builtin_amdgcn_s_waitcnt(0);
        unsigned nloc = b.st[0], nx = b.st[1];
        if (nloc == 0u) { xcd_barrier_complete(bar, bx, nloc, nx); b.st[0] = nloc; b.st[1] = nx; }
        const unsigned old = xb_add(&bar[XB_XSUB(bx)], 1u);
        const unsigned gen = old / nloc;
        if (old + 1u == (gen + 1u) * nloc) {
            __builtin_amdgcn_fence(__ATOMIC_RELEASE, "agent");
            asm volatile("s_waitcnt vmcnt(0)" ::: "memory");
            const unsigned og = xb_add(&bar[XB_TOP], 1u);
            const unsigned tg = og / nx;
            if (og + 1u == (tg + 1u) * nx) xb_add(&bar[XB_TOPGEN], 1u);
            else XB_SPIN(xb_ld(&bar[XB_TOPGEN]) == tg, bar);
            __builtin_amdgcn_fence(__ATOMIC_ACQUIRE, "agent");
            xb_add(&bar[XB_XGEN(bx)], 1u);
            asm volatile("s_waitcnt vmcnt(0)" ::: "memory");
        } else {
            XB_SPIN(xb_ld(&bar[XB_XGEN(bx)]) == gen, bar);
            __builtin_amdgcn_fence(__ATOMIC_ACQUIRE, "agent");
            asm volatile("s_waitcnt vmcnt(0)" ::: "memory");
        }
    }
    __syncthreads();
}

template <typename T> DI float ldval(const T* p);
template <> DI float ldval<float>(const float* p) { return *p; }
template <> DI float ldval<bf16_t>(const bf16_t* p) { return bf2f(*p); }
template <typename T>
DI void transpose_tile(const T* src, int src_ld, bf16_t* dst, int dst_ld, float* lds) {
  const int tid = tid_opaque();
#pragma unroll 8
  for (int i = 0; i < 16; ++i) { int r = (tid >> 6) + 4 * i, c = tid & 63; lds[r * 65 + c] = ldval<T>(src + (size_t)r * src_ld + c); }
  __syncthreads();
#pragma unroll 4
  for (int i = 0; i < 16; ++i) { int c = (tid >> 6) + 4 * i, r = tid & 63; dst[(size_t)c * dst_ld + r] = f2bf(lds[r * 65 + c]); }
  __syncthreads();
}

__device__ __forceinline__ void weight_tile(const Params& p, int l, int item, float* lds) {
  if (item < 864) {
    const int kt = item / 54, nt = item % 54;
    transpose_tile<float>(p.w_in + (size_t)l * 1024 * PW + (size_t)kt * 64 * PW + nt * 64, PW,
                          p.WINT + (size_t)l * PW * LDK + (size_t)nt * 64 * LDK + kt * 64, LDK, lds);
  } else {
    const int r = item - 864, kt = r / 16, nt = r % 16;
    transpose_tile<float>(p.w_out + (size_t)l * 1024 * 1024 + (size_t)kt * 64 * 1024 + nt * 64, 1024,
                          p.WOUTT + (size_t)l * 1024 * LDK + (size_t)nt * 64 * LDK + kt * 64, LDK, lds);
  }
}

__device__ __forceinline__ void phase_prologue(const Params& p, unsigned char* smem) {
  float* lds = (float*)smem;
  const int n0 = 1728, n1 = n0 + 512, n2 = n1 + 192, n3 = n2 + 64, n4 = n3 + 128, n5 = n4 + 192, n6 = n5 + 32, n7 = n6 + 32;
#pragma unroll 1
  for (int it = blockIdx.x; it < n7; it += gridDim.x) {
    const int tid = tid_opaque();
    if (it < n1) {
      if (it < 1120) weight_tile(p, 0, it, lds);
      else if (gridDim.x < 320) weight_tile(p, 1, it - 1120, lds);
    } else if (it < n2) {
      int i2 = it - n1; int l = i2 / 96, nb = (i2 % 96) * 32;
      float* sc = lds;
      float* red = lds + 5 * 1024;
      for (int i = tid; i < 5 * 1024; i += 256) { int v = i >> 10, k = i & 1023; float x = v == 0 ? p.c_ctx[k] : p.c[(v - 1) * 1024 + k]; sc[i] = siluf_(x); }
      __syncthreads();
      int n = tid & 31, kg = tid >> 5;
      float a0 = 0, a1 = 0, a2 = 0, a3 = 0, a4 = 0;
      const float* wp = p.w_mod + (size_t)l * 1024 * 3072 + nb + n;
      for (int k = kg * 128; k < kg * 128 + 128; ++k) {
        float w = wp[(size_t)k * 3072];
        a0 += sc[k] * w; a1 += sc[1024 + k] * w; a2 += sc[2048 + k] * w; a3 += sc[3072 + k] * w; a4 += sc[4096 + k] * w;
      }
      red[(kg * 5 + 0) * 32 + n] = a0; red[(kg * 5 + 1) * 32 + n] = a1; red[(kg * 5 + 2) * 32 + n] = a2; red[(kg * 5 + 3) * 32 + n] = a3; red[(kg * 5 + 4) * 32 + n] = a4;
      __syncthreads();
      if (tid < 160) { int v = tid >> 5, nn = tid & 31; float s = p.b_mod[l * 3072 + nb + nn]; for (int q = 0; q < 8; ++q) s += red[(q * 5 + v) * 32 + nn]; p.MOD[(size_t)(l * 5 + v) * 3072 + nb + nn] = s; }
      __syncthreads();
    } else if (it < n3) {
      int i2 = it - n2; int bl = i2 >> 3, r = i2 & 7, pt = r >> 1, ct = r & 1;
      transpose_tile<float>(p.cwv + (size_t)bl * 256 * 128 + (size_t)pt * 64 * 128 + ct * 64, 128,
                            p.CWVT + (size_t)bl * 128 * 256 + (size_t)ct * 64 * 256 + pt * 64, 256, lds);
    } else if (it < n4) {
      int i2 = it - n3; int bl = i2 >> 4, r = i2 & 15, pt = r >> 2, ct = r & 3;
      transpose_tile<float>(p.cdv + (size_t)bl * 256 * 256 + (size_t)pt * 64 * 256 + ct * 64, 256,
                            p.CDVT + (size_t)bl * 256 * 256 + (size_t)ct * 64 * 256 + pt * 64, 256, lds);
    } else if (it >= n6) {
      int i2 = it - n6; int l = i2 >> 4, mat = (i2 >> 2) & 3, n = i2 & 3;
      const float* src = (mat < 2 ? p.lru_wa : p.lru_wx) + (size_t)(((l * 2 + (mat & 1)) * 4 + n)) * 4096;
      transpose_tile<float>(src, 64, p.LWT + (size_t)(((l * 4 + mat) * 4 + n)) * 4096, 64, lds);
    } else if (it >= n5) {
      int i2 = it - n5; int l = i2 >> 4, mat = (i2 >> 2) & 3, ct = i2 & 3;
      const float* src = (mat < 2 ? p.rw_wup : p.rw_aup) + (size_t)(l * 2 + (mat & 1)) * 64 * 256 + ct * 64;
      transpose_tile<float>(src, 256, p.RWT + ((size_t)(l * 4 + mat) * 256 + ct * 64) * 64, 64, lds);
    } else {
      int i2 = it - n4;
      const float* src; bf16_t* dst;
      if (i2 < 64) { src = p.cwk + (size_t)i2 * 4096; dst = p.CWK + (size_t)i2 * 4096; }
      else { src = p.cdk + (size_t)(i2 - 64) * 4096; dst = p.CDK + (size_t)(i2 - 64) * 4096; }
      for (int i = tid * 4; i < 4096; i += 1024) { float4 v = *(const float4*)(src + i); uint2 o; o.x = pack2(v.x, v.y); o.y = pack2(v.z, v.w); *(uint2*)(dst + i) = o; }
    }
  }
}

__device__ __forceinline__ void phase_norm(const Params& p, int stage) {
  const int tid0 = tid_opaque();
  const int lane = tid0 & 63, wave = tid0 >> 6;
#pragma unroll 1
  for (int tok = blockIdx.x * 4 + wave; tok < NTOK; tok += gridDim.x * 4) {
    const int mv = tok < 4096 ? 0 : 1 + ((tok - 4096) >> 10);
    const float* xin;
    if (stage <= 1) xin = tok < 4096 ? p.x_prompt + (size_t)tok * 1024 : p.x_sample + (size_t)(tok - 4096) * 1024;
    else xin = p.out + (size_t)tok * 1024;
    f32x4 x[4], gt[4], gq[4], sh[4], sc[4], gpre[4]; u32x2 yb[4];
    const int lp = stage >= 1 ? stage - 1 : 0, ln = stage <= 1 ? stage : 0;
    const float* gate = p.MOD + (size_t)(lp * 5 + mv) * 3072 + 2048;
    const float* gpo = p.g_post + lp * 1024;
    const float* md = p.MOD + (size_t)(ln * 5 + mv) * 3072;
    const float* gpr = p.g_pre + ln * 1024;
#pragma unroll
    for (int i = 0; i < 4; ++i) {
      const int col = i * 256 + lane * 4;
      x[i] = *(const f32x4*)(xin + col);
      if (stage >= 1) { yb[i] = *(const u32x2*)((const bf16_t*)p.Y2 + (size_t)tok * 1024 + col); gt[i] = *(const f32x4*)(gate + col); gq[i] = *(const f32x4*)(gpo + col); }
      if (stage <= 1) { sh[i] = *(const f32x4*)(md + col); sc[i] = *(const f32x4*)(md + 1024 + col); gpre[i] = *(const f32x4*)(gpr + col); }
    }
    __builtin_amdgcn_sched_barrier(0);
    if (stage >= 1) {
      f32x4 y[4]; float ss = 0.f;
#pragma unroll
      for (int i = 0; i < 4; ++i) { y[i] = (f32x4){bflo(yb[i].x), bfhi(yb[i].x), bflo(yb[i].y), bfhi(yb[i].y)}; ss += y[i][0] * y[i][0] + y[i][1] * y[i][1] + y[i][2] * y[i][2] + y[i][3] * y[i][3]; }
      ss = wave_sum(ss);
      const float rstd = rsqrtf(ss * (1.0f / 1024.0f) + 1e-6f);
#pragma unroll
      for (int i = 0; i < 4; ++i) {
        const int col = i * 256 + lane * 4;
        x[i] += gt[i] * (y[i] * rstd * gq[i]);
        *(f32x4*)(p.out + (size_t)tok * 1024 + col) = x[i];
      }
    }
    if (stage <= 1) {
      float ss = 0.f;
#pragma unroll
      for (int i = 0; i < 4; ++i) ss += x[i][0] * x[i][0] + x[i][1] * x[i][1] + x[i][2] * x[i][2] + x[i][3] * x[i][3];
      ss = wave_sum(ss);
      const float rstd = rsqrtf(ss * (1.0f / 1024.0f) + 1e-6f);
#pragma unroll
      for (int i = 0; i < 4; ++i) {
        const int col = i * 256 + lane * 4;
        const f32x4 hv = x[i] * rstd * gpre[i] * (sc[i] + 1.f) + sh[i];
        u32x2 o; o.x = pack2(hv[0], hv[1]); o.y = pack2(hv[2], hv[3]);
        *(u32x2*)(p.H + (size_t)tok * LDK + col) = o;
      }
    }
  }
}

template <int MODE>
__device__ __forceinline__ void phase_gemm(const Params& p, int l, unsigned char* smem, int vb) {
  const bf16_t* A = p.H;
  const bf16_t* Bt = MODE == 0 ? p.WINT + (size_t)l * PW * LDK : p.WOUTT + (size_t)l * 1024 * LDK;
  const int N = MODE == 0 ? PW : 1024, K = LDK;
  const int NTN = N / 128;
  bf16_t* As = (bf16_t*)smem; bf16_t* Bs = As + 128 * 64;
  const int per = gridDim.x >> 3;
  const bool even8 = (gridDim.x & 7) == 0;
  const int xcd = even8 ? vb / per : (vb & 7), slot = even8 ? vb % per : (vb >> 3), nslot = even8 ? per : (int)((gridDim.x + 7 - xcd) >> 3);
  const int nx = (NTN - xcd + 7) >> 3;
#pragma unroll 1
  for (int j = slot; j < 64 * nx; j += nslot) {
    const int tid = tid_opaque(), lane = tid & 63, wave = tid >> 6, wm = wave >> 1, wn = wave & 1, r16 = lane & 15, quad = lane >> 4;
    const int tm = j / nx, tn = xcd + 8 * (j % nx), m0 = tm * 128, n0 = tn * 128;
    f32x4 acc[4][4];
#pragma unroll
    for (int i = 0; i < 4; ++i)
#pragma unroll
      for (int j = 0; j < 4; ++j) acc[i][j] = (f32x4){0.f, 0.f, 0.f, 0.f};
    u32x4 ra0[4], rb0[4];
    const int lrow = tid >> 3, lc8 = tid & 7;
    const bf16_t* ga = A + (size_t)(m0 + lrow) * K + lc8 * 8;
    const bf16_t* gb = Bt + (size_t)(n0 + lrow) * K + lc8 * 8;
    const int swz_w = (lc8 ^ ((lrow >> 1) & 7)) * 8, swz_r = (r16 >> 1) & 7;
    bf16_t* const sa_ = As + lrow * 64 + swz_w; bf16_t* const sb_ = Bs + lrow * 64 + swz_w;
#define G_LOAD(RA, RB, KT) { _Pragma("unroll") for (int i = 0; i < 4; ++i) { RA[i] = *(const u32x4*)(ga + (size_t)i * 32 * K + (KT) * 64); RB[i] = *(const u32x4*)(gb + (size_t)i * 32 * K + (KT) * 64); } }
#define G_STORE(RA, RB) { _Pragma("unroll") for (int i = 0; i < 4; ++i) { *(u32x4*)(sa_ + i * 32 * 64) = RA[i]; *(u32x4*)(sb_ + i * 32 * 64) = RB[i]; } }
#define G_COMPUTE() { _Pragma("unroll") for (int ks = 0; ks < 2; ++ks) { bf16x8 af[4], bfr[4]; \
      _Pragma("unroll") for (int i = 0; i < 4; ++i) { af[i] = *(const bf16x8*)(As + (wm * 64 + i * 16 + r16) * 64 + (((ks * 4 + quad) ^ swz_r) * 8)); bfr[i] = *(const bf16x8*)(Bs + (wn * 64 + i * 16 + r16) * 64 + (((ks * 4 + quad) ^ swz_r) * 8)); } \
      _Pragma("unroll") for (int mi = 0; mi < 4; ++mi) _Pragma("unroll") for (int ni = 0; ni < 4; ++ni) acc[mi][ni] = mfma16(bfr[ni], af[mi], acc[mi][ni]); } }
    G_LOAD(ra0, rb0, 0);
    G_STORE(ra0, rb0);
    __syncthreads();
#pragma unroll 1
    for (int kt = 0; kt < 16; ++kt) {
      if (kt + 1 < 16) G_LOAD(ra0, rb0, kt + 1);
      __builtin_amdgcn_sched_barrier(0);
      G_COMPUTE();
      lds_barrier();
      if (kt + 1 < 16) { G_STORE(ra0, rb0); lds_barrier(); }
    }
#undef G_LOAD
#undef G_STORE
#undef G_COMPUTE
#pragma unroll
    for (int mi = 0; mi < 4; ++mi)
#pragma unroll
      for (int ni = 0; ni < 4; ++ni) {
        const int m = m0 + wm * 64 + mi * 16 + r16, n = n0 + wn * 64 + ni * 16 + quad * 4;
        const f32x4 v = acc[mi][ni];
        if (MODE == 0) {
          uint2 o; o.x = pack2(v[0], v[1]); o.y = pack2(v[2], v[3]);
          *(uint2*)(p.P + (size_t)m * PW + n) = o;
          if (m0 < 4096) {
            const int row = ((m >> 8) * 2 + l) * 256 + (m & 255);
            float* dst = nullptr;
            if (tn == 11) dst = p.out + O_NWK + (size_t)row * 128 + (n - 1408);
            else if (tn == 12) dst = p.out + O_NWV + (size_t)row * 128 + (n - 1536);
            else if (tn == 21 || tn == 22) dst = p.out + O_NDK + (size_t)row * 256 + (n - 2688);
            else if (tn == 23 || tn == 24) dst = p.out + O_NDV + (size_t)row * 256 + (n - 2944);
            if (dst) *(float4*)dst = (float4){v[0], v[1], v[2], v[3]};
          }
        } else {
          { u32x2 o; o.x = pack2(v[0], v[1]); o.y = pack2(v[2], v[3]); *(u32x2*)((bf16_t*)p.Y2 + (size_t)m * 1024 + n) = o; }
        }
      }
  }
}

DI void unpack8(u32x4 u, float (&o)[8]) { o[0] = bflo(u.x); o[1] = bfhi(u.x); o[2] = bflo(u.y); o[3] = bfhi(u.y); o[4] = bflo(u.z); o[5] = bfhi(u.z); o[6] = bflo(u.w); o[7] = bfhi(u.w); }
DI bf16x8 pack8(const float (&o)[8]) { u32x4 u; u.x = pack2(o[0], o[1]); u.y = pack2(o[2], o[3]); u.z = pack2(o[4], o[5]); u.w = pack2(o[6], o[7]); return __builtin_bit_cast(bf16x8, u); }

__device__ __forceinline__ void pre_rwkv(const Params& p, int l, int item) {
  const int tid = tid_opaque(), lane = tid & 63, h = tid >> 6, r16 = lane & 15, quad = lane >> 4;
  const int tok = item * 16 + r16;
  const bf16_t* pr = p.P + (size_t)tok * PW;
  bf16x8 wdf[2], adf[2];
#pragma unroll
  for (int ks = 0; ks < 2; ++ks) {
    float o[8]; unpack8(*(const u32x4*)(pr + 768 + ks * 32 + quad * 8), o);
#pragma unroll
    for (int j = 0; j < 8; ++j) o[j] = 1.0f - 2.0f * __builtin_amdgcn_rcpf(1.0f + __expf(2.0f * o[j]));
    wdf[ks] = pack8(o);
    adf[ks] = *(const bf16x8*)(pr + 832 + ks * 32 + quad * 8);
  }
  float kv[4][4];
#pragma unroll
  for (int ct = 0; ct < 4; ++ct) ld4bf(pr + 256 + h * 64 + ct * 16 + quad * 4, kv[ct]);
  const bf16_t* wt = p.RWT + (size_t)l * 4 * 256 * 64;
  float ss = 0.f;
#pragma unroll
  for (int ct = 0; ct < 4; ++ct) {
    const f32x4 kkc = *(const f32x4*)(p.rw_kk + l * 256 + h * 64 + ct * 16 + quad * 4);
#pragma unroll
    for (int r = 0; r < 4; ++r) { const float q = kv[ct][r] * kkc[r]; ss += q * q; }
  }
  ss += __shfl_xor(ss, 16); ss += __shfl_xor(ss, 32);
  const float rn = rsqrtf(ss + 1e-12f);
#pragma unroll
  for (int ct = 0; ct < 4; ++ct) {
    f32x4 acc[4];
    const int c0 = h * 64 + ct * 16 + quad * 4;
    bf16x8 wfr[4][2];
#pragma unroll
    for (int mat = 0; mat < 4; ++mat)
#pragma unroll
      for (int ks = 0; ks < 2; ++ks) wfr[mat][ks] = *(const bf16x8*)(wt + ((size_t)mat * 256 + h * 64 + ct * 16 + r16) * 64 + ks * 32 + quad * 8);
    const f32x4 kkc = *(const f32x4*)(p.rw_kk + l * 256 + c0), kac = *(const f32x4*)(p.rw_ka + l * 256 + c0);
    const f32x4 w00 = *(const f32x4*)(p.rw_w0 + (l * 2 + 0) * 256 + c0), w01 = *(const f32x4*)(p.rw_w0 + (l * 2 + 1) * 256 + c0);
    const f32x4 a00 = *(const f32x4*)(p.rw_a0 + (l * 2 + 0) * 256 + c0), a01 = *(const f32x4*)(p.rw_a0 + (l * 2 + 1) * 256 + c0);
    __builtin_amdgcn_sched_barrier(0);
#pragma unroll
    for (int mat = 0; mat < 4; ++mat) {
      f32x4 a = {0.f, 0.f, 0.f, 0.f};
#pragma unroll
      for (int ks = 0; ks < 2; ++ks) a = mfma16(wfr[mat][ks], mat < 2 ? wdf[ks] : adf[ks], a);
      acc[mat] = a;
    }
    f32x4 nkk, w0v, w1v, b0v, b1v, k0v, k1v;
#pragma unroll
    for (int r = 0; r < 4; ++r) {
      const float k = kv[ct][r];
      const float kkn = k * kkc[r] * rn;
      nkk[r] = -kkn;
#pragma unroll
      for (int d = 0; d < 2; ++d) {
        const float wl = (d ? w01[r] : w00[r]) + acc[d][r];
        const float w_log = -__logf(1.0f + __expf(-wl)) - 0.5f;
        const float decay = __expf(-__expf(w_log));
        const float a = fsigmoid((d ? a01[r] : a00[r]) + acc[2 + d][r]);
        const float kd = k * (1.f + (a - 1.f) * kac[r]);
        if (d) { w1v[r] = decay; b1v[r] = kkn * a; k1v[r] = kd; } else { w0v[r] = decay; b0v[r] = kkn * a; k0v[r] = kd; }
      }
    }
    const size_t o0 = (size_t)tok * 256 + c0, o1 = ((size_t)NTOK + tok) * 256 + c0;
    *(f32x4*)(p.NKK + o0) = nkk;
    *(f32x4*)(p.AW + o0) = w0v; *(f32x4*)(p.AW + o1) = w1v;
    *(f32x4*)(p.AB + o0) = b0v; *(f32x4*)(p.AB + o1) = b1v;
    *(f32x4*)(p.AKD + o0) = k0v; *(f32x4*)(p.AKD + o1) = k1v;
  }
}

#define LSCAN_STEP(A, H, CTRL) { \
    const float Ap = __builtin_bit_cast(float, __builtin_amdgcn_update_dpp(0x3f800000, __builtin_bit_cast(int, A), CTRL, 0xf, 0xf, false)); \
    const float Hp = __builtin_bit_cast(float, __builtin_amdgcn_update_dpp(0, __builtin_bit_cast(int, H), CTRL, 0xf, 0xf, true)); \
    H = A * Hp + H; A = A * Ap; }

__device__ __forceinline__ void pre_lru(const Params& p, int l, int item) {
  const int tid = tid_opaque(), lane = tid & 63, n = tid >> 6, r16 = lane & 15, quad = lane >> 4;
  const int tok0 = item * 16;
  int T, sb, t0;
  if (tok0 < 4096) { T = 256; sb = tok0 & ~255; t0 = tok0 & 255; } else { T = 1024; sb = 4096 + ((tok0 - 4096) & ~1023); t0 = (tok0 - 4096) & 1023; }
  const int t = t0 + r16, tok = tok0 + r16;
  bf16x8 xf[2];
  float xo[2][8];
#pragma unroll
  for (int ks = 0; ks < 2; ++ks) {
    const int cb = n * 64 + ks * 32 + quad * 8;
    float o[8];
    { const f32x4 b0 = *(const f32x4*)(p.lru_cb + l * 256 + cb), b1 = *(const f32x4*)(p.lru_cb + l * 256 + cb + 4);
      o[0] = b0[0]; o[1] = b0[1]; o[2] = b0[2]; o[3] = b0[3]; o[4] = b1[0]; o[5] = b1[1]; o[6] = b1[2]; o[7] = b1[3]; }
#pragma unroll
    for (int i = 0; i < 4; ++i) {
      const int tt = t - 2 + i;
      u32x4 xr = {0u, 0u, 0u, 0u};
      if (tt >= 0 && tt < T) xr = *(const u32x4*)(p.P + (size_t)(sb + tt) * PW + 1920 + cb);
      float x[8]; unpack8(xr, x);
      const f32x4 w0 = *(const f32x4*)(p.lru_cw + (l * 4 + i) * 256 + cb), w1 = *(const f32x4*)(p.lru_cw + (l * 4 + i) * 256 + cb + 4);
      o[0] += w0[0] * x[0]; o[1] += w0[1] * x[1]; o[2] += w0[2] * x[2]; o[3] += w0[3] * x[3];
      o[4] += w1[0] * x[4]; o[5] += w1[1] * x[5]; o[6] += w1[2] * x[6]; o[7] += w1[3] * x[7];
    }
    xf[ks] = pack8(o);
#pragma unroll
    for (int j = 0; j < 8; ++j) xo[ks][j] = o[j];
  }
#pragma unroll
  for (int et = 0; et < 4; ++et) {
    f32x4 acc[4];
    const int c0 = n * 64 + (et >> 1) * 32 + quad * 8 + (et & 1) * 4;
    const int erow = (et >> 1) * 32 + (r16 >> 2) * 8 + (et & 1) * 4 + (r16 & 3);
    bf16x8 wfr[4][2];
#pragma unroll
    for (int mat = 0; mat < 4; ++mat)
#pragma unroll
      for (int ks = 0; ks < 2; ++ks) wfr[mat][ks] = *(const bf16x8*)(p.LWT + ((size_t)((l * 4 + mat) * 4 + n) * 64 + erow) * 64 + ks * 32 + quad * 8);
    const f32x4 ba0 = *(const f32x4*)(p.lru_ba + (l * 2 + 0) * 256 + c0), ba1 = *(const f32x4*)(p.lru_ba + (l * 2 + 1) * 256 + c0);
    const f32x4 bx0 = *(const f32x4*)(p.lru_bx + (l * 2 + 0) * 256 + c0), bx1 = *(const f32x4*)(p.lru_bx + (l * 2 + 1) * 256 + c0);
    const f32x4 lm0 = *(const f32x4*)(p.lru_lam + (l * 2 + 0) * 256 + c0), lm1 = *(const f32x4*)(p.lru_lam + (l * 2 + 1) * 256 + c0);
    __builtin_amdgcn_sched_barrier(0);
#pragma unroll
    for (int mat = 0; mat < 4; ++mat) {
      f32x4 a = {0.f, 0.f, 0.f, 0.f};
#pragma unroll
      for (int ks = 0; ks < 2; ++ks) a = mfma16(wfr[mat][ks], xf[ks], a);
      acc[mat] = a;
    }
    f32x4 A0, H0, A1, H1;
#pragma unroll
    for (int r = 0; r < 4; ++r) {
      const float x = xo[et >> 1][(et & 1) * 4 + r];
#pragma unroll
      for (int d = 0; d < 2; ++d) {
        const float ga = fsigmoid(acc[d][r] + (d ? ba1[r] : ba0[r]));
        const float gx = fsigmoid(acc[2 + d][r] + (d ? bx1[r] : bx0[r]));
        const float e_ = __expf(-(d ? lm1[r] : lm0[r]));
        const float sp = e_ < 0.05f ? e_ * (1.0f - e_ * (0.5f - e_ * (0.33333334f - 0.25f * e_))) : __logf(1.0f + e_);
        const float log_a = -8.0f * ga * sp;
        float a = __expf(log_a);
        const float x2 = 2.0f * log_a;
        const float om = x2 > -0.05f ? -(x2 * (1.0f + x2 * (0.5f + x2 * (0.16666667f + x2 * 0.041666667f)))) : 1.0f - __expf(x2);
        float u = __fsqrt_rn(om) * (gx * x);
        if (d == 0) { LSCAN_STEP(a, u, 0x111) LSCAN_STEP(a, u, 0x112) LSCAN_STEP(a, u, 0x114) LSCAN_STEP(a, u, 0x118) A0[r] = a; H0[r] = u; }
        else        { LSCAN_STEP(a, u, 0x101) LSCAN_STEP(a, u, 0x102) LSCAN_STEP(a, u, 0x104) LSCAN_STEP(a, u, 0x108) A1[r] = a; H1[r] = u; }
      }
    }
    const size_t o0 = (size_t)tok * 256 + c0, o1 = ((size_t)NTOK + tok) * 256 + c0;
    *(f32x4*)(p.LA + o0) = A0; *(f32x4*)(p.LU + o0) = H0;
    *(f32x4*)(p.LA + o1) = A1; *(f32x4*)(p.LU + o1) = H1;
  }
}

__device__ __forceinline__ void pre_rope(const Params& p, int item) {
  const int tid = tid_opaque();
  const int ts0 = item * 16;
#pragma unroll 1
  for (int pp = tid; pp < 448; pp += 256) {
    int scol, d1, d2, half, i, dstride; bf16_t* dst; float inv;
    if (pp < 192) {
      int q = pp < 128 ? pp : pp - 128; int vec = q >> 5, pi = q & 31; half = pi >> 4; i = pi & 15;
      d1 = half * 32 + i; d2 = d1 + 16; inv = exp2f(-(float)i * (13.287712379549449f / 16.0f));
      if (pp < 128) { scol = 1152 + vec * 64; dst = p.QBR + vec * 64; dstride = 256; }
      else { scol = 1408 + vec * 64; dst = p.KBR + vec * 64; dstride = 128; }
    } else {
      int q = pp < 320 ? pp - 192 : pp - 320; int vec = q >> 4, pi = q & 15; half = pi >> 3; i = pi & 7;
      d1 = half * 16 + i; d2 = d1 + 8; inv = exp2f(-(float)i * (13.287712379549449f / 8.0f));
      if (pp < 320) { scol = 2432 + vec * 32; dst = p.QDR + vec * 32; dstride = 256; }
      else { scol = 2688 + vec * 32; dst = p.KDR + vec * 32; dstride = 256; }
    }
    float x1[16], x2[16];
#pragma unroll
    for (int tt = 0; tt < 16; ++tt) { const bf16_t* src = p.P + (size_t)(4096 + ts0 + tt) * PW + scol; x1[tt] = bf2f(src[d1]); x2[tt] = bf2f(src[d2]); }
#pragma unroll
    for (int tt = 0; tt < 16; ++tt) {
      const int t = (ts0 + tt) & 1023;
      const float ang = (float)(half ? (t & 63) : (t >> 6)) * inv;
      const float sn = __sinf(ang), cs = __cosf(ang);
      const float a = x1[tt], b = x2[tt];
      bf16_t* o = dst + (size_t)(ts0 + tt) * dstride;
      o[d1] = f2bf(a * cs - b * sn); o[d2] = f2bf(a * sn + b * cs);
    }
  }
}

__device__ __forceinline__ void phase_pre(const Params& p, int l, unsigned char* smem) {
  const int n0 = 512, n1 = n0 + 512, n2 = n1 + 256, n3 = n2 + 256, n4 = n3 + 512;
#pragma unroll 1
  for (int it = blockIdx.x; it < n4; it += gridDim.x) {
    if (it < n0) pre_rwkv(p, l, it);
    else if (it < n1) pre_lru(p, l, it - n0);
    else if (it < n2) pre_rope(p, it - n1);
    else if (it < n3) {
      int i2 = it - n2; int tt = i2 >> 1, ct = i2 & 1; int tok0 = tt * 64;
      int T, sb; if (tok0 < 4096) { T = 256; sb = tok0 & ~255; } else { T = 1024; sb = 4096 + ((tok0 - 4096) & ~1023); }
      transpose_tile<bf16_t>(p.P + (size_t)tok0 * PW + 1536 + ct * 64, PW, p.VBT + (size_t)sb * 128 + (size_t)(ct * 64) * T + (tok0 - sb), T, (float*)smem);
    } else {
      int i2 = it - n3; int tt = i2 >> 2, ct = i2 & 3; int tok0 = tt * 64;
      int T, sb; if (tok0 < 4096) { T = 256; sb = tok0 & ~255; } else { T = 1024; sb = 4096 + ((tok0 - 4096) & ~1023); }
      transpose_tile<bf16_t>(p.P + (size_t)tok0 * PW + 2944 + ct * 64, PW, p.VDT + (size_t)sb * 256 + (size_t)(ct * 64) * T + (tok0 - sb), T, (float*)smem);
    }
  }
}

template <int LR> DI float group_sum(float v) {
  v += __builtin_bit_cast(float, __builtin_amdgcn_update_dpp(0, __builtin_bit_cast(int, v), 0xB1, 0xf, 0xf, true));
  v += __builtin_bit_cast(float, __builtin_amdgcn_update_dpp(0, __builtin_bit_cast(int, v), 0x4E, 0xf, 0xf, true));
  if (LR >= 8) v += __builtin_bit_cast(float, __builtin_amdgcn_update_dpp(0, __builtin_bit_cast(int, v), 0x141, 0xf, 0xf, true));
  if (LR >= 16) v += __builtin_bit_cast(float, __builtin_amdgcn_update_dpp(0, __builtin_bit_cast(int, v), 0x140, 0xf, 0xf, true));
  return v;
}
typedef float f32x2 __attribute__((ext_vector_type(2)));
template <int E> struct RwOps { f32x4 nk[E / 4], ww[E / 4], bb[E / 4], kk[E / 4], rr[E / 4]; float vi; };
template <int E> DI void rw_load(const float* ob, int g, int i, RwOps<E>& o) {
  constexpr int LR = 64 / E, NM = E / 4;
#pragma unroll
  for (int m = 0; m < NM; ++m) {
    const int off = 4 * (g + LR * m);
    o.nk[m] = *(const f32x4*)(ob + off); o.ww[m] = *(const f32x4*)(ob + 64 + off); o.bb[m] = *(const f32x4*)(ob + 128 + off);
    o.kk[m] = *(const f32x4*)(ob + 192 + off); o.rr[m] = *(const f32x4*)(ob + 256 + off);
  }
  o.vi = ob[320 + i];
}
#define DPP_ADD(V, CTRL) V += __builtin_bit_cast(float, __builtin_amdgcn_update_dpp(0, __builtin_bit_cast(int, V), CTRL, 0xf, 0xf, true))
template <int E> DI float rw_step(f32x2 (&S)[E / 2], const RwOps<E>& o, float& ypart) {
  constexpr int LR = 64 / E, NM = E / 4;
  f32x2 p2 = S[0] * o.nk[0].xy;
  p2 = S[1] * o.nk[0].zw + p2;
#pragma unroll
  for (int m = 1; m < NM; ++m) { p2 = S[2 * m] * o.nk[m].xy + p2; p2 = S[2 * m + 1] * o.nk[m].zw + p2; }
  float sa = p2.x + p2.y, yr = ypart;
  DPP_ADD(sa, 0xB1); DPP_ADD(yr, 0xB1);
  DPP_ADD(sa, 0x4E); DPP_ADD(yr, 0x4E);
  if (LR >= 8) { DPP_ADD(sa, 0x141); DPP_ADD(yr, 0x141); }
  if (LR >= 16) { DPP_ADD(sa, 0x140); DPP_ADD(yr, 0x140); }
  const f32x2 sa2 = {sa, sa}, v2 = {o.vi, o.vi};
  f32x2 y2 = {0.f, 0.f};
#pragma unroll
  for (int m = 0; m < NM; ++m) {
    S[2 * m] = S[2 * m] * o.ww[m].xy + (sa2 * o.bb[m].xy + v2 * o.kk[m].xy);
    S[2 * m + 1] = S[2 * m + 1] * o.ww[m].zw + (sa2 * o.bb[m].zw + v2 * o.kk[m].zw);
    y2 = S[2 * m] * o.rr[m].xy + y2; y2 = S[2 * m + 1] * o.rr[m].zw + y2;
  }
  ypart = y2.x + y2.y;
  return yr;
}
template <int E>
__device__ __forceinline__ void rwkv_chain(const Params& p, int l, int chain, int part, unsigned char* smem) {
  constexpr int LR = 64 / E, NM = E / 4;
  const int tid = tid_opaque(), lane = tid & 63, wave = tid >> 6;
  int seq, d, h;
  if (chain < 32) { seq = 16 + (chain >> 3); d = (chain >> 2) & 1; h = chain & 3; }
  else { int c2 = chain - 32; seq = c2 >> 3; d = (c2 >> 2) & 1; h = c2 & 3; }
  const int T = seq < 16 ? 256 : 1024, tokb = seq < 16 ? seq * 256 : 4096 + (seq - 16) * 1024;
  const int g = lane % LR, rl = lane / LR, i = part * 4 * E + wave * E + rl;
  f32x2 S[E / 2];
  if (seq >= 16) {
    const float* s0 = p.st_rwkv + ((((size_t)(seq - 16) * 2 + l) * 2 + d) * 4 + h) * 4096 + i * 64;
#pragma unroll
    for (int m = 0; m < NM; ++m) { f32x4 t = *(const f32x4*)(s0 + 4 * (g + LR * m)); S[2 * m] = t.xy; S[2 * m + 1] = t.zw; }
  } else {
#pragma unroll
    for (int j = 0; j < E / 2; ++j) S[j] = (f32x2){0.f, 0.f};
  }
  float* buf = (float*)smem;
  const int lvec = (tid >> 4) & 3, lc4 = tid & 15, ls = tid >> 6;
  const float* fsrc = (lvec == 0 ? p.NKK : lvec == 1 ? p.AW + (size_t)d * NTOK * 256 : lvec == 2 ? p.AB + (size_t)d * NTOK * 256 : p.AKD + (size_t)d * NTOK * 256) + h * 64 + lc4 * 4;
  const int bs = tid >> 4, bvec = (tid >> 3) & 1, bc8 = tid & 7;
  const bf16_t* bsrc = p.P + (bvec ? 512 : 0) + h * 64 + bc8 * 8;
  f32x4 rfA[4], rfB[4]; u32x4 rbA, rbB;
  const int nch = T / 16;
#define RW_GLOAD(RF, RB, CK) { _Pragma("unroll") for (int i4 = 0; i4 < 4; ++i4) { int step = (CK) * 16 + ls + 4 * i4; int t = d ? T - 1 - step : step; RF[i4] = *(const f32x4*)(fsrc + (size_t)(tokb + t) * 256); } \
    { int step = (CK) * 16 + bs; int t = d ? T - 1 - step : step; RB = *(const u32x4*)(bsrc + (size_t)(tokb + t) * PW); } }
#define RW_SSTORE(RF, RB, BI) { float* b_ = buf + (BI) * 16 * 384; \
    _Pragma("unroll") for (int i4 = 0; i4 < 4; ++i4) *(f32x4*)(b_ + (ls + 4 * i4) * 384 + lvec * 64 + lc4 * 4) = RF[i4]; \
    float* q_ = b_ + bs * 384 + (4 + bvec) * 64 + bc8 * 8; \
    *(f32x4*)q_ = (f32x4){bflo(RB.x), bfhi(RB.x), bflo(RB.y), bfhi(RB.y)}; \
    *(f32x4*)(q_ + 4) = (f32x4){bflo(RB.z), bfhi(RB.z), bflo(RB.w), bfhi(RB.w)}; }
  float* yout = p.YA + ((size_t)d * NTOK + tokb) * 256 + h * 64 + i;
  constexpr int NY = 16 / LR;
  auto compute = [&](int ck) {
    const float* cb = buf + (ck & 1) * 16 * 384;
    float yk[NY];
#pragma unroll
    for (int q = 0; q < NY; ++q) yk[q] = 0.f;
    constexpr int NSET = (E == 4) ? 4 : 2;
    float ypart = 0.f;
    RwOps<E> ops[NSET];
#pragma unroll
    for (int q = 0; q < NSET - 1; ++q) rw_load<E>(cb + q * 384, g, i, ops[q]);
#pragma unroll 1
    for (int s = 0; s < 16; s += NSET) {
#pragma unroll
      for (int u = 0; u < NSET; ++u) {
        const int sn = s + u + NSET - 1;
        rw_load<E>(buf + (((ck & 1) * 16 + sn) & 31) * 384, g, i, ops[(u + NSET - 1) % NSET]);
        const float y0 = rw_step<E>(S, ops[u], ypart);
#pragma unroll
        for (int q = 0; q < NY; ++q) yk[q] = (s + u - 1 == q * LR + g) ? y0 : yk[q];
      }
    }
    {
      const float y15 = group_sum<LR>(ypart);
#pragma unroll
      for (int q = 0; q < NY; ++q) yk[q] = (15 == q * LR + g) ? y15 : yk[q];
    }
#pragma unroll
    for (int q = 0; q < NY; ++q) { const int step = ck * 16 + q * LR + g; const int t = d ? T - 1 - step : step; yout[(size_t)t * 256] = yk[q]; }
  };
  __builtin_amdgcn_s_setprio(2);
  RW_GLOAD(rfA, rbA, 0); RW_SSTORE(rfA, rbA, 0); RW_GLOAD(rfA, rbA, 1); RW_GLOAD(rfB, rbB, 2);
  __syncthreads();
#pragma unroll 1
  for (int ck = 0; ck < nch; ck += 2) {
    compute(ck);
    RW_SSTORE(rfA, rbA, 1);
    if (ck + 3 < nch) RW_GLOAD(rfA, rbA, ck + 3);
    lds_barrier();
    compute(ck + 1);
    if (ck + 2 < nch) RW_SSTORE(rfB, rbB, 0);
    if (ck + 4 < nch) RW_GLOAD(rfB, rbB, ck + 4);
    lds_barrier();
  }
  __builtin_amdgcn_s_setprio(0);
#undef RW_GLOAD
#undef RW_SSTORE
  if (seq < 16) {
    float* so = p.out + O_NSR + ((((size_t)seq * 2 + l) * 2 + d) * 4 + h) * 4096 + i * 64;
#pragma unroll
    for (int m = 0; m < NM; ++m) *(f32x4*)(so + 4 * (g + LR * m)) = (f32x4){S[2 * m].x, S[2 * m].y, S[2 * m + 1].x, S[2 * m + 1].y};
  }
}

__device__ __forceinline__ void lru_scan(const Params& p, int l, int item) {
  const int c = tid_opaque();
  int seq, d;
  if (item < 8) { seq = 16 + (item >> 1); d = item & 1; } else { seq = (item - 8) >> 1; d = item & 1; }
  const int T = seq < 16 ? 256 : 1024, tokb = seq < 16 ? seq * 256 : 4096 + (seq - 16) * 1024;
  const int NC = T >> 4;
  float h = seq >= 16 ? p.st_lru[(((seq - 16) * 2 + l) * 2 + d) * 256 + c] : 0.f;
  const float* la = p.LA + (size_t)d * NTOK * 256 + c; const float* lu = p.LU + (size_t)d * NTOK * 256 + c;
  float* lc = p.LC + (size_t)d * 512 * 256 + (size_t)(tokb >> 4) * 256 + c;
  for (int k0 = 0; k0 < NC; k0 += 8) {
    float a[8], u[8];
#pragma unroll
    for (int q = 0; q < 8; ++q) { const int k = d ? NC - 1 - (k0 + q) : k0 + q; const size_t idx = (size_t)(tokb + k * 16 + (d ? 0 : 15)) * 256; a[q] = la[idx]; u[q] = lu[idx]; }
#pragma unroll
    for (int q = 0; q < 8; ++q) { const int k = d ? NC - 1 - (k0 + q) : k0 + q; lc[(size_t)k * 256] = h; h = a[q] * h + u[q]; }
  }
  if (seq < 16) p.out[O_NSL + ((seq * 2 + l) * 2 + d) * 256 + c] = h;
}

template <bool DIFF>
__device__ __forceinline__ void attn_item(const Params& p, int l, bool sample, int sq  , int h, int qt, unsigned char* smem) {
  constexpr int NS = DIFF ? 2 : 1;
  const int tid = tid_opaque();
  const int lane = tid & 63, wave = tid >> 6, r16 = lane & 15, quad = lane >> 4;
  const int T = sample ? 1024 : 256;
  const int tokb = sample ? 4096 + sq * 1024 : sq * 256;
  const int q0 = qt * 64 + wave * 16;
  const int qpos = q0 + r16;
  const int kvh = DIFF ? h : (h >> 1);
  bf16x8 qf[2];
  {
    const bf16_t* qp;
    if (sample) qp = (DIFF ? p.QDR : p.QBR) + (size_t)(sq * 1024 + qpos) * 256 + h * 64;
    else qp = p.P + (size_t)(tokb + qpos) * PW + (DIFF ? 2432 : 1152) + h * 64;
    qf[0] = *(const bf16x8*)(qp + quad * 8); qf[1] = *(const bf16x8*)(qp + 32 + quad * 8);
  }
  float m[2] = {-3.0e38f, -3.0e38f}, lsum[2] = {0.f, 0.f};
  f32x4 o[2][4];
#pragma unroll
  for (int a = 0; a < 2; ++a)
#pragma unroll
    for (int b = 0; b < 4; ++b) o[a][b] = (f32x4){0.f, 0.f, 0.f, 0.f};
  const float scale_log2 = (DIFF ? 0.17677669529663687f : 0.125f) * 1.4426950408889634f;
  const int nctx = sample ? 4 : 0;
  const bf16_t* Kc = nullptr; const bf16_t* Vc = nullptr; int ksc = 0;
  if (sample) {
    const int bl = sq * 2 + l;
    if (DIFF) { Kc = p.CDK + (size_t)bl * 256 * 256 + h * 64; ksc = 256; Vc = p.CDVT + (size_t)bl * 256 * 256 + (size_t)(h * 64) * 256; }
    else { Kc = p.CWK + (size_t)bl * 256 * 128 + kvh * 64; ksc = 128; Vc = p.CWVT + (size_t)bl * 128 * 256 + (size_t)(kvh * 64) * 256; }
  }
  const bf16_t* Kl; const bf16_t* Vl; int ksl;
  if (sample) {
    if (DIFF) { Kl = p.KDR + (size_t)(sq * 1024) * 256 + h * 64; ksl = 256; Vl = p.VDT + (size_t)tokb * 256 + (size_t)(h * 64) * T; }
    else { Kl = p.KBR + (size_t)(sq * 1024) * 128 + kvh * 64; ksl = 128; Vl = p.VBT + (size_t)tokb * 128 + (size_t)(kvh * 64) * T; }
  } else {
    if (DIFF) { Kl = p.P + (size_t)tokb * PW + 2688 + h * 64; ksl = PW; Vl = p.VDT + (size_t)tokb * 256 + (size_t)(h * 64) * T; }
    else { Kl = p.P + (size_t)tokb * PW + 1408 + kvh * 64; ksl = PW; Vl = p.VBT + (size_t)tokb * 128 + (size_t)(kvh * 64) * T; }
  }
  int kb0 = 0, kb1 = T; bool lmask = false;
  if (sample && !DIFF) { const int qb = qt * 64; kb0 = qb - 128 < 0 ? 0 : qb - 128; kb1 = qb + 192 > T ? T : qb + 192; lmask = true; }
  const int nt = nctx + ((kb1 - kb0) >> 6);
  bf16_t* const lds = (bf16_t*)smem;
  const int lrow = tid >> 2, lch = (tid & 3) * 16;
  auto gsrc = [&](int t, const bf16_t*& kp, const bf16_t*& vp) {
    if (t < nctx) { kp = Kc + (size_t)(t * 64 + lrow) * ksc + lch; vp = Vc + (size_t)lrow * 256 + t * 64 + lch; }
    else { const int kb = kb0 + (t - nctx) * 64; kp = Kl + (size_t)(kb + lrow) * ksl + lch; vp = Vl + (size_t)lrow * T + kb + lch; }
  };
  u32x4 rk0, rk1, rv0, rv1;
  { const bf16_t* kp; const bf16_t* vp; gsrc(0, kp, vp); rk0 = *(const u32x4*)kp; rk1 = *(const u32x4*)(kp + 8); rv0 = *(const u32x4*)vp; rv1 = *(const u32x4*)(vp + 8); }
  __syncthreads();
  { bf16_t* d = lds + lrow * 72 + lch; *(u32x4*)d = rk0; *(u32x4*)(d + 8) = rk1; *(u32x4*)(d + 64 * 72) = rv0; *(u32x4*)(d + 64 * 72 + 8) = rv1; }
  __syncthreads();
  const f32x4 z4 = {0.f, 0.f, 0.f, 0.f};
  const int krow = 8 * (r16 >> 2) + (r16 & 3);
#pragma unroll 1
  for (int t = 0; t < nt; ++t) {
    const bool isctx = t < nctx;
    const bool masked = !isctx && lmask;
    const int kpos0 = kb0 + (t - nctx) * 64;
    if (t + 1 < nt) { const bf16_t* kp; const bf16_t* vp; gsrc(t + 1, kp, vp); rk0 = *(const u32x4*)kp; rk1 = *(const u32x4*)(kp + 8); rv0 = *(const u32x4*)vp; rv1 = *(const u32x4*)(vp + 8); }
    const bf16_t* Ks = lds + (t & 1) * (2 * 64 * 72);
    const bf16_t* Vs = Ks + 64 * 72;
    bf16x8 pf[NS][2];
#pragma unroll
    for (int st = 0; st < NS; ++st) {
      f32x4 sc[4];
#pragma unroll
      for (int kt = 0; kt < 4; ++kt) {
        const bf16_t* kr = Ks + (32 * (kt >> 1) + 4 * (kt & 1) + krow) * 72 + quad * 8;
        if (!DIFF) { sc[kt] = mfma16(*(const bf16x8*)kr, qf[0], z4); sc[kt] = mfma16(*(const bf16x8*)(kr + 32), qf[1], sc[kt]); }
        else sc[kt] = mfma16(*(const bf16x8*)(kr + 32 * st), qf[st], z4);
      }
      float mx = -3.0e38f;
#pragma unroll
      for (int kt = 0; kt < 4; ++kt)
#pragma unroll
        for (int r = 0; r < 4; ++r) {
          float x = sc[kt][r] * scale_log2;
          if (masked) { const int kp = kpos0 + 32 * (kt >> 1) + 8 * quad + 4 * (kt & 1) + r; const int dd = kp - qpos; if (dd > 128 || dd < -128) x = -1.0e30f; }
          sc[kt][r] = x; mx = fmaxf(mx, x);
        }
      mx = fmaxf(mx, __shfl_xor(mx, 16)); mx = fmaxf(mx, __shfl_xor(mx, 32));
      const float mnew = fmaxf(m[st], mx);
      const float alpha = __builtin_amdgcn_exp2f(m[st] - mnew);
      m[st] = mnew;
      float ps = 0.f;
#pragma unroll
      for (int kt = 0; kt < 4; ++kt)
#pragma unroll
        for (int r = 0; r < 4; ++r) { const float e = __builtin_amdgcn_exp2f(sc[kt][r] - mnew); sc[kt][r] = e; ps += e; }
      lsum[st] = lsum[st] * alpha + ps;
#pragma unroll
      for (int dt = 0; dt < 4; ++dt) o[st][dt] *= alpha;
#pragma unroll
      for (int s2 = 0; s2 < 2; ++s2) {
        u32x4 tt;
        tt.x = pack2(sc[2 * s2][0], sc[2 * s2][1]); tt.y = pack2(sc[2 * s2][2], sc[2 * s2][3]);
        tt.z = pack2(sc[2 * s2 + 1][0], sc[2 * s2 + 1][1]); tt.w = pack2(sc[2 * s2 + 1][2], sc[2 * s2 + 1][3]);
        pf[st][s2] = __builtin_bit_cast(bf16x8, tt);
      }
    }
#pragma unroll
    for (int dt = 0; dt < 4; ++dt)
#pragma unroll
      for (int s2 = 0; s2 < 2; ++s2) {
        const bf16x8 vf = *(const bf16x8*)(Vs + (dt * 16 + r16) * 72 + 32 * s2 + 8 * quad);
#pragma unroll
        for (int st = 0; st < NS; ++st) o[st][dt] = mfma16(vf, pf[st][s2], o[st][dt]);
      }
    if (t + 1 < nt) {
      bf16_t* d = lds + ((t + 1) & 1) * (2 * 64 * 72) + lrow * 72 + lch;
      *(u32x4*)d = rk0; *(u32x4*)(d + 8) = rk1; *(u32x4*)(d + 64 * 72) = rv0; *(u32x4*)(d + 64 * 72 + 8) = rv1;
    }
    __syncthreads();
  }
  float l0 = lsum[0]; l0 += __shfl_xor(l0, 16); l0 += __shfl_xor(l0, 32);
  const int tok = tokb + qpos;
  if (!DIFF) {
    l0 += __builtin_amdgcn_exp2f(p.win_sink[l * 4 + h] * 1.4426950408889634f - m[0]);
    const float inv = 1.0f / l0;
#pragma unroll
    for (int dt = 0; dt < 4; ++dt) {
      f32x4 v = o[0][dt] * inv;
      *(f32x4*)(p.OB + (size_t)tok * 256 + h * 64 + dt * 16 + quad * 4) = v;
    }
  } else {
    float l1 = lsum[1]; l1 += __shfl_xor(l1, 16); l1 += __shfl_xor(l1, 32);
    float d1 = 0.f, d2 = 0.f;
    const float* dl = p.diff_lam + l * 128;
    for (int j = 0; j < 32; ++j) { d1 += dl[j] * dl[32 + j]; d2 += dl[64 + j] * dl[96 + j]; }
    const float lam_init = 0.8f - 0.6f * expf(-0.3f * (float)l);
    const float lam = expf(d1) - expf(d2) + lam_init;
    const float i0 = 1.0f / l0, i1 = lam / l1;
    f32x4 v[4]; float ss = 0.f;
#pragma unroll
    for (int dt = 0; dt < 4; ++dt) { v[dt] = o[0][dt] * i0 - o[1][dt] * i1; ss += v[dt][0] * v[dt][0] + v[dt][1] * v[dt][1] + v[dt][2] * v[dt][2] + v[dt][3] * v[dt][3]; }
    ss += __shfl_xor(ss, 16); ss += __shfl_xor(ss, 32);
    const float rstd = rsqrtf(ss * (1.0f / 64.0f) + 1e-6f) * (1.0f - lam_init);
#pragma unroll
    for (int dt = 0; dt < 4; ++dt) {
      const f32x4 g = *(const f32x4*)(p.diff_g + l * 64 + dt * 16 + quad * 4);
      *(f32x4*)(p.OD + (size_t)tok * 256 + h * 64 + dt * 16 + quad * 4) = v[dt] * rstd * g;
    }
  }
}

__device__ __forceinline__ void mix_other(const Params& p, int l, int it, unsigned char* smem) {
  if (it < 256) { attn_item<true>(p, l, true, it >> 6, (it >> 4) & 3, it & 15, smem); return; }
  it -= 256;
  if (it < 40) { lru_scan(p, l, it); return; }
  it -= 40;
  if (it < 256) { attn_item<false>(p, l, true, it >> 6, (it >> 4) & 3, it & 15, smem); return; }
  it -= 256;
  if (it < 256) { attn_item<true>(p, l, false, it >> 4, (it >> 2) & 3, it & 3, smem); return; }
  it -= 256;
  attn_item<false>(p, l, false, it >> 4, (it >> 2) & 3, it & 3, smem);
}

#define ES 4
#define EP 8
__device__ __forceinline__ void mix_item(const Params& p, int l, int it, unsigned char* smem) {
  constexpr int NPS = 16 / ES, NPP = 16 / EP, NS = 32 * NPS, NP = 128 * NPP;
  if (it < NS) {
#pragma unroll 1
    for (int r = 0; r < p.rep2[0]; ++r) rwkv_chain<ES>(p, l, it / NPS, it % NPS, smem);
    return;
  }
  it -= NS;
  if (it < NP) {
#pragma unroll 1
    for (int r = 0; r < p.rep2[1]; ++r) rwkv_chain<EP>(p, l, 32 + it / NPP, it % NPP, smem);
    return;
  }
  it -= NP;
#pragma unroll 1
  for (int r = 0; r < p.rep2[2]; ++r) mix_other(p, l, it, smem);
}
__device__ __forceinline__ void phase_mix(const Params& p, int l, unsigned char* smem) {
  constexpr int NS = 32 * (16 / ES), NP = 128 * (16 / EP), NALL = NS + NP + 1064;
  const int G = gridDim.x, b = blockIdx.x;
  if (G >= 2 * NS) {
    if (b < NS) mix_item(p, l, b, smem);
    else {
#pragma unroll 1
      for (int it = NS + (b - NS); it < NALL; it += G - NS) mix_item(p, l, it, smem);
      if (l == 0 && G >= 320) {
#pragma unroll 1
        for (int it = b - NS; it < 1120; it += G - NS) weight_tile(p, 1, it, (float*)smem);
      }
    }
  } else {
#pragma unroll 1
    for (int it = b; it < NALL; it += G) mix_item(p, l, it, smem);
  }
}

DI float sum16(float v) { v += __shfl_xor(v, 1); v += __shfl_xor(v, 2); v += __shfl_xor(v, 4); v += __shfl_xor(v, 8); return v; }

__device__ __forceinline__ void phase_post(const Params& p, int l) {
  const int tid0 = tid_opaque();
  const int lane = tid0 & 63, wave = tid0 >> 6;
  const int c = lane * 4;
#pragma unroll 1
  for (int tok = blockIdx.x * 4 + wave; tok < NTOK; tok += gridDim.x * 4) {
    const bf16_t* pr = p.P + (size_t)tok * PW;
    const f32x4 ya0 = *(const f32x4*)(p.YA + (size_t)tok * 256 + c), ya1 = *(const f32x4*)(p.YA + ((size_t)NTOK + tok) * 256 + c);
    const u32x2 r_ = *(const u32x2*)(pr + c), k_ = *(const u32x2*)(pr + 256 + c), v_ = *(const u32x2*)(pr + 512 + c), ga_ = *(const u32x2*)(pr + 896 + c);
    const u32x2 gb_ = *(const u32x2*)(pr + 1664 + c), gc_ = *(const u32x2*)(pr + 2176 + c), gd_ = *(const u32x2*)(pr + 3200 + c);
    const f32x4 rk = *(const f32x4*)(p.rw_rk + l * 256 + c), gg = *(const f32x4*)(p.rw_gng + l * 256 + c), gbias = *(const f32x4*)(p.rw_gnb + l * 256 + c);
    const f32x4 ob = *(const f32x4*)(p.OB + (size_t)tok * 256 + c), od = *(const f32x4*)(p.OD + (size_t)tok * 256 + c);
    const f32x4 h0 = *(const f32x4*)(p.LU + (size_t)tok * 256 + c), h1 = *(const f32x4*)(p.LU + ((size_t)NTOK + tok) * 256 + c);
    const f32x4 A0 = *(const f32x4*)(p.LA + (size_t)tok * 256 + c), A1 = *(const f32x4*)(p.LA + ((size_t)NTOK + tok) * 256 + c);
    const f32x4 c0 = *(const f32x4*)(p.LC + (size_t)(tok >> 4) * 256 + c), c1 = *(const f32x4*)(p.LC + ((size_t)512 + (tok >> 4)) * 256 + c);
    __builtin_amdgcn_sched_barrier(0);
    float out[4];
    {
      const f32x4 y = ya0 + ya1;
      const float mu = sum16(y[0] + y[1] + y[2] + y[3]) * (1.0f / 64.0f);
      const f32x4 dv = y - mu;
      const float var = sum16(dv[0] * dv[0] + dv[1] * dv[1] + dv[2] * dv[2] + dv[3] * dv[3]) * (1.0f / 64.0f);
      const float rstd = rsqrtf(var + 64e-5f);
      const float r[4] = {bflo(r_.x), bfhi(r_.x), bflo(r_.y), bfhi(r_.y)}, k[4] = {bflo(k_.x), bfhi(k_.x), bflo(k_.y), bfhi(k_.y)};
      const float v[4] = {bflo(v_.x), bfhi(v_.x), bflo(v_.y), bfhi(v_.y)}, g[4] = {bflo(ga_.x), bfhi(ga_.x), bflo(ga_.y), bfhi(ga_.y)};
      const float bs = sum16(r[0] * k[0] * rk[0] + r[1] * k[1] * rk[1] + r[2] * k[2] * rk[2] + r[3] * k[3] * rk[3]);
#pragma unroll
      for (int q = 0; q < 4; ++q) out[q] = (dv[q] * rstd * gg[q] + gbias[q] + bs * v[q]) * siluf_(g[q]);
      st4bf(p.H + (size_t)tok * LDK + c, out);
    }
    {
      const float g[4] = {bflo(gb_.x), bfhi(gb_.x), bflo(gb_.y), bfhi(gb_.y)};
#pragma unroll
      for (int q = 0; q < 4; ++q) out[q] = ob[q] * siluf_(g[q]);
      st4bf(p.H + (size_t)tok * LDK + 256 + c, out);
    }
    {
      const float g[4] = {bflo(gc_.x), bfhi(gc_.x), bflo(gc_.y), bfhi(gc_.y)};
#pragma unroll
      for (int q = 0; q < 4; ++q) out[q] = (h0[q] + A0[q] * c0[q] + h1[q] + A1[q] * c1[q]) * siluf_(g[q]);
      st4bf(p.H + (size_t)tok * LDK + 512 + c, out);
    }
    {
      const float g[4] = {bflo(gd_.x), bfhi(gd_.x), bflo(gd_.y), bfhi(gd_.y)};
#pragma unroll
      for (int q = 0; q < 4; ++q) out[q] = od[q] * siluf_(g[q]);
      st4bf(p.H + (size_t)tok * LDK + 768 + c, out);
    }
  }
}

__global__ void __launch_bounds__(256, 2) fwd_megakernel(Params p) {
  __shared__ __attribute__((aligned(16))) unsigned char smem[49152];
  __shared__ uint4 xb_words;
  if (threadIdx.x == 0) xb_words = make_uint4(0u, 0u, 0u, 0u);
  __syncthreads();
  XcdBarrier xb = xcd_barrier_post(p.bar, (volatile LAS unsigned*)&xb_words);
  if (threadIdx.x == 0) ((volatile LAS unsigned*)&xb_words)[3] = xb_add(&p.bar[xb_xcc_id()], 1u);
#pragma unroll 1
  for (int r = 0; r < p.rep[0]; ++r) phase_prologue(p, smem);
  xcd_barrier(xb);
  if (threadIdx.x == 0) {
    const unsigned x = xb_xcc_id(); unsigned pre = 0;
    for (unsigned j = 0; j < 16; ++j) { const unsigned c = xb_ld(&p.bar[XB_XCNT(j)]); pre += (j < x) ? c : 0u; }
    ((volatile LAS unsigned*)&xb_words)[2] = pre + ((volatile LAS unsigned*)&xb_words)[3];
  }
  __syncthreads();
#pragma unroll 1
  for (int r = 0; r < p.rep[1]; ++r) phase_norm(p, 0);
  xcd_barrier(xb);
#pragma unroll 1
  for (int l = 0; l < 2; ++l) {
#pragma unroll 1
    for (int r = 0; r < p.rep[2]; ++r) phase_gemm<0>(p, l, smem, (int)((volatile LAS unsigned*)&xb_words)[2]);
    xcd_barrier(xb);
#pragma unroll 1
    for (int r = 0; r < p.rep[3]; ++r) phase_pre(p, l, smem);
    xcd_barrier(xb);
#pragma unroll 1
    for (int r = 0; r < p.rep[4]; ++r) phase_mix(p, l, smem);
    xcd_barrier(xb);
#pragma unroll 1
    for (int r = 0; r < p.rep[5]; ++r) phase_post(p, l);
    xcd_barrier(xb);
#pragma unroll 1
    for (int r = 0; r < p.rep[6]; ++r) phase_gemm<1>(p, l, smem, (int)((volatile LAS unsigned*)&xb_words)[2]);
    xcd_barrier(xb);
    phase_norm(p, l + 1);
    if (l == 0) xcd_barrier(xb);
#pragma unroll 1
    for (int r = 1; r < p.rep[7]; ++r) xcd_barrier(xb);
  }
}

extern "C" void kernel_launch(void* const* d_in, const int* in_sizes, int n_in, void* d_out, int out_size, void* d_ws, size_t ws_size, hipStream_t stream) {
  static int grid_blocks = 0;
  if (!grid_blocks) {
    int dev = 0, cus = 0, per_cu = 0;
    hipGetDevice(&dev);
    hipDeviceGetAttribute(&cus, hipDeviceAttributeMultiprocessorCount, dev);
    hipOccupancyMaxActiveBlocksPerMultiprocessor(&per_cu, (const void*)fwd_megakernel, 256, 0);
    if (per_cu < 1) per_cu = 1;
    if (per_cu > 2) per_cu = 2;
    grid_blocks = cus * per_cu;
  }
  Params p{};
  const float** f = (const float**)&p;
  for (int i = 0; i < 35; ++i) f[i] = (const float*)d_in[i];
  p.out = (float*)d_out;
  size_t off = 0;
  auto take = [&](size_t bytes) { void* r = (char*)d_ws + off; off += (bytes + 255) & ~(size_t)255; return r; };
  p.MOD = (float*)take(2 * 5 * 3072 * 4);
  p.WINT = (bf16_t*)take((size_t)2 * PW * LDK * 2);
  p.WOUTT = (bf16_t*)take((size_t)2 * 1024 * LDK * 2);
  p.CWK = (bf16_t*)take((size_t)4 * 2 * 256 * 128 * 2);
  p.CWVT = (bf16_t*)take((size_t)4 * 2 * 256 * 128 * 2);
  p.CDK = (bf16_t*)take((size_t)4 * 2 * 256 * 256 * 2);
  p.CDVT = (bf16_t*)take((size_t)4 * 2 * 256 * 256 * 2);
  p.H = (bf16_t*)take((size_t)NTOK * LDK * 2);
  p.P = (bf16_t*)take((size_t)NTOK * PW * 2);
  p.NKK = (float*)take((size_t)NTOK * 256 * 4);
  p.AW = (float*)take((size_t)2 * NTOK * 256 * 4);
  p.AB = (float*)take((size_t)2 * NTOK * 256 * 4);
  p.AKD = (float*)take((size_t)2 * NTOK * 256 * 4);
  p.Y2 = p.NKK;
  p.YA = (float*)take((size_t)2 * NTOK * 256 * 4);
  p.LA = (float*)take((size_t)2 * NTOK * 256 * 4);
  p.LU = (float*)take((size_t)2 * NTOK * 256 * 4);
  p.QBR = (bf16_t*)take((size_t)4096 * 256 * 2);
  p.KBR = (bf16_t*)take((size_t)4096 * 128 * 2);
  p.QDR = (bf16_t*)take((size_t)4096 * 256 * 2);
  p.KDR = (bf16_t*)take((size_t)4096 * 256 * 2);
  p.VBT = (bf16_t*)take((size_t)NTOK * 128 * 2);
  p.VDT = (bf16_t*)take((size_t)NTOK * 256 * 2);
  p.OB = (float*)take((size_t)NTOK * 256 * 4);
  p.OD = (float*)take((size_t)NTOK * 256 * 4);
  p.LC = (float*)take((size_t)2 * 512 * 256 * 4);
  p.bar = (unsigned*)take((size_t)XCD_BAR_WORDS * 4);
  p.RWT = (bf16_t*)take((size_t)2 * 4 * 256 * 64 * 2);
  p.LWT = (bf16_t*)take((size_t)2 * 4 * 4 * 64 * 64 * 2);
  if (off > ws_size) { fprintf(stderr, "workspace too small: need %zu have %zu\n", off, ws_size); return; }
  static const int REPS[8] = {1, 1, 1, 1, 1, 1, 1, 1};
  for (int i = 0; i < 8; ++i) p.rep[i] = REPS[i];
  static const int REPS2[8] = {1, 1, 1, 1, 1, 1, 1, 1};
  for (int i = 0; i < 8; ++i) p.rep2[i] = REPS2[i];
  hipMemsetAsync(p.bar, 0, (size_t)XCD_BAR_WORDS * 4, stream);
  void* args[] = {&p};
  hipError_t e = hipLaunchCooperativeKernel((const void*)fwd_megakernel, dim3(grid_blocks), dim3(256), args, 0, stream);
  if (e != hipSuccess) fprintf(stderr, "cooperative launch failed: %s (grid %d)\n", hipGetErrorString(e), grid_blocks);
}
```

```cpp
#include <hip/hip_runtime.h>
#include <cstdio>
#include <cstdint>

typedef unsigned short bf16_t;
typedef short bf16x8 __attribute__((ext_vector_type(8)));
typedef float f32x4 __attribute__((ext_vector_type(4)));
typedef unsigned u32x4 __attribute__((ext_vector_type(4)));
typedef unsigned u32x2 __attribute__((ext_vector_type(2)));
#define DI __device__ __forceinline__

#define O_YP 0
#define O_NWK 8388608
#define O_NWV 9437184
#define O_NDK 10485760
#define O_NDV 12582912
#define O_NSR 14680064
#define O_NSL 15728640

#define NTOK 8192
#define PW 3456
#define LDK 1088

struct Params {
  const float *x_prompt, *x_sample, *c, *cwk, *cwv, *cdk, *cdv, *st_rwkv, *st_lru, *c_ctx, *w_mod, *b_mod, *g_pre, *g_post, *w_in, *w_out;
  const float *rw_w0, *rw_wup, *rw_a0, *rw_aup, *rw_kk, *rw_ka, *rw_rk, *rw_gng, *rw_gnb, *win_sink;
  const float *lru_cw, *lru_cb, *lru_wa, *lru_ba, *lru_wx, *lru_bx, *lru_lam, *diff_lam, *diff_g;
  float* out;
  float* MOD; bf16_t* WINT; bf16_t* WOUTT; bf16_t* CWK; bf16_t* CWVT; bf16_t* CDK; bf16_t* CDVT;
  bf16_t* H; bf16_t* P; float* NKK; float* AW; float* AB; float* AKD; float* YA; float* LA; float* LU;
  bf16_t* QBR; bf16_t* KBR; bf16_t* QDR; bf16_t* KDR; bf16_t* VBT; bf16_t* VDT; float* OB; float* OD; float* Y2; float* LC; unsigned* bar; bf16_t* RWT; bf16_t* LWT;
  int rep[8];
  int rep2[8];
};

DI void lds_barrier() { asm volatile("s_waitcnt lgkmcnt(0)\n\ts_barrier" ::: "memory"); }
DI int tid_opaque() { int t = threadIdx.x; asm volatile("" : "+v"(t)); return t; }
DI bf16_t f2bf(float x) { unsigned u = __float_as_uint(x); u += 0x7fffu + ((u >> 16) & 1u); return (bf16_t)(u >> 16); }
DI float bf2f(bf16_t b) { return __uint_as_float(((unsigned)b) << 16); }
typedef float f32x2_ __attribute__((ext_vector_type(2)));
typedef __bf16 bf16x2_t __attribute__((ext_vector_type(2)));
DI unsigned pack2(float a, float b) { f32x2_ v = {a, b}; bf16x2_t r = __builtin_convertvector(v, bf16x2_t); return __builtin_bit_cast(unsigned, r); }
DI float bflo(unsigned u) { return __uint_as_float(u << 16); }
DI float bfhi(unsigned u) { return __uint_as_float(u & 0xffff0000u); }
DI void ld4bf(const bf16_t* q, float (&o)[4]) { u32x2 u = *(const u32x2*)q; o[0] = bflo(u.x); o[1] = bfhi(u.x); o[2] = bflo(u.y); o[3] = bfhi(u.y); }
DI void st4bf(bf16_t* q, const float (&v)[4]) { u32x2 u; u.x = pack2(v[0], v[1]); u.y = pack2(v[2], v[3]); *(u32x2*)q = u; }
DI float wave_sum(float v) { for (int o = 32; o > 0; o >>= 1) v += __shfl_xor(v, o); return v; }
DI float sigmoidf_(float x) { return 1.0f / (1.0f + expf(-x)); }
DI float fsigmoid(float x) { return __builtin_amdgcn_rcpf(1.0f + __expf(-x)); }
DI float wave_sum_dpp(float v) {
  v += __builtin_bit_cast(float, __builtin_amdgcn_update_dpp(0, __builtin_bit_cast(int, v), 0xB1, 0xf, 0xf, true));
  v += __builtin_bit_cast(float, __builtin_amdgcn_update_dpp(0, __builtin_bit_cast(int, v), 0x4E, 0xf, 0xf, true));
  v += __builtin_bit_cast(float, __builtin_amdgcn_update_dpp(0, __builtin_bit_cast(int, v), 0x141, 0xf, 0xf, true));
  v += __builtin_bit_cast(float, __builtin_amdgcn_update_dpp(0, __builtin_bit_cast(int, v), 0x140, 0xf, 0xf, true));
  const int iv = __builtin_bit_cast(int, v);
  return __builtin_bit_cast(float, __builtin_amdgcn_readlane(iv, 0)) + __builtin_bit_cast(float, __builtin_amdgcn_readlane(iv, 16)) + __builtin_bit_cast(float, __builtin_amdgcn_readlane(iv, 32)) + __builtin_bit_cast(float, __builtin_amdgcn_readlane(iv, 48));
}
DI float siluf_(float x) { return x * __builtin_amdgcn_rcpf(1.0f + __expf(-x)); }
DI float softplusf_(float z) { return z > 20.f ? z : log1pf(expf(z)); }
DI f32x4 mfma16(bf16x8 a, bf16x8 b, f32x4 c) { return __builtin_amdgcn_mfma_f32_16x16x32_bf16(a, b, c, 0, 0, 0); }
DI float quad_sum(float v) {
  v += __builtin_bit_cast(float, __builtin_amdgcn_update_dpp(0, __builtin_bit_cast(int, v), 0xB1, 0xf, 0xf, true));
  v += __builtin_bit_cast(float, __builtin_amdgcn_update_dpp(0, __builtin_bit_cast(int, v), 0x4E, 0xf, 0xf, true));
  return v;
}


#define XB_TMO      128
#define XB_XCNT(j)  (256  + 64 * (j))
#define XB_XSUB(j)  (1280 + 64 * (j))
#define XB_XGEN(j)  (2304 + 64 * (j))
#define XB_TOP      3328
#define XB_TOPGEN   3392
#define XCD_BAR_WORDS 3456
#define XB_SPIN_CAP (1u << 18)
#define LAS __attribute__((address_space(3)))
DI unsigned xb_ld(unsigned* p)              { return __hip_atomic_load(p, __ATOMIC_RELAXED, __HIP_MEMORY_SCOPE_AGENT); }
DI unsigned xb_add(unsigned* p, unsigned v) { return __hip_atomic_fetch_add(p, v, __ATOMIC_RELAXED, __HIP_MEMORY_SCOPE_AGENT); }
DI unsigned xb_xcc_id() { return (unsigned)__builtin_amdgcn_s_getreg((3 << 11) | 20) & 0xFu; }
#define XB_SPIN(cond, bar) do { unsigned _sp = 0; while (cond) { __builtin_amdgcn_s_sleep(1); \
    if ((++_sp & 255u) == 0u) { if (xb_ld(&(bar)[XB_TMO])) break; if (_sp > XB_SPIN_CAP) { atomicAdd(&(bar)[XB_TMO], 1u); break; } } } } while (0)
struct XcdBarrier { unsigned* bar; unsigned x; volatile LAS unsigned* st; };
DI XcdBarrier xcd_barrier_post(unsigned* bar, volatile LAS unsigned* st) {
    XcdBarrier b; b.bar = bar; b.x = xb_xcc_id(); b.st = st;
    if (threadIdx.x == 0) (void)xb_add(&bar[XB_XCNT(b.x)], 1u);
    return b;
}
DI void xcd_barrier_complete(unsigned* bar, unsigned x, unsigned& nloc, unsigned& nx) {
    const unsigned G = gridDim.x * gridDim.y * gridDim.z;
    unsigned sum, cnt, mine, sp = 0u;
    for (;;) {
        sum = 0u; cnt = 0u; mine = 0u;
#pragma unroll
        for (unsigned j = 0; j < 16; ++j) { const unsigned c = xb_ld(&bar[XB_XCNT(j)]); sum += c; cnt += (c > 0u) ? 1u : 0u; mine = (j == x) ? c : mine; }
        if (sum == G) break;
        __builtin_amdgcn_s_sleep(1);
        if ((++sp & 255u) == 0u) { if (xb_ld(&bar[XB_TMO])) break; if (sp > XB_SPIN_CAP) { atomicAdd(&bar[XB_TMO], 1u); break; } }
    }
    nloc = mine > 0u ? mine : 1u; nx = cnt > 0u ? cnt : 1u;
}
DI void xcd_barrier(const XcdBarrier& b) {
    asm volatile("s_waitcnt vmcnt(0)" ::: "memory");
    __syncthreads();
    if (threadIdx.x == 0) {
        unsigned* bar = b.bar;
        unsigned bx = xb_xcc_id();
        __builtin_amdgcn_s_waitcnt(0);
        unsigned nloc = b.st[0], nx = b.st[1];
        if (nloc == 0u) { xcd_barrier_complete(bar, bx, nloc, nx); b.st[0] = nloc; b.st[1] = nx; }
        const unsigned old = xb_add(&bar[XB_XSUB(bx)], 1u);
        const unsigned gen = old / nloc;
        if (old + 1u == (gen + 1u) * nloc) {
            __builtin_amdgcn_fence(__ATOMIC_RELEASE, "agent");
            asm volatile("s_waitcnt vmcnt(0)" ::: "memory");
            const unsigned og = xb_add(&bar[XB_TOP], 1u);
            const unsigned tg = og / nx;
            if (og + 1u == (tg + 1u) * nx) xb_add(&bar[XB_TOPGEN], 1u);
            else XB_SPIN(xb_ld(&bar[XB_TOPGEN]) == tg, bar);
            __builtin_amdgcn_fence(__ATOMIC_ACQUIRE, "agent");
            xb_add(&bar[XB_XGEN(bx)], 1u);
            asm volatile("s_waitcnt vmcnt(0)" ::: "memory");
        } else {
            XB_SPIN(xb_ld(&bar[XB_XGEN(bx)]) == gen, bar);
            __builtin_amdgcn_fence(__ATOMIC_ACQUIRE, "agent");
            asm volatile("s_waitcnt vmcnt(0)" ::: "memory");
        }
    }
    __syncthreads();
}

template <typename T> DI float ldval(const T* p);
template <> DI float ldval<float>(const float* p) { return *p; }
template <> DI float ldval<bf16_t>(const bf16_t* p) { return bf2f(*p); }
template <typename T>
DI void transpose_tile(const T* src, int src_ld, bf16_t* dst, int dst_ld, float* lds) {
  const int tid = tid_opaque();
#pragma unroll 8
  for (int i = 0; i < 16; ++i) { int r = (tid >> 6) + 4 * i, c = tid & 63; lds[r * 65 + c] = ldval<T>(src + (size_t)r * src_ld + c); }
  __syncthreads();
#pragma unroll 4
  for (int i = 0; i < 16; ++i) { int c = (tid >> 6) + 4 * i, r = tid & 63; dst[(size_t)c * dst_ld + r] = f2bf(lds[r * 65 + c]); }
  __syncthreads();
}

__device__ __forceinline__ void weight_tile(const Params& p, int l, int item, float* lds) {
  if (item < 864) {
    const int kt = item / 54, nt = item % 54;
    transpose_tile<float>(p.w_in + (size_t)l * 1024 * PW + (size_t)kt * 64 * PW + nt * 64, PW,
                          p.WINT + (size_t)l * PW * LDK + (size_t)nt * 64 * LDK + kt * 64, LDK, lds);
  } else {
    const int r = item - 864, kt = r / 16, nt = r % 16;
    transpose_tile<float>(p.w_out + (size_t)l * 1024 * 1024 + (size_t)kt * 64 * 1024 + nt * 64, 1024,
                          p.WOUTT + (size_t)l * 1024 * LDK + (size_t)nt * 64 * LDK + kt * 64, LDK, lds);
  }
}

__device__ __forceinline__ void phase_prologue(const Params& p, unsigned char* smem) {
  float* lds = (float*)smem;
  const int n0 = 1728, n1 = n0 + 512, n2 = n1 + 192, n3 = n2 + 64, n4 = n3 + 128, n5 = n4 + 192, n6 = n5 + 32, n7 = n6 + 32;
#pragma unroll 1
  for (int it = blockIdx.x; it < n7; it += gridDim.x) {
    const int tid = tid_opaque();
    if (it < n1) {
      if (it < 1120) weight_tile(p, 0, it, lds);
      else if (gridDim.x < 320) weight_tile(p, 1, it - 1120, lds);
    } else if (it < n2) {
      int i2 = it - n1; int l = i2 / 96, nb = (i2 % 96) * 32;
      float* sc = lds;
      float* red = lds + 5 * 1024;
      for (int i = tid; i < 5 * 1024; i += 256) { int v = i >> 10, k = i & 1023; float x = v == 0 ? p.c_ctx[k] : p.c[(v - 1) * 1024 + k]; sc[i] = siluf_(x); }
      __syncthreads();
      int n = tid & 31, kg = tid >> 5;
      float a0 = 0, a1 = 0, a2 = 0, a3 = 0, a4 = 0;
      const float* wp = p.w_mod + (size_t)l * 1024 * 3072 + nb + n;
      for (int k = kg * 128; k < kg * 128 + 128; ++k) {
        float w = wp[(size_t)k * 3072];
        a0 += sc[k] * w; a1 += sc[1024 + k] * w; a2 += sc[2048 + k] * w; a3 += sc[3072 + k] * w; a4 += sc[4096 + k] * w;
      }
      red[(kg * 5 + 0) * 32 + n] = a0; red[(kg * 5 + 1) * 32 + n] = a1; red[(kg * 5 + 2) * 32 + n] = a2; red[(kg * 5 + 3) * 32 + n] = a3; red[(kg * 5 + 4) * 32 + n] = a4;
      __syncthreads();
      if (tid < 160) { int v = tid >> 5, nn = tid & 31; float s = p.b_mod[l * 3072 + nb + nn]; for (int q = 0; q < 8; ++q) s += red[(q * 5 + v) * 32 + nn]; p.MOD[(size_t)(l * 5 + v) * 3072 + nb + nn] = s; }
      __syncthreads();
    } else if (it < n3) {
      int i2 = it - n2; int bl = i2 >> 3, r = i2 & 7, pt = r >> 1, ct = r & 1;
      transpose_tile<float>(p.cwv + (size_t)bl * 256 * 128 + (size_t)pt * 64 * 128 + ct * 64, 128,
                            p.CWVT + (size_t)bl * 128 * 256 + (size_t)ct * 64 * 256 + pt * 64, 256, lds);
    } else if (it < n4) {
      int i2 = it - n3; int bl = i2 >> 4, r = i2 & 15, pt = r >> 2, ct = r & 3;
      transpose_tile<float>(p.cdv + (size_t)bl * 256 * 256 + (size_t)pt * 64 * 256 + ct * 64, 256,
                            p.CDVT + (size_t)bl * 256 * 256 + (size_t)ct * 64 * 256 + pt * 64, 256, lds);
    } else if (it >= n6) {
      int i2 = it - n6; int l = i2 >> 4, mat = (i2 >> 2) & 3, n = i2 & 3;
      const float* src = (mat < 2 ? p.lru_wa : p.lru_wx) + (size_t)(((l * 2 + (mat & 1)) * 4 + n)) * 4096;
      transpose_tile<float>(src, 64, p.LWT + (size_t)(((l * 4 + mat) * 4 + n)) * 4096, 64, lds);
    } else if (it >= n5) {
      int i2 = it - n5; int l = i2 >> 4, mat = (i2 >> 2) & 3, ct = i2 & 3;
      const float* src = (mat < 2 ? p.rw_wup : p.rw_aup) + (size_t)(l * 2 + (mat & 1)) * 64 * 256 + ct * 64;
      transpose_tile<float>(src, 256, p.RWT + ((size_t)(l * 4 + mat) * 256 + ct * 64) * 64, 64, lds);
    } else {
      int i2 = it - n4;
      const float* src; bf16_t* dst;
      if (i2 < 64) { src = p.cwk + (size_t)i2 * 4096; dst = p.CWK + (size_t)i2 * 4096; }
      else { src = p.cdk + (size_t)(i2 - 64) * 4096; dst = p.CDK + (size_t)(i2 - 64) * 4096; }
      for (int i = tid * 4; i < 4096; i += 1024) { float4 v = *(const float4*)(src + i); uint2 o; o.x = pack2(v.x, v.y); o.y = pack2(v.z, v.w); *(uint2*)(dst + i) = o; }
    }
  }
}

__device__ __forceinline__ void phase_norm(const Params& p, int stage) {
  const int tid0 = tid_opaque();
  const int lane = tid0 & 63, wave = tid0 >> 6;
#pragma unroll 1
  for (int tok = blockIdx.x * 4 + wave; tok < NTOK; tok += gridDim.x * 4) {
    const int mv = tok < 4096 ? 0 : 1 + ((tok - 4096) >> 10);
    const float* xin;
    if (stage <= 1) xin = tok < 4096 ? p.x_prompt + (size_t)tok * 1024 : p.x_sample + (size_t)(tok - 4096) * 1024;
    else xin = p.out + (size_t)tok * 1024;
    f32x4 x[4], gt[4], gq[4], sh[4], sc[4], gpre[4]; u32x2 yb[4];
    const int lp = stage >= 1 ? stage - 1 : 0, ln = stage <= 1 ? stage : 0;
    const float* gate = p.MOD + (size_t)(lp * 5 + mv) * 3072 + 2048;
    const float* gpo = p.g_post + lp * 1024;
    const float* md = p.MOD + (size_t)(ln * 5 + mv) * 3072;
    const float* gpr = p.g_pre + ln * 1024;
#pragma unroll
    for (int i = 0; i < 4; ++i) {
      const int col = i * 256 + lane * 4;
      x[i] = *(const f32x4*)(xin + col);
      if (stage >= 1) { yb[i] = *(const u32x2*)((const bf16_t*)p.Y2 + (size_t)tok * 1024 + col); gt[i] = *(const f32x4*)(gate + col); gq[i] = *(const f32x4*)(gpo + col); }
      if (stage <= 1) { sh[i] = *(const f32x4*)(md + col); sc[i] = *(const f32x4*)(md + 1024 + col); gpre[i] = *(const f32x4*)(gpr + col); }
    }
    __builtin_amdgcn_sched_barrier(0);
    if (stage >= 1) {
      f32x4 y[4]; float ss = 0.f;
#pragma unroll
      for (int i = 0; i < 4; ++i) { y[i] = (f32x4){bflo(yb[i].x), bfhi(yb[i].x), bflo(yb[i].y), bfhi(yb[i].y)}; ss += y[i][0] * y[i][0] + y[i][1] * y[i][1] + y[i][2] * y[i][2] + y[i][3] * y[i][3]; }
      ss = wave_sum(ss);
      const float rstd = rsqrtf(ss * (1.0f / 1024.0f) + 1e-6f);
#pragma unroll
      for (int i = 0; i < 4; ++i) {
        const int col = i * 256 + lane * 4;
        x[i] += gt[i] * (y[i] * rstd * gq[i]);
        *(f32x4*)(p.out + (size_t)tok * 1024 + col) = x[i];
      }
    }
    if (stage <= 1) {
      float ss = 0.f;
#pragma unroll
      for (int i = 0; i < 4; ++i) ss += x[i][0] * x[i][0] + x[i][1] * x[i][1] + x[i][2] * x[i][2] + x[i][3] * x[i][3];
      ss = wave_sum(ss);
      const float rstd = rsqrtf(ss * (1.0f / 1024.0f) + 1e-6f);
#pragma unroll
      for (int i = 0; i < 4; ++i) {
        const int col = i * 256 + lane * 4;
        const f32x4 hv = x[i] * rstd * gpre[i] * (sc[i] + 1.f) + sh[i];
        u32x2 o; o.x = pack2(hv[0], hv[1]); o.y = pack2(hv[2], hv[3]);
        *(u32x2*)(p.H + (size_t)tok * LDK + col) = o;
      }
    }
  }
}

template <int MODE, int BMT>
__device__ __forceinline__ void gemm_tile(const Params& p, int l, unsigned char* smem, const bf16_t* A, const bf16_t* Bt, int m0, int tn) {
  constexpr int MI = BMT / 32, NA = BMT / 32;
  const int K = LDK;
  bf16_t* As = (bf16_t*)smem; bf16_t* Bs = As + 128 * 64;
  const int tid = tid_opaque(), lane = tid & 63, wave = tid >> 6, wm = wave >> 1, wn = wave & 1, r16 = lane & 15, quad = lane >> 4;
  const int n0 = tn * 128;
  f32x4 acc[MI][4];
#pragma unroll
  for (int i = 0; i < MI; ++i)
#pragma unroll
    for (int jj = 0; jj < 4; ++jj) acc[i][jj] = (f32x4){0.f, 0.f, 0.f, 0.f};
  u32x4 ra0[NA], rb0[4];
  const int lrow = tid >> 3, lc8 = tid & 7;
  const bf16_t* ga = A + (size_t)(m0 + lrow) * K + lc8 * 8;
  const bf16_t* gb = Bt + (size_t)(n0 + lrow) * K + lc8 * 8;
  const int swz_w = (lc8 ^ ((lrow >> 1) & 7)) * 8, swz_r = (r16 >> 1) & 7;
  bf16_t* const sa_ = As + lrow * 64 + swz_w; bf16_t* const sb_ = Bs + lrow * 64 + swz_w;
#define G_LOAD(KT) { _Pragma("unroll") for (int i = 0; i < NA; ++i) ra0[i] = *(const u32x4*)(ga + (size_t)i * 32 * K + (KT) * 64); \
                     _Pragma("unroll") for (int i = 0; i < 4; ++i) rb0[i] = *(const u32x4*)(gb + (size_t)i * 32 * K + (KT) * 64); }
#define G_STORE() { _Pragma("unroll") for (int i = 0; i < NA; ++i) *(u32x4*)(sa_ + i * 32 * 64) = ra0[i]; \
                    _Pragma("unroll") for (int i = 0; i < 4; ++i) *(u32x4*)(sb_ + i * 32 * 64) = rb0[i]; }
#define G_COMPUTE() { _Pragma("unroll") for (int ks = 0; ks < 2; ++ks) { bf16x8 af[MI], bfr[4]; \
      _Pragma("unroll") for (int i = 0; i < MI; ++i) af[i] = *(const bf16x8*)(As + (wm * (BMT / 2) + i * 16 + r16) * 64 + (((ks * 4 + quad) ^ swz_r) * 8)); \
      _Pragma("unroll") for (int i = 0; i < 4; ++i) bfr[i] = *(const bf16x8*)(Bs + (wn * 64 + i * 16 + r16) * 64 + (((ks * 4 + quad) ^ swz_r) * 8)); \
      _Pragma("unroll") for (int mi = 0; mi < MI; ++mi) _Pragma("unroll") for (int ni = 0; ni < 4; ++ni) acc[mi][ni] = mfma16(bfr[ni], af[mi], acc[mi][ni]); } }
  G_LOAD(0);
  G_STORE();
  __syncthreads();
#pragma unroll 1
  for (int kt = 0; kt < 16; ++kt) {
    if (kt + 1 < 16) G_LOAD(kt + 1);
    __builtin_amdgcn_sched_barrier(0);
    G_COMPUTE();
    lds_barrier();
    if (kt + 1 < 16) { G_STORE(); lds_barrier(); }
  }
#undef G_LOAD
#undef G_STORE
#undef G_COMPUTE
#pragma unroll
  for (int mi = 0; mi < MI; ++mi)
#pragma unroll
    for (int ni = 0; ni < 4; ++ni) {
      const int m = m0 + wm * (BMT / 2) + mi * 16 + r16, n = n0 + wn * 64 + ni * 16 + quad * 4;
      const f32x4 v = acc[mi][ni];
      u32x2 o; o.x = pack2(v[0], v[1]); o.y = pack2(v[2], v[3]);
      if (MODE == 0) {
        *(u32x2*)(p.P + (size_t)m * PW + n) = o;
        if (m0 < 4096) {
          const int row = ((m >> 8) * 2 + l) * 256 + (m & 255);
          float* dst = nullptr;
          if (tn == 11) dst = p.out + O_NWK + (size_t)row * 128 + (n - 1408);
          else if (tn == 12) dst = p.out + O_NWV + (size_t)row * 128 + (n - 1536);
          else if (tn == 21 || tn == 22) dst = p.out + O_NDK + (size_t)row * 256 + (n - 2688);
          else if (tn == 23 || tn == 24) dst = p.out + O_NDV + (size_t)row * 256 + (n - 2944);
          if (dst) *(f32x4*)dst = v;
        }
      } else {
        *(u32x2*)((bf16_t*)p.Y2 + (size_t)m * 1024 + n) = o;
      }
    }
}

template <int MODE>
__device__ __forceinline__ void phase_gemm(const Params& p, int l, unsigned char* smem, int vb) {
  const bf16_t* A = p.H;
  const bf16_t* Bt = MODE == 0 ? p.WINT + (size_t)l * PW * LDK : p.WOUTT + (size_t)l * 1024 * LDK;
  const int NTN = (MODE == 0 ? PW : 1024) / 128;
  const int per = gridDim.x >> 3;
  const bool even8 = (gridDim.x & 7) == 0;
  const int xcd = even8 ? vb / per : (vb & 7), slot = even8 ? vb % per : (vb >> 3), nslot = even8 ? per : (int)((gridDim.x + 7 - xcd) >> 3);
  if (MODE == 0 && gridDim.x == 512) {
#pragma unroll 1
    for (int j = slot; j < 64 * 3; j += 64) gemm_tile<MODE, 128>(p, l, smem, A, Bt, (j / 3) * 128, xcd + 8 * (j % 3));
    if (xcd < 6) gemm_tile<MODE, 64>(p, l, smem, A, Bt, ((xcd & 1) * 64 + slot) * 64, 24 + (xcd >> 1));
  } else {
    const int nx = (NTN - xcd + 7) >> 3;
#pragma unroll 1
    for (int j = slot; j < 64 * nx; j += nslot) gemm_tile<MODE, 128>(p, l, smem, A, Bt, (j / nx) * 128, xcd + 8 * (j % nx));
  }
}

DI void unpack8(u32x4 u, float (&o)[8]) { o[0] = bflo(u.x); o[1] = bfhi(u.x); o[2] = bflo(u.y); o[3] = bfhi(u.y); o[4] = bflo(u.z); o[5] = bfhi(u.z); o[6] = bflo(u.w); o[7] = bfhi(u.w); }
DI bf16x8 pack8(const float (&o)[8]) { u32x4 u; u.x = pack2(o[0], o[1]); u.y = pack2(o[2], o[3]); u.z = pack2(o[4], o[5]); u.w = pack2(o[6], o[7]); return __builtin_bit_cast(bf16x8, u); }

__device__ __forceinline__ void pre_rwkv(const Params& p, int l, int item) {
  const int tid = tid_opaque(), lane = tid & 63, h = tid >> 6, r16 = lane & 15, quad = lane >> 4;
  const int tok = item * 16 + r16;
  const bf16_t* pr = p.P + (size_t)tok * PW;
  bf16x8 wdf[2], adf[2];
#pragma unroll
  for (int ks = 0; ks < 2; ++ks) {
    float o[8]; unpack8(*(const u32x4*)(pr + 768 + ks * 32 + quad * 8), o);
#pragma unroll
    for (int j = 0; j < 8; ++j) o[j] = 1.0f - 2.0f * __builtin_amdgcn_rcpf(1.0f + __expf(2.0f * o[j]));
    wdf[ks] = pack8(o);
    adf[ks] = *(const bf16x8*)(pr + 832 + ks * 32 + quad * 8);
  }
  float kv[4][4];
#pragma unroll
  for (int ct = 0; ct < 4; ++ct) ld4bf(pr + 256 + h * 64 + ct * 16 + quad * 4, kv[ct]);
  const bf16_t* wt = p.RWT + (size_t)l * 4 * 256 * 64;
  float ss = 0.f;
#pragma unroll
  for (int ct = 0; ct < 4; ++ct) {
    const f32x4 kkc = *(const f32x4*)(p.rw_kk + l * 256 + h * 64 + ct * 16 + quad * 4);
#pragma unroll
    for (int r = 0; r < 4; ++r) { const float q = kv[ct][r] * kkc[r]; ss += q * q; }
  }
  ss += __shfl_xor(ss, 16); ss += __shfl_xor(ss, 32);
  const float rn = rsqrtf(ss + 1e-12f);
#pragma unroll
  for (int ct = 0; ct < 4; ++ct) {
    f32x4 acc[4];
    const int c0 = h * 64 + ct * 16 + quad * 4;
    bf16x8 wfr[4][2];
#pragma unroll
    for (int mat = 0; mat < 4; ++mat)
#pragma unroll
      for (int ks = 0; ks < 2; ++ks) wfr[mat][ks] = *(const bf16x8*)(wt + ((size_t)mat * 256 + h * 64 + ct * 16 + r16) * 64 + ks * 32 + quad * 8);
    const f32x4 kkc = *(const f32x4*)(p.rw_kk + l * 256 + c0), kac = *(const f32x4*)(p.rw_ka + l * 256 + c0);
    const f32x4 w00 = *(const f32x4*)(p.rw_w0 + (l * 2 + 0) * 256 + c0), w01 = *(const f32x4*)(p.rw_w0 + (l * 2 + 1) * 256 + c0);
    const f32x4 a00 = *(const f32x4*)(p.rw_a0 + (l * 2 + 0) * 256 + c0), a01 = *(const f32x4*)(p.rw_a0 + (l * 2 + 1) * 256 + c0);
    __builtin_amdgcn_sched_barrier(0);
#pragma unroll
    for (int mat = 0; mat < 4; ++mat) {
      f32x4 a = {0.f, 0.f, 0.f, 0.f};
#pragma unroll
      for (int ks = 0; ks < 2; ++ks) a = mfma16(wfr[mat][ks], mat < 2 ? wdf[ks] : adf[ks], a);
      acc[mat] = a;
    }
    f32x4 nkk, w0v, w1v, b0v, b1v, k0v, k1v;
#pragma unroll
    for (int r = 0; r < 4; ++r) {
      const float k = kv[ct][r];
      const float kkn = k * kkc[r] * rn;
      nkk[r] = -kkn;
#pragma unroll
      for (int d = 0; d < 2; ++d) {
        const float wl = (d ? w01[r] : w00[r]) + acc[d][r];
        const float w_log = -__logf(1.0f + __expf(-wl)) - 0.5f;
        const float decay = __expf(-__expf(w_log));
        const float a = fsigmoid((d ? a01[r] : a00[r]) + acc[2 + d][r]);
        const float kd = k * (1.f + (a - 1.f) * kac[r]);
        if (d) { w1v[r] = decay; b1v[r] = kkn * a; k1v[r] = kd; } else { w0v[r] = decay; b0v[r] = kkn * a; k0v[r] = kd; }
      }
    }
    const size_t o0 = (size_t)tok * 256 + c0, o1 = ((size_t)NTOK + tok) * 256 + c0;
    *(f32x4*)(p.NKK + o0) = nkk;
    *(f32x4*)(p.AW + o0) = w0v; *(f32x4*)(p.AW + o1) = w1v;
    *(f32x4*)(p.AB + o0) = b0v; *(f32x4*)(p.AB + o1) = b1v;
    *(f32x4*)(p.AKD + o0) = k0v; *(f32x4*)(p.AKD + o1) = k1v;
  }
}

#define LSCAN_STEP(A, H, CTRL) { \
    const float Ap = __builtin_bit_cast(float, __builtin_amdgcn_update_dpp(0x3f800000, __builtin_bit_cast(int, A), CTRL, 0xf, 0xf, false)); \
    const float Hp = __builtin_bit_cast(float, __builtin_amdgcn_update_dpp(0, __builtin_bit_cast(int, H), CTRL, 0xf, 0xf, true)); \
    H = A * Hp + H; A = A * Ap; }

__device__ __forceinline__ void pre_lru(const Params& p, int l, int item) {
  const int tid = tid_opaque(), lane = tid & 63, n = tid >> 6, r16 = lane & 15, quad = lane >> 4;
  const int tok0 = item * 16;
  int T, sb, t0;
  if (tok0 < 4096) { T = 256; sb = tok0 & ~255; t0 = tok0 & 255; } else { T = 1024; sb = 4096 + ((tok0 - 4096) & ~1023); t0 = (tok0 - 4096) & 1023; }
  const int t = t0 + r16, tok = tok0 + r16;
  bf16x8 xf[2];
  float xo[2][8];
#pragma unroll
  for (int ks = 0; ks < 2; ++ks) {
    const int cb = n * 64 + ks * 32 + quad * 8;
    float o[8];
    { const f32x4 b0 = *(const f32x4*)(p.lru_cb + l * 256 + cb), b1 = *(const f32x4*)(p.lru_cb + l * 256 + cb + 4);
      o[0] = b0[0]; o[1] = b0[1]; o[2] = b0[2]; o[3] = b0[3]; o[4] = b1[0]; o[5] = b1[1]; o[6] = b1[2]; o[7] = b1[3]; }
#pragma unroll
    for (int i = 0; i < 4; ++i) {
      const int tt = t - 2 + i;
      u32x4 xr = {0u, 0u, 0u, 0u};
      if (tt >= 0 && tt < T) xr = *(const u32x4*)(p.P + (size_t)(sb + tt) * PW + 1920 + cb);
      float x[8]; unpack8(xr, x);
      const f32x4 w0 = *(const f32x4*)(p.lru_cw + (l * 4 + i) * 256 + cb), w1 = *(const f32x4*)(p.lru_cw + (l * 4 + i) * 256 + cb + 4);
      o[0] += w0[0] * x[0]; o[1] += w0[1] * x[1]; o[2] += w0[2] * x[2]; o[3] += w0[3] * x[3];
      o[4] += w1[0] * x[4]; o[5] += w1[1] * x[5]; o[6] += w1[2] * x[6]; o[7] += w1[3] * x[7];
    }
    xf[ks] = pack8(o);
#pragma unroll
    for (int j = 0; j < 8; ++j) xo[ks][j] = o[j];
  }
#pragma unroll
  for (int et = 0; et < 4; ++et) {
    f32x4 acc[4];
    const int c0 = n * 64 + (et >> 1) * 32 + quad * 8 + (et & 1) * 4;
    const int erow = (et >> 1) * 32 + (r16 >> 2) * 8 + (et & 1) * 4 + (r16 & 3);
    bf16x8 wfr[4][2];
#pragma unroll
    for (int mat = 0; mat < 4; ++mat)
#pragma unroll
      for (int ks = 0; ks < 2; ++ks) wfr[mat][ks] = *(const bf16x8*)(p.LWT + ((size_t)((l * 4 + mat) * 4 + n) * 64 + erow) * 64 + ks * 32 + quad * 8);
    const f32x4 ba0 = *(const f32x4*)(p.lru_ba + (l * 2 + 0) * 256 + c0), ba1 = *(const f32x4*)(p.lru_ba + (l * 2 + 1) * 256 + c0);
    const f32x4 bx0 = *(const f32x4*)(p.lru_bx + (l * 2 + 0) * 256 + c0), bx1 = *(const f32x4*)(p.lru_bx + (l * 2 + 1) * 256 + c0);
    const f32x4 lm0 = *(const f32x4*)(p.lru_lam + (l * 2 + 0) * 256 + c0), lm1 = *(const f32x4*)(p.lru_lam + (l * 2 + 1) * 256 + c0);
    __builtin_amdgcn_sched_barrier(0);
#pragma unroll
    for (int mat = 0; mat < 4; ++mat) {
      f32x4 a = {0.f, 0.f, 0.f, 0.f};
#pragma unroll
      for (int ks = 0; ks < 2; ++ks) a = mfma16(wfr[mat][ks], xf[ks], a);
      acc[mat] = a;
    }
    f32x4 A0, H0, A1, H1;
#pragma unroll
    for (int r = 0; r < 4; ++r) {
      const float x = xo[et >> 1][(et & 1) * 4 + r];
#pragma unroll
      for (int d = 0; d < 2; ++d) {
        const float ga = fsigmoid(acc[d][r] + (d ? ba1[r] : ba0[r]));
        const float gx = fsigmoid(acc[2 + d][r] + (d ? bx1[r] : bx0[r]));
        const float e_ = __expf(-(d ? lm1[r] : lm0[r]));
        const float sp = e_ < 0.05f ? e_ * (1.0f - e_ * (0.5f - e_ * (0.33333334f - 0.25f * e_))) : __logf(1.0f + e_);
        const float log_a = -8.0f * ga * sp;
        float a = __expf(log_a);
        const float x2 = 2.0f * log_a;
        const float om = x2 > -0.05f ? -(x2 * (1.0f + x2 * (0.5f + x2 * (0.16666667f + x2 * 0.041666667f)))) : 1.0f - __expf(x2);
        float u = __fsqrt_rn(om) * (gx * x);
        if (d == 0) { LSCAN_STEP(a, u, 0x111) LSCAN_STEP(a, u, 0x112) LSCAN_STEP(a, u, 0x114) LSCAN_STEP(a, u, 0x118) A0[r] = a; H0[r] = u; }
        else        { LSCAN_STEP(a, u, 0x101) LSCAN_STEP(a, u, 0x102) LSCAN_STEP(a, u, 0x104) LSCAN_STEP(a, u, 0x108) A1[r] = a; H1[r] = u; }
      }
    }
    const size_t o0 = (size_t)tok * 256 + c0, o1 = ((size_t)NTOK + tok) * 256 + c0;
    *(f32x4*)(p.LA + o0) = A0; *(f32x4*)(p.LU + o0) = H0;
    *(f32x4*)(p.LA + o1) = A1; *(f32x4*)(p.LU + o1) = H1;
  }
}

__device__ __forceinline__ void pre_rope(const Params& p, int item) {
  const int tid = tid_opaque();
  const int ts0 = item * 16;
#pragma unroll 1
  for (int pp = tid; pp < 448; pp += 256) {
    int scol, d1, d2, half, i, dstride; bf16_t* dst; float inv;
    if (pp < 192) {
      int q = pp < 128 ? pp : pp - 128; int vec = q >> 5, pi = q & 31; half = pi >> 4; i = pi & 15;
      d1 = half * 32 + i; d2 = d1 + 16; inv = exp2f(-(float)i * (13.287712379549449f / 16.0f));
      if (pp < 128) { scol = 1152 + vec * 64; dst = p.QBR + vec * 64; dstride = 256; }
      else { scol = 1408 + vec * 64; dst = p.KBR + vec * 64; dstride = 128; }
    } else {
      int q = pp < 320 ? pp - 192 : pp - 320; int vec = q >> 4, pi = q & 15; half = pi >> 3; i = pi & 7;
      d1 = half * 16 + i; d2 = d1 + 8; inv = exp2f(-(float)i * (13.287712379549449f / 8.0f));
      if (pp < 320) { scol = 2432 + vec * 32; dst = p.QDR + vec * 32; dstride = 256; }
      else { scol = 2688 + vec * 32; dst = p.KDR + vec * 32; dstride = 256; }
    }
    float x1[16], x2[16];
#pragma unroll
    for (int tt = 0; tt < 16; ++tt) { const bf16_t* src = p.P + (size_t)(4096 + ts0 + tt) * PW + scol; x1[tt] = bf2f(src[d1]); x2[tt] = bf2f(src[d2]); }
#pragma unroll
    for (int tt = 0; tt < 16; ++tt) {
      const int t = (ts0 + tt) & 1023;
      const float ang = (float)(half ? (t & 63) : (t >> 6)) * inv;
      const float sn = __sinf(ang), cs = __cosf(ang);
      const float a = x1[tt], b = x2[tt];
      bf16_t* o = dst + (size_t)(ts0 + tt) * dstride;
      o[d1] = f2bf(a * cs - b * sn); o[d2] = f2bf(a * sn + b * cs);
    }
  }
}

__device__ __forceinline__ void phase_pre(const Params& p, int l, unsigned char* smem) {
  const int n0 = 512, n1 = n0 + 512, n2 = n1 + 256, n3 = n2 + 256, n4 = n3 + 512;
#pragma unroll 1
  for (int it = blockIdx.x; it < n4; it += gridDim.x) {
    if (it < n0) pre_rwkv(p, l, it);
    else if (it < n1) pre_lru(p, l, it - n0);
    else if (it < n2) pre_rope(p, it - n1);
    else if (it < n3) {
      int i2 = it - n2; int tt = i2 >> 1, ct = i2 & 1; int tok0 = tt * 64;
      int T, sb; if (tok0 < 4096) { T = 256; sb = tok0 & ~255; } else { T = 1024; sb = 4096 + ((tok0 - 4096) & ~1023); }
      transpose_tile<bf16_t>(p.P + (size_t)tok0 * PW + 1536 + ct * 64, PW, p.VBT + (size_t)sb * 128 + (size_t)(ct * 64) * T + (tok0 - sb), T, (float*)smem);
    } else {
      int i2 = it - n3; int tt = i2 >> 2, ct = i2 & 3; int tok0 = tt * 64;
      int T, sb; if (tok0 < 4096) { T = 256; sb = tok0 & ~255; } else { T = 1024; sb = 4096 + ((tok0 - 4096) & ~1023); }
      transpose_tile<bf16_t>(p.P + (size_t)tok0 * PW + 2944 + ct * 64, PW, p.VDT + (size_t)sb * 256 + (size_t)(ct * 64) * T + (tok0 - sb), T, (float*)smem);
    }
  }
}

template <int LR> DI float group_sum(float v) {
  v += __builtin_bit_cast(float, __builtin_amdgcn_update_dpp(0, __builtin_bit_cast(int, v), 0xB1, 0xf, 0xf, true));
  v += __builtin_bit_cast(float, __builtin_amdgcn_update_dpp(0, __builtin_bit_cast(int, v), 0x4E, 0xf, 0xf, true));
  if (LR >= 8) v += __builtin_bit_cast(float, __builtin_amdgcn_update_dpp(0, __builtin_bit_cast(int, v), 0x141, 0xf, 0xf, true));
  if (LR >= 16) v += __builtin_bit_cast(float, __builtin_amdgcn_update_dpp(0, __builtin_bit_cast(int, v), 0x140, 0xf, 0xf, true));
  return v;
}
typedef float f32x2 __attribute__((ext_vector_type(2)));
template <int E> struct RwOps { f32x4 nk[E / 4], ww[E / 4], bb[E / 4], kk[E / 4], rr[E / 4]; float vi; };
template <int E> DI void rw_load(const float* ob, int g, int i, RwOps<E>& o) {
  constexpr int LR = 64 / E, NM = E / 4;
#pragma unroll
  for (int m = 0; m < NM; ++m) {
    const int off = 4 * (g + LR * m);
    o.nk[m] = *(const f32x4*)(ob + off); o.ww[m] = *(const f32x4*)(ob + 64 + off); o.bb[m] = *(const f32x4*)(ob + 128 + off);
    o.kk[m] = *(const f32x4*)(ob + 192 + off); o.rr[m] = *(const f32x4*)(ob + 256 + off);
  }
  o.vi = ob[320 + i];
}
#define DPP_ADD(V, CTRL) V += __builtin_bit_cast(float, __builtin_amdgcn_update_dpp(0, __builtin_bit_cast(int, V), CTRL, 0xf, 0xf, true))
template <int E> DI float rw_step(f32x2 (&S)[E / 2], const RwOps<E>& o, float& ypart) {
  constexpr int LR = 64 / E, NM = E / 4;
  f32x2 p2 = S[0] * o.nk[0].xy;
  p2 = S[1] * o.nk[0].zw + p2;
#pragma unroll
  for (int m = 1; m < NM; ++m) { p2 = S[2 * m] * o.nk[m].xy + p2; p2 = S[2 * m + 1] * o.nk[m].zw + p2; }
  float sa = p2.x + p2.y, yr = ypart;
  DPP_ADD(sa, 0xB1); DPP_ADD(yr, 0xB1);
  DPP_ADD(sa, 0x4E); DPP_ADD(yr, 0x4E);
  if (LR >= 8) { DPP_ADD(sa, 0x141); DPP_ADD(yr, 0x141); }
  if (LR >= 16) { DPP_ADD(sa, 0x140); DPP_ADD(yr, 0x140); }
  const f32x2 sa2 = {sa, sa}, v2 = {o.vi, o.vi};
  f32x2 y2 = {0.f, 0.f};
#pragma unroll
  for (int m = 0; m < NM; ++m) {
    S[2 * m] = S[2 * m] * o.ww[m].xy + (sa2 * o.bb[m].xy + v2 * o.kk[m].xy);
    S[2 * m + 1] = S[2 * m + 1] * o.ww[m].zw + (sa2 * o.bb[m].zw + v2 * o.kk[m].zw);
    y2 = S[2 * m] * o.rr[m].xy + y2; y2 = S[2 * m + 1] * o.rr[m].zw + y2;
  }
  ypart = y2.x + y2.y;
  return yr;
}
template <int E>
__device__ __forceinline__ void rwkv_chain(const Params& p, int l, int chain, int part, unsigned char* smem) {
  constexpr int LR = 64 / E, NM = E / 4;
  const int tid = tid_opaque(), lane = tid & 63, wave = tid >> 6;
  int seq, d, h;
  if (chain < 32) { seq = 16 + (chain >> 3); d = (chain >> 2) & 1; h = chain & 3; }
  else { int c2 = chain - 32; seq = c2 >> 3; d = (c2 >> 2) & 1; h = c2 & 3; }
  const int T = seq < 16 ? 256 : 1024, tokb = seq < 16 ? seq * 256 : 4096 + (seq - 16) * 1024;
  const int g = lane % LR, rl = lane / LR, i = part * 4 * E + wave * E + rl;
  f32x2 S[E / 2];
  if (seq >= 16) {
    const float* s0 = p.st_rwkv + ((((size_t)(seq - 16) * 2 + l) * 2 + d) * 4 + h) * 4096 + i * 64;
#pragma unroll
    for (int m = 0; m < NM; ++m) { f32x4 t = *(const f32x4*)(s0 + 4 * (g + LR * m)); S[2 * m] = t.xy; S[2 * m + 1] = t.zw; }
  } else {
#pragma unroll
    for (int j = 0; j < E / 2; ++j) S[j] = (f32x2){0.f, 0.f};
  }
  float* buf = (float*)smem;
  const int lvec = (tid >> 4) & 3, lc4 = tid & 15, ls = tid >> 6;
  const float* fsrc = (lvec == 0 ? p.NKK : lvec == 1 ? p.AW + (size_t)d * NTOK * 256 : lvec == 2 ? p.AB + (size_t)d * NTOK * 256 : p.AKD + (size_t)d * NTOK * 256) + h * 64 + lc4 * 4;
  const int bs = tid >> 4, bvec = (tid >> 3) & 1, bc8 = tid & 7;
  const bf16_t* bsrc = p.P + (bvec ? 512 : 0) + h * 64 + bc8 * 8;
  f32x4 rfA[4], rfB[4]; u32x4 rbA, rbB;
  const int nch = T / 16;
#define RW_GLOAD(RF, RB, CK) { _Pragma("unroll") for (int i4 = 0; i4 < 4; ++i4) { int step = (CK) * 16 + ls + 4 * i4; int t = d ? T - 1 - step : step; RF[i4] = *(const f32x4*)(fsrc + (size_t)(tokb + t) * 256); } \
    { int step = (CK) * 16 + bs; int t = d ? T - 1 - step : step; RB = *(const u32x4*)(bsrc + (size_t)(tokb + t) * PW); } }
#define RW_SSTORE(RF, RB, BI) { float* b_ = buf + (BI) * 16 * 384; \
    _Pragma("unroll") for (int i4 = 0; i4 < 4; ++i4) *(f32x4*)(b_ + (ls + 4 * i4) * 384 + lvec * 64 + lc4 * 4) = RF[i4]; \
    float* q_ = b_ + bs * 384 + (4 + bvec) * 64 + bc8 * 8; \
    *(f32x4*)q_ = (f32x4){bflo(RB.x), bfhi(RB.x), bflo(RB.y), bfhi(RB.y)}; \
    *(f32x4*)(q_ + 4) = (f32x4){bflo(RB.z), bfhi(RB.z), bflo(RB.w), bfhi(RB.w)}; }
  float* yout = p.YA + ((size_t)d * NTOK + tokb) * 256 + h * 64 + i;
  constexpr int NY = 16 / LR;
  auto compute = [&](int ck) {
    const float* cb = buf + (ck & 1) * 16 * 384;
    float yk[NY];
#pragma unroll
    for (int q = 0; q < NY; ++q) yk[q] = 0.f;
    constexpr int NSET = (E == 4) ? 4 : 2;
    float ypart = 0.f;
    RwOps<E> ops[NSET];
#pragma unroll
    for (int q = 0; q < NSET - 1; ++q) rw_load<E>(cb + q * 384, g, i, ops[q]);
#pragma unroll 1
    for (int s = 0; s < 16; s += NSET) {
#pragma unroll
      for (int u = 0; u < NSET; ++u) {
        const int sn = s + u + NSET - 1;
        rw_load<E>(buf + (((ck & 1) * 16 + sn) & 31) * 384, g, i, ops[(u + NSET - 1) % NSET]);
        const float y0 = rw_step<E>(S, ops[u], ypart);
#pragma unroll
        for (int q = 0; q < NY; ++q) yk[q] = (s + u - 1 == q * LR + g) ? y0 : yk[q];
      }
    }
    {
      const float y15 = group_sum<LR>(ypart);
#pragma unroll
      for (int q = 0; q < NY; ++q) yk[q] = (15 == q * LR + g) ? y15 : yk[q];
    }
#pragma unroll
    for (int q = 0; q < NY; ++q) { const int step = ck * 16 + q * LR + g; const int t = d ? T - 1 - step : step; yout[(size_t)t * 256] = yk[q]; }
  };
  __builtin_amdgcn_s_setprio(2);
  RW_GLOAD(rfA, rbA, 0); RW_SSTORE(rfA, rbA, 0); RW_GLOAD(rfA, rbA, 1); RW_GLOAD(rfB, rbB, 2);
  __syncthreads();
#pragma unroll 1
  for (int ck = 0; ck < nch; ck += 2) {
    compute(ck);
    RW_SSTORE(rfA, rbA, 1);
    if (ck + 3 < nch) RW_GLOAD(rfA, rbA, ck + 3);
    lds_barrier();
    compute(ck + 1);
    if (ck + 2 < nch) RW_SSTORE(rfB, rbB, 0);
    if (ck + 4 < nch) RW_GLOAD(rfB, rbB, ck + 4);
    lds_barrier();
  }
  __builtin_amdgcn_s_setprio(0);
#undef RW_GLOAD
#undef RW_SSTORE
  if (seq < 16) {
    float* so = p.out + O_NSR + ((((size_t)seq * 2 + l) * 2 + d) * 4 + h) * 4096 + i * 64;
#pragma unroll
    for (int m = 0; m < NM; ++m) *(f32x4*)(so + 4 * (g + LR * m)) = (f32x4){S[2 * m].x, S[2 * m].y, S[2 * m + 1].x, S[2 * m + 1].y};
  }
}

__device__ __forceinline__ void lru_scan(const Params& p, int l, int item) {
  const int c = tid_opaque();
  int seq, d;
  if (item < 8) { seq = 16 + (item >> 1); d = item & 1; } else { seq = (item - 8) >> 1; d = item & 1; }
  const int T = seq < 16 ? 256 : 1024, tokb = seq < 16 ? seq * 256 : 4096 + (seq - 16) * 1024;
  const int NC = T >> 4;
  float h = seq >= 16 ? p.st_lru[(((seq - 16) * 2 + l) * 2 + d) * 256 + c] : 0.f;
  const float* la = p.LA + (size_t)d * NTOK * 256 + c; const float* lu = p.LU + (size_t)d * NTOK * 256 + c;
  float* lc = p.LC + (size_t)d * 512 * 256 + (size_t)(tokb >> 4) * 256 + c;
  for (int k0 = 0; k0 < NC; k0 += 8) {
    float a[8], u[8];
#pragma unroll
    for (int q = 0; q < 8; ++q) { const int k = d ? NC - 1 - (k0 + q) : k0 + q; const size_t idx = (size_t)(tokb + k * 16 + (d ? 0 : 15)) * 256; a[q] = la[idx]; u[q] = lu[idx]; }
#pragma unroll
    for (int q = 0; q < 8; ++q) { const int k = d ? NC - 1 - (k0 + q) : k0 + q; lc[(size_t)k * 256] = h; h = a[q] * h + u[q]; }
  }
  if (seq < 16) p.out[O_NSL + ((seq * 2 + l) * 2 + d) * 256 + c] = h;
}

template <bool DIFF>
__device__ __forceinline__ void attn_item(const Params& p, int l, bool sample, int sq  , int h, int qt, unsigned char* smem) {
  constexpr int NS = DIFF ? 2 : 1;
  const int tid = tid_opaque();
  const int lane = tid & 63, wave = tid >> 6, r16 = lane & 15, quad = lane >> 4;
  const int T = sample ? 1024 : 256;
  const int tokb = sample ? 4096 + sq * 1024 : sq * 256;
  const int q0 = qt * 64 + wave * 16;
  const int qpos = q0 + r16;
  const int kvh = DIFF ? h : (h >> 1);
  bf16x8 qf[2];
  {
    const bf16_t* qp;
    if (sample) qp = (DIFF ? p.QDR : p.QBR) + (size_t)(sq * 1024 + qpos) * 256 + h * 64;
    else qp = p.P + (size_t)(tokb + qpos) * PW + (DIFF ? 2432 : 1152) + h * 64;
    qf[0] = *(const bf16x8*)(qp + quad * 8); qf[1] = *(const bf16x8*)(qp + 32 + quad * 8);
  }
  float m[2] = {-3.0e38f, -3.0e38f}, lsum[2] = {0.f, 0.f};
  f32x4 o[2][4];
#pragma unroll
  for (int a = 0; a < 2; ++a)
#pragma unroll
    for (int b = 0; b < 4; ++b) o[a][b] = (f32x4){0.f, 0.f, 0.f, 0.f};
  const float scale_log2 = (DIFF ? 0.17677669529663687f : 0.125f) * 1.4426950408889634f;
  const int nctx = sample ? 4 : 0;
  const bf16_t* Kc = nullptr; const bf16_t* Vc = nullptr; int ksc = 0;
  if (sample) {
    const int bl = sq * 2 + l;
    if (DIFF) { Kc = p.CDK + (size_t)bl * 256 * 256 + h * 64; ksc = 256; Vc = p.CDVT + (size_t)bl * 256 * 256 + (size_t)(h * 64) * 256; }
    else { Kc = p.CWK + (size_t)bl * 256 * 128 + kvh * 64; ksc = 128; Vc = p.CWVT + (size_t)bl * 128 * 256 + (size_t)(kvh * 64) * 256; }
  }
  const bf16_t* Kl; const bf16_t* Vl; int ksl;
  if (sample) {
    if (DIFF) { Kl = p.KDR + (size_t)(sq * 1024) * 256 + h * 64; ksl = 256; Vl = p.VDT + (size_t)tokb * 256 + (size_t)(h * 64) * T; }
    else { Kl = p.KBR + (size_t)(sq * 1024) * 128 + kvh * 64; ksl = 128; Vl = p.VBT + (size_t)tokb * 128 + (size_t)(kvh * 64) * T; }
  } else {
    if (DIFF) { Kl = p.P + (size_t)tokb * PW + 2688 + h * 64; ksl = PW; Vl = p.VDT + (size_t)tokb * 256 + (size_t)(h * 64) * T; }
    else { Kl = p.P + (size_t)tokb * PW + 1408 + kvh * 64; ksl = PW; Vl = p.VBT + (size_t)tokb * 128 + (size_t)(kvh * 64) * T; }
  }
  int kb0 = 0, kb1 = T; bool lmask = false;
  if (sample && !DIFF) { const int qb = qt * 64; kb0 = qb - 128 < 0 ? 0 : qb - 128; kb1 = qb + 192 > T ? T : qb + 192; lmask = true; }
  const int nt = nctx + ((kb1 - kb0) >> 6);
  bf16_t* const lds = (bf16_t*)smem;
  const int lrow = tid >> 2, lch = (tid & 3) * 16;
  auto gsrc = [&](int t, const bf16_t*& kp, const bf16_t*& vp) {
    if (t < nctx) { kp = Kc + (size_t)(t * 64 + lrow) * ksc + lch; vp = Vc + (size_t)lrow * 256 + t * 64 + lch; }
    else { const int kb = kb0 + (t - nctx) * 64; kp = Kl + (size_t)(kb + lrow) * ksl + lch; vp = Vl + (size_t)lrow * T + kb + lch; }
  };
  u32x4 rk0, rk1, rv0, rv1;
  { const bf16_t* kp; const bf16_t* vp; gsrc(0, kp, vp); rk0 = *(const u32x4*)kp; rk1 = *(const u32x4*)(kp + 8); rv0 = *(const u32x4*)vp; rv1 = *(const u32x4*)(vp + 8); }
  __syncthreads();
  { bf16_t* d = lds + lrow * 72 + lch; *(u32x4*)d = rk0; *(u32x4*)(d + 8) = rk1; *(u32x4*)(d + 64 * 72) = rv0; *(u32x4*)(d + 64 * 72 + 8) = rv1; }
  __syncthreads();
  const f32x4 z4 = {0.f, 0.f, 0.f, 0.f};
  const int krow = 8 * (r16 >> 2) + (r16 & 3);
#pragma unroll 1
  for (int t = 0; t < nt; ++t) {
    const bool isctx = t < nctx;
    const bool masked = !isctx && lmask;
    const int kpos0 = kb0 + (t - nctx) * 64;
    if (t + 1 < nt) { const bf16_t* kp; const bf16_t* vp; gsrc(t + 1, kp, vp); rk0 = *(const u32x4*)kp; rk1 = *(const u32x4*)(kp + 8); rv0 = *(const u32x4*)vp; rv1 = *(const u32x4*)(vp + 8); }
    const bf16_t* Ks = lds + (t & 1) * (2 * 64 * 72);
    const bf16_t* Vs = Ks + 64 * 72;
    bf16x8 pf[NS][2];
#pragma unroll
    for (int st = 0; st < NS; ++st) {
      f32x4 sc[4];
#pragma unroll
      for (int kt = 0; kt < 4; ++kt) {
        const bf16_t* kr = Ks + (32 * (kt >> 1) + 4 * (kt & 1) + krow) * 72 + quad * 8;
        if (!DIFF) { sc[kt] = mfma16(*(const bf16x8*)kr, qf[0], z4); sc[kt] = mfma16(*(const bf16x8*)(kr + 32), qf[1], sc[kt]); }
        else sc[kt] = mfma16(*(const bf16x8*)(kr + 32 * st), qf[st], z4);
      }
      float mx = -3.0e38f;
#pragma unroll
      for (int kt = 0; kt < 4; ++kt)
#pragma unroll
        for (int r = 0; r < 4; ++r) {
          float x = sc[kt][r] * scale_log2;
          if (masked) { const int kp = kpos0 + 32 * (kt >> 1) + 8 * quad + 4 * (kt & 1) + r; const int dd = kp - qpos; if (dd > 128 || dd < -128) x = -1.0e30f; }
          sc[kt][r] = x; mx = fmaxf(mx, x);
        }
      mx = fmaxf(mx, __shfl_xor(mx, 16)); mx = fmaxf(mx, __shfl_xor(mx, 32));
      const float mnew = fmaxf(m[st], mx);
      const float alpha = __builtin_amdgcn_exp2f(m[st] - mnew);
      m[st] = mnew;
      float ps = 0.f;
#pragma unroll
      for (int kt = 0; kt < 4; ++kt)
#pragma unroll
        for (int r = 0; r < 4; ++r) { const float e = __builtin_amdgcn_exp2f(sc[kt][r] - mnew); sc[kt][r] = e; ps += e; }
      lsum[st] = lsum[st] * alpha + ps;
#pragma unroll
      for (int dt = 0; dt < 4; ++dt) o[st][dt] *= alpha;
#pragma unroll
      for (int s2 = 0; s2 < 2; ++s2) {
        u32x4 tt;
        tt.x = pack2(sc[2 * s2][0], sc[2 * s2][1]); tt.y = pack2(sc[2 * s2][2], sc[2 * s2][3]);
        tt.z = pack2(sc[2 * s2 + 1][0], sc[2 * s2 + 1][1]); tt.w = pack2(sc[2 * s2 + 1][2], sc[2 * s2 + 1][3]);
        pf[st][s2] = __builtin_bit_cast(bf16x8, tt);
      }
    }
#pragma unroll
    for (int dt = 0; dt < 4; ++dt)
#pragma unroll
      for (int s2 = 0; s2 < 2; ++s2) {
        const bf16x8 vf = *(const bf16x8*)(Vs + (dt * 16 + r16) * 72 + 32 * s2 + 8 * quad);
#pragma unroll
        for (int st = 0; st < NS; ++st) o[st][dt] = mfma16(vf, pf[st][s2], o[st][dt]);
      }
    if (t + 1 < nt) {
      bf16_t* d = lds + ((t + 1) & 1) * (2 * 64 * 72) + lrow * 72 + lch;
      *(u32x4*)d = rk0; *(u32x4*)(d + 8) = rk1; *(u32x4*)(d + 64 * 72) = rv0; *(u32x4*)(d + 64 * 72 + 8) = rv1;
    }
    __syncthreads();
  }
  float l0 = lsum[0]; l0 += __shfl_xor(l0, 16); l0 += __shfl_xor(l0, 32);
  const int tok = tokb + qpos;
  if (!DIFF) {
    l0 += __builtin_amdgcn_exp2f(p.win_sink[l * 4 + h] * 1.4426950408889634f - m[0]);
    const float inv = 1.0f / l0;
#pragma unroll
    for (int dt = 0; dt < 4; ++dt) {
      f32x4 v = o[0][dt] * inv;
      *(f32x4*)(p.OB + (size_t)tok * 256 + h * 64 + dt * 16 + quad * 4) = v;
    }
  } else {
    float l1 = lsum[1]; l1 += __shfl_xor(l1, 16); l1 += __shfl_xor(l1, 32);
    float d1 = 0.f, d2 = 0.f;
    const float* dl = p.diff_lam + l * 128;
    for (int j = 0; j < 32; ++j) { d1 += dl[j] * dl[32 + j]; d2 += dl[64 + j] * dl[96 + j]; }
    const float lam_init = 0.8f - 0.6f * expf(-0.3f * (float)l);
    const float lam = expf(d1) - expf(d2) + lam_init;
    const float i0 = 1.0f / l0, i1 = lam / l1;
    f32x4 v[4]; float ss = 0.f;
#pragma unroll
    for (int dt = 0; dt < 4; ++dt) { v[dt] = o[0][dt] * i0 - o[1][dt] * i1; ss += v[dt][0] * v[dt][0] + v[dt][1] * v[dt][1] + v[dt][2] * v[dt][2] + v[dt][3] * v[dt][3]; }
    ss += __shfl_xor(ss, 16); ss += __shfl_xor(ss, 32);
    const float rstd = rsqrtf(ss * (1.0f / 64.0f) + 1e-6f) * (1.0f - lam_init);
#pragma unroll
    for (int dt = 0; dt < 4; ++dt) {
      const f32x4 g = *(const f32x4*)(p.diff_g + l * 64 + dt * 16 + quad * 4);
      *(f32x4*)(p.OD + (size_t)tok * 256 + h * 64 + dt * 16 + quad * 4) = v[dt] * rstd * g;
    }
  }
}

__device__ __forceinline__ void mix_other(const Params& p, int l, int it, unsigned char* smem) {
  if (it < 256) { attn_item<true>(p, l, true, it >> 6, (it >> 4) & 3, it & 15, smem); return; }
  it -= 256;
  if (it < 40) { lru_scan(p, l, it); return; }
  it -= 40;
  if (it < 256) { attn_item<false>(p, l, true, it >> 6, (it >> 4) & 3, it & 15, smem); return; }
  it -= 256;
  if (it < 256) { attn_item<true>(p, l, false, it >> 4, (it >> 2) & 3, it & 3, smem); return; }
  it -= 256;
  attn_item<false>(p, l, false, it >> 4, (it >> 2) & 3, it & 3, smem);
}

#define ES 4
#define EP 8
__device__ __forceinline__ void mix_item(const Params& p, int l, int it, unsigned char* smem) {
  constexpr int NPS = 16 / ES, NPP = 16 / EP, NS = 32 * NPS, NP = 128 * NPP;
  if (it < NS) {
#pragma unroll 1
    for (int r = 0; r < p.rep2[0]; ++r) rwkv_chain<ES>(p, l, it / NPS, it % NPS, smem);
    return;
  }
  it -= NS;
  if (it < NP) {
#pragma unroll 1
    for (int r = 0; r < p.rep2[1]; ++r) rwkv_chain<EP>(p, l, 32 + it / NPP, it % NPP, smem);
    return;
  }
  it -= NP;
#pragma unroll 1
  for (int r = 0; r < p.rep2[2]; ++r) mix_other(p, l, it, smem);
}
__device__ __forceinline__ void phase_mix(const Params& p, int l, unsigned char* smem) {
  constexpr int NS = 32 * (16 / ES), NP = 128 * (16 / EP), NALL = NS + NP + 1064;
  const int G = gridDim.x, b = blockIdx.x;
  if (G >= 2 * NS) {
    if (b < NS) mix_item(p, l, b, smem);
    else {
#pragma unroll 1
      for (int it = NS + (b - NS); it < NALL; it += G - NS) mix_item(p, l, it, smem);
      if (l == 0 && G >= 320) {
#pragma unroll 1
        for (int it = b - NS; it < 1120; it += G - NS) weight_tile(p, 1, it, (float*)smem);
      }
    }
  } else {
#pragma unroll 1
    for (int it = b; it < NALL; it += G) mix_item(p, l, it, smem);
  }
}

DI float sum16(float v) { v += __shfl_xor(v, 1); v += __shfl_xor(v, 2); v += __shfl_xor(v, 4); v += __shfl_xor(v, 8); return v; }

__device__ __forceinline__ void phase_post(const Params& p, int l) {
  const int tid0 = tid_opaque();
  const int lane = tid0 & 63, wave = tid0 >> 6;
  const int c = lane * 4;
#pragma unroll 1
  for (int tok = blockIdx.x * 4 + wave; tok < NTOK; tok += gridDim.x * 4) {
    const bf16_t* pr = p.P + (size_t)tok * PW;
    const f32x4 ya0 = *(const f32x4*)(p.YA + (size_t)tok * 256 + c), ya1 = *(const f32x4*)(p.YA + ((size_t)NTOK + tok) * 256 + c);
    const u32x2 r_ = *(const u32x2*)(pr + c), k_ = *(const u32x2*)(pr + 256 + c), v_ = *(const u32x2*)(pr + 512 + c), ga_ = *(const u32x2*)(pr + 896 + c);
    const u32x2 gb_ = *(const u32x2*)(pr + 1664 + c), gc_ = *(const u32x2*)(pr + 2176 + c), gd_ = *(const u32x2*)(pr + 3200 + c);
    const f32x4 rk = *(const f32x4*)(p.rw_rk + l * 256 + c), gg = *(const f32x4*)(p.rw_gng + l * 256 + c), gbias = *(const f32x4*)(p.rw_gnb + l * 256 + c);
    const f32x4 ob = *(const f32x4*)(p.OB + (size_t)tok * 256 + c), od = *(const f32x4*)(p.OD + (size_t)tok * 256 + c);
    const f32x4 h0 = *(const f32x4*)(p.LU + (size_t)tok * 256 + c), h1 = *(const f32x4*)(p.LU + ((size_t)NTOK + tok) * 256 + c);
    const f32x4 A0 = *(const f32x4*)(p.LA + (size_t)tok * 256 + c), A1 = *(const f32x4*)(p.LA + ((size_t)NTOK + tok) * 256 + c);
    const f32x4 c0 = *(const f32x4*)(p.LC + (size_t)(tok >> 4) * 256 + c), c1 = *(const f32x4*)(p.LC + ((size_t)512 + (tok >> 4)) * 256 + c);
    __builtin_amdgcn_sched_barrier(0);
    float out[4];
    {
      const f32x4 y = ya0 + ya1;
      const float mu = sum16(y[0] + y[1] + y[2] + y[3]) * (1.0f / 64.0f);
      const f32x4 dv = y - mu;
      const float var = sum16(dv[0] * dv[0] + dv[1] * dv[1] + dv[2] * dv[2] + dv[3] * dv[3]) * (1.0f / 64.0f);
      const float rstd = rsqrtf(var + 64e-5f);
      const float r[4] = {bflo(r_.x), bfhi(r_.x), bflo(r_.y), bfhi(r_.y)}, k[4] = {bflo(k_.x), bfhi(k_.x), bflo(k_.y), bfhi(k_.y)};
      const float v[4] = {bflo(v_.x), bfhi(v_.x), bflo(v_.y), bfhi(v_.y)}, g[4] = {bflo(ga_.x), bfhi(ga_.x), bflo(ga_.y), bfhi(ga_.y)};
      const float bs = sum16(r[0] * k[0] * rk[0] + r[1] * k[1] * rk[1] + r[2] * k[2] * rk[2] + r[3] * k[3] * rk[3]);
#pragma unroll
      for (int q = 0; q < 4; ++q) out[q] = (dv[q] * rstd * gg[q] + gbias[q] + bs * v[q]) * siluf_(g[q]);
      st4bf(p.H + (size_t)tok * LDK + c, out);
    }
    {
      const float g[4] = {bflo(gb_.x), bfhi(gb_.x), bflo(gb_.y), bfhi(gb_.y)};
#pragma unroll
      for (int q = 0; q < 4; ++q) out[q] = ob[q] * siluf_(g[q]);
      st4bf(p.H + (size_t)tok * LDK + 256 + c, out);
    }
    {
      const float g[4] = {bflo(gc_.x), bfhi(gc_.x), bflo(gc_.y), bfhi(gc_.y)};
#pragma unroll
      for (int q = 0; q < 4; ++q) out[q] = (h0[q] + A0[q] * c0[q] + h1[q] + A1[q] * c1[q]) * siluf_(g[q]);
      st4bf(p.H + (size_t)tok * LDK + 512 + c, out);
    }
    {
      const float g[4] = {bflo(gd_.x), bfhi(gd_.x), bflo(gd_.y), bfhi(gd_.y)};
#pragma unroll
      for (int q = 0; q < 4; ++q) out[q] = od[q] * siluf_(g[q]);
      st4bf(p.H + (size_t)tok * LDK + 768 + c, out);
    }
  }
}

__global__ void __launch_bounds__(256, 2) fwd_megakernel(Params p) {
  __shared__ __attribute__((aligned(16))) unsigned char smem[49152];
  __shared__ uint4 xb_words;
  if (threadIdx.x == 0) xb_words = make_uint4(0u, 0u, 0u, 0u);
  __syncthreads();
  XcdBarrier xb = xcd_barrier_post(p.bar, (volatile LAS unsigned*)&xb_words);
  if (threadIdx.x == 0) ((volatile LAS unsigned*)&xb_words)[3] = xb_add(&p.bar[xb_xcc_id()], 1u);
#pragma unroll 1
  for (int r = 0; r < p.rep[0]; ++r) phase_prologue(p, smem);
  xcd_barrier(xb);
  if (threadIdx.x == 0) {
    const unsigned x = xb_xcc_id(); unsigned pre = 0;
    for (unsigned j = 0; j < 16; ++j) { const unsigned c = xb_ld(&p.bar[XB_XCNT(j)]); pre += (j < x) ? c : 0u; }
    ((volatile LAS unsigned*)&xb_words)[2] = pre + ((volatile LAS unsigned*)&xb_words)[3];
  }
  __syncthreads();
#pragma unroll 1
  for (int r = 0; r < p.rep[1]; ++r) phase_norm(p, 0);
  xcd_barrier(xb);
#pragma unroll 1
  for (int l = 0; l < 2; ++l) {
#pragma unroll 1
    for (int r = 0; r < p.rep[2]; ++r) phase_gemm<0>(p, l, smem, (int)((volatile LAS unsigned*)&xb_words)[2]);
    xcd_barrier(xb);
#pragma unroll 1
    for (int r = 0; r < p.rep[3]; ++r) phase_pre(p, l, smem);
    xcd_barrier(xb);
#pragma unroll 1
    for (int r = 0; r < p.rep[4]; ++r) phase_mix(p, l, smem);
    xcd_barrier(xb);
#pragma unroll 1
    for (int r = 0; r < p.rep[5]; ++r) phase_post(p, l);
    xcd_barrier(xb);
#pragma unroll 1
    for (int r = 0; r < p.rep[6]; ++r) phase_gemm<1>(p, l, smem, (int)((volatile LAS unsigned*)&xb_words)[2]);
    xcd_barrier(xb);
    phase_norm(p, l + 1);
    if (l == 0) xcd_barrier(xb);
#pragma unroll 1
    for (int r = 1; r < p.rep[7]; ++r) xcd_barrier(xb);
  }
}

extern "C" void kernel_launch(void* const* d_in, const int* in_sizes, int n_in, void* d_out, int out_size, void* d_ws, size_t ws_size, hipStream_t stream) {
  static int grid_blocks = 0;
  if (!grid_blocks) {
    int dev = 0, cus = 0, per_cu = 0;
    hipGetDevice(&dev);
    hipDeviceGetAttribute(&cus, hipDeviceAttributeMultiprocessorCount, dev);
    hipOccupancyMaxActiveBlocksPerMultiprocessor(&per_cu, (const void*)fwd_megakernel, 256, 0);
    if (per_cu < 1) per_cu = 1;
    if (per_cu > 2) per_cu = 2;
    grid_blocks = cus * per_cu;
  }
  Params p{};
  const float** f = (const float**)&p;
  for (int i = 0; i < 35; ++i) f[i] = (const float*)d_in[i];
  p.out = (float*)d_out;
  size_t off = 0;
  auto take = [&](size_t bytes) { void* r = (char*)d_ws + off; off += (bytes + 255) & ~(size_t)255; return r; };
  p.MOD = (float*)take(2 * 5 * 3072 * 4);
  p.WINT = (bf16_t*)take((size_t)2 * PW * LDK * 2);
  p.WOUTT = (bf16_t*)take((size_t)2 * 1024 * LDK * 2);
  p.CWK = (bf16_t*)take((size_t)4 * 2 * 256 * 128 * 2);
  p.CWVT = (bf16_t*)take((size_t)4 * 2 * 256 * 128 * 2);
  p.CDK = (bf16_t*)take((size_t)4 * 2 * 256 * 256 * 2);
  p.CDVT = (bf16_t*)take((size_t)4 * 2 * 256 * 256 * 2);
  p.H = (bf16_t*)take((size_t)NTOK * LDK * 2);
  p.P = (bf16_t*)take((size_t)NTOK * PW * 2);
  p.NKK = (float*)take((size_t)NTOK * 256 * 4);
  p.AW = (float*)take((size_t)2 * NTOK * 256 * 4);
  p.AB = (float*)take((size_t)2 * NTOK * 256 * 4);
  p.AKD = (float*)take((size_t)2 * NTOK * 256 * 4);
  p.Y2 = p.NKK;
  p.YA = (float*)take((size_t)2 * NTOK * 256 * 4);
  p.LA = (float*)take((size_t)2 * NTOK * 256 * 4);
  p.LU = (float*)take((size_t)2 * NTOK * 256 * 4);
  p.QBR = (bf16_t*)take((size_t)4096 * 256 * 2);
  p.KBR = (bf16_t*)take((size_t)4096 * 128 * 2);
  p.QDR = (bf16_t*)take((size_t)4096 * 256 * 2);
  p.KDR = (bf16_t*)take((size_t)4096 * 256 * 2);
  p.VBT = (bf16_t*)take((size_t)NTOK * 128 * 2);
  p.VDT = (bf16_t*)take((size_t)NTOK * 256 * 2);
  p.OB = (float*)take((size_t)NTOK * 256 * 4);
  p.OD = (float*)take((size_t)NTOK * 256 * 4);
  p.LC = (float*)take((size_t)2 * 512 * 256 * 4);
  p.bar = (unsigned*)take((size_t)XCD_BAR_WORDS * 4);
  p.RWT = (bf16_t*)take((size_t)2 * 4 * 256 * 64 * 2);
  p.LWT = (bf16_t*)take((size_t)2 * 4 * 4 * 64 * 64 * 2);
  if (off > ws_size) { fprintf(stderr, "workspace too small: need %zu have %zu\n", off, ws_size); return; }
  static const int REPS[8] = {1, 1, 1, 1, 1, 1, 1, 1};
  for (int i = 0; i < 8; ++i) p.rep[i] = REPS[i];
  static const int REPS2[8] = {1, 1, 1, 1, 1, 1, 1, 1};
  for (int i = 0; i < 8; ++i) p.rep2[i] = REPS2[i];
  hipMemsetAsync(p.bar, 0, (size_t)XCD_BAR_WORDS * 4, stream);
  void* args[] = {&p};
  hipError_t e = hipLaunchCooperativeKernel((const void*)fwd_megakernel, dim3(grid_blocks), dim3(256), args, 0, stream);
  if (e != hipSuccess) fprintf(stderr, "cooperative launch failed: %s (grid %d)\n", hipGetErrorString(e), grid_blocks);
}
```

```cpp
#include <hip/hip_runtime.h>
#include <cstdio>
#include <cstdint>

typedef unsigned short bf16_t;
typedef short bf16x8 __attribute__((ext_vector_type(8)));
typedef float f32x4 __attribute__((ext_vector_type(4)));
typedef unsigned u32x4 __attribute__((ext_vector_type(4)));
typedef unsigned u32x2 __attribute__((ext_vector_type(2)));
#define DI __device__ __forceinline__

#define O_YP 0
#define O_NWK 8388608
#define O_NWV 9437184
#define O_NDK 10485760
#define O_NDV 12582912
#define O_NSR 14680064
#define O_NSL 15728640

#define NTOK 8192
#define PW 3456
#define LDK 1088

struct Params {
  const float *x_prompt, *x_sample, *c, *cwk, *cwv, *cdk, *cdv, *st_rwkv, *st_lru, *c_ctx, *w_mod, *b_mod, *g_pre, *g_post, *w_in, *w_out;
  const float *rw_w0, *rw_wup, *rw_a0, *rw_aup, *rw_kk, *rw_ka, *rw_rk, *rw_gng, *rw_gnb, *win_sink;
  const float *lru_cw, *lru_cb, *lru_wa, *lru_ba, *lru_wx, *lru_bx, *lru_lam, *diff_lam, *diff_g;
  float* out;
  float* MOD; bf16_t* WINT; bf16_t* WOUTT; bf16_t* CWK; bf16_t* CWVT; bf16_t* CDK; bf16_t* CDVT;
  bf16_t* H; bf16_t* P; float* NKK; float* AW; float* AB; float* AKD; float* YA; float* LA; float* LU;
  bf16_t* QBR; bf16_t* KBR; bf16_t* QDR; bf16_t* KDR; bf16_t* VBT; bf16_t* VDT; float* OB; float* OD; float* Y2; float* LC; unsigned* bar; bf16_t* RWT; bf16_t* LWT;
  int rep[8];
  int rep2[8];
};

DI void lds_barrier() { asm volatile("s_waitcnt lgkmcnt(0)\n\ts_barrier" ::: "memory"); }
DI int tid_opaque() { int t = threadIdx.x; asm volatile("" : "+v"(t)); return t; }
DI bf16_t f2bf(float x) { unsigned u = __float_as_uint(x); u += 0x7fffu + ((u >> 16) & 1u); return (bf16_t)(u >> 16); }
DI float bf2f(bf16_t b) { return __uint_as_float(((unsigned)b) << 16); }
typedef float f32x2_ __attribute__((ext_vector_type(2)));
typedef __bf16 bf16x2_t __attribute__((ext_vector_type(2)));
DI unsigned pack2(float a, float b) { f32x2_ v = {a, b}; bf16x2_t r = __builtin_convertvector(v, bf16x2_t); return __builtin_bit_cast(unsigned, r); }
DI float bflo(unsigned u) { return __uint_as_float(u << 16); }
DI float bfhi(unsigned u) { return __uint_as_float(u & 0xffff0000u); }
DI void ld4bf(const bf16_t* q, float (&o)[4]) { u32x2 u = *(const u32x2*)q; o[0] = bflo(u.x); o[1] = bfhi(u.x); o[2] = bflo(u.y); o[3] = bfhi(u.y); }
DI void st4bf(bf16_t* q, const float (&v)[4]) { u32x2 u; u.x = pack2(v[0], v[1]); u.y = pack2(v[2], v[3]); *(u32x2*)q = u; }
DI float wave_sum(float v) { for (int o = 32; o > 0; o >>= 1) v += __shfl_xor(v, o); return v; }
DI float sigmoidf_(float x) { return 1.0f / (1.0f + expf(-x)); }
DI float fsigmoid(float x) { return __builtin_amdgcn_rcpf(1.0f + __expf(-x)); }
DI float wave_sum_dpp(float v) {
  v += __builtin_bit_cast(float, __builtin_amdgcn_update_dpp(0, __builtin_bit_cast(int, v), 0xB1, 0xf, 0xf, true));
  v += __builtin_bit_cast(float, __builtin_amdgcn_update_dpp(0, __builtin_bit_cast(int, v), 0x4E, 0xf, 0xf, true));
  v += __builtin_bit_cast(float, __builtin_amdgcn_update_dpp(0, __builtin_bit_cast(int, v), 0x141, 0xf, 0xf, true));
  v += __builtin_bit_cast(float, __builtin_amdgcn_update_dpp(0, __builtin_bit_cast(int, v), 0x140, 0xf, 0xf, true));
  const int iv = __builtin_bit_cast(int, v);
  return __builtin_bit_cast(float, __builtin_amdgcn_readlane(iv, 0)) + __builtin_bit_cast(float, __builtin_amdgcn_readlane(iv, 16)) + __builtin_bit_cast(float, __builtin_amdgcn_readlane(iv, 32)) + __builtin_bit_cast(float, __builtin_amdgcn_readlane(iv, 48));
}
DI float siluf_(float x) { return x * __builtin_amdgcn_rcpf(1.0f + __expf(-x)); }
DI float softplusf_(float z) { return z > 20.f ? z : log1pf(expf(z)); }
DI f32x4 mfma16(bf16x8 a, bf16x8 b, f32x4 c) { return __builtin_amdgcn_mfma_f32_16x16x32_bf16(a, b, c, 0, 0, 0); }
DI float quad_sum(float v) {
  v += __builtin_bit_cast(float, __builtin_amdgcn_update_dpp(0, __builtin_bit_cast(int, v), 0xB1, 0xf, 0xf, true));
  v += __builtin_bit_cast(float, __builtin_amdgcn_update_dpp(0, __builtin_bit_cast(int, v), 0x4E, 0xf, 0xf, true));
  return v;
}


#define XB_TMO      128
#define XB_XCNT(j)  (256  + 64 * (j))
#define XB_XSUB(j)  (1280 + 64 * (j))
#define XB_XGEN(j)  (2304 + 64 * (j))
#define XB_TOP      3328
#define XB_TOPGEN   3392
#define XCD_BAR_WORDS 3456
#define XB_SPIN_CAP (1u << 18)
#define LAS __attribute__((address_space(3)))
DI unsigned xb_ld(unsigned* p)              { return __hip_atomic_load(p, __ATOMIC_RELAXED, __HIP_MEMORY_SCOPE_AGENT); }
DI unsigned xb_add(unsigned* p, unsigned v) { return __hip_atomic_fetch_add(p, v, __ATOMIC_RELAXED, __HIP_MEMORY_SCOPE_AGENT); }
DI unsigned xb_xcc_id() { return (unsigned)__builtin_amdgcn_s_getreg((3 << 11) | 20) & 0xFu; }
#define XB_SPIN(cond, bar) do { unsigned _sp = 0; while (cond) { __builtin_amdgcn_s_sleep(1); \
    if ((++_sp & 255u) == 0u) { if (xb_ld(&(bar)[XB_TMO])) break; if (_sp > XB_SPIN_CAP) { atomicAdd(&(bar)[XB_TMO], 1u); break; } } } } while (0)
struct XcdBarrier { unsigned* bar; unsigned x; volatile LAS unsigned* st; };
DI XcdBarrier xcd_barrier_post(unsigned* bar, volatile LAS unsigned* st) {
    XcdBarrier b; b.bar = bar; b.x = xb_xcc_id(); b.st = st;
    if (threadIdx.x == 0) (void)xb_add(&bar[XB_XCNT(b.x)], 1u);
    return b;
}
DI void xcd_barrier_complete(unsigned* bar, unsigned x, unsigned& nloc, unsigned& nx) {
    const unsigned G = gridDim.x * gridDim.y * gridDim.z;
    unsigned sum, cnt, mine, sp = 0u;
    for (;;) {
        sum = 0u; cnt = 0u; mine = 0u;
#pragma unroll
        for (unsigned j = 0; j < 16; ++j) { const unsigned c = xb_ld(&bar[XB_XCNT(j)]); sum += c; cnt += (c > 0u) ? 1u : 0u; mine = (j == x) ? c : mine; }
        if (sum == G) break;
        __builtin_amdgcn_s_sleep(1);
        if ((++sp & 255u) == 0u) { if (xb_ld(&bar[XB_TMO])) break; if (sp > XB_SPIN_CAP) { atomicAdd(&bar[XB_TMO], 1u); break; } }
    }
    nloc = mine > 0u ? mine : 1u; nx = cnt > 0u ? cnt : 1u;
}
DI void xcd_barrier(const XcdBarrier& b) {
    asm volatile("s_waitcnt vmcnt(0)" ::: "memory");
    __syncthreads();
    if (threadIdx.x == 0) {
        unsigned* bar = b.bar;
        unsigned bx = xb_xcc_id();
        __builtin_amdgcn_s_waitcnt(0);
        unsigned nloc = b.st[0], nx = b.st[1];
        if (nloc == 0u) { xcd_barrier_complete(bar, bx, nloc, nx); b.st[0] = nloc; b.st[1] = nx; }
        const unsigned old = xb_add(&bar[XB_XSUB(bx)], 1u);
        const unsigned gen = old / nloc;
        if (old + 1u == (gen + 1u) * nloc) {
            __builtin_amdgcn_fence(__ATOMIC_RELEASE, "agent");
            asm volatile("s_waitcnt vmcnt(0)" ::: "memory");
            const unsigned og = xb_add(&bar[XB_TOP], 1u);
            const unsigned tg = og / nx;
            if (og + 1u == (tg + 1u) * nx) xb_add(&bar[XB_TOPGEN], 1u);
            else XB_SPIN(xb_ld(&bar[XB_TOPGEN]) == tg, bar);
            __builtin_amdgcn_fence(__ATOMIC_ACQUIRE, "agent");
            xb_add(&bar[XB_XGEN(bx)], 1u);
            asm volatile("s_waitcnt vmcnt(0)" ::: "memory");
        } else {
            XB_SPIN(xb_ld(&bar[XB_XGEN(bx)]) == gen, bar);
            __builtin_amdgcn_fence(__ATOMIC_ACQUIRE, "agent");
            asm volatile("s_waitcnt vmcnt(0)" ::: "memory");
        }
    }
    __syncthreads();
}

template <typename T> DI float ldval(const T* p);
template <> DI float ldval<float>(const float* p) { return *p; }
template <> DI float ldval<bf16_t>(const bf16_t* p) { return bf2f(*p); }
template <typename T>
DI void transpose_tile(const T* src, int src_ld, bf16_t* dst, int dst_ld, float* lds) {
  const int tid = tid_opaque();
#pragma unroll 8
  for (int i = 0; i < 16; ++i) { int r = (tid >> 6) + 4 * i, c = tid & 63; lds[r * 65 + c] = ldval<T>(src + (size_t)r * src_ld + c); }
  __syncthreads();
#pragma unroll 4
  for (int i = 0; i < 16; ++i) { int c = (tid >> 6) + 4 * i, r = tid & 63; dst[(size_t)c * dst_ld + r] = f2bf(lds[r * 65 + c]); }
  __syncthreads();
}

__device__ __forceinline__ void weight_tile(const Params& p, int l, int item, float* lds) {
  if (item < 864) {
    const int kt = item / 54, nt = item % 54;
    transpose_tile<float>(p.w_in + (size_t)l * 1024 * PW + (size_t)kt * 64 * PW + nt * 64, PW,
                          p.WINT + (size_t)l * PW * LDK + (size_t)nt * 64 * LDK + kt * 64, LDK, lds);
  } else {
    const int r = item - 864, kt = r / 16, nt = r % 16;
    transpose_tile<float>(p.w_out + (size_t)l * 1024 * 1024 + (size_t)kt * 64 * 1024 + nt * 64, 1024,
                          p.WOUTT + (size_t)l * 1024 * LDK + (size_t)nt * 64 * LDK + kt * 64, LDK, lds);
  }
}

__device__ __forceinline__ void phase_prologue(const Params& p, unsigned char* smem) {
  float* lds = (float*)smem;
  const int n0 = 1728, n1 = n0 + 512, n2 = n1 + 192, n3 = n2 + 64, n4 = n3 + 128, n5 = n4 + 192, n6 = n5 + 32, n7 = n6 + 32;
#pragma unroll 1
  for (int it = blockIdx.x; it < n7; it += gridDim.x) {
    const int tid = tid_opaque();
    if (it < n1) {
      if (it < 1120) weight_tile(p, 0, it, lds);
      else if (gridDim.x < 320) weight_tile(p, 1, it - 1120, lds);
    } else if (it < n2) {
      int i2 = it - n1; int l = i2 / 96, nb = (i2 % 96) * 32;
      float* sc = lds;
      float* red = lds + 5 * 1024;
      for (int i = tid; i < 5 * 1024; i += 256) { int v = i >> 10, k = i & 1023; float x = v == 0 ? p.c_ctx[k] : p.c[(v - 1) * 1024 + k]; sc[i] = siluf_(x); }
      __syncthreads();
      int n = tid & 31, kg = tid >> 5;
      float a0 = 0, a1 = 0, a2 = 0, a3 = 0, a4 = 0;
      const float* wp = p.w_mod + (size_t)l * 1024 * 3072 + nb + n;
      for (int k = kg * 128; k < kg * 128 + 128; ++k) {
        float w = wp[(size_t)k * 3072];
        a0 += sc[k] * w; a1 += sc[1024 + k] * w; a2 += sc[2048 + k] * w; a3 += sc[3072 + k] * w; a4 += sc[4096 + k] * w;
      }
      red[(kg * 5 + 0) * 32 + n] = a0; red[(kg * 5 + 1) * 32 + n] = a1; red[(kg * 5 + 2) * 32 + n] = a2; red[(kg * 5 + 3) * 32 + n] = a3; red[(kg * 5 + 4) * 32 + n] = a4;
      __syncthreads();
      if (tid < 160) { int v = tid >> 5, nn = tid & 31; float s = p.b_mod[l * 3072 + nb + nn]; for (int q = 0; q < 8; ++q) s += red[(q * 5 + v) * 32 + nn]; p.MOD[(size_t)(l * 5 + v) * 3072 + nb + nn] = s; }
      __syncthreads();
    } else if (it < n3) {
      int i2 = it - n2; int bl = i2 >> 3, r = i2 & 7, pt = r >> 1, ct = r & 1;
      transpose_tile<float>(p.cwv + (size_t)bl * 256 * 128 + (size_t)pt * 64 * 128 + ct * 64, 128,
                            p.CWVT + (size_t)bl * 128 * 256 + (size_t)ct * 64 * 256 + pt * 64, 256, lds);
    } else if (it < n4) {
      int i2 = it - n3; int bl = i2 >> 4, r = i2 & 15, pt = r >> 2, ct = r & 3;
      transpose_tile<float>(p.cdv + (size_t)bl * 256 * 256 + (size_t)pt * 64 * 256 + ct * 64, 256,
                            p.CDVT + (size_t)bl * 256 * 256 + (size_t)ct * 64 * 256 + pt * 64, 256, lds);
    } else if (it >= n6) {
      int i2 = it - n6; int l = i2 >> 4, mat = (i2 >> 2) & 3, n = i2 & 3;
      const float* src = (mat < 2 ? p.lru_wa : p.lru_wx) + (size_t)(((l * 2 + (mat & 1)) * 4 + n)) * 4096;
      transpose_tile<float>(src, 64, p.LWT + (size_t)(((l * 4 + mat) * 4 + n)) * 4096, 64, lds);
    } else if (it >= n5) {
      int i2 = it - n5; int l = i2 >> 4, mat = (i2 >> 2) & 3, ct = i2 & 3;
      const float* src = (mat < 2 ? p.rw_wup : p.rw_aup) + (size_t)(l * 2 + (mat & 1)) * 64 * 256 + ct * 64;
      transpose_tile<float>(src, 256, p.RWT + ((size_t)(l * 4 + mat) * 256 + ct * 64) * 64, 64, lds);
    } else {
      int i2 = it - n4;
      const float* src; bf16_t* dst;
      if (i2 < 64) { src = p.cwk + (size_t)i2 * 4096; dst = p.CWK + (size_t)i2 * 4096; }
      else { src = p.cdk + (size_t)(i2 - 64) * 4096; dst = p.CDK + (size_t)(i2 - 64) * 4096; }
      for (int i = tid * 4; i < 4096; i += 1024) { float4 v = *(const float4*)(src + i); uint2 o; o.x = pack2(v.x, v.y); o.y = pack2(v.z, v.w); *(uint2*)(dst + i) = o; }
    }
  }
}

__device__ __forceinline__ void phase_norm(const Params& p, int stage) {
  const int tid0 = tid_opaque();
  const int lane = tid0 & 63, wave = tid0 >> 6;
#pragma unroll 1
  for (int tok = blockIdx.x * 4 + wave; tok < NTOK; tok += gridDim.x * 4) {
    const int mv = tok < 4096 ? 0 : 1 + ((tok - 4096) >> 10);
    const float* xin;
    if (stage <= 1) xin = tok < 4096 ? p.x_prompt + (size_t)tok * 1024 : p.x_sample + (size_t)(tok - 4096) * 1024;
    else xin = p.out + (size_t)tok * 1024;
    f32x4 x[4], gt[4], gq[4], sh[4], sc[4], gpre[4]; u32x2 yb[4];
    const int lp = stage >= 1 ? stage - 1 : 0, ln = stage <= 1 ? stage : 0;
    const float* gate = p.MOD + (size_t)(lp * 5 + mv) * 3072 + 2048;
    const float* gpo = p.g_post + lp * 1024;
    const float* md = p.MOD + (size_t)(ln * 5 + mv) * 3072;
    const float* gpr = p.g_pre + ln * 1024;
#pragma unroll
    for (int i = 0; i < 4; ++i) {
      const int col = i * 256 + lane * 4;
      x[i] = *(const f32x4*)(xin + col);
      if (stage >= 1) { yb[i] = *(const u32x2*)((const bf16_t*)p.Y2 + (size_t)tok * 1024 + col); gt[i] = *(const f32x4*)(gate + col); gq[i] = *(const f32x4*)(gpo + col); }
      if (stage <= 1) { sh[i] = *(const f32x4*)(md + col); sc[i] = *(const f32x4*)(md + 1024 + col); gpre[i] = *(const f32x4*)(gpr + col); }
    }
    __builtin_amdgcn_sched_barrier(0);
    if (stage >= 1) {
      f32x4 y[4]; float ss = 0.f;
#pragma unroll
      for (int i = 0; i < 4; ++i) { y[i] = (f32x4){bflo(yb[i].x), bfhi(yb[i].x), bflo(yb[i].y), bfhi(yb[i].y)}; ss += y[i][0] * y[i][0] + y[i][1] * y[i][1] + y[i][2] * y[i][2] + y[i][3] * y[i][3]; }
      ss = wave_sum(ss);
      const float rstd = rsqrtf(ss * (1.0f / 1024.0f) + 1e-6f);
#pragma unroll
      for (int i = 0; i < 4; ++i) {
        const int col = i * 256 + lane * 4;
        x[i] += gt[i] * (y[i] * rstd * gq[i]);
        *(f32x4*)(p.out + (size_t)tok * 1024 + col) = x[i];
      }
    }
    if (stage <= 1) {
      float ss = 0.f;
#pragma unroll
      for (int i = 0; i < 4; ++i) ss += x[i][0] * x[i][0] + x[i][1] * x[i][1] + x[i][2] * x[i][2] + x[i][3] * x[i][3];
      ss = wave_sum(ss);
      const float rstd = rsqrtf(ss * (1.0f / 1024.0f) + 1e-6f);
#pragma unroll
      for (int i = 0; i < 4; ++i) {
        const int col = i * 256 + lane * 4;
        const f32x4 hv = x[i] * rstd * gpre[i] * (sc[i] + 1.f) + sh[i];
        u32x2 o; o.x = pack2(hv[0], hv[1]); o.y = pack2(hv[2], hv[3]);
        *(u32x2*)(p.H + (size_t)tok * LDK + col) = o;
      }
    }
  }
}

template <int MODE, int BMT>
__device__ __forceinline__ void gemm_tile(const Params& p, int l, unsigned char* smem, const bf16_t* A, const bf16_t* Bt, int m0, int tn) {
  constexpr int MI = BMT / 32, NA = BMT / 32;
  const int K = LDK;
  bf16_t* As = (bf16_t*)smem; bf16_t* Bs = As + 128 * 64;
  const int tid = tid_opaque(), lane = tid & 63, wave = tid >> 6, wm = wave >> 1, wn = wave & 1, r16 = lane & 15, quad = lane >> 4;
  const int n0 = tn * 128;
  f32x4 acc[MI][4];
#pragma unroll
  for (int i = 0; i < MI; ++i)
#pragma unroll
    for (int jj = 0; jj < 4; ++jj) acc[i][jj] = (f32x4){0.f, 0.f, 0.f, 0.f};
  u32x4 ra0[NA], rb0[4];
  const int lrow = tid >> 3, lc8 = tid & 7;
  const bf16_t* ga = A + (size_t)(m0 + lrow) * K + lc8 * 8;
  const bf16_t* gb = Bt + (size_t)(n0 + lrow) * K + lc8 * 8;
  const int swz_w = (lc8 ^ ((lrow >> 1) & 7)) * 8, swz_r = (r16 >> 1) & 7;
  bf16_t* const sa_ = As + lrow * 64 + swz_w; bf16_t* const sb_ = Bs + lrow * 64 + swz_w;
#define G_LOAD(KT) { _Pragma("unroll") for (int i = 0; i < NA; ++i) ra0[i] = *(const u32x4*)(ga + (size_t)i * 32 * K + (KT) * 64); \
                     _Pragma("unroll") for (int i = 0; i < 4; ++i) rb0[i] = *(const u32x4*)(gb + (size_t)i * 32 * K + (KT) * 64); }
#define G_STORE() { _Pragma("unroll") for (int i = 0; i < NA; ++i) *(u32x4*)(sa_ + i * 32 * 64) = ra0[i]; \
                    _Pragma("unroll") for (int i = 0; i < 4; ++i) *(u32x4*)(sb_ + i * 32 * 64) = rb0[i]; }
#define G_COMPUTE() { _Pragma("unroll") for (int ks = 0; ks < 2; ++ks) { bf16x8 af[MI], bfr[4]; \
      _Pragma("unroll") for (int i = 0; i < MI; ++i) af[i] = *(const bf16x8*)(As + (wm * (BMT / 2) + i * 16 + r16) * 64 + (((ks * 4 + quad) ^ swz_r) * 8)); \
      _Pragma("unroll") for (int i = 0; i < 4; ++i) { const int br_ = wn * 64 + (i >> 1) * 32 + (r16 >> 2) * 8 + (i & 1) * 4 + (r16 & 3); bfr[i] = *(const bf16x8*)(Bs + br_ * 64 + (((ks * 4 + quad) ^ ((br_ >> 1) & 7)) * 8)); } \
      _Pragma("unroll") for (int mi = 0; mi < MI; ++mi) _Pragma("unroll") for (int ni = 0; ni < 4; ++ni) acc[mi][ni] = mfma16(bfr[ni], af[mi], acc[mi][ni]); } }
  G_LOAD(0);
  G_STORE();
  __syncthreads();
#pragma unroll 1
  for (int kt = 0; kt < 16; ++kt) {
    if (kt + 1 < 16) G_LOAD(kt + 1);
    __builtin_amdgcn_sched_barrier(0);
    G_COMPUTE();
    lds_barrier();
    if (kt + 1 < 16) { G_STORE(); lds_barrier(); }
  }
#undef G_LOAD
#undef G_STORE
#undef G_COMPUTE
#pragma unroll
  for (int mi = 0; mi < MI; ++mi)
#pragma unroll
    for (int k2 = 0; k2 < 2; ++k2) {
      const int m = m0 + wm * (BMT / 2) + mi * 16 + r16, n = n0 + wn * 64 + k2 * 32 + quad * 8;
      const f32x4 v0 = acc[mi][2 * k2], v1 = acc[mi][2 * k2 + 1];
      u32x4 o; o.x = pack2(v0[0], v0[1]); o.y = pack2(v0[2], v0[3]); o.z = pack2(v1[0], v1[1]); o.w = pack2(v1[2], v1[3]);
      if (MODE == 0) {
        *(u32x4*)(p.P + (size_t)m * PW + n) = o;
        if (m0 < 4096) {
          const int row = ((m >> 8) * 2 + l) * 256 + (m & 255);
          float* dst = nullptr;
          if (tn == 11) dst = p.out + O_NWK + (size_t)row * 128 + (n - 1408);
          else if (tn == 12) dst = p.out + O_NWV + (size_t)row * 128 + (n - 1536);
          else if (tn == 21 || tn == 22) dst = p.out + O_NDK + (size_t)row * 256 + (n - 2688);
          else if (tn == 23 || tn == 24) dst = p.out + O_NDV + (size_t)row * 256 + (n - 2944);
          if (dst) { *(f32x4*)dst = v0; *(f32x4*)(dst + 4) = v1; }
        }
      } else {
        *(u32x4*)((bf16_t*)p.Y2 + (size_t)m * 1024 + n) = o;
      }
    }
}

template <int MODE>
__device__ __forceinline__ void phase_gemm(const Params& p, int l, unsigned char* smem, int vb) {
  const bf16_t* A = p.H;
  const bf16_t* Bt = MODE == 0 ? p.WINT + (size_t)l * PW * LDK : p.WOUTT + (size_t)l * 1024 * LDK;
  const int NTN = (MODE == 0 ? PW : 1024) / 128;
  const int per = gridDim.x >> 3;
  const bool even8 = (gridDim.x & 7) == 0;
  const int xcd = even8 ? vb / per : (vb & 7), slot = even8 ? vb % per : (vb >> 3), nslot = even8 ? per : (int)((gridDim.x + 7 - xcd) >> 3);
  if (MODE == 0 && gridDim.x == 512) {
#pragma unroll 1
    for (int j = slot; j < 64 * 3; j += 64) gemm_tile<MODE, 128>(p, l, smem, A, Bt, (j / 3) * 128, xcd + 8 * (j % 3));
    if (xcd < 6) gemm_tile<MODE, 64>(p, l, smem, A, Bt, ((xcd & 1) * 64 + slot) * 64, 24 + (xcd >> 1));
  } else {
    const int nx = (NTN - xcd + 7) >> 3;
#pragma unroll 1
    for (int j = slot; j < 64 * nx; j += nslot) gemm_tile<MODE, 128>(p, l, smem, A, Bt, (j / nx) * 128, xcd + 8 * (j % nx));
  }
}

DI void unpack8(u32x4 u, float (&o)[8]) { o[0] = bflo(u.x); o[1] = bfhi(u.x); o[2] = bflo(u.y); o[3] = bfhi(u.y); o[4] = bflo(u.z); o[5] = bfhi(u.z); o[6] = bflo(u.w); o[7] = bfhi(u.w); }
DI bf16x8 pack8(const float (&o)[8]) { u32x4 u; u.x = pack2(o[0], o[1]); u.y = pack2(o[2], o[3]); u.z = pack2(o[4], o[5]); u.w = pack2(o[6], o[7]); return __builtin_bit_cast(bf16x8, u); }

__device__ __forceinline__ void pre_rwkv(const Params& p, int l, int item) {
  const int tid = tid_opaque(), lane = tid & 63, h = tid >> 6, r16 = lane & 15, quad = lane >> 4;
  const int tok = item * 16 + r16;
  const bf16_t* pr = p.P + (size_t)tok * PW;
  bf16x8 wdf[2], adf[2];
#pragma unroll
  for (int ks = 0; ks < 2; ++ks) {
    float o[8]; unpack8(*(const u32x4*)(pr + 768 + ks * 32 + quad * 8), o);
#pragma unroll
    for (int j = 0; j < 8; ++j) o[j] = 1.0f - 2.0f * __builtin_amdgcn_rcpf(1.0f + __expf(2.0f * o[j]));
    wdf[ks] = pack8(o);
    adf[ks] = *(const bf16x8*)(pr + 832 + ks * 32 + quad * 8);
  }
  float kv[4][4];
#pragma unroll
  for (int ct = 0; ct < 4; ++ct) ld4bf(pr + 256 + h * 64 + ct * 16 + quad * 4, kv[ct]);
  const bf16_t* wt = p.RWT + (size_t)l * 4 * 256 * 64;
  float ss = 0.f;
#pragma unroll
  for (int ct = 0; ct < 4; ++ct) {
    const f32x4 kkc = *(const f32x4*)(p.rw_kk + l * 256 + h * 64 + ct * 16 + quad * 4);
#pragma unroll
    for (int r = 0; r < 4; ++r) { const float q = kv[ct][r] * kkc[r]; ss += q * q; }
  }
  ss += __shfl_xor(ss, 16); ss += __shfl_xor(ss, 32);
  const float rn = rsqrtf(ss + 1e-12f);
#pragma unroll
  for (int ct = 0; ct < 4; ++ct) {
    f32x4 acc[4];
    const int c0 = h * 64 + ct * 16 + quad * 4;
    bf16x8 wfr[4][2];
#pragma unroll
    for (int mat = 0; mat < 4; ++mat)
#pragma unroll
      for (int ks = 0; ks < 2; ++ks) wfr[mat][ks] = *(const bf16x8*)(wt + ((size_t)mat * 256 + h * 64 + ct * 16 + r16) * 64 + ks * 32 + quad * 8);
    const f32x4 kkc = *(const f32x4*)(p.rw_kk + l * 256 + c0), kac = *(const f32x4*)(p.rw_ka + l * 256 + c0);
    const f32x4 w00 = *(const f32x4*)(p.rw_w0 + (l * 2 + 0) * 256 + c0), w01 = *(const f32x4*)(p.rw_w0 + (l * 2 + 1) * 256 + c0);
    const f32x4 a00 = *(const f32x4*)(p.rw_a0 + (l * 2 + 0) * 256 + c0), a01 = *(const f32x4*)(p.rw_a0 + (l * 2 + 1) * 256 + c0);
    __builtin_amdgcn_sched_barrier(0);
#pragma unroll
    for (int mat = 0; mat < 4; ++mat) {
      f32x4 a = {0.f, 0.f, 0.f, 0.f};
#pragma unroll
      for (int ks = 0; ks < 2; ++ks) a = mfma16(wfr[mat][ks], mat < 2 ? wdf[ks] : adf[ks], a);
      acc[mat] = a;
    }
    f32x4 nkk, w0v, w1v, b0v, b1v, k0v, k1v;
#pragma unroll
    for (int r = 0; r < 4; ++r) {
      const float k = kv[ct][r];
      const float kkn = k * kkc[r] * rn;
      nkk[r] = -kkn;
#pragma unroll
      for (int d = 0; d < 2; ++d) {
        const float wl = (d ? w01[r] : w00[r]) + acc[d][r];
        const float w_log = -__logf(1.0f + __expf(-wl)) - 0.5f;
        const float decay = __expf(-__expf(w_log));
        const float a = fsigmoid((d ? a01[r] : a00[r]) + acc[2 + d][r]);
        const float kd = k * (1.f + (a - 1.f) * kac[r]);
        if (d) { w1v[r] = decay; b1v[r] = kkn * a; k1v[r] = kd; } else { w0v[r] = decay; b0v[r] = kkn * a; k0v[r] = kd; }
      }
    }
    const size_t o0 = (size_t)tok * 256 + c0, o1 = ((size_t)NTOK + tok) * 256 + c0;
    *(f32x4*)(p.NKK + o0) = nkk;
    *(f32x4*)(p.AW + o0) = w0v; *(f32x4*)(p.AW + o1) = w1v;
    *(f32x4*)(p.AB + o0) = b0v; *(f32x4*)(p.AB + o1) = b1v;
    *(f32x4*)(p.AKD + o0) = k0v; *(f32x4*)(p.AKD + o1) = k1v;
  }
}

#define LSCAN_STEP(A, H, CTRL) { \
    const float Ap = __builtin_bit_cast(float, __builtin_amdgcn_update_dpp(0x3f800000, __builtin_bit_cast(int, A), CTRL, 0xf, 0xf, false)); \
    const float Hp = __builtin_bit_cast(float, __builtin_amdgcn_update_dpp(0, __builtin_bit_cast(int, H), CTRL, 0xf, 0xf, true)); \
    H = A * Hp + H; A = A * Ap; }

__device__ __forceinline__ void pre_lru(const Params& p, int l, int item) {
  const int tid = tid_opaque(), lane = tid & 63, n = tid >> 6, r16 = lane & 15, quad = lane >> 4;
  const int tok0 = item * 16;
  int T, sb, t0;
  if (tok0 < 4096) { T = 256; sb = tok0 & ~255; t0 = tok0 & 255; } else { T = 1024; sb = 4096 + ((tok0 - 4096) & ~1023); t0 = (tok0 - 4096) & 1023; }
  const int t = t0 + r16, tok = tok0 + r16;
  bf16x8 xf[2];
  float xo[2][8];
#pragma unroll
  for (int ks = 0; ks < 2; ++ks) {
    const int cb = n * 64 + ks * 32 + quad * 8;
    float o[8];
    { const f32x4 b0 = *(const f32x4*)(p.lru_cb + l * 256 + cb), b1 = *(const f32x4*)(p.lru_cb + l * 256 + cb + 4);
      o[0] = b0[0]; o[1] = b0[1]; o[2] = b0[2]; o[3] = b0[3]; o[4] = b1[0]; o[5] = b1[1]; o[6] = b1[2]; o[7] = b1[3]; }
#pragma unroll
    for (int i = 0; i < 4; ++i) {
      const int tt = t - 2 + i;
      u32x4 xr = {0u, 0u, 0u, 0u};
      if (tt >= 0 && tt < T) xr = *(const u32x4*)(p.P + (size_t)(sb + tt) * PW + 1920 + cb);
      float x[8]; unpack8(xr, x);
      const f32x4 w0 = *(const f32x4*)(p.lru_cw + (l * 4 + i) * 256 + cb), w1 = *(const f32x4*)(p.lru_cw + (l * 4 + i) * 256 + cb + 4);
      o[0] += w0[0] * x[0]; o[1] += w0[1] * x[1]; o[2] += w0[2] * x[2]; o[3] += w0[3] * x[3];
      o[4] += w1[0] * x[4]; o[5] += w1[1] * x[5]; o[6] += w1[2] * x[6]; o[7] += w1[3] * x[7];
    }
    xf[ks] = pack8(o);
#pragma unroll
    for (int j = 0; j < 8; ++j) xo[ks][j] = o[j];
  }
#pragma unroll
  for (int et = 0; et < 4; ++et) {
    f32x4 acc[4];
    const int c0 = n * 64 + (et >> 1) * 32 + quad * 8 + (et & 1) * 4;
    const int erow = (et >> 1) * 32 + (r16 >> 2) * 8 + (et & 1) * 4 + (r16 & 3);
    bf16x8 wfr[4][2];
#pragma unroll
    for (int mat = 0; mat < 4; ++mat)
#pragma unroll
      for (int ks = 0; ks < 2; ++ks) wfr[mat][ks] = *(const bf16x8*)(p.LWT + ((size_t)((l * 4 + mat) * 4 + n) * 64 + erow) * 64 + ks * 32 + quad * 8);
    const f32x4 ba0 = *(const f32x4*)(p.lru_ba + (l * 2 + 0) * 256 + c0), ba1 = *(const f32x4*)(p.lru_ba + (l * 2 + 1) * 256 + c0);
    const f32x4 bx0 = *(const f32x4*)(p.lru_bx + (l * 2 + 0) * 256 + c0), bx1 = *(const f32x4*)(p.lru_bx + (l * 2 + 1) * 256 + c0);
    const f32x4 lm0 = *(const f32x4*)(p.lru_lam + (l * 2 + 0) * 256 + c0), lm1 = *(const f32x4*)(p.lru_lam + (l * 2 + 1) * 256 + c0);
    __builtin_amdgcn_sched_barrier(0);
#pragma unroll
    for (int mat = 0; mat < 4; ++mat) {
      f32x4 a = {0.f, 0.f, 0.f, 0.f};
#pragma unroll
      for (int ks = 0; ks < 2; ++ks) a = mfma16(wfr[mat][ks], xf[ks], a);
      acc[mat] = a;
    }
    f32x4 A0, H0, A1, H1;
#pragma unroll
    for (int r = 0; r < 4; ++r) {
      const float x = xo[et >> 1][(et & 1) * 4 + r];
#pragma unroll
      for (int d = 0; d < 2; ++d) {
        const float ga = fsigmoid(acc[d][r] + (d ? ba1[r] : ba0[r]));
        const float gx = fsigmoid(acc[2 + d][r] + (d ? bx1[r] : bx0[r]));
        const float e_ = __expf(-(d ? lm1[r] : lm0[r]));
        const float sp = e_ < 0.05f ? e_ * (1.0f - e_ * (0.5f - e_ * (0.33333334f - 0.25f * e_))) : __logf(1.0f + e_);
        const float log_a = -8.0f * ga * sp;
        float a = __expf(log_a);
        const float x2 = 2.0f * log_a;
        const float om = x2 > -0.05f ? -(x2 * (1.0f + x2 * (0.5f + x2 * (0.16666667f + x2 * 0.041666667f)))) : 1.0f - __expf(x2);
        float u = __fsqrt_rn(om) * (gx * x);
        if (d == 0) { LSCAN_STEP(a, u, 0x111) LSCAN_STEP(a, u, 0x112) LSCAN_STEP(a, u, 0x114) LSCAN_STEP(a, u, 0x118) A0[r] = a; H0[r] = u; }
        else        { LSCAN_STEP(a, u, 0x101) LSCAN_STEP(a, u, 0x102) LSCAN_STEP(a, u, 0x104) LSCAN_STEP(a, u, 0x108) A1[r] = a; H1[r] = u; }
      }
    }
    const size_t o0 = (size_t)tok * 256 + c0, o1 = ((size_t)NTOK + tok) * 256 + c0;
    *(f32x4*)(p.LA + o0) = A0; *(f32x4*)(p.LU + o0) = H0;
    *(f32x4*)(p.LA + o1) = A1; *(f32x4*)(p.LU + o1) = H1;
  }
}

__device__ __forceinline__ void pre_rope(const Params& p, int item) {
  const int tid = tid_opaque();
  const int ts0 = item * 16;
#pragma unroll 1
  for (int pp = tid; pp < 448; pp += 256) {
    int scol, d1, d2, half, i, dstride; bf16_t* dst; float inv;
    if (pp < 192) {
      int q = pp < 128 ? pp : pp - 128; int vec = q >> 5, pi = q & 31; half = pi >> 4; i = pi & 15;
      d1 = half * 32 + i; d2 = d1 + 16; inv = exp2f(-(float)i * (13.287712379549449f / 16.0f));
      if (pp < 128) { scol = 1152 + vec * 64; dst = p.QBR + vec * 64; dstride = 256; }
      else { scol = 1408 + vec * 64; dst = p.KBR + vec * 64; dstride = 128; }
    } else {
      int q = pp < 320 ? pp - 192 : pp - 320; int vec = q >> 4, pi = q & 15; half = pi >> 3; i = pi & 7;
      d1 = half * 16 + i; d2 = d1 + 8; inv = exp2f(-(float)i * (13.287712379549449f / 8.0f));
      if (pp < 320) { scol = 2432 + vec * 32; dst = p.QDR + vec * 32; dstride = 256; }
      else { scol = 2688 + vec * 32; dst = p.KDR + vec * 32; dstride = 256; }
    }
    float x1[16], x2[16];
#pragma unroll
    for (int tt = 0; tt < 16; ++tt) { const bf16_t* src = p.P + (size_t)(4096 + ts0 + tt) * PW + scol; x1[tt] = bf2f(src[d1]); x2[tt] = bf2f(src[d2]); }
#pragma unroll
    for (int tt = 0; tt < 16; ++tt) {
      const int t = (ts0 + tt) & 1023;
      const float ang = (float)(half ? (t & 63) : (t >> 6)) * inv;
      const float sn = __sinf(ang), cs = __cosf(ang);
      const float a = x1[tt], b = x2[tt];
      bf16_t* o = dst + (size_t)(ts0 + tt) * dstride;
      o[d1] = f2bf(a * cs - b * sn); o[d2] = f2bf(a * sn + b * cs);
    }
  }
}

__device__ __forceinline__ void phase_pre(const Params& p, int l, unsigned char* smem) {
  const int n0 = 512, n1 = n0 + 512, n2 = n1 + 256, n3 = n2 + 256, n4 = n3 + 512;
#pragma unroll 1
  for (int it = blockIdx.x; it < n4; it += gridDim.x) {
    if (it < n0) pre_rwkv(p, l, it);
    else if (it < n1) pre_lru(p, l, it - n0);
    else if (it < n2) pre_rope(p, it - n1);
    else if (it < n3) {
      int i2 = it - n2; int tt = i2 >> 1, ct = i2 & 1; int tok0 = tt * 64;
      int T, sb; if (tok0 < 4096) { T = 256; sb = tok0 & ~255; } else { T = 1024; sb = 4096 + ((tok0 - 4096) & ~1023); }
      transpose_tile<bf16_t>(p.P + (size_t)tok0 * PW + 1536 + ct * 64, PW, p.VBT + (size_t)sb * 128 + (size_t)(ct * 64) * T + (tok0 - sb), T, (float*)smem);
    } else {
      int i2 = it - n3; int tt = i2 >> 2, ct = i2 & 3; int tok0 = tt * 64;
      int T, sb; if (tok0 < 4096) { T = 256; sb = tok0 & ~255; } else { T = 1024; sb = 4096 + ((tok0 - 4096) & ~1023); }
      transpose_tile<bf16_t>(p.P + (size_t)tok0 * PW + 2944 + ct * 64, PW, p.VDT + (size_t)sb * 256 + (size_t)(ct * 64) * T + (tok0 - sb), T, (float*)smem);
    }
  }
}

template <int LR> DI float group_sum(float v) {
  v += __builtin_bit_cast(float, __builtin_amdgcn_update_dpp(0, __builtin_bit_cast(int, v), 0xB1, 0xf, 0xf, true));
  v += __builtin_bit_cast(float, __builtin_amdgcn_update_dpp(0, __builtin_bit_cast(int, v), 0x4E, 0xf, 0xf, true));
  if (LR >= 8) v += __builtin_bit_cast(float, __builtin_amdgcn_update_dpp(0, __builtin_bit_cast(int, v), 0x141, 0xf, 0xf, true));
  if (LR >= 16) v += __builtin_bit_cast(float, __builtin_amdgcn_update_dpp(0, __builtin_bit_cast(int, v), 0x140, 0xf, 0xf, true));
  return v;
}
typedef float f32x2 __attribute__((ext_vector_type(2)));
template <int E> struct RwOps { f32x4 nk[E / 4], ww[E / 4], bb[E / 4], kk[E / 4], rr[E / 4]; float vi; };
template <int E> DI void rw_load(const float* ob, int g, int i, RwOps<E>& o) {
  constexpr int LR = 64 / E, NM = E / 4;
#pragma unroll
  for (int m = 0; m < NM; ++m) {
    const int off = 4 * (g + LR * m);
    o.nk[m] = *(const f32x4*)(ob + off); o.ww[m] = *(const f32x4*)(ob + 64 + off); o.bb[m] = *(const f32x4*)(ob + 128 + off);
    o.kk[m] = *(const f32x4*)(ob + 192 + off); o.rr[m] = *(const f32x4*)(ob + 256 + off);
  }
  o.vi = ob[320 + i];
}
#define DPP_ADD(V, CTRL) V += __builtin_bit_cast(float, __builtin_amdgcn_update_dpp(0, __builtin_bit_cast(int, V), CTRL, 0xf, 0xf, true))
template <int E> DI float rw_step(f32x2 (&S)[E / 2], const RwOps<E>& o, float& ypart) {
  constexpr int LR = 64 / E, NM = E / 4;
  f32x2 p2 = S[0] * o.nk[0].xy;
  p2 = S[1] * o.nk[0].zw + p2;
#pragma unroll
  for (int m = 1; m < NM; ++m) { p2 = S[2 * m] * o.nk[m].xy + p2; p2 = S[2 * m + 1] * o.nk[m].zw + p2; }
  float sa = p2.x + p2.y, yr = ypart;
  DPP_ADD(sa, 0xB1); DPP_ADD(yr, 0xB1);
  DPP_ADD(sa, 0x4E); DPP_ADD(yr, 0x4E);
  if (LR >= 8) { DPP_ADD(sa, 0x141); DPP_ADD(yr, 0x141); }
  if (LR >= 16) { DPP_ADD(sa, 0x140); DPP_ADD(yr, 0x140); }
  const f32x2 sa2 = {sa, sa}, v2 = {o.vi, o.vi};
  f32x2 y2 = {0.f, 0.f};
#pragma unroll
  for (int m = 0; m < NM; ++m) {
    S[2 * m] = S[2 * m] * o.ww[m].xy + (sa2 * o.bb[m].xy + v2 * o.kk[m].xy);
    S[2 * m + 1] = S[2 * m + 1] * o.ww[m].zw + (sa2 * o.bb[m].zw + v2 * o.kk[m].zw);
    y2 = S[2 * m] * o.rr[m].xy + y2; y2 = S[2 * m + 1] * o.rr[m].zw + y2;
  }
  ypart = y2.x + y2.y;
  return yr;
}
template <int E>
__device__ __forceinline__ void rwkv_chain(const Params& p, int l, int chain, int part, unsigned char* smem) {
  constexpr int LR = 64 / E, NM = E / 4;
  const int tid = tid_opaque(), lane = tid & 63, wave = tid >> 6;
  int seq, d, h;
  if (chain < 32) { seq = 16 + (chain >> 3); d = (chain >> 2) & 1; h = chain & 3; }
  else { int c2 = chain - 32; seq = c2 >> 3; d = (c2 >> 2) & 1; h = c2 & 3; }
  const int T = seq < 16 ? 256 : 1024, tokb = seq < 16 ? seq * 256 : 4096 + (seq - 16) * 1024;
  const int g = lane % LR, rl = lane / LR, i = part * 4 * E + wave * E + rl;
  f32x2 S[E / 2];
  if (seq >= 16) {
    const float* s0 = p.st_rwkv + ((((size_t)(seq - 16) * 2 + l) * 2 + d) * 4 + h) * 4096 + i * 64;
#pragma unroll
    for (int m = 0; m < NM; ++m) { f32x4 t = *(const f32x4*)(s0 + 4 * (g + LR * m)); S[2 * m] = t.xy; S[2 * m + 1] = t.zw; }
  } else {
#pragma unroll
    for (int j = 0; j < E / 2; ++j) S[j] = (f32x2){0.f, 0.f};
  }
  float* buf = (float*)smem;
  const int lvec = (tid >> 4) & 3, lc4 = tid & 15, ls = tid >> 6;
  const float* fsrc = (lvec == 0 ? p.NKK : lvec == 1 ? p.AW + (size_t)d * NTOK * 256 : lvec == 2 ? p.AB + (size_t)d * NTOK * 256 : p.AKD + (size_t)d * NTOK * 256) + h * 64 + lc4 * 4;
  const int bs = tid >> 4, bvec = (tid >> 3) & 1, bc8 = tid & 7;
  const bf16_t* bsrc = p.P + (bvec ? 512 : 0) + h * 64 + bc8 * 8;
  f32x4 rfA[4], rfB[4]; u32x4 rbA, rbB;
  const int nch = T / 16;
#define RW_GLOAD(RF, RB, CK) { _Pragma("unroll") for (int i4 = 0; i4 < 4; ++i4) { int step = (CK) * 16 + ls + 4 * i4; int t = d ? T - 1 - step : step; RF[i4] = *(const f32x4*)(fsrc + (size_t)(tokb + t) * 256); } \
    { int step = (CK) * 16 + bs; int t = d ? T - 1 - step : step; RB = *(const u32x4*)(bsrc + (size_t)(tokb + t) * PW); } }
#define RW_SSTORE(RF, RB, BI) { float* b_ = buf + (BI) * 16 * 384; \
    _Pragma("unroll") for (int i4 = 0; i4 < 4; ++i4) *(f32x4*)(b_ + (ls + 4 * i4) * 384 + lvec * 64 + lc4 * 4) = RF[i4]; \
    float* q_ = b_ + bs * 384 + (4 + bvec) * 64 + bc8 * 8; \
    *(f32x4*)q_ = (f32x4){bflo(RB.x), bfhi(RB.x), bflo(RB.y), bfhi(RB.y)}; \
    *(f32x4*)(q_ + 4) = (f32x4){bflo(RB.z), bfhi(RB.z), bflo(RB.w), bfhi(RB.w)}; }
  float* yout = p.YA + ((size_t)d * NTOK + tokb) * 256 + h * 64 + i;
  constexpr int NY = 16 / LR;
  auto compute = [&](int ck) {
    const float* cb = buf + (ck & 1) * 16 * 384;
    float yk[NY];
#pragma unroll
    for (int q = 0; q < NY; ++q) yk[q] = 0.f;
    constexpr int NSET = (E == 4) ? 4 : 2;
    float ypart = 0.f;
    RwOps<E> ops[NSET];
#pragma unroll
    for (int q = 0; q < NSET - 1; ++q) rw_load<E>(cb + q * 384, g, i, ops[q]);
#pragma unroll 1
    for (int s = 0; s < 16; s += NSET) {
#pragma unroll
      for (int u = 0; u < NSET; ++u) {
        const int sn = s + u + NSET - 1;
        rw_load<E>(buf + (((ck & 1) * 16 + sn) & 31) * 384, g, i, ops[(u + NSET - 1) % NSET]);
        const float y0 = rw_step<E>(S, ops[u], ypart);
#pragma unroll
        for (int q = 0; q < NY; ++q) yk[q] = (s + u - 1 == q * LR + g) ? y0 : yk[q];
      }
    }
    {
      const float y15 = group_sum<LR>(ypart);
#pragma unroll
      for (int q = 0; q < NY; ++q) yk[q] = (15 == q * LR + g) ? y15 : yk[q];
    }
#pragma unroll
    for (int q = 0; q < NY; ++q) { const int step = ck * 16 + q * LR + g; const int t = d ? T - 1 - step : step; yout[(size_t)t * 256] = yk[q]; }
  };
  __builtin_amdgcn_s_setprio(2);
  RW_GLOAD(rfA, rbA, 0); RW_SSTORE(rfA, rbA, 0); RW_GLOAD(rfA, rbA, 1); RW_GLOAD(rfB, rbB, 2);
  __syncthreads();
#pragma unroll 1
  for (int ck = 0; ck < nch; ck += 2) {
    compute(ck);
    RW_SSTORE(rfA, rbA, 1);
    if (ck + 3 < nch) RW_GLOAD(rfA, rbA, ck + 3);
    lds_barrier();
    compute(ck + 1);
    if (ck + 2 < nch) RW_SSTORE(rfB, rbB, 0);
    if (ck + 4 < nch) RW_GLOAD(rfB, rbB, ck + 4);
    lds_barrier();
  }
  __builtin_amdgcn_s_setprio(0);
#undef RW_GLOAD
#undef RW_SSTORE
  if (seq < 16) {
    float* so = p.out + O_NSR + ((((size_t)seq * 2 + l) * 2 + d) * 4 + h) * 4096 + i * 64;
#pragma unroll
    for (int m = 0; m < NM; ++m) *(f32x4*)(so + 4 * (g + LR * m)) = (f32x4){S[2 * m].x, S[2 * m].y, S[2 * m + 1].x, S[2 * m + 1].y};
  }
}

__device__ __forceinline__ void lru_scan(const Params& p, int l, int item) {
  const int c = tid_opaque();
  int seq, d;
  if (item < 8) { seq = 16 + (item >> 1); d = item & 1; } else { seq = (item - 8) >> 1; d = item & 1; }
  const int T = seq < 16 ? 256 : 1024, tokb = seq < 16 ? seq * 256 : 4096 + (seq - 16) * 1024;
  const int NC = T >> 4;
  float h = seq >= 16 ? p.st_lru[(((seq - 16) * 2 + l) * 2 + d) * 256 + c] : 0.f;
  const float* la = p.LA + (size_t)d * NTOK * 256 + c; const float* lu = p.LU + (size_t)d * NTOK * 256 + c;
  float* lc = p.LC + (size_t)d * 512 * 256 + (size_t)(tokb >> 4) * 256 + c;
  for (int k0 = 0; k0 < NC; k0 += 8) {
    float a[8], u[8];
#pragma unroll
    for (int q = 0; q < 8; ++q) { const int k = d ? NC - 1 - (k0 + q) : k0 + q; const size_t idx = (size_t)(tokb + k * 16 + (d ? 0 : 15)) * 256; a[q] = la[idx]; u[q] = lu[idx]; }
#pragma unroll
    for (int q = 0; q < 8; ++q) { const int k = d ? NC - 1 - (k0 + q) : k0 + q; lc[(size_t)k * 256] = h; h = a[q] * h + u[q]; }
  }
  if (seq < 16) p.out[O_NSL + ((seq * 2 + l) * 2 + d) * 256 + c] = h;
}

template <bool DIFF>
__device__ __forceinline__ void attn_item(const Params& p, int l, bool sample, int sq  , int h, int qt, unsigned char* smem) {
  constexpr int NS = DIFF ? 2 : 1;
  const int tid = tid_opaque();
  const int lane = tid & 63, wave = tid >> 6, r16 = lane & 15, quad = lane >> 4;
  const int T = sample ? 1024 : 256;
  const int tokb = sample ? 4096 + sq * 1024 : sq * 256;
  const int q0 = qt * 64 + wave * 16;
  const int qpos = q0 + r16;
  const int kvh = DIFF ? h : (h >> 1);
  bf16x8 qf[2];
  {
    const bf16_t* qp;
    if (sample) qp = (DIFF ? p.QDR : p.QBR) + (size_t)(sq * 1024 + qpos) * 256 + h * 64;
    else qp = p.P + (size_t)(tokb + qpos) * PW + (DIFF ? 2432 : 1152) + h * 64;
    qf[0] = *(const bf16x8*)(qp + quad * 8); qf[1] = *(const bf16x8*)(qp + 32 + quad * 8);
  }
  float m[2] = {-3.0e38f, -3.0e38f}, lsum[2] = {0.f, 0.f};
  f32x4 o[2][4];
#pragma unroll
  for (int a = 0; a < 2; ++a)
#pragma unroll
    for (int b = 0; b < 4; ++b) o[a][b] = (f32x4){0.f, 0.f, 0.f, 0.f};
  const float scale_log2 = (DIFF ? 0.17677669529663687f : 0.125f) * 1.4426950408889634f;
  const int nctx = sample ? 4 : 0;
  const bf16_t* Kc = nullptr; const bf16_t* Vc = nullptr; int ksc = 0;
  if (sample) {
    const int bl = sq * 2 + l;
    if (DIFF) { Kc = p.CDK + (size_t)bl * 256 * 256 + h * 64; ksc = 256; Vc = p.CDVT + (size_t)bl * 256 * 256 + (size_t)(h * 64) * 256; }
    else { Kc = p.CWK + (size_t)bl * 256 * 128 + kvh * 64; ksc = 128; Vc = p.CWVT + (size_t)bl * 128 * 256 + (size_t)(kvh * 64) * 256; }
  }
  const bf16_t* Kl; const bf16_t* Vl; int ksl;
  if (sample) {
    if (DIFF) { Kl = p.KDR + (size_t)(sq * 1024) * 256 + h * 64; ksl = 256; Vl = p.VDT + (size_t)tokb * 256 + (size_t)(h * 64) * T; }
    else { Kl = p.KBR + (size_t)(sq * 1024) * 128 + kvh * 64; ksl = 128; Vl = p.VBT + (size_t)tokb * 128 + (size_t)(kvh * 64) * T; }
  } else {
    if (DIFF) { Kl = p.P + (size_t)tokb * PW + 2688 + h * 64; ksl = PW; Vl = p.VDT + (size_t)tokb * 256 + (size_t)(h * 64) * T; }
    else { Kl = p.P + (size_t)tokb * PW + 1408 + kvh * 64; ksl = PW; Vl = p.VBT + (size_t)tokb * 128 + (size_t)(kvh * 64) * T; }
  }
  int kb0 = 0, kb1 = T; bool lmask = false;
  if (sample && !DIFF) { const int qb = qt * 64; kb0 = qb - 128 < 0 ? 0 : qb - 128; kb1 = qb + 192 > T ? T : qb + 192; lmask = true; }
  const int nt = nctx + ((kb1 - kb0) >> 6);
  bf16_t* const lds = (bf16_t*)smem;
  const int lrow = tid >> 2, lch = (tid & 3) * 16;
  auto gsrc = [&](int t, const bf16_t*& kp, const bf16_t*& vp) {
    if (t < nctx) { kp = Kc + (size_t)(t * 64 + lrow) * ksc + lch; vp = Vc + (size_t)lrow * 256 + t * 64 + lch; }
    else { const int kb = kb0 + (t - nctx) * 64; kp = Kl + (size_t)(kb + lrow) * ksl + lch; vp = Vl + (size_t)lrow * T + kb + lch; }
  };
  u32x4 rk0, rk1, rv0, rv1;
  { const bf16_t* kp; const bf16_t* vp; gsrc(0, kp, vp); rk0 = *(const u32x4*)kp; rk1 = *(const u32x4*)(kp + 8); rv0 = *(const u32x4*)vp; rv1 = *(const u32x4*)(vp + 8); }
  __syncthreads();
  { bf16_t* d = lds + lrow * 72 + lch; *(u32x4*)d = rk0; *(u32x4*)(d + 8) = rk1; *(u32x4*)(d + 64 * 72) = rv0; *(u32x4*)(d + 64 * 72 + 8) = rv1; }
  __syncthreads();
  const f32x4 z4 = {0.f, 0.f, 0.f, 0.f};
  const int krow = 8 * (r16 >> 2) + (r16 & 3);
#pragma unroll 1
  for (int t = 0; t < nt; ++t) {
    const bool isctx = t < nctx;
    const bool masked = !isctx && lmask;
    const int kpos0 = kb0 + (t - nctx) * 64;
    if (t + 1 < nt) { const bf16_t* kp; const bf16_t* vp; gsrc(t + 1, kp, vp); rk0 = *(const u32x4*)kp; rk1 = *(const u32x4*)(kp + 8); rv0 = *(const u32x4*)vp; rv1 = *(const u32x4*)(vp + 8); }
    const bf16_t* Ks = lds + (t & 1) * (2 * 64 * 72);
    const bf16_t* Vs = Ks + 64 * 72;
    bf16x8 pf[NS][2];
#pragma unroll
    for (int st = 0; st < NS; ++st) {
      f32x4 sc[4];
#pragma unroll
      for (int kt = 0; kt < 4; ++kt) {
        const bf16_t* kr = Ks + (32 * (kt >> 1) + 4 * (kt & 1) + krow) * 72 + quad * 8;
        if (!DIFF) { sc[kt] = mfma16(*(const bf16x8*)kr, qf[0], z4); sc[kt] = mfma16(*(const bf16x8*)(kr + 32), qf[1], sc[kt]); }
        else sc[kt] = mfma16(*(const bf16x8*)(kr + 32 * st), qf[st], z4);
      }
      float mx = -3.0e38f;
#pragma unroll
      for (int kt = 0; kt < 4; ++kt)
#pragma unroll
        for (int r = 0; r < 4; ++r) {
          float x = sc[kt][r] * scale_log2;
          if (masked) { const int kp = kpos0 + 32 * (kt >> 1) + 8 * quad + 4 * (kt & 1) + r; const int dd = kp - qpos; if (dd > 128 || dd < -128) x = -1.0e30f; }
          sc[kt][r] = x; mx = fmaxf(mx, x);
        }
      mx = fmaxf(mx, __shfl_xor(mx, 16)); mx = fmaxf(mx, __shfl_xor(mx, 32));
      const float mnew = fmaxf(m[st], mx);
      const float alpha = __builtin_amdgcn_exp2f(m[st] - mnew);
      m[st] = mnew;
      float ps = 0.f;
#pragma unroll
      for (int kt = 0; kt < 4; ++kt)
#pragma unroll
        for (int r = 0; r < 4; ++r) { const float e = __builtin_amdgcn_exp2f(sc[kt][r] - mnew); sc[kt][r] = e; ps += e; }
      lsum[st] = lsum[st] * alpha + ps;
#pragma unroll
      for (int dt = 0; dt < 4; ++dt) o[st][dt] *= alpha;
#pragma unroll
      for (int s2 = 0; s2 < 2; ++s2) {
        u32x4 tt;
        tt.x = pack2(sc[2 * s2][0], sc[2 * s2][1]); tt.y = pack2(sc[2 * s2][2], sc[2 * s2][3]);
        tt.z = pack2(sc[2 * s2 + 1][0], sc[2 * s2 + 1][1]); tt.w = pack2(sc[2 * s2 + 1][2], sc[2 * s2 + 1][3]);
        pf[st][s2] = __builtin_bit_cast(bf16x8, tt);
      }
    }
#pragma unroll
    for (int dt = 0; dt < 4; ++dt)
#pragma unroll
      for (int s2 = 0; s2 < 2; ++s2) {
        const bf16x8 vf = *(const bf16x8*)(Vs + (dt * 16 + r16) * 72 + 32 * s2 + 8 * quad);
#pragma unroll
        for (int st = 0; st < NS; ++st) o[st][dt] = mfma16(vf, pf[st][s2], o[st][dt]);
      }
    if (t + 1 < nt) {
      bf16_t* d = lds + ((t + 1) & 1) * (2 * 64 * 72) + lrow * 72 + lch;
      *(u32x4*)d = rk0; *(u32x4*)(d + 8) = rk1; *(u32x4*)(d + 64 * 72) = rv0; *(u32x4*)(d + 64 * 72 + 8) = rv1;
    }
    __syncthreads();
  }
  float l0 = lsum[0]; l0 += __shfl_xor(l0, 16); l0 += __shfl_xor(l0, 32);
  const int tok = tokb + qpos;
  if (!DIFF) {
    l0 += __builtin_amdgcn_exp2f(p.win_sink[l * 4 + h] * 1.4426950408889634f - m[0]);
    const float inv = 1.0f / l0;
#pragma unroll
    for (int dt = 0; dt < 4; ++dt) {
      f32x4 v = o[0][dt] * inv;
      *(f32x4*)(p.OB + (size_t)tok * 256 + h * 64 + dt * 16 + quad * 4) = v;
    }
  } else {
    float l1 = lsum[1]; l1 += __shfl_xor(l1, 16); l1 += __shfl_xor(l1, 32);
    float d1 = 0.f, d2 = 0.f;
    const float* dl = p.diff_lam + l * 128;
    for (int j = 0; j < 32; ++j) { d1 += dl[j] * dl[32 + j]; d2 += dl[64 + j] * dl[96 + j]; }
    const float lam_init = 0.8f - 0.6f * expf(-0.3f * (float)l);
    const float lam = expf(d1) - expf(d2) + lam_init;
    const float i0 = 1.0f / l0, i1 = lam / l1;
    f32x4 v[4]; float ss = 0.f;
#pragma unroll
    for (int dt = 0; dt < 4; ++dt) { v[dt] = o[0][dt] * i0 - o[1][dt] * i1; ss += v[dt][0] * v[dt][0] + v[dt][1] * v[dt][1] + v[dt][2] * v[dt][2] + v[dt][3] * v[dt][3]; }
    ss += __shfl_xor(ss, 16); ss += __shfl_xor(ss, 32);
    const float rstd = rsqrtf(ss * (1.0f / 64.0f) + 1e-6f) * (1.0f - lam_init);
#pragma unroll
    for (int dt = 0; dt < 4; ++dt) {
      const f32x4 g = *(const f32x4*)(p.diff_g + l * 64 + dt * 16 + quad * 4);
      *(f32x4*)(p.OD + (size_t)tok * 256 + h * 64 + dt * 16 + quad * 4) = v[dt] * rstd * g;
    }
  }
}

__device__ __forceinline__ void mix_other(const Params& p, int l, int it, unsigned char* smem) {
  if (it < 256) { attn_item<true>(p, l, true, it >> 6, (it >> 4) & 3, it & 15, smem); return; }
  it -= 256;
  if (it < 40) { lru_scan(p, l, it); return; }
  it -= 40;
  if (it < 256) { attn_item<false>(p, l, true, it >> 6, (it >> 4) & 3, it & 15, smem); return; }
  it -= 256;
  if (it < 256) { attn_item<true>(p, l, false, it >> 4, (it >> 2) & 3, it & 3, smem); return; }
  it -= 256;
  attn_item<false>(p, l, false, it >> 4, (it >> 2) & 3, it & 3, smem);
}

#define ES 4
#define EP 8
__device__ __forceinline__ void mix_item(const Params& p, int l, int it, unsigned char* smem) {
  constexpr int NPS = 16 / ES, NPP = 16 / EP, NS = 32 * NPS, NP = 128 * NPP;
  if (it < NS) {
#pragma unroll 1
    for (int r = 0; r < p.rep2[0]; ++r) rwkv_chain<ES>(p, l, it / NPS, it % NPS, smem);
    return;
  }
  it -= NS;
  if (it < NP) {
#pragma unroll 1
    for (int r = 0; r < p.rep2[1]; ++r) rwkv_chain<EP>(p, l, 32 + it / NPP, it % NPP, smem);
    return;
  }
  it -= NP;
#pragma unroll 1
  for (int r = 0; r < p.rep2[2]; ++r) mix_other(p, l, it, smem);
}
__device__ __forceinline__ void phase_mix(const Params& p, int l, unsigned char* smem) {
  constexpr int NS = 32 * (16 / ES), NP = 128 * (16 / EP), NALL = NS + NP + 1064;
  const int G = gridDim.x, b = blockIdx.x;
  if (G >= 2 * NS) {
    if (b < NS) mix_item(p, l, b, smem);
    else {
#pragma unroll 1
      for (int it = NS + (b - NS); it < NALL; it += G - NS) mix_item(p, l, it, smem);
      if (l == 0 && G >= 320) {
#pragma unroll 1
        for (int it = b - NS; it < 1120; it += G - NS) weight_tile(p, 1, it, (float*)smem);
      }
    }
  } else {
#pragma unroll 1
    for (int it = b; it < NALL; it += G) mix_item(p, l, it, smem);
  }
}

DI float sum16(float v) { v += __shfl_xor(v, 1); v += __shfl_xor(v, 2); v += __shfl_xor(v, 4); v += __shfl_xor(v, 8); return v; }

__device__ __forceinline__ void phase_post(const Params& p, int l) {
  const int tid0 = tid_opaque();
  const int lane = tid0 & 63, wave = tid0 >> 6;
  const int c = lane * 4;
#pragma unroll 1
  for (int tok = blockIdx.x * 4 + wave; tok < NTOK; tok += gridDim.x * 4) {
    const bf16_t* pr = p.P + (size_t)tok * PW;
    const f32x4 ya0 = *(const f32x4*)(p.YA + (size_t)tok * 256 + c), ya1 = *(const f32x4*)(p.YA + ((size_t)NTOK + tok) * 256 + c);
    const u32x2 r_ = *(const u32x2*)(pr + c), k_ = *(const u32x2*)(pr + 256 + c), v_ = *(const u32x2*)(pr + 512 + c), ga_ = *(const u32x2*)(pr + 896 + c);
    const u32x2 gb_ = *(const u32x2*)(pr + 1664 + c), gc_ = *(const u32x2*)(pr + 2176 + c), gd_ = *(const u32x2*)(pr + 3200 + c);
    const f32x4 rk = *(const f32x4*)(p.rw_rk + l * 256 + c), gg = *(const f32x4*)(p.rw_gng + l * 256 + c), gbias = *(const f32x4*)(p.rw_gnb + l * 256 + c);
    const f32x4 ob = *(const f32x4*)(p.OB + (size_t)tok * 256 + c), od = *(const f32x4*)(p.OD + (size_t)tok * 256 + c);
    const f32x4 h0 = *(const f32x4*)(p.LU + (size_t)tok * 256 + c), h1 = *(const f32x4*)(p.LU + ((size_t)NTOK + tok) * 256 + c);
    const f32x4 A0 = *(const f32x4*)(p.LA + (size_t)tok * 256 + c), A1 = *(const f32x4*)(p.LA + ((size_t)NTOK + tok) * 256 + c);
    const f32x4 c0 = *(const f32x4*)(p.LC + (size_t)(tok >> 4) * 256 + c), c1 = *(const f32x4*)(p.LC + ((size_t)512 + (tok >> 4)) * 256 + c);
    __builtin_amdgcn_sched_barrier(0);
    float out[4];
    {
      const f32x4 y = ya0 + ya1;
      const float mu = sum16(y[0] + y[1] + y[2] + y[3]) * (1.0f / 64.0f);
      const f32x4 dv = y - mu;
      const float var = sum16(dv[0] * dv[0] + dv[1] * dv[1] + dv[2] * dv[2] + dv[3] * dv[3]) * (1.0f / 64.0f);
      const float rstd = rsqrtf(var + 64e-5f);
      const float r[4] = {bflo(r_.x), bfhi(r_.x), bflo(r_.y), bfhi(r_.y)}, k[4] = {bflo(k_.x), bfhi(k_.x), bflo(k_.y), bfhi(k_.y)};
      const float v[4] = {bflo(v_.x), bfhi(v_.x), bflo(v_.y), bfhi(v_.y)}, g[4] = {bflo(ga_.x), bfhi(ga_.x), bflo(ga_.y), bfhi(ga_.y)};
      const float bs = sum16(r[0] * k[0] * rk[0] + r[1] * k[1] * rk[1] + r[2] * k[2] * rk[2] + r[3] * k[3] * rk[3]);
#pragma unroll
      for (int q = 0; q < 4; ++q) out[q] = (dv[q] * rstd * gg[q] + gbias[q] + bs * v[q]) * siluf_(g[q]);
      st4bf(p.H + (size_t)tok * LDK + c, out);
    }
    {
      const float g[4] = {bflo(gb_.x), bfhi(gb_.x), bflo(gb_.y), bfhi(gb_.y)};
#pragma unroll
      for (int q = 0; q < 4; ++q) out[q] = ob[q] * siluf_(g[q]);
      st4bf(p.H + (size_t)tok * LDK + 256 + c, out);
    }
    {
      const float g[4] = {bflo(gc_.x), bfhi(gc_.x), bflo(gc_.y), bfhi(gc_.y)};
#pragma unroll
      for (int q = 0; q < 4; ++q) out[q] = (h0[q] + A0[q] * c0[q] + h1[q] + A1[q] * c1[q]) * siluf_(g[q]);
      st4bf(p.H + (size_t)tok * LDK + 512 + c, out);
    }
    {
      const float g[4] = {bflo(gd_.x), bfhi(gd_.x), bflo(gd_.y), bfhi(gd_.y)};
#pragma unroll
      for (int q = 0; q < 4; ++q) out[q] = od[q] * siluf_(g[q]);
      st4bf(p.H + (size_t)tok * LDK + 768 + c, out);
    }
  }
}

__global__ void __launch_bounds__(256, 2) fwd_megakernel(Params p) {
  __shared__ __attribute__((aligned(16))) unsigned char smem[49152];
  __shared__ uint4 xb_words;
  if (threadIdx.x == 0) xb_words = make_uint4(0u, 0u, 0u, 0u);
  __syncthreads();
  XcdBarrier xb = xcd_barrier_post(p.bar, (volatile LAS unsigned*)&xb_words);
  if (threadIdx.x == 0) ((volatile LAS unsigned*)&xb_words)[3] = xb_add(&p.bar[xb_xcc_id()], 1u);
#pragma unroll 1
  for (int r = 0; r < p.rep[0]; ++r) phase_prologue(p, smem);
  xcd_barrier(xb);
  if (threadIdx.x == 0) {
    const unsigned x = xb_xcc_id(); unsigned pre = 0;
    for (unsigned j = 0; j < 16; ++j) { const unsigned c = xb_ld(&p.bar[XB_XCNT(j)]); pre += (j < x) ? c : 0u; }
    ((volatile LAS unsigned*)&xb_words)[2] = pre + ((volatile LAS unsigned*)&xb_words)[3];
  }
  __syncthreads();
#pragma unroll 1
  for (int r = 0; r < p.rep[1]; ++r) phase_norm(p, 0);
  xcd_barrier(xb);
#pragma unroll 1
  for (int l = 0; l < 2; ++l) {
#pragma unroll 1
    for (int r = 0; r < p.rep[2]; ++r) phase_gemm<0>(p, l, smem, (int)((volatile LAS unsigned*)&xb_words)[2]);
    xcd_barrier(xb);
#pragma unroll 1
    for (int r = 0; r < p.rep[3]; ++r) phase_pre(p, l, smem);
    xcd_barrier(xb);
#pragma unroll 1
    for (int r = 0; r < p.rep[4]; ++r) phase_mix(p, l, smem);
    xcd_barrier(xb);
#pragma unroll 1
    for (int r = 0; r < p.rep[5]; ++r) phase_post(p, l);
    xcd_barrier(xb);
#pragma unroll 1
    for (int r = 0; r < p.rep[6]; ++r) phase_gemm<1>(p, l, smem, (int)((volatile LAS unsigned*)&xb_words)[2]);
    xcd_barrier(xb);
    phase_norm(p, l + 1);
    if (l == 0) xcd_barrier(xb);
#pragma unroll 1
    for (int r = 1; r < p.rep[7]; ++r) xcd_barrier(xb);
  }
}

extern "C" void kernel_launch(void* const* d_in, const int* in_sizes, int n_in, void* d_out, int out_size, void* d_ws, size_t ws_size, hipStream_t stream) {
  static int grid_blocks = 0;
  if (!grid_blocks) {
    int dev = 0, cus = 0, per_cu = 0;
    hipGetDevice(&dev);
    hipDeviceGetAttribute(&cus, hipDeviceAttributeMultiprocessorCount, dev);
    hipOccupancyMaxActiveBlocksPerMultiprocessor(&per_cu, (const void*)fwd_megakernel, 256, 0);
    if (per_cu < 1) per_cu = 1;
    if (per_cu > 2) per_cu = 2;
    grid_blocks = cus * per_cu;
  }
  Params p{};
  const float** f = (const float**)&p;
  for (int i = 0; i < 35; ++i) f[i] = (const float*)d_in[i];
  p.out = (float*)d_out;
  size_t off = 0;
  auto take = [&](size_t bytes) { void* r = (char*)d_ws + off; off += (bytes + 255) & ~(size_t)255; return r; };
  p.MOD = (float*)take(2 * 5 * 3072 * 4);
  p.WINT = (bf16_t*)take((size_t)2 * PW * LDK * 2);
  p.WOUTT = (bf16_t*)take((size_t)2 * 1024 * LDK * 2);
  p.CWK = (bf16_t*)take((size_t)4 * 2 * 256 * 128 * 2);
  p.CWVT = (bf16_t*)take((size_t)4 * 2 * 256 * 128 * 2);
  p.CDK = (bf16_t*)take((size_t)4 * 2 * 256 * 256 * 2);
  p.CDVT = (bf16_t*)take((size_t)4 * 2 * 256 * 256 * 2);
  p.H = (bf16_t*)take((size_t)NTOK * LDK * 2);
  p.P = (bf16_t*)take((size_t)NTOK * PW * 2);
  p.NKK = (float*)take((size_t)NTOK * 256 * 4);
  p.AW = (float*)take((size_t)2 * NTOK * 256 * 4);
  p.AB = (float*)take((size_t)2 * NTOK * 256 * 4);
  p.AKD = (float*)take((size_t)2 * NTOK * 256 * 4);
  p.Y2 = p.NKK;
  p.YA = (float*)take((size_t)2 * NTOK * 256 * 4);
  p.LA = (float*)take((size_t)2 * NTOK * 256 * 4);
  p.LU = (float*)take((size_t)2 * NTOK * 256 * 4);
  p.QBR = (bf16_t*)take((size_t)4096 * 256 * 2);
  p.KBR = (bf16_t*)take((size_t)4096 * 128 * 2);
  p.QDR = (bf16_t*)take((size_t)4096 * 256 * 2);
  p.KDR = (bf16_t*)take((size_t)4096 * 256 * 2);
  p.VBT = (bf16_t*)take((size_t)NTOK * 128 * 2);
  p.VDT = (bf16_t*)take((size_t)NTOK * 256 * 2);
  p.OB = (float*)take((size_t)NTOK * 256 * 4);
  p.OD = (float*)take((size_t)NTOK * 256 * 4);
  p.LC = (float*)take((size_t)2 * 512 * 256 * 4);
  p.bar = (unsigned*)take((size_t)XCD_BAR_WORDS * 4);
  p.RWT = (bf16_t*)take((size_t)2 * 4 * 256 * 64 * 2);
  p.LWT = (bf16_t*)take((size_t)2 * 4 * 4 * 64 * 64 * 2);
  if (off > ws_size) { fprintf(stderr, "workspace too small: need %zu have %zu\n", off, ws_size); return; }
  static const int REPS[8] = {1, 1, 1, 1, 1, 1, 1, 1};
  for (int i = 0; i < 8; ++i) p.rep[i] = REPS[i];
  static const int REPS2[8] = {1, 1, 1, 1, 1, 1, 1, 1};
  for (int i = 0; i < 8; ++i) p.rep2[i] = REPS2[i];
  hipMemsetAsync(p.bar, 0, (size_t)XCD_BAR_WORDS * 4, stream);
  void* args[] = {&p};
  hipError_t e = hipLaunchCooperativeKernel((const void*)fwd_megakernel, dim3(grid_blocks), dim3(256), args, 0, stream);
  if (e != hipSuccess) fprintf(stderr, "cooperative launch failed: %s (grid %d)\n", hipGetErrorString(e), grid_blocks);
}
```

```cpp
#include <hip/hip_runtime.h>
#include <cstdio>
#include <cstdint>

typedef unsigned short bf16_t;
typedef short bf16x8 __attribute__((ext_vector_type(8)));
typedef float f32x4 __attribute__((ext_vector_type(4)));
typedef unsigned u32x4 __attribute__((ext_vector_type(4)));
typedef unsigned u32x2 __attribute__((ext_vector_type(2)));
#define DI __device__ __forceinline__

#define O_YP 0
#define O_NWK 8388608
#define O_NWV 9437184
#define O_NDK 10485760
#define O_NDV 12582912
#define O_NSR 14680064
#define O_NSL 15728640

#define NTOK 8192
#define PW 3456
#define LDK 1088

struct Params {
  const float *x_prompt, *x_sample, *c, *cwk, *cwv, *cdk, *cdv, *st_rwkv, *st_lru, *c_ctx, *w_mod, *b_mod, *g_pre, *g_post, *w_in, *w_out;
  const float *rw_w0, *rw_wup, *rw_a0, *rw_aup, *rw_kk, *rw_ka, *rw_rk, *rw_gng, *rw_gnb, *win_sink;
  const float *lru_cw, *lru_cb, *lru_wa, *lru_ba, *lru_wx, *lru_bx, *lru_lam, *diff_lam, *diff_g;
  float* out;
  float* MOD; bf16_t* WINT; bf16_t* WOUTT; bf16_t* CWK; bf16_t* CWVT; bf16_t* CDK; bf16_t* CDVT;
  bf16_t* H; bf16_t* P; float* NKK; float* AW; float* AB; float* AKD; float* YA; float* LA; float* LU;
  bf16_t* QBR; bf16_t* KBR; bf16_t* QDR; bf16_t* KDR; bf16_t* VBT; bf16_t* VDT; float* OB; float* OD; float* Y2; float* LC; unsigned* bar; bf16_t* RWT; bf16_t* LWT;
  int rep[8];
  int rep2[8];
};

DI void lds_barrier() { asm volatile("s_waitcnt lgkmcnt(0)\n\ts_barrier" ::: "memory"); }
DI int tid_opaque() { int t = threadIdx.x; asm volatile("" : "+v"(t)); return t; }
DI bf16_t f2bf(float x) { unsigned u = __float_as_uint(x); u += 0x7fffu + ((u >> 16) & 1u); return (bf16_t)(u >> 16); }
DI float bf2f(bf16_t b) { return __uint_as_float(((unsigned)b) << 16); }
typedef float f32x2_ __attribute__((ext_vector_type(2)));
typedef __bf16 bf16x2_t __attribute__((ext_vector_type(2)));
DI unsigned pack2(float a, float b) { f32x2_ v = {a, b}; bf16x2_t r = __builtin_convertvector(v, bf16x2_t); return __builtin_bit_cast(unsigned, r); }
DI float bflo(unsigned u) { return __uint_as_float(u << 16); }
DI float bfhi(unsigned u) { return __uint_as_float(u & 0xffff0000u); }
DI void ld4bf(const bf16_t* q, float (&o)[4]) { u32x2 u = *(const u32x2*)q; o[0] = bflo(u.x); o[1] = bfhi(u.x); o[2] = bflo(u.y); o[3] = bfhi(u.y); }
DI void st4bf(bf16_t* q, const float (&v)[4]) { u32x2 u; u.x = pack2(v[0], v[1]); u.y = pack2(v[2], v[3]); *(u32x2*)q = u; }
DI float wave_sum(float v) { for (int o = 32; o > 0; o >>= 1) v += __shfl_xor(v, o); return v; }
DI float sigmoidf_(float x) { return 1.0f / (1.0f + expf(-x)); }
DI float fsigmoid(float x) { return __builtin_amdgcn_rcpf(1.0f + __expf(-x)); }
DI float wave_sum_dpp(float v) {
  v += __builtin_bit_cast(float, __builtin_amdgcn_update_dpp(0, __builtin_bit_cast(int, v), 0xB1, 0xf, 0xf, true));
  v += __builtin_bit_cast(float, __builtin_amdgcn_update_dpp(0, __builtin_bit_cast(int, v), 0x4E, 0xf, 0xf, true));
  v += __builtin_bit_cast(float, __builtin_amdgcn_update_dpp(0, __builtin_bit_cast(int, v), 0x141, 0xf, 0xf, true));
  v += __builtin_bit_cast(float, __builtin_amdgcn_update_dpp(0, __builtin_bit_cast(int, v), 0x140, 0xf, 0xf, true));
  const int iv = __builtin_bit_cast(int, v);
  return __builtin_bit_cast(float, __builtin_amdgcn_readlane(iv, 0)) + __builtin_bit_cast(float, __builtin_amdgcn_readlane(iv, 16)) + __builtin_bit_cast(float, __builtin_amdgcn_readlane(iv, 32)) + __builtin_bit_cast(float, __builtin_amdgcn_readlane(iv, 48));
}
DI float siluf_(float x) { return x * __builtin_amdgcn_rcpf(1.0f + __expf(-x)); }
DI float softplusf_(float z) { return z > 20.f ? z : log1pf(expf(z)); }
DI f32x4 mfma16(bf16x8 a, bf16x8 b, f32x4 c) { return __builtin_amdgcn_mfma_f32_16x16x32_bf16(a, b, c, 0, 0, 0); }
DI float quad_sum(float v) {
  v += __builtin_bit_cast(float, __builtin_amdgcn_update_dpp(0, __builtin_bit_cast(int, v), 0xB1, 0xf, 0xf, true));
  v += __builtin_bit_cast(float, __builtin_amdgcn_update_dpp(0, __builtin_bit_cast(int, v), 0x4E, 0xf, 0xf, true));
  return v;
}


#define XB_TMO      128
#define XB_XCNT(j)  (256  + 64 * (j))
#define XB_XSUB(j)  (1280 + 64 * (j))
#define XB_XGEN(j)  (2304 + 64 * (j))
#define XB_TOP      3328
#define XB_TOPGEN   3392
#define XCD_BAR_WORDS 3456
#define XB_SPIN_CAP (1u << 18)
#define LAS __attribute__((address_space(3)))
DI unsigned xb_ld(unsigned* p)              { return __hip_atomic_load(p, __ATOMIC_RELAXED, __HIP_MEMORY_SCOPE_AGENT); }
DI unsigned xb_add(unsigned* p, unsigned v) { return __hip_atomic_fetch_add(p, v, __ATOMIC_RELAXED, __HIP_MEMORY_SCOPE_AGENT); }
DI unsigned xb_xcc_id() { return (unsigned)__builtin_amdgcn_s_getreg((3 << 11) | 20) & 0xFu; }
#define XB_SPIN(cond, bar) do { unsigned _sp = 0; while (cond) { __builtin_amdgcn_s_sleep(1); \
    if ((++_sp & 255u) == 0u) { if (xb_ld(&(bar)[XB_TMO])) break; if (_sp > XB_SPIN_CAP) { atomicAdd(&(bar)[XB_TMO], 1u); break; } } } } while (0)
struct XcdBarrier { unsigned* bar; unsigned x; volatile LAS unsigned* st; };
DI XcdBarrier xcd_barrier_post(unsigned* bar, volatile LAS unsigned* st) {
    XcdBarrier b; b.bar = bar; b.x = xb_xcc_id(); b.st = st;
    if (threadIdx.x == 0) (void)xb_add(&bar[XB_XCNT(b.x)], 1u);
    return b;
}
DI void xcd_barrier_complete(unsigned* bar, unsigned x, unsigned& nloc, unsigned& nx) {
    const unsigned G = gridDim.x * gridDim.y * gridDim.z;
    unsigned sum, cnt, mine, sp = 0u;
    for (;;) {
        sum = 0u; cnt = 0u; mine = 0u;
#pragma unroll
        for (unsigned j = 0; j < 16; ++j) { const unsigned c = xb_ld(&bar[XB_XCNT(j)]); sum += c; cnt += (c > 0u) ? 1u : 0u; mine = (j == x) ? c : mine; }
        if (sum == G) break;
        __builtin_amdgcn_s_sleep(1);
        if ((++sp & 255u) == 0u) { if (xb_ld(&bar[XB_TMO])) break; if (sp > XB_SPIN_CAP) { atomicAdd(&bar[XB_TMO], 1u); break; } }
    }
    nloc = mine > 0u ? mine : 1u; nx = cnt > 0u ? cnt : 1u;
}
DI void xcd_barrier(const XcdBarrier& b) {
    asm volatile("s_waitcnt vmcnt(0)" ::: "memory");
    __syncthreads();
    if (threadIdx.x == 0) {
        unsigned* bar = b.bar;
        unsigned bx = xb_xcc_id();
        __builtin_amdgcn_s_waitcnt(0);
        unsigned nloc = b.st[0], nx = b.st[1];
        if (nloc == 0u) { xcd_barrier_complete(bar, bx, nloc, nx); b.st[0] = nloc; b.st[1] = nx; }
        const unsigned old = xb_add(&bar[XB_XSUB(bx)], 1u);
        const unsigned gen = old / nloc;
        if (old + 1u == (gen + 1u) * nloc) {
            __builtin_amdgcn_fence(__ATOMIC_RELEASE, "agent");
            asm volatile("s_waitcnt vmcnt(0)" ::: "memory");
            const unsigned og = xb_add(&bar[XB_TOP], 1u);
            const unsigned tg = og / nx;
            if (og + 1u == (tg + 1u) * nx) xb_add(&bar[XB_TOPGEN], 1u);
            else XB_SPIN(xb_ld(&bar[XB_TOPGEN]) == tg, bar);
            __builtin_amdgcn_fence(__ATOMIC_ACQUIRE, "agent");
            xb_add(&bar[XB_XGEN(bx)], 1u);
            asm volatile("s_waitcnt vmcnt(0)" ::: "memory");
        } else {
            XB_SPIN(xb_ld(&bar[XB_XGEN(bx)]) == gen, bar);
            __builtin_amdgcn_fence(__ATOMIC_ACQUIRE, "agent");
            asm volatile("s_waitcnt vmcnt(0)" ::: "memory");
        }
    }
    __syncthreads();
}

template <typename T> DI float ldval(const T* p);
template <> DI float ldval<float>(const float* p) { return *p; }
template <> DI float ldval<bf16_t>(const bf16_t* p) { return bf2f(*p); }
template <typename T>
DI void transpose_tile(const T* src, int src_ld, bf16_t* dst, int dst_ld, float* lds) {
  const int tid = tid_opaque();
#pragma unroll 8
  for (int i = 0; i < 16; ++i) { int r = (tid >> 6) + 4 * i, c = tid & 63; lds[r * 65 + c] = ldval<T>(src + (size_t)r * src_ld + c); }
  __syncthreads();
#pragma unroll 4
  for (int i = 0; i < 16; ++i) { int c = (tid >> 6) + 4 * i, r = tid & 63; dst[(size_t)c * dst_ld + r] = f2bf(lds[r * 65 + c]); }
  __syncthreads();
}

__device__ __forceinline__ void weight_tile(const Params& p, int l, int item, float* lds) {
  if (item < 864) {
    const int kt = item / 54, nt = item % 54;
    transpose_tile<float>(p.w_in + (size_t)l * 1024 * PW + (size_t)kt * 64 * PW + nt * 64, PW,
                          p.WINT + (size_t)l * PW * LDK + (size_t)nt * 64 * LDK + kt * 64, LDK, lds);
  } else {
    const int r = item - 864, kt = r / 16, nt = r % 16;
    transpose_tile<float>(p.w_out + (size_t)l * 1024 * 1024 + (size_t)kt * 64 * 1024 + nt * 64, 1024,
                          p.WOUTT + (size_t)l * 1024 * LDK + (size_t)nt * 64 * LDK + kt * 64, LDK, lds);
  }
}

__device__ __forceinline__ void phase_prologue(const Params& p, unsigned char* smem) {
  float* lds = (float*)smem;
  const int n0 = 1728, n1 = n0 + 512, n2 = n1 + 192, n3 = n2 + 64, n4 = n3 + 128, n5 = n4 + 192, n6 = n5 + 32, n7 = n6 + 32;
#pragma unroll 1
  for (int it = blockIdx.x; it < n7; it += gridDim.x) {
    const int tid = tid_opaque();
    if (it < n1) {
      if (it < 1120) weight_tile(p, 0, it, lds);
      else if (gridDim.x < 320) weight_tile(p, 1, it - 1120, lds);
    } else if (it < n2) {
      int i2 = it - n1; int l = i2 / 96, nb = (i2 % 96) * 32;
      float* sc = lds;
      float* red = lds + 5 * 1024;
      for (int i = tid; i < 5 * 1024; i += 256) { int v = i >> 10, k = i & 1023; float x = v == 0 ? p.c_ctx[k] : p.c[(v - 1) * 1024 + k]; sc[i] = siluf_(x); }
      __syncthreads();
      int n = tid & 31, kg = tid >> 5;
      float a0 = 0, a1 = 0, a2 = 0, a3 = 0, a4 = 0;
      const float* wp = p.w_mod + (size_t)l * 1024 * 3072 + nb + n;
      for (int k = kg * 128; k < kg * 128 + 128; ++k) {
        float w = wp[(size_t)k * 3072];
        a0 += sc[k] * w; a1 += sc[1024 + k] * w; a2 += sc[2048 + k] * w; a3 += sc[3072 + k] * w; a4 += sc[4096 + k] * w;
      }
      red[(kg * 5 + 0) * 32 + n] = a0; red[(kg * 5 + 1) * 32 + n] = a1; red[(kg * 5 + 2) * 32 + n] = a2; red[(kg * 5 + 3) * 32 + n] = a3; red[(kg * 5 + 4) * 32 + n] = a4;
      __syncthreads();
      if (tid < 160) { int v = tid >> 5, nn = tid & 31; float s = p.b_mod[l * 3072 + nb + nn]; for (int q = 0; q < 8; ++q) s += red[(q * 5 + v) * 32 + nn]; p.MOD[(size_t)(l * 5 + v) * 3072 + nb + nn] = s; }
      __syncthreads();
    } else if (it < n3) {
      int i2 = it - n2; int bl = i2 >> 3, r = i2 & 7, pt = r >> 1, ct = r & 1;
      transpose_tile<float>(p.cwv + (size_t)bl * 256 * 128 + (size_t)pt * 64 * 128 + ct * 64, 128,
                            p.CWVT + (size_t)bl * 128 * 256 + (size_t)ct * 64 * 256 + pt * 64, 256, lds);
    } else if (it < n4) {
      int i2 = it - n3; int bl = i2 >> 4, r = i2 & 15, pt = r >> 2, ct = r & 3;
      transpose_tile<float>(p.cdv + (size_t)bl * 256 * 256 + (size_t)pt * 64 * 256 + ct * 64, 256,
                            p.CDVT + (size_t)bl * 256 * 256 + (size_t)ct * 64 * 256 + pt * 64, 256, lds);
    } else if (it >= n6) {
      int i2 = it - n6; int l = i2 >> 4, mat = (i2 >> 2) & 3, n = i2 & 3;
      const float* src = (mat < 2 ? p.lru_wa : p.lru_wx) + (size_t)(((l * 2 + (mat & 1)) * 4 + n)) * 4096;
      transpose_tile<float>(src, 64, p.LWT + (size_t)(((l * 4 + mat) * 4 + n)) * 4096, 64, lds);
    } else if (it >= n5) {
      int i2 = it - n5; int l = i2 >> 4, mat = (i2 >> 2) & 3, ct = i2 & 3;
      const float* src = (mat < 2 ? p.rw_wup : p.rw_aup) + (size_t)(l * 2 + (mat & 1)) * 64 * 256 + ct * 64;
      transpose_tile<float>(src, 256, p.RWT + ((size_t)(l * 4 + mat) * 256 + ct * 64) * 64, 64, lds);
    } else {
      int i2 = it - n4;
      const float* src; bf16_t* dst;
      if (i2 < 64) { src = p.cwk + (size_t)i2 * 4096; dst = p.CWK + (size_t)i2 * 4096; }
      else { src = p.cdk + (size_t)(i2 - 64) * 4096; dst = p.CDK + (size_t)(i2 - 64) * 4096; }
      for (int i = tid * 4; i < 4096; i += 1024) { float4 v = *(const float4*)(src + i); uint2 o; o.x = pack2(v.x, v.y); o.y = pack2(v.z, v.w); *(uint2*)(dst + i) = o; }
    }
  }
}

__device__ __forceinline__ void phase_norm(const Params& p, int stage) {
  const int tid0 = tid_opaque();
  const int lane = tid0 & 63, wave = tid0 >> 6;
#pragma unroll 1
  for (int tok = blockIdx.x * 4 + wave; tok < NTOK; tok += gridDim.x * 4) {
    const int mv = tok < 4096 ? 0 : 1 + ((tok - 4096) >> 10);
    const float* xin;
    if (stage <= 1) xin = tok < 4096 ? p.x_prompt + (size_t)tok * 1024 : p.x_sample + (size_t)(tok - 4096) * 1024;
    else xin = p.out + (size_t)tok * 1024;
    f32x4 x[4], gt[4], gq[4], sh[4], sc[4], gpre[4]; u32x2 yb[4];
    const int lp = stage >= 1 ? stage - 1 : 0, ln = stage <= 1 ? stage : 0;
    const float* gate = p.MOD + (size_t)(lp * 5 + mv) * 3072 + 2048;
    const float* gpo = p.g_post + lp * 1024;
    const float* md = p.MOD + (size_t)(ln * 5 + mv) * 3072;
    const float* gpr = p.g_pre + ln * 1024;
#pragma unroll
    for (int i = 0; i < 4; ++i) {
      const int col = i * 256 + lane * 4;
      x[i] = *(const f32x4*)(xin + col);
      if (stage >= 1) { yb[i] = *(const u32x2*)((const bf16_t*)p.Y2 + (size_t)tok * 1024 + col); gt[i] = *(const f32x4*)(gate + col); gq[i] = *(const f32x4*)(gpo + col); }
      if (stage <= 1) { sh[i] = *(const f32x4*)(md + col); sc[i] = *(const f32x4*)(md + 1024 + col); gpre[i] = *(const f32x4*)(gpr + col); }
    }
    __builtin_amdgcn_sched_barrier(0);
    if (stage >= 1) {
      f32x4 y[4]; float ss = 0.f;
#pragma unroll
      for (int i = 0; i < 4; ++i) { y[i] = (f32x4){bflo(yb[i].x), bfhi(yb[i].x), bflo(yb[i].y), bfhi(yb[i].y)}; ss += y[i][0] * y[i][0] + y[i][1] * y[i][1] + y[i][2] * y[i][2] + y[i][3] * y[i][3]; }
      ss = wave_sum(ss);
      const float rstd = rsqrtf(ss * (1.0f / 1024.0f) + 1e-6f);
#pragma unroll
      for (int i = 0; i < 4; ++i) {
        const int col = i * 256 + lane * 4;
        x[i] += gt[i] * (y[i] * rstd * gq[i]);
        *(f32x4*)(p.out + (size_t)tok * 1024 + col) = x[i];
      }
    }
    if (stage <= 1) {
      float ss = 0.f;
#pragma unroll
      for (int i = 0; i < 4; ++i) ss += x[i][0] * x[i][0] + x[i][1] * x[i][1] + x[i][2] * x[i][2] + x[i][3] * x[i][3];
      ss = wave_sum(ss);
      const float rstd = rsqrtf(ss * (1.0f / 1024.0f) + 1e-6f);
#pragma unroll
      for (int i = 0; i < 4; ++i) {
        const int col = i * 256 + lane * 4;
        const f32x4 hv = x[i] * rstd * gpre[i] * (sc[i] + 1.f) + sh[i];
        u32x2 o; o.x = pack2(hv[0], hv[1]); o.y = pack2(hv[2], hv[3]);
        *(u32x2*)(p.H + (size_t)tok * LDK + col) = o;
      }
    }
  }
}

template <int MODE, int BMT>
__device__ __forceinline__ void gemm_tile(const Params& p, int l, unsigned char* smem, const bf16_t* A, const bf16_t* Bt, int m0, int tn) {
  constexpr int MI = BMT / 32, NA = BMT / 32;
  const int K = LDK;
  bf16_t* As = (bf16_t*)smem; bf16_t* Bs = As + 128 * 64;
  const int tid = tid_opaque(), lane = tid & 63, wave = tid >> 6, wm = wave >> 1, wn = wave & 1, r16 = lane & 15, quad = lane >> 4;
  const int n0 = tn * 128;
  f32x4 acc[MI][4];
#pragma unroll
  for (int i = 0; i < MI; ++i)
#pragma unroll
    for (int jj = 0; jj < 4; ++jj) acc[i][jj] = (f32x4){0.f, 0.f, 0.f, 0.f};
  u32x4 ra0[NA], rb0[4];
  const int lrow = tid >> 3, lc8 = tid & 7;
  const bf16_t* ga = A + (size_t)(m0 + lrow) * K + lc8 * 8;
  const bf16_t* gb = Bt + (size_t)(n0 + lrow) * K + lc8 * 8;
  const int swz_w = (lc8 ^ ((lrow >> 1) & 7)) * 8, swz_r = (r16 >> 1) & 7;
  const int swz_wb = (lc8 ^ (((lrow >> 1) & 1) | (((lrow >> 3) & 3) << 1))) * 8;
  bf16_t* const sa_ = As + lrow * 64 + swz_w; bf16_t* const sb_ = Bs + lrow * 64 + swz_wb;
#define G_LOAD(KT) { _Pragma("unroll") for (int i = 0; i < NA; ++i) ra0[i] = *(const u32x4*)(ga + (size_t)i * 32 * K + (KT) * 64); \
                     _Pragma("unroll") for (int i = 0; i < 4; ++i) rb0[i] = *(const u32x4*)(gb + (size_t)i * 32 * K + (KT) * 64); }
#define G_STORE() { _Pragma("unroll") for (int i = 0; i < NA; ++i) *(u32x4*)(sa_ + i * 32 * 64) = ra0[i]; \
                    _Pragma("unroll") for (int i = 0; i < 4; ++i) *(u32x4*)(sb_ + i * 32 * 64) = rb0[i]; }
#define G_COMPUTE() { _Pragma("unroll") for (int ks = 0; ks < 2; ++ks) { bf16x8 af[MI], bfr[4]; \
      _Pragma("unroll") for (int i = 0; i < MI; ++i) af[i] = *(const bf16x8*)(As + (wm * (BMT / 2) + i * 16 + r16) * 64 + (((ks * 4 + quad) ^ swz_r) * 8)); \
      _Pragma("unroll") for (int i = 0; i < 4; ++i) { const int br_ = wn * 64 + (i >> 1) * 32 + (r16 >> 2) * 8 + (i & 1) * 4 + (r16 & 3); bfr[i] = *(const bf16x8*)(Bs + br_ * 64 + (((ks * 4 + quad) ^ (((br_ >> 1) & 1) | (((br_ >> 3) & 3) << 1))) * 8)); } \
      _Pragma("unroll") for (int mi = 0; mi < MI; ++mi) _Pragma("unroll") for (int ni = 0; ni < 4; ++ni) acc[mi][ni] = mfma16(bfr[ni], af[mi], acc[mi][ni]); } }
  G_LOAD(0);
  G_STORE();
  __syncthreads();
#pragma unroll 1
  for (int kt = 0; kt < 16; ++kt) {
    if (kt + 1 < 16) G_LOAD(kt + 1);
    __builtin_amdgcn_sched_barrier(0);
    G_COMPUTE();
    lds_barrier();
    if (kt + 1 < 16) { G_STORE(); lds_barrier(); }
  }
#undef G_LOAD
#undef G_STORE
#undef G_COMPUTE
#pragma unroll
  for (int mi = 0; mi < MI; ++mi)
#pragma unroll
    for (int k2 = 0; k2 < 2; ++k2) {
      const int m = m0 + wm * (BMT / 2) + mi * 16 + r16, n = n0 + wn * 64 + k2 * 32 + quad * 8;
      const f32x4 v0 = acc[mi][2 * k2], v1 = acc[mi][2 * k2 + 1];
      u32x4 o; o.x = pack2(v0[0], v0[1]); o.y = pack2(v0[2], v0[3]); o.z = pack2(v1[0], v1[1]); o.w = pack2(v1[2], v1[3]);
      if (MODE == 0) {
        *(u32x4*)(p.P + (size_t)m * PW + n) = o;
        if (m0 < 4096) {
          const int row = ((m >> 8) * 2 + l) * 256 + (m & 255);
          float* dst = nullptr;
          if (tn == 11) dst = p.out + O_NWK + (size_t)row * 128 + (n - 1408);
          else if (tn == 12) dst = p.out + O_NWV + (size_t)row * 128 + (n - 1536);
          else if (tn == 21 || tn == 22) dst = p.out + O_NDK + (size_t)row * 256 + (n - 2688);
          else if (tn == 23 || tn == 24) dst = p.out + O_NDV + (size_t)row * 256 + (n - 2944);
          if (dst) { *(f32x4*)dst = v0; *(f32x4*)(dst + 4) = v1; }
        }
      } else {
        *(u32x4*)((bf16_t*)p.Y2 + (size_t)m * 1024 + n) = o;
      }
    }
}

template <int MODE>
__device__ __forceinline__ void phase_gemm(const Params& p, int l, unsigned char* smem, int vb) {
  const bf16_t* A = p.H;
  const bf16_t* Bt = MODE == 0 ? p.WINT + (size_t)l * PW * LDK : p.WOUTT + (size_t)l * 1024 * LDK;
  const int NTN = (MODE == 0 ? PW : 1024) / 128;
  const int per = gridDim.x >> 3;
  const bool even8 = (gridDim.x & 7) == 0;
  const int xcd = even8 ? vb / per : (vb & 7), slot = even8 ? vb % per : (vb >> 3), nslot = even8 ? per : (int)((gridDim.x + 7 - xcd) >> 3);
  if (MODE == 0 && gridDim.x == 512) {
#pragma unroll 1
    for (int j = slot; j < 64 * 3; j += 64) gemm_tile<MODE, 128>(p, l, smem, A, Bt, (j / 3) * 128, xcd + 8 * (j % 3));
    if (xcd < 6) gemm_tile<MODE, 64>(p, l, smem, A, Bt, ((xcd & 1) * 64 + slot) * 64, 24 + (xcd >> 1));
  } else {
    const int nx = (NTN - xcd + 7) >> 3;
#pragma unroll 1
    for (int j = slot; j < 64 * nx; j += nslot) gemm_tile<MODE, 128>(p, l, smem, A, Bt, (j / nx) * 128, xcd + 8 * (j % nx));
  }
}

DI void unpack8(u32x4 u, float (&o)[8]) { o[0] = bflo(u.x); o[1] = bfhi(u.x); o[2] = bflo(u.y); o[3] = bfhi(u.y); o[4] = bflo(u.z); o[5] = bfhi(u.z); o[6] = bflo(u.w); o[7] = bfhi(u.w); }
DI bf16x8 pack8(const float (&o)[8]) { u32x4 u; u.x = pack2(o[0], o[1]); u.y = pack2(o[2], o[3]); u.z = pack2(o[4], o[5]); u.w = pack2(o[6], o[7]); return __builtin_bit_cast(bf16x8, u); }

__device__ __forceinline__ void pre_rwkv(const Params& p, int l, int item) {
  const int tid = tid_opaque(), lane = tid & 63, h = tid >> 6, r16 = lane & 15, quad = lane >> 4;
  const int tok = item * 16 + r16;
  const bf16_t* pr = p.P + (size_t)tok * PW;
  bf16x8 wdf[2], adf[2];
#pragma unroll
  for (int ks = 0; ks < 2; ++ks) {
    float o[8]; unpack8(*(const u32x4*)(pr + 768 + ks * 32 + quad * 8), o);
#pragma unroll
    for (int j = 0; j < 8; ++j) o[j] = 1.0f - 2.0f * __builtin_amdgcn_rcpf(1.0f + __expf(2.0f * o[j]));
    wdf[ks] = pack8(o);
    adf[ks] = *(const bf16x8*)(pr + 832 + ks * 32 + quad * 8);
  }
  float kv[4][4];
#pragma unroll
  for (int ct = 0; ct < 4; ++ct) ld4bf(pr + 256 + h * 64 + ct * 16 + quad * 4, kv[ct]);
  const bf16_t* wt = p.RWT + (size_t)l * 4 * 256 * 64;
  float ss = 0.f;
#pragma unroll
  for (int ct = 0; ct < 4; ++ct) {
    const f32x4 kkc = *(const f32x4*)(p.rw_kk + l * 256 + h * 64 + ct * 16 + quad * 4);
#pragma unroll
    for (int r = 0; r < 4; ++r) { const float q = kv[ct][r] * kkc[r]; ss += q * q; }
  }
  ss += __shfl_xor(ss, 16); ss += __shfl_xor(ss, 32);
  const float rn = rsqrtf(ss + 1e-12f);
#pragma unroll
  for (int ct = 0; ct < 4; ++ct) {
    f32x4 acc[4];
    const int c0 = h * 64 + ct * 16 + quad * 4;
    bf16x8 wfr[4][2];
#pragma unroll
    for (int mat = 0; mat < 4; ++mat)
#pragma unroll
      for (int ks = 0; ks < 2; ++ks) wfr[mat][ks] = *(const bf16x8*)(wt + ((size_t)mat * 256 + h * 64 + ct * 16 + r16) * 64 + ks * 32 + quad * 8);
    const f32x4 kkc = *(const f32x4*)(p.rw_kk + l * 256 + c0), kac = *(const f32x4*)(p.rw_ka + l * 256 + c0);
    const f32x4 w00 = *(const f32x4*)(p.rw_w0 + (l * 2 + 0) * 256 + c0), w01 = *(const f32x4*)(p.rw_w0 + (l * 2 + 1) * 256 + c0);
    const f32x4 a00 = *(const f32x4*)(p.rw_a0 + (l * 2 + 0) * 256 + c0), a01 = *(const f32x4*)(p.rw_a0 + (l * 2 + 1) * 256 + c0);
    __builtin_amdgcn_sched_barrier(0);
#pragma unroll
    for (int mat = 0; mat < 4; ++mat) {
      f32x4 a = {0.f, 0.f, 0.f, 0.f};
#pragma unroll
      for (int ks = 0; ks < 2; ++ks) a = mfma16(wfr[mat][ks], mat < 2 ? wdf[ks] : adf[ks], a);
      acc[mat] = a;
    }
    f32x4 nkk, w0v, w1v, b0v, b1v, k0v, k1v;
#pragma unroll
    for (int r = 0; r < 4; ++r) {
      const float k = kv[ct][r];
      const float kkn = k * kkc[r] * rn;
      nkk[r] = -kkn;
#pragma unroll
      for (int d = 0; d < 2; ++d) {
        const float wl = (d ? w01[r] : w00[r]) + acc[d][r];
        const float w_log = -__logf(1.0f + __expf(-wl)) - 0.5f;
        const float decay = __expf(-__expf(w_log));
        const float a = fsigmoid((d ? a01[r] : a00[r]) + acc[2 + d][r]);
        const float kd = k * (1.f + (a - 1.f) * kac[r]);
        if (d) { w1v[r] = decay; b1v[r] = kkn * a; k1v[r] = kd; } else { w0v[r] = decay; b0v[r] = kkn * a; k0v[r] = kd; }
      }
    }
    const size_t o0 = (size_t)tok * 256 + c0, o1 = ((size_t)NTOK + tok) * 256 + c0;
    *(f32x4*)(p.NKK + o0) = nkk;
    *(f32x4*)(p.AW + o0) = w0v; *(f32x4*)(p.AW + o1) = w1v;
    *(f32x4*)(p.AB + o0) = b0v; *(f32x4*)(p.AB + o1) = b1v;
    *(f32x4*)(p.AKD + o0) = k0v; *(f32x4*)(p.AKD + o1) = k1v;
  }
}

#define LSCAN_STEP(A, H, CTRL) { \
    const float Ap = __builtin_bit_cast(float, __builtin_amdgcn_update_dpp(0x3f800000, __builtin_bit_cast(int, A), CTRL, 0xf, 0xf, false)); \
    const float Hp = __builtin_bit_cast(float, __builtin_amdgcn_update_dpp(0, __builtin_bit_cast(int, H), CTRL, 0xf, 0xf, true)); \
    H = A * Hp + H; A = A * Ap; }

__device__ __forceinline__ void pre_lru(const Params& p, int l, int item) {
  const int tid = tid_opaque(), lane = tid & 63, n = tid >> 6, r16 = lane & 15, quad = lane >> 4;
  const int tok0 = item * 16;
  int T, sb, t0;
  if (tok0 < 4096) { T = 256; sb = tok0 & ~255; t0 = tok0 & 255; } else { T = 1024; sb = 4096 + ((tok0 - 4096) & ~1023); t0 = (tok0 - 4096) & 1023; }
  const int t = t0 + r16, tok = tok0 + r16;
  bf16x8 xf[2];
  float xo[2][8];
#pragma unroll
  for (int ks = 0; ks < 2; ++ks) {
    const int cb = n * 64 + ks * 32 + quad * 8;
    float o[8];
    { const f32x4 b0 = *(const f32x4*)(p.lru_cb + l * 256 + cb), b1 = *(const f32x4*)(p.lru_cb + l * 256 + cb + 4);
      o[0] = b0[0]; o[1] = b0[1]; o[2] = b0[2]; o[3] = b0[3]; o[4] = b1[0]; o[5] = b1[1]; o[6] = b1[2]; o[7] = b1[3]; }
#pragma unroll
    for (int i = 0; i < 4; ++i) {
      const int tt = t - 2 + i;
      u32x4 xr = {0u, 0u, 0u, 0u};
      if (tt >= 0 && tt < T) xr = *(const u32x4*)(p.P + (size_t)(sb + tt) * PW + 1920 + cb);
      float x[8]; unpack8(xr, x);
      const f32x4 w0 = *(const f32x4*)(p.lru_cw + (l * 4 + i) * 256 + cb), w1 = *(const f32x4*)(p.lru_cw + (l * 4 + i) * 256 + cb + 4);
      o[0] += w0[0] * x[0]; o[1] += w0[1] * x[1]; o[2] += w0[2] * x[2]; o[3] += w0[3] * x[3];
      o[4] += w1[0] * x[4]; o[5] += w1[1] * x[5]; o[6] += w1[2] * x[6]; o[7] += w1[3] * x[7];
    }
    xf[ks] = pack8(o);
#pragma unroll
    for (int j = 0; j < 8; ++j) xo[ks][j] = o[j];
  }
#pragma unroll
  for (int et = 0; et < 4; ++et) {
    f32x4 acc[4];
    const int c0 = n * 64 + (et >> 1) * 32 + quad * 8 + (et & 1) * 4;
    const int erow = (et >> 1) * 32 + (r16 >> 2) * 8 + (et & 1) * 4 + (r16 & 3);
    bf16x8 wfr[4][2];
#pragma unroll
    for (int mat = 0; mat < 4; ++mat)
#pragma unroll
      for (int ks = 0; ks < 2; ++ks) wfr[mat][ks] = *(const bf16x8*)(p.LWT + ((size_t)((l * 4 + mat) * 4 + n) * 64 + erow) * 64 + ks * 32 + quad * 8);
    const f32x4 ba0 = *(const f32x4*)(p.lru_ba + (l * 2 + 0) * 256 + c0), ba1 = *(const f32x4*)(p.lru_ba + (l * 2 + 1) * 256 + c0);
    const f32x4 bx0 = *(const f32x4*)(p.lru_bx + (l * 2 + 0) * 256 + c0), bx1 = *(const f32x4*)(p.lru_bx + (l * 2 + 1) * 256 + c0);
    const f32x4 lm0 = *(const f32x4*)(p.lru_lam + (l * 2 + 0) * 256 + c0), lm1 = *(const f32x4*)(p.lru_lam + (l * 2 + 1) * 256 + c0);
    __builtin_amdgcn_sched_barrier(0);
#pragma unroll
    for (int mat = 0; mat < 4; ++mat) {
      f32x4 a = {0.f, 0.f, 0.f, 0.f};
#pragma unroll
      for (int ks = 0; ks < 2; ++ks) a = mfma16(wfr[mat][ks], xf[ks], a);
      acc[mat] = a;
    }
    f32x4 A0, H0, A1, H1;
#pragma unroll
    for (int r = 0; r < 4; ++r) {
      const float x = xo[et >> 1][(et & 1) * 4 + r];
#pragma unroll
      for (int d = 0; d < 2; ++d) {
        const float ga = fsigmoid(acc[d][r] + (d ? ba1[r] : ba0[r]));
        const float gx = fsigmoid(acc[2 + d][r] + (d ? bx1[r] : bx0[r]));
        const float e_ = __expf(-(d ? lm1[r] : lm0[r]));
        const float sp = e_ < 0.05f ? e_ * (1.0f - e_ * (0.5f - e_ * (0.33333334f - 0.25f * e_))) : __logf(1.0f + e_);
        const float log_a = -8.0f * ga * sp;
        float a = __expf(log_a);
        const float x2 = 2.0f * log_a;
        const float om = x2 > -0.05f ? -(x2 * (1.0f + x2 * (0.5f + x2 * (0.16666667f + x2 * 0.041666667f)))) : 1.0f - __expf(x2);
        float u = __fsqrt_rn(om) * (gx * x);
        if (d == 0) { LSCAN_STEP(a, u, 0x111) LSCAN_STEP(a, u, 0x112) LSCAN_STEP(a, u, 0x114) LSCAN_STEP(a, u, 0x118) A0[r] = a; H0[r] = u; }
        else        { LSCAN_STEP(a, u, 0x101) LSCAN_STEP(a, u, 0x102) LSCAN_STEP(a, u, 0x104) LSCAN_STEP(a, u, 0x108) A1[r] = a; H1[r] = u; }
      }
    }
    const size_t o0 = (size_t)tok * 256 + c0, o1 = ((size_t)NTOK + tok) * 256 + c0;
    *(f32x4*)(p.LA + o0) = A0; *(f32x4*)(p.LU + o0) = H0;
    *(f32x4*)(p.LA + o1) = A1; *(f32x4*)(p.LU + o1) = H1;
  }
}

__device__ __forceinline__ void pre_rope(const Params& p, int item) {
  const int tid = tid_opaque();
  const int ts0 = item * 16;
#pragma unroll 1
  for (int pp = tid; pp < 448; pp += 256) {
    int scol, d1, d2, half, i, dstride; bf16_t* dst; float inv;
    if (pp < 192) {
      int q = pp < 128 ? pp : pp - 128; int vec = q >> 5, pi = q & 31; half = pi >> 4; i = pi & 15;
      d1 = half * 32 + i; d2 = d1 + 16; inv = exp2f(-(float)i * (13.287712379549449f / 16.0f));
      if (pp < 128) { scol = 1152 + vec * 64; dst = p.QBR + vec * 64; dstride = 256; }
      else { scol = 1408 + vec * 64; dst = p.KBR + vec * 64; dstride = 128; }
    } else {
      int q = pp < 320 ? pp - 192 : pp - 320; int vec = q >> 4, pi = q & 15; half = pi >> 3; i = pi & 7;
      d1 = half * 16 + i; d2 = d1 + 8; inv = exp2f(-(float)i * (13.287712379549449f / 8.0f));
      if (pp < 320) { scol = 2432 + vec * 32; dst = p.QDR + vec * 32; dstride = 256; }
      else { scol = 2688 + vec * 32; dst = p.KDR + vec * 32; dstride = 256; }
    }
    float x1[16], x2[16];
#pragma unroll
    for (int tt = 0; tt < 16; ++tt) { const bf16_t* src = p.P + (size_t)(4096 + ts0 + tt) * PW + scol; x1[tt] = bf2f(src[d1]); x2[tt] = bf2f(src[d2]); }
#pragma unroll
    for (int tt = 0; tt < 16; ++tt) {
      const int t = (ts0 + tt) & 1023;
      const float ang = (float)(half ? (t & 63) : (t >> 6)) * inv;
      const float sn = __sinf(ang), cs = __cosf(ang);
      const float a = x1[tt], b = x2[tt];
      bf16_t* o = dst + (size_t)(ts0 + tt) * dstride;
      o[d1] = f2bf(a * cs - b * sn); o[d2] = f2bf(a * sn + b * cs);
    }
  }
}

__device__ __forceinline__ void phase_pre(const Params& p, int l, unsigned char* smem) {
  const int n0 = 512, n1 = n0 + 512, n2 = n1 + 256, n3 = n2 + 256, n4 = n3 + 512;
#pragma unroll 1
  for (int it = blockIdx.x; it < n4; it += gridDim.x) {
    if (it < n0) pre_rwkv(p, l, it);
    else if (it < n1) pre_lru(p, l, it - n0);
    else if (it < n2) pre_rope(p, it - n1);
    else if (it < n3) {
      int i2 = it - n2; int tt = i2 >> 1, ct = i2 & 1; int tok0 = tt * 64;
      int T, sb; if (tok0 < 4096) { T = 256; sb = tok0 & ~255; } else { T = 1024; sb = 4096 + ((tok0 - 4096) & ~1023); }
      transpose_tile<bf16_t>(p.P + (size_t)tok0 * PW + 1536 + ct * 64, PW, p.VBT + (size_t)sb * 128 + (size_t)(ct * 64) * T + (tok0 - sb), T, (float*)smem);
    } else {
      int i2 = it - n3; int tt = i2 >> 2, ct = i2 & 3; int tok0 = tt * 64;
      int T, sb; if (tok0 < 4096) { T = 256; sb = tok0 & ~255; } else { T = 1024; sb = 4096 + ((tok0 - 4096) & ~1023); }
      transpose_tile<bf16_t>(p.P + (size_t)tok0 * PW + 2944 + ct * 64, PW, p.VDT + (size_t)sb * 256 + (size_t)(ct * 64) * T + (tok0 - sb), T, (float*)smem);
    }
  }
}

template <int LR> DI float group_sum(float v) {
  v += __builtin_bit_cast(float, __builtin_amdgcn_update_dpp(0, __builtin_bit_cast(int, v), 0xB1, 0xf, 0xf, true));
  v += __builtin_bit_cast(float, __builtin_amdgcn_update_dpp(0, __builtin_bit_cast(int, v), 0x4E, 0xf, 0xf, true));
  if (LR >= 8) v += __builtin_bit_cast(float, __builtin_amdgcn_update_dpp(0, __builtin_bit_cast(int, v), 0x141, 0xf, 0xf, true));
  if (LR >= 16) v += __builtin_bit_cast(float, __builtin_amdgcn_update_dpp(0, __builtin_bit_cast(int, v), 0x140, 0xf, 0xf, true));
  return v;
}
typedef float f32x2 __attribute__((ext_vector_type(2)));
template <int E> struct RwOps { f32x4 nk[E / 4], ww[E / 4], bb[E / 4], kk[E / 4], rr[E / 4]; float vi; };
template <int E> DI void rw_load(const float* ob, int g, int i, RwOps<E>& o) {
  constexpr int LR = 64 / E, NM = E / 4;
#pragma unroll
  for (int m = 0; m < NM; ++m) {
    const int off = 4 * (g + LR * m);
    o.nk[m] = *(const f32x4*)(ob + off); o.ww[m] = *(const f32x4*)(ob + 64 + off); o.bb[m] = *(const f32x4*)(ob + 128 + off);
    o.kk[m] = *(const f32x4*)(ob + 192 + off); o.rr[m] = *(const f32x4*)(ob + 256 + off);
  }
  o.vi = ob[320 + i];
}
#define DPP_ADD(V, CTRL) V += __builtin_bit_cast(float, __builtin_amdgcn_update_dpp(0, __builtin_bit_cast(int, V), CTRL, 0xf, 0xf, true))
template <int E> DI float rw_step(f32x2 (&S)[E / 2], const RwOps<E>& o, float& ypart) {
  constexpr int LR = 64 / E, NM = E / 4;
  f32x2 p2 = S[0] * o.nk[0].xy;
  p2 = S[1] * o.nk[0].zw + p2;
#pragma unroll
  for (int m = 1; m < NM; ++m) { p2 = S[2 * m] * o.nk[m].xy + p2; p2 = S[2 * m + 1] * o.nk[m].zw + p2; }
  float sa = p2.x + p2.y, yr = ypart;
  DPP_ADD(sa, 0xB1); DPP_ADD(yr, 0xB1);
  DPP_ADD(sa, 0x4E); DPP_ADD(yr, 0x4E);
  if (LR >= 8) { DPP_ADD(sa, 0x141); DPP_ADD(yr, 0x141); }
  if (LR >= 16) { DPP_ADD(sa, 0x140); DPP_ADD(yr, 0x140); }
  const f32x2 sa2 = {sa, sa}, v2 = {o.vi, o.vi};
  f32x2 y2 = {0.f, 0.f};
#pragma unroll
  for (int m = 0; m < NM; ++m) {
    S[2 * m] = S[2 * m] * o.ww[m].xy + (sa2 * o.bb[m].xy + v2 * o.kk[m].xy);
    S[2 * m + 1] = S[2 * m + 1] * o.ww[m].zw + (sa2 * o.bb[m].zw + v2 * o.kk[m].zw);
    y2 = S[2 * m] * o.rr[m].xy + y2; y2 = S[2 * m + 1] * o.rr[m].zw + y2;
  }
  ypart = y2.x + y2.y;
  return yr;
}
template <int E>
__device__ __forceinline__ void rwkv_chain(const Params& p, int l, int chain, int part, unsigned char* smem) {
  constexpr int LR = 64 / E, NM = E / 4;
  const int tid = tid_opaque(), lane = tid & 63, wave = tid >> 6;
  int seq, d, h;
  if (chain < 32) { seq = 16 + (chain >> 3); d = (chain >> 2) & 1; h = chain & 3; }
  else { int c2 = chain - 32; seq = c2 >> 3; d = (c2 >> 2) & 1; h = c2 & 3; }
  const int T = seq < 16 ? 256 : 1024, tokb = seq < 16 ? seq * 256 : 4096 + (seq - 16) * 1024;
  const int g = lane % LR, rl = lane / LR, i = part * 4 * E + wave * E + rl;
  f32x2 S[E / 2];
  if (seq >= 16) {
    const float* s0 = p.st_rwkv + ((((size_t)(seq - 16) * 2 + l) * 2 + d) * 4 + h) * 4096 + i * 64;
#pragma unroll
    for (int m = 0; m < NM; ++m) { f32x4 t = *(const f32x4*)(s0 + 4 * (g + LR * m)); S[2 * m] = t.xy; S[2 * m + 1] = t.zw; }
  } else {
#pragma unroll
    for (int j = 0; j < E / 2; ++j) S[j] = (f32x2){0.f, 0.f};
  }
  float* buf = (float*)smem;
  const int lvec = (tid >> 4) & 3, lc4 = tid & 15, ls = tid >> 6;
  const float* fsrc = (lvec == 0 ? p.NKK : lvec == 1 ? p.AW + (size_t)d * NTOK * 256 : lvec == 2 ? p.AB + (size_t)d * NTOK * 256 : p.AKD + (size_t)d * NTOK * 256) + h * 64 + lc4 * 4;
  const int bs = tid >> 4, bvec = (tid >> 3) & 1, bc8 = tid & 7;
  const bf16_t* bsrc = p.P + (bvec ? 512 : 0) + h * 64 + bc8 * 8;
  f32x4 rfA[4], rfB[4]; u32x4 rbA, rbB;
  const int nch = T / 16;
#define RW_GLOAD(RF, RB, CK) { _Pragma("unroll") for (int i4 = 0; i4 < 4; ++i4) { int step = (CK) * 16 + ls + 4 * i4; int t = d ? T - 1 - step : step; RF[i4] = *(const f32x4*)(fsrc + (size_t)(tokb + t) * 256); } \
    { int step = (CK) * 16 + bs; int t = d ? T - 1 - step : step; RB = *(const u32x4*)(bsrc + (size_t)(tokb + t) * PW); } }
#define RW_SSTORE(RF, RB, BI) { float* b_ = buf + (BI) * 16 * 384; \
    _Pragma("unroll") for (int i4 = 0; i4 < 4; ++i4) *(f32x4*)(b_ + (ls + 4 * i4) * 384 + lvec * 64 + lc4 * 4) = RF[i4]; \
    float* q_ = b_ + bs * 384 + (4 + bvec) * 64 + bc8 * 8; \
    *(f32x4*)q_ = (f32x4){bflo(RB.x), bfhi(RB.x), bflo(RB.y), bfhi(RB.y)}; \
    *(f32x4*)(q_ + 4) = (f32x4){bflo(RB.z), bfhi(RB.z), bflo(RB.w), bfhi(RB.w)}; }
  float* yout = p.YA + ((size_t)d * NTOK + tokb) * 256 + h * 64 + i;
  constexpr int NY = 16 / LR;
  auto compute = [&](int ck) {
    const float* cb = buf + (ck & 1) * 16 * 384;
    float yk[NY];
#pragma unroll
    for (int q = 0; q < NY; ++q) yk[q] = 0.f;
    constexpr int NSET = (E == 4) ? 4 : 2;
    float ypart = 0.f;
    RwOps<E> ops[NSET];
#pragma unroll
    for (int q = 0; q < NSET - 1; ++q) rw_load<E>(cb + q * 384, g, i, ops[q]);
#pragma unroll 1
    for (int s = 0; s < 16; s += NSET) {
#pragma unroll
      for (int u = 0; u < NSET; ++u) {
        const int sn = s + u + NSET - 1;
        rw_load<E>(buf + (((ck & 1) * 16 + sn) & 31) * 384, g, i, ops[(u + NSET - 1) % NSET]);
        const float y0 = rw_step<E>(S, ops[u], ypart);
#pragma unroll
        for (int q = 0; q < NY; ++q) yk[q] = (s + u - 1 == q * LR + g) ? y0 : yk[q];
      }
    }
    {
      const float y15 = group_sum<LR>(ypart);
#pragma unroll
      for (int q = 0; q < NY; ++q) yk[q] = (15 == q * LR + g) ? y15 : yk[q];
    }
#pragma unroll
    for (int q = 0; q < NY; ++q) { const int step = ck * 16 + q * LR + g; const int t = d ? T - 1 - step : step; yout[(size_t)t * 256] = yk[q]; }
  };
  __builtin_amdgcn_s_setprio(2);
  RW_GLOAD(rfA, rbA, 0); RW_SSTORE(rfA, rbA, 0); RW_GLOAD(rfA, rbA, 1); RW_GLOAD(rfB, rbB, 2);
  __syncthreads();
#pragma unroll 1
  for (int ck = 0; ck < nch; ck += 2) {
    compute(ck);
    RW_SSTORE(rfA, rbA, 1);
    if (ck + 3 < nch) RW_GLOAD(rfA, rbA, ck + 3);
    lds_barrier();
    compute(ck + 1);
    if (ck + 2 < nch) RW_SSTORE(rfB, rbB, 0);
    if (ck + 4 < nch) RW_GLOAD(rfB, rbB, ck + 4);
    lds_barrier();
  }
  __builtin_amdgcn_s_setprio(0);
#undef RW_GLOAD
#undef RW_SSTORE
  if (seq < 16) {
    float* so = p.out + O_NSR + ((((size_t)seq * 2 + l) * 2 + d) * 4 + h) * 4096 + i * 64;
#pragma unroll
    for (int m = 0; m < NM; ++m) *(f32x4*)(so + 4 * (g + LR * m)) = (f32x4){S[2 * m].x, S[2 * m].y, S[2 * m + 1].x, S[2 * m + 1].y};
  }
}

__device__ __forceinline__ void lru_scan(const Params& p, int l, int item) {
  const int c = tid_opaque();
  int seq, d;
  if (item < 8) { seq = 16 + (item >> 1); d = item & 1; } else { seq = (item - 8) >> 1; d = item & 1; }
  const int T = seq < 16 ? 256 : 1024, tokb = seq < 16 ? seq * 256 : 4096 + (seq - 16) * 1024;
  const int NC = T >> 4;
  float h = seq >= 16 ? p.st_lru[(((seq - 16) * 2 + l) * 2 + d) * 256 + c] : 0.f;
  const float* la = p.LA + (size_t)d * NTOK * 256 + c; const float* lu = p.LU + (size_t)d * NTOK * 256 + c;
  float* lc = p.LC + (size_t)d * 512 * 256 + (size_t)(tokb >> 4) * 256 + c;
  for (int k0 = 0; k0 < NC; k0 += 8) {
    float a[8], u[8];
#pragma unroll
    for (int q = 0; q < 8; ++q) { const int k = d ? NC - 1 - (k0 + q) : k0 + q; const size_t idx = (size_t)(tokb + k * 16 + (d ? 0 : 15)) * 256; a[q] = la[idx]; u[q] = lu[idx]; }
#pragma unroll
    for (int q = 0; q < 8; ++q) { const int k = d ? NC - 1 - (k0 + q) : k0 + q; lc[(size_t)k * 256] = h; h = a[q] * h + u[q]; }
  }
  if (seq < 16) p.out[O_NSL + ((seq * 2 + l) * 2 + d) * 256 + c] = h;
}

template <bool DIFF>
__device__ __forceinline__ void attn_item(const Params& p, int l, bool sample, int sq  , int h, int qt, unsigned char* smem) {
  constexpr int NS = DIFF ? 2 : 1;
  const int tid = tid_opaque();
  const int lane = tid & 63, wave = tid >> 6, r16 = lane & 15, quad = lane >> 4;
  const int T = sample ? 1024 : 256;
  const int tokb = sample ? 4096 + sq * 1024 : sq * 256;
  const int q0 = qt * 64 + wave * 16;
  const int qpos = q0 + r16;
  const int kvh = DIFF ? h : (h >> 1);
  bf16x8 qf[2];
  {
    const bf16_t* qp;
    if (sample) qp = (DIFF ? p.QDR : p.QBR) + (size_t)(sq * 1024 + qpos) * 256 + h * 64;
    else qp = p.P + (size_t)(tokb + qpos) * PW + (DIFF ? 2432 : 1152) + h * 64;
    qf[0] = *(const bf16x8*)(qp + quad * 8); qf[1] = *(const bf16x8*)(qp + 32 + quad * 8);
  }
  float m[2] = {-3.0e38f, -3.0e38f}, lsum[2] = {0.f, 0.f};
  f32x4 o[2][4];
#pragma unroll
  for (int a = 0; a < 2; ++a)
#pragma unroll
    for (int b = 0; b < 4; ++b) o[a][b] = (f32x4){0.f, 0.f, 0.f, 0.f};
  const float scale_log2 = (DIFF ? 0.17677669529663687f : 0.125f) * 1.4426950408889634f;
  const int nctx = sample ? 4 : 0;
  const bf16_t* Kc = nullptr; const bf16_t* Vc = nullptr; int ksc = 0;
  if (sample) {
    const int bl = sq * 2 + l;
    if (DIFF) { Kc = p.CDK + (size_t)bl * 256 * 256 + h * 64; ksc = 256; Vc = p.CDVT + (size_t)bl * 256 * 256 + (size_t)(h * 64) * 256; }
    else { Kc = p.CWK + (size_t)bl * 256 * 128 + kvh * 64; ksc = 128; Vc = p.CWVT + (size_t)bl * 128 * 256 + (size_t)(kvh * 64) * 256; }
  }
  const bf16_t* Kl; const bf16_t* Vl; int ksl;
  if (sample) {
    if (DIFF) { Kl = p.KDR + (size_t)(sq * 1024) * 256 + h * 64; ksl = 256; Vl = p.VDT + (size_t)tokb * 256 + (size_t)(h * 64) * T; }
    else { Kl = p.KBR + (size_t)(sq * 1024) * 128 + kvh * 64; ksl = 128; Vl = p.VBT + (size_t)tokb * 128 + (size_t)(kvh * 64) * T; }
  } else {
    if (DIFF) { Kl = p.P + (size_t)tokb * PW + 2688 + h * 64; ksl = PW; Vl = p.VDT + (size_t)tokb * 256 + (size_t)(h * 64) * T; }
    else { Kl = p.P + (size_t)tokb * PW + 1408 + kvh * 64; ksl = PW; Vl = p.VBT + (size_t)tokb * 128 + (size_t)(kvh * 64) * T; }
  }
  int kb0 = 0, kb1 = T; bool lmask = false;
  if (sample && !DIFF) { const int qb = qt * 64; kb0 = qb - 128 < 0 ? 0 : qb - 128; kb1 = qb + 192 > T ? T : qb + 192; lmask = true; }
  const int nt = nctx + ((kb1 - kb0) >> 6);
  bf16_t* const lds = (bf16_t*)smem;
  const int lrow = tid >> 2, lch = (tid & 3) * 16;
  auto gsrc = [&](int t, const bf16_t*& kp, const bf16_t*& vp) {
    if (t < nctx) { kp = Kc + (size_t)(t * 64 + lrow) * ksc + lch; vp = Vc + (size_t)lrow * 256 + t * 64 + lch; }
    else { const int kb = kb0 + (t - nctx) * 64; kp = Kl + (size_t)(kb + lrow) * ksl + lch; vp = Vl + (size_t)lrow * T + kb + lch; }
  };
  u32x4 rk0, rk1, rv0, rv1;
  { const bf16_t* kp; const bf16_t* vp; gsrc(0, kp, vp); rk0 = *(const u32x4*)kp; rk1 = *(const u32x4*)(kp + 8); rv0 = *(const u32x4*)vp; rv1 = *(const u32x4*)(vp + 8); }
  __syncthreads();
  { bf16_t* d = lds + lrow * 72 + lch; *(u32x4*)d = rk0; *(u32x4*)(d + 8) = rk1; *(u32x4*)(d + 64 * 72) = rv0; *(u32x4*)(d + 64 * 72 + 8) = rv1; }
  __syncthreads();
  const f32x4 z4 = {0.f, 0.f, 0.f, 0.f};
  const int krow = 8 * (r16 >> 2) + (r16 & 3);
#pragma unroll 1
  for (int t = 0; t < nt; ++t) {
    const bool isctx = t < nctx;
    const bool masked = !isctx && lmask;
    const int kpos0 = kb0 + (t - nctx) * 64;
    if (t + 1 < nt) { const bf16_t* kp; const bf16_t* vp; gsrc(t + 1, kp, vp); rk0 = *(const u32x4*)kp; rk1 = *(const u32x4*)(kp + 8); rv0 = *(const u32x4*)vp; rv1 = *(const u32x4*)(vp + 8); }
    const bf16_t* Ks = lds + (t & 1) * (2 * 64 * 72);
    const bf16_t* Vs = Ks + 64 * 72;
    bf16x8 pf[NS][2];
#pragma unroll
    for (int st = 0; st < NS; ++st) {
      f32x4 sc[4];
#pragma unroll
      for (int kt = 0; kt < 4; ++kt) {
        const bf16_t* kr = Ks + (32 * (kt >> 1) + 4 * (kt & 1) + krow) * 72 + quad * 8;
        if (!DIFF) { sc[kt] = mfma16(*(const bf16x8*)kr, qf[0], z4); sc[kt] = mfma16(*(const bf16x8*)(kr + 32), qf[1], sc[kt]); }
        else sc[kt] = mfma16(*(const bf16x8*)(kr + 32 * st), qf[st], z4);
      }
      float mx = -3.0e38f;
#pragma unroll
      for (int kt = 0; kt < 4; ++kt)
#pragma unroll
        for (int r = 0; r < 4; ++r) {
          float x = sc[kt][r] * scale_log2;
          if (masked) { const int kp = kpos0 + 32 * (kt >> 1) + 8 * quad + 4 * (kt & 1) + r; const int dd = kp - qpos; if (dd > 128 || dd < -128) x = -1.0e30f; }
          sc[kt][r] = x; mx = fmaxf(mx, x);
        }
      mx = fmaxf(mx, __shfl_xor(mx, 16)); mx = fmaxf(mx, __shfl_xor(mx, 32));
      const float mnew = fmaxf(m[st], mx);
      const float alpha = __builtin_amdgcn_exp2f(m[st] - mnew);
      m[st] = mnew;
      float ps = 0.f;
#pragma unroll
      for (int kt = 0; kt < 4; ++kt)
#pragma unroll
        for (int r = 0; r < 4; ++r) { const float e = __builtin_amdgcn_exp2f(sc[kt][r] - mnew); sc[kt][r] = e; ps += e; }
      lsum[st] = lsum[st] * alpha + ps;
#pragma unroll
      for (int dt = 0; dt < 4; ++dt) o[st][dt] *= alpha;
#pragma unroll
      for (int s2 = 0; s2 < 2; ++s2) {
        u32x4 tt;
        tt.x = pack2(sc[2 * s2][0], sc[2 * s2][1]); tt.y = pack2(sc[2 * s2][2], sc[2 * s2][3]);
        tt.z = pack2(sc[2 * s2 + 1][0], sc[2 * s2 + 1][1]); tt.w = pack2(sc[2 * s2 + 1][2], sc[2 * s2 + 1][3]);
        pf[st][s2] = __builtin_bit_cast(bf16x8, tt);
      }
    }
#pragma unroll
    for (int dt = 0; dt < 4; ++dt)
#pragma unroll
      for (int s2 = 0; s2 < 2; ++s2) {
        const bf16x8 vf = *(const bf16x8*)(Vs + (dt * 16 + r16) * 72 + 32 * s2 + 8 * quad);
#pragma unroll
        for (int st = 0; st < NS; ++st) o[st][dt] = mfma16(vf, pf[st][s2], o[st][dt]);
      }
    if (t + 1 < nt) {
      bf16_t* d = lds + ((t + 1) & 1) * (2 * 64 * 72) + lrow * 72 + lch;
      *(u32x4*)d = rk0; *(u32x4*)(d + 8) = rk1; *(u32x4*)(d + 64 * 72) = rv0; *(u32x4*)(d + 64 * 72 + 8) = rv1;
    }
    __syncthreads();
  }
  float l0 = lsum[0]; l0 += __shfl_xor(l0, 16); l0 += __shfl_xor(l0, 32);
  const int tok = tokb + qpos;
  if (!DIFF) {
    l0 += __builtin_amdgcn_exp2f(p.win_sink[l * 4 + h] * 1.4426950408889634f - m[0]);
    const float inv = 1.0f / l0;
#pragma unroll
    for (int dt = 0; dt < 4; ++dt) {
      f32x4 v = o[0][dt] * inv;
      *(f32x4*)(p.OB + (size_t)tok * 256 + h * 64 + dt * 16 + quad * 4) = v;
    }
  } else {
    float l1 = lsum[1]; l1 += __shfl_xor(l1, 16); l1 += __shfl_xor(l1, 32);
    float d1 = 0.f, d2 = 0.f;
    const float* dl = p.diff_lam + l * 128;
    for (int j = 0; j < 32; ++j) { d1 += dl[j] * dl[32 + j]; d2 += dl[64 + j] * dl[96 + j]; }
    const float lam_init = 0.8f - 0.6f * expf(-0.3f * (float)l);
    const float lam = expf(d1) - expf(d2) + lam_init;
    const float i0 = 1.0f / l0, i1 = lam / l1;
    f32x4 v[4]; float ss = 0.f;
#pragma unroll
    for (int dt = 0; dt < 4; ++dt) { v[dt] = o[0][dt] * i0 - o[1][dt] * i1; ss += v[dt][0] * v[dt][0] + v[dt][1] * v[dt][1] + v[dt][2] * v[dt][2] + v[dt][3] * v[dt][3]; }
    ss += __shfl_xor(ss, 16); ss += __shfl_xor(ss, 32);
    const float rstd = rsqrtf(ss * (1.0f / 64.0f) + 1e-6f) * (1.0f - lam_init);
#pragma unroll
    for (int dt = 0; dt < 4; ++dt) {
      const f32x4 g = *(const f32x4*)(p.diff_g + l * 64 + dt * 16 + quad * 4);
      *(f32x4*)(p.OD + (size_t)tok * 256 + h * 64 + dt * 16 + quad * 4) = v[dt] * rstd * g;
    }
  }
}

__device__ __forceinline__ void mix_other(const Params& p, int l, int it, unsigned char* smem) {
  if (it < 256) { attn_item<true>(p, l, true, it >> 6, (it >> 4) & 3, it & 15, smem); return; }
  it -= 256;
  if (it < 40) { lru_scan(p, l, it); return; }
  it -= 40;
  if (it < 256) { attn_item<false>(p, l, true, it >> 6, (it >> 4) & 3, it & 15, smem); return; }
  it -= 256;
  if (it < 256) { attn_item<true>(p, l, false, it >> 4, (it >> 2) & 3, it & 3, smem); return; }
  it -= 256;
  attn_item<false>(p, l, false, it >> 4, (it >> 2) & 3, it & 3, smem);
}

#define ES 4
#define EP 8
__device__ __forceinline__ void mix_item(const Params& p, int l, int it, unsigned char* smem) {
  constexpr int NPS = 16 / ES, NPP = 16 / EP, NS = 32 * NPS, NP = 128 * NPP;
  if (it < NS) {
#pragma unroll 1
    for (int r = 0; r < p.rep2[0]; ++r) rwkv_chain<ES>(p, l, it / NPS, it % NPS, smem);
    return;
  }
  it -= NS;
  if (it < NP) {
#pragma unroll 1
    for (int r = 0; r < p.rep2[1]; ++r) rwkv_chain<EP>(p, l, 32 + it / NPP, it % NPP, smem);
    return;
  }
  it -= NP;
#pragma unroll 1
  for (int r = 0; r < p.rep2[2]; ++r) mix_other(p, l, it, smem);
}
__device__ __forceinline__ void phase_mix(const Params& p, int l, unsigned char* smem) {
  constexpr int NS = 32 * (16 / ES), NP = 128 * (16 / EP), NALL = NS + NP + 1064;
  const int G = gridDim.x, b = blockIdx.x;
  if (G >= 2 * NS) {
    if (b < NS) mix_item(p, l, b, smem);
    else {
#pragma unroll 1
      for (int it = NS + (b - NS); it < NALL; it += G - NS) mix_item(p, l, it, smem);
      if (l == 0 && G >= 320) {
#pragma unroll 1
        for (int it = b - NS; it < 1120; it += G - NS) weight_tile(p, 1, it, (float*)smem);
      }
    }
  } else {
#pragma unroll 1
    for (int it = b; it < NALL; it += G) mix_item(p, l, it, smem);
  }
}

DI float sum16(float v) { v += __shfl_xor(v, 1); v += __shfl_xor(v, 2); v += __shfl_xor(v, 4); v += __shfl_xor(v, 8); return v; }

__device__ __forceinline__ void phase_post(const Params& p, int l) {
  const int tid0 = tid_opaque();
  const int lane = tid0 & 63, wave = tid0 >> 6;
  const int c = lane * 4;
#pragma unroll 1
  for (int tok = blockIdx.x * 4 + wave; tok < NTOK; tok += gridDim.x * 4) {
    const bf16_t* pr = p.P + (size_t)tok * PW;
    const f32x4 ya0 = *(const f32x4*)(p.YA + (size_t)tok * 256 + c), ya1 = *(const f32x4*)(p.YA + ((size_t)NTOK + tok) * 256 + c);
    const u32x2 r_ = *(const u32x2*)(pr + c), k_ = *(const u32x2*)(pr + 256 + c), v_ = *(const u32x2*)(pr + 512 + c), ga_ = *(const u32x2*)(pr + 896 + c);
    const u32x2 gb_ = *(const u32x2*)(pr + 1664 + c), gc_ = *(const u32x2*)(pr + 2176 + c), gd_ = *(const u32x2*)(pr + 3200 + c);
    const f32x4 rk = *(const f32x4*)(p.rw_rk + l * 256 + c), gg = *(const f32x4*)(p.rw_gng + l * 256 + c), gbias = *(const f32x4*)(p.rw_gnb + l * 256 + c);
    const f32x4 ob = *(const f32x4*)(p.OB + (size_t)tok * 256 + c), od = *(const f32x4*)(p.OD + (size_t)tok * 256 + c);
    const f32x4 h0 = *(const f32x4*)(p.LU + (size_t)tok * 256 + c), h1 = *(const f32x4*)(p.LU + ((size_t)NTOK + tok) * 256 + c);
    const f32x4 A0 = *(const f32x4*)(p.LA + (size_t)tok * 256 + c), A1 = *(const f32x4*)(p.LA + ((size_t)NTOK + tok) * 256 + c);
    const f32x4 c0 = *(const f32x4*)(p.LC + (size_t)(tok >> 4) * 256 + c), c1 = *(const f32x4*)(p.LC + ((size_t)512 + (tok >> 4)) * 256 + c);
    __builtin_amdgcn_sched_barrier(0);
    float out[4];
    {
      const f32x4 y = ya0 + ya1;
      const float mu = sum16(y[0] + y[1] + y[2] + y[3]) * (1.0f / 64.0f);
      const f32x4 dv = y - mu;
      const float var = sum16(dv[0] * dv[0] + dv[1] * dv[1] + dv[2] * dv[2] + dv[3] * dv[3]) * (1.0f / 64.0f);
      const float rstd = rsqrtf(var + 64e-5f);
      const float r[4] = {bflo(r_.x), bfhi(r_.x), bflo(r_.y), bfhi(r_.y)}, k[4] = {bflo(k_.x), bfhi(k_.x), bflo(k_.y), bfhi(k_.y)};
      const float v[4] = {bflo(v_.x), bfhi(v_.x), bflo(v_.y), bfhi(v_.y)}, g[4] = {bflo(ga_.x), bfhi(ga_.x), bflo(ga_.y), bfhi(ga_.y)};
      const float bs = sum16(r[0] * k[0] * rk[0] + r[1] * k[1] * rk[1] + r[2] * k[2] * rk[2] + r[3] * k[3] * rk[3]);
#pragma unroll
      for (int q = 0; q < 4; ++q) out[q] = (dv[q] * rstd * gg[q] + gbias[q] + bs * v[q]) * siluf_(g[q]);
      st4bf(p.H + (size_t)tok * LDK + c, out);
    }
    {
      const float g[4] = {bflo(gb_.x), bfhi(gb_.x), bflo(gb_.y), bfhi(gb_.y)};
#pragma unroll
      for (int q = 0; q < 4; ++q) out[q] = ob[q] * siluf_(g[q]);
      st4bf(p.H + (size_t)tok * LDK + 256 + c, out);
    }
    {
      const float g[4] = {bflo(gc_.x), bfhi(gc_.x), bflo(gc_.y), bfhi(gc_.y)};
#pragma unroll
      for (int q = 0; q < 4; ++q) out[q] = (h0[q] + A0[q] * c0[q] + h1[q] + A1[q] * c1[q]) * siluf_(g[q]);
      st4bf(p.H + (size_t)tok * LDK + 512 + c, out);
    }
    {
      const float g[4] = {bflo(gd_.x), bfhi(gd_.x), bflo(gd_.y), bfhi(gd_.y)};
#pragma unroll
      for (int q = 0; q < 4; ++q) out[q] = od[q] * siluf_(g[q]);
      st4bf(p.H + (size_t)tok * LDK + 768 + c, out);
    }
  }
}

__global__ void __launch_bounds__(256, 2) fwd_megakernel(Params p) {
  __shared__ __attribute__((aligned(16))) unsigned char smem[49152];
  __shared__ uint4 xb_words;
  if (threadIdx.x == 0) xb_words = make_uint4(0u, 0u, 0u, 0u);
  __syncthreads();
  XcdBarrier xb = xcd_barrier_post(p.bar, (volatile LAS unsigned*)&xb_words);
  if (threadIdx.x == 0) ((volatile LAS unsigned*)&xb_words)[3] = xb_add(&p.bar[xb_xcc_id()], 1u);
#pragma unroll 1
  for (int r = 0; r < p.rep[0]; ++r) phase_prologue(p, smem);
  xcd_barrier(xb);
  if (threadIdx.x == 0) {
    const unsigned x = xb_xcc_id(); unsigned pre = 0;
    for (unsigned j = 0; j < 16; ++j) { const unsigned c = xb_ld(&p.bar[XB_XCNT(j)]); pre += (j < x) ? c : 0u; }
    ((volatile LAS unsigned*)&xb_words)[2] = pre + ((volatile LAS unsigned*)&xb_words)[3];
  }
  __syncthreads();
#pragma unroll 1
  for (int r = 0; r < p.rep[1]; ++r) phase_norm(p, 0);
  xcd_barrier(xb);
#pragma unroll 1
  for (int l = 0; l < 2; ++l) {
#pragma unroll 1
    for (int r = 0; r < p.rep[2]; ++r) phase_gemm<0>(p, l, smem, (int)((volatile LAS unsigned*)&xb_words)[2]);
    xcd_barrier(xb);
#pragma unroll 1
    for (int r = 0; r < p.rep[3]; ++r) phase_pre(p, l, smem);
    xcd_barrier(xb);
#pragma unroll 1
    for (int r = 0; r < p.rep[4]; ++r) phase_mix(p, l, smem);
    xcd_barrier(xb);
#pragma unroll 1
    for (int r = 0; r < p.rep[5]; ++r) phase_post(p, l);
    xcd_barrier(xb);
#pragma unroll 1
    for (int r = 0; r < p.rep[6]; ++r) phase_gemm<1>(p, l, smem, (int)((volatile LAS unsigned*)&xb_words)[2]);
    xcd_barrier(xb);
    phase_norm(p, l + 1);
    if (l == 0) xcd_barrier(xb);
#pragma unroll 1
    for (int r = 1; r < p.rep[7]; ++r) xcd_barrier(xb);
  }
}

extern "C" void kernel_launch(void* const* d_in, const int* in_sizes, int n_in, void* d_out, int out_size, void* d_ws, size_t ws_size, hipStream_t stream) {
  static int grid_blocks = 0;
  if (!grid_blocks) {
    int dev = 0, cus = 0, per_cu = 0;
    hipGetDevice(&dev);
    hipDeviceGetAttribute(&cus, hipDeviceAttributeMultiprocessorCount, dev);
    hipOccupancyMaxActiveBlocksPerMultiprocessor(&per_cu, (const void*)fwd_megakernel, 256, 0);
    if (per_cu < 1) per_cu = 1;
    if (per_cu > 2) per_cu = 2;
    grid_blocks = cus * per_cu;
  }
  Params p{};
  const float** f = (const float**)&p;
  for (int i = 0; i < 35; ++i) f[i] = (const float*)d_in[i];
  p.out = (float*)d_out;
  size_t off = 0;
  auto take = [&](size_t bytes) { void* r = (char*)d_ws + off; off += (bytes + 255) & ~(size_t)255; return r; };
  p.MOD = (float*)take(2 * 5 * 3072 * 4);
  p.WINT = (bf16_t*)take((size_t)2 * PW * LDK * 2);
  p.WOUTT = (bf16_t*)take((size_t)2 * 1024 * LDK * 2);
  p.CWK = (bf16_t*)take((size_t)4 * 2 * 256 * 128 * 2);
  p.CWVT = (bf16_t*)take((size_t)4 * 2 * 256 * 128 * 2);
  p.CDK = (bf16_t*)take((size_t)4 * 2 * 256 * 256 * 2);
  p.CDVT = (bf16_t*)take((size_t)4 * 2 * 256 * 256 * 2);
  p.H = (bf16_t*)take((size_t)NTOK * LDK * 2);
  p.P = (bf16_t*)take((size_t)NTOK * PW * 2);
  p.NKK = (float*)take((size_t)NTOK * 256 * 4);
  p.AW = (float*)take((size_t)2 * NTOK * 256 * 4);
  p.AB = (float*)take((size_t)2 * NTOK * 256 * 4);
  p.AKD = (float*)take((size_t)2 * NTOK * 256 * 4);
  p.Y2 = p.NKK;
  p.YA = (float*)take((size_t)2 * NTOK * 256 * 4);
  p.LA = (float*)take((size_t)2 * NTOK * 256 * 4);
  p.LU = (float*)take((size_t)2 * NTOK * 256 * 4);
  p.QBR = (bf16_t*)take((size_t)4096 * 256 * 2);
  p.KBR = (bf16_t*)take((size_t)4096 * 128 * 2);
  p.QDR = (bf16_t*)take((size_t)4096 * 256 * 2);
  p.KDR = (bf16_t*)take((size_t)4096 * 256 * 2);
  p.VBT = (bf16_t*)take((size_t)NTOK * 128 * 2);
  p.VDT = (bf16_t*)take((size_t)NTOK * 256 * 2);
  p.OB = (float*)take((size_t)NTOK * 256 * 4);
  p.OD = (float*)take((size_t)NTOK * 256 * 4);
  p.LC = (float*)take((size_t)2 * 512 * 256 * 4);
  p.bar = (unsigned*)take((size_t)XCD_BAR_WORDS * 4);
  p.RWT = (bf16_t*)take((size_t)2 * 4 * 256 * 64 * 2);
  p.LWT = (bf16_t*)take((size_t)2 * 4 * 4 * 64 * 64 * 2);
  if (off > ws_size) { fprintf(stderr, "workspace too small: need %zu have %zu\n", off, ws_size); return; }
  static const int REPS[8] = {1, 1, 1, 1, 1, 1, 1, 1};
  for (int i = 0; i < 8; ++i) p.rep[i] = REPS[i];
  static const int REPS2[8] = {1, 1, 1, 1, 1, 1, 1, 1};
  for (int i = 0; i < 8; ++i) p.rep2[i] = REPS2[i];
  hipMemsetAsync(p.bar, 0, (size_t)XCD_BAR_WORDS * 4, stream);
  void* args[] = {&p};
  hipError_t e = hipLaunchCooperativeKernel((const void*)fwd_megakernel, dim3(grid_blocks), dim3(256), args, 0, stream);
  if (e != hipSuccess) fprintf(stderr, "cooperative launch failed: %s (grid %d)\n", hipGetErrorString(e), grid_blocks);
}
```
